# Optimizing an MI355X kernel written in HIP

```python
import jax, jax.numpy as jnp
from jax import lax
import numpy as np

D_MODEL = 2048
BATCH = 4
SEQ = 2048
DEPTH = 2
DEC_BATCH = 8
DEC_SEQ = 32
PAST_LEN = 4096

CHUNK = 64
Q_BLOCK = 128
MLA_HEADS = 16
QK_NOPE = 128
QK_ROPE = 64
QK_HEAD = QK_NOPE + QK_ROPE
V_HEAD = 128
Q_LORA = 512
KV_LORA = 512
ROPE_THETA = 10000.0
ATTN_SCALE = QK_HEAD ** -0.5
HG_HEADS = 16
HG_DK = 128
HG_DV = D_MODEL // HG_HEADS
HG_WIDTH_K = HG_HEADS * HG_DK
HG_WIDTH_V = HG_HEADS * HG_DV
D_FF = 4 * D_MODEL
EPS = 1e-6
SPLIT_SIZES = (Q_LORA, KV_LORA, QK_ROPE, HG_WIDTH_K, HG_WIDTH_K, HG_WIDTH_V, HG_WIDTH_V, D_MODEL, D_MODEL)
D_IN = Q_LORA + KV_LORA + QK_ROPE + 2 * HG_WIDTH_K + 2 * HG_WIDTH_V + 2 * D_MODEL

kernel_name = "mla_hgrn2_gated_streaming_encoder"


def rmsnorm(x, g):
    xf = x.astype(jnp.float32)
    y = xf * lax.rsqrt(jnp.mean(xf * xf, axis=-1, keepdims=True) + EPS)
    return (y * g.astype(jnp.float32)).astype(x.dtype)


def rope(x, pos):
    half = QK_ROPE // 2
    inv = ROPE_THETA ** (-jnp.arange(half, dtype=jnp.float32) / half)
    ang = pos.astype(jnp.float32)[:, None] * inv[None, :]
    cos = jnp.cos(ang)[None, :, None, :]
    sin = jnp.sin(ang)[None, :, None, :]
    xf = x.astype(jnp.float32)
    x1, x2 = xf[..., :half], xf[..., half:]
    return jnp.concatenate([x1 * cos - x2 * sin, x1 * sin + x2 * cos], axis=-1).astype(x.dtype)


def split_in(z):
    idx = np.cumsum(np.array(SPLIT_SIZES))[:-1].tolist()
    return jnp.split(z, idx, axis=-1)


def mla_core(q_abs, q_pe, ckv, kpe, mask):
    s = (jnp.einsum('bshc,btc->bhst', q_abs, ckv, preferred_element_type=jnp.float32)
         + jnp.einsum('bshr,btr->bhst', q_pe, kpe, preferred_element_type=jnp.float32)) * ATTN_SCALE
    if mask is not None:
        s = jnp.where(mask[None, None], s, -jnp.inf)
    p = jax.nn.softmax(s, axis=-1).astype(ckv.dtype)
    return jnp.einsum('bhst,btc->bshc', p, ckv)


def mla_prompt(q_abs, q_pe, ckv, kpe):
    B, S, H, C = q_abs.shape
    nb = S // Q_BLOCK
    key_chunk = jnp.arange(S, dtype=jnp.int32) // CHUNK

    def block(args):
        j, qa, qp = args
        q_chunk = (j * Q_BLOCK + jnp.arange(Q_BLOCK, dtype=jnp.int32)) // CHUNK
        mask = key_chunk[None, :] <= q_chunk[:, None]
        return mla_core(qa, qp, ckv, kpe, mask)

    qa = q_abs.reshape(B, nb, Q_BLOCK, H, C).transpose(1, 0, 2, 3, 4)
    qp = q_pe.reshape(B, nb, Q_BLOCK, H, QK_ROPE).transpose(1, 0, 2, 3, 4)
    o = lax.map(block, (jnp.arange(nb, dtype=jnp.int32), qa, qp))
    return o.transpose(1, 0, 2, 3, 4).reshape(B, S, H, C)


def hgrn_inputs(hq, hf, hi, lb):
    B, S, _ = hq.shape
    z = hf.astype(jnp.float32)
    logf = jnp.logaddexp(jnp.log(lb), jnp.log1p(-lb) + jax.nn.log_sigmoid(z))
    k = (1.0 - lb) * jax.nn.sigmoid(-z)
    q = jax.nn.silu(hq.astype(jnp.float32))
    v = hi.astype(jnp.float32)

    def heads(t, d):
        return t.reshape(B, S, HG_HEADS, d).transpose(0, 2, 1, 3)
    return heads(q, HG_DK), heads(k, HG_DK), heads(v, HG_DV), heads(logf, HG_DK)


def hgrn_chunk(S0, q, k, v, logf):
    L = q.shape[2]
    b = jnp.cumsum(logf, axis=2)
    causal = jnp.tril(jnp.ones((L, L), dtype=bool))
    diff = b[:, :, :, None, :] - b[:, :, None, :, :]
    decay = jnp.exp(jnp.where(causal[None, None, :, :, None], diff, -jnp.inf))
    attn = jnp.einsum('bhtk,bhsk,bhtsk->bhts', q, k, decay)
    o = (jnp.einsum('bhts,bhsv->bhtv', attn, v)
         + jnp.einsum('bhtk,bhkv->bhtv', q * jnp.exp(b), S0))
    b_last = b[:, :, -1:, :]
    S_new = (jnp.exp(b_last[:, :, 0, :])[..., None] * S0
             + jnp.einsum('bhsk,bhsv->bhkv', k * jnp.exp(b_last - b), v))
    return o, S_new


def hgrn_prompt(q, k, v, logf):
    B, H, S, _ = q.shape
    nc = S // CHUNK

    def to_chunks(t):
        return t.reshape(B, H, nc, CHUNK, t.shape[-1]).transpose(2, 0, 1, 3, 4)

    def step(S_c, xs):
        o, S_n = hgrn_chunk(S_c, *xs)
        return S_n, o

    S0 = jnp.zeros((B, H, HG_DK, HG_DV), jnp.float32)
    S_fin, o = lax.scan(step, S0, (to_chunks(q), to_chunks(k), to_chunks(v), to_chunks(logf)))
    return o.transpose(1, 2, 0, 3, 4).reshape(B, H, S, HG_DV), S_fin


def layer_forward(x, pos, p, lb, cache_ckv, cache_kpe, state):
    B, S, _ = x.shape
    h = rmsnorm(x, p['pre_mix_g'])
    q_lat, kv_lat, k_pe, hq, hf, hi, hg, ga, gb = split_in(h @ p['w_in'])
    q = (rmsnorm(q_lat, p['q_norm_g']) @ p['w_uq']).reshape(B, S, MLA_HEADS, QK_HEAD)
    q_pe = rope(q[..., QK_NOPE:], pos)
    q_abs = jnp.einsum('bshn,chn->bshc', q[..., :QK_NOPE], p['w_uk'])
    c_kv = rmsnorm(kv_lat, p['kv_norm_g'])
    k_rot = rope(k_pe[:, :, None, :], pos)[:, :, 0, :]
    if cache_ckv is None:
        o_lat = mla_prompt(q_abs, q_pe, c_kv, k_rot)
    else:
        o_lat = mla_core(q_abs, q_pe, jnp.concatenate([cache_ckv, c_kv], axis=1),
                         jnp.concatenate([cache_kpe, k_rot], axis=1), None)
    o_a = jnp.einsum('bshc,chv->bshv', o_lat, p['w_uv']).reshape(B, S, MLA_HEADS * V_HEAD)
    branch_a = o_a @ p['w_oa']
    qh, kh, vh, lfh = hgrn_inputs(hq, hf, hi, lb)
    if state is None:
        o_h, S_fin = hgrn_prompt(qh, kh, vh, lfh)
    else:
        o_h, S_fin = hgrn_chunk(state.astype(jnp.float32), qh, kh, vh, lfh)
    o_h = rmsnorm(o_h.transpose(0, 2, 1, 3).astype(x.dtype), p['hg_norm_g'])
    o_h = o_h * jax.nn.silu(hg.reshape(B, S, HG_HEADS, HG_DV))
    branch_b = o_h.reshape(B, S, HG_WIDTH_V) @ p['w_ob']
    mix = (jax.nn.sigmoid(ga) * branch_a + jax.nn.sigmoid(gb) * branch_b) @ p['w_out']
    x = x + rmsnorm(mix, p['post_mix_g'])
    h2 = rmsnorm(x, p['pre_mlp_g'])
    m = jnp.square(jax.nn.relu(h2 @ p['w_up'])) @ p['w_down']
    x = x + rmsnorm(m, p['post_mlp_g'])
    return x, c_kv, k_rot, S_fin.astype(x.dtype)


def setup_inputs(seed: int = 0) -> dict:
    key = jax.random.key(seed)
    ks = jax.random.split(key, 24)
    f32 = jnp.float32

    def nrm(k, shape, scale):
        return jax.random.normal(k, shape, f32) * scale

    def gain(k, n):
        return 1.0 + 0.01 * jax.random.normal(k, (DEPTH, n), f32)

    return {
        "x_prompt": nrm(ks[0], (BATCH, SEQ, D_MODEL), 1.0),
        "x_sample": nrm(ks[1], (DEC_BATCH, DEC_SEQ, D_MODEL), 1.0),
        "cache_ckv": nrm(ks[2], (DEPTH, DEC_BATCH, PAST_LEN, KV_LORA), 1.0),
        "cache_kpe": nrm(ks[3], (DEPTH, DEC_BATCH, PAST_LEN, QK_ROPE), 1.0),
        "state_hgrn": nrm(ks[4], (DEPTH, DEC_BATCH, HG_HEADS, HG_DK, HG_DV), 0.5),
        "pre_mix_g": gain(ks[5], D_MODEL),
        "w_in": nrm(ks[6], (DEPTH, D_MODEL, D_IN), D_MODEL ** -0.5),
        "q_norm_g": gain(ks[7], Q_LORA),
        "w_uq": nrm(ks[8], (DEPTH, Q_LORA, MLA_HEADS * QK_HEAD), Q_LORA ** -0.5),
        "kv_norm_g": gain(ks[9], KV_LORA),
        "w_uk": nrm(ks[10], (DEPTH, KV_LORA, MLA_HEADS, QK_NOPE), KV_LORA ** -0.5),
        "w_uv": nrm(ks[11], (DEPTH, KV_LORA, MLA_HEADS, V_HEAD), KV_LORA ** -0.5),
        "w_oa": nrm(ks[12], (DEPTH, MLA_HEADS * V_HEAD, D_MODEL), (MLA_HEADS * V_HEAD) ** -0.5),
        "hg_lb": nrm(ks[13], (DEPTH, HG_WIDTH_K), 1.0),
        "hg_norm_g": gain(ks[14], HG_DV),
        "w_ob": nrm(ks[15], (DEPTH, HG_WIDTH_V, D_MODEL), HG_WIDTH_V ** -0.5),
        "w_out": nrm(ks[16], (DEPTH, D_MODEL, D_MODEL), D_MODEL ** -0.5),
        "post_mix_g": gain(ks[17], D_MODEL),
        "pre_mlp_g": gain(ks[18], D_MODEL),
        "w_up": nrm(ks[19], (DEPTH, D_MODEL, D_FF), D_MODEL ** -0.5),
        "w_down": nrm(ks[20], (DEPTH, D_FF, D_MODEL), D_FF ** -0.5),
        "post_mlp_g": gain(ks[21], D_MODEL),
    }


def reference(x_prompt, x_sample, cache_ckv, cache_kpe, state_hgrn,
              pre_mix_g, w_in, q_norm_g, w_uq, kv_norm_g, w_uk, w_uv, w_oa,
              hg_lb, hg_norm_g, w_ob, w_out, post_mix_g, pre_mlp_g, w_up, w_down, post_mlp_g):
    cs = jnp.cumsum(jax.nn.softmax(hg_lb.astype(jnp.float32), axis=0), axis=0)
    lbs = cs - cs[0:1]
    past = cache_ckv.shape[2]
    pos_p = jnp.arange(x_prompt.shape[1], dtype=jnp.int32)
    pos_s = past + jnp.arange(x_sample.shape[1], dtype=jnp.int32)
    yp, ys = x_prompt, x_sample
    ckv_p, kpe_p, st_p, ckv_s, kpe_s, st_s = [], [], [], [], [], []
    for l in range(DEPTH):
        p = dict(pre_mix_g=pre_mix_g[l], w_in=w_in[l], q_norm_g=q_norm_g[l], w_uq=w_uq[l],
                 kv_norm_g=kv_norm_g[l], w_uk=w_uk[l], w_uv=w_uv[l], w_oa=w_oa[l],
                 hg_norm_g=hg_norm_g[l], w_ob=w_ob[l], w_out=w_out[l], post_mix_g=post_mix_g[l],
                 pre_mlp_g=pre_mlp_g[l], w_up=w_up[l], w_down=w_down[l], post_mlp_g=post_mlp_g[l])
        yp, c1, k1, s1 = layer_forward(yp, pos_p, p, lbs[l], None, None, None)
        ys, c2, k2, s2 = layer_forward(ys, pos_s, p, lbs[l], cache_ckv[l], cache_kpe[l], state_hgrn[l])
        ckv_p.append(c1); kpe_p.append(k1); st_p.append(s1)
        ckv_s.append(c2); kpe_s.append(k2); st_s.append(s2)
    return (yp, ys,
            jnp.stack(ckv_p), jnp.stack(kpe_p), jnp.stack(st_p),
            jnp.stack(ckv_s), jnp.stack(kpe_s), jnp.stack(st_s))
```

```cpp
#include <hip/hip_runtime.h>
#include <hip/hip_cooperative_groups.h>
#include <cstdio>
#include <cstdint>
namespace cg = cooperative_groups;

#define DI __device__ __forceinline__
#define LAS __attribute__((address_space(3)))
typedef short bf16x8 __attribute__((ext_vector_type(8)));
typedef short s16x4 __attribute__((ext_vector_type(4)));
typedef float f32x4 __attribute__((ext_vector_type(4)));
typedef float f32x16 __attribute__((ext_vector_type(16)));
typedef unsigned u32x4 __attribute__((ext_vector_type(4)));
typedef unsigned u32x2 __attribute__((ext_vector_type(2)));
typedef float f32x2_t __attribute__((ext_vector_type(2)));
typedef __bf16 bf16x2_t __attribute__((ext_vector_type(2)));

constexpr int MP = 8192, MS = 256, MTOK = 8448, DM = 2048, DINP = 13568, ZSW = 1280, FFN = 8192;
constexpr int KVB = 4160;
constexpr int KVR = 8192 + 8 * KVB;
constexpr int NU = 2048 + 128;
constexpr float EPS = 1e-6f;
constexpr float QSCALE = 0.07216878364870322f * 1.4426950408889634f;

constexpr size_t MiB = 1u << 20;
constexpr size_t WS_WIN = 0, WS_WUQ = 53 * MiB, WS_WUK = 56 * MiB, WS_WUV = 58 * MiB, WS_WOA = 60 * MiB, WS_WOB = 68 * MiB, WS_WOUT = 76 * MiB, WS_WUP = 84 * MiB, WS_WDN = 116 * MiB;
constexpr size_t WS_XN = 148 * MiB, WS_HG = 181 * MiB, WS_GA = 214 * MiB, WS_GB = 247 * MiB, WS_QN = 280 * MiB, WS_Q = 289 * MiB, WS_OA = 339 * MiB, WS_OH = 372 * MiB;
constexpr size_t WS_CKV = 405 * MiB, WS_KPE = 446 * MiB, WS_TBL = 452 * MiB, WS_LB = 453 * MiB, WS_D = 454 * MiB, WS_R = 456 * MiB;
constexpr size_t WS_SPT = WS_Q;
constexpr size_t WS_ZS = WS_R, WS_HQ = WS_R + 42 * MiB, WS_HK = WS_R + 75 * MiB, WS_HV = WS_R + 108 * MiB, WS_LF = WS_R + 141 * MiB, WS_UT = WS_R + 207 * MiB;
constexpr size_t WS_KN = WS_R, WS_VT = WS_R + 162 * MiB;
constexpr size_t WS_T = WS_R, WS_MIX = WS_R + 33 * MiB, WS_H = WS_R + 99 * MiB, WS_M2 = WS_R + 231 * MiB;
constexpr size_t WS_END = WS_R + 343 * MiB;
static_assert((size_t)NU * 128 * 128 * 2 <= 83 * MiB && (size_t)NU * 65536 <= 136 * MiB && (size_t)KVR * 2048 * 2 <= 162 * MiB, "ws map");

constexpr size_t OUT_X = 0, OUT_CKVP = 17301504, OUT_KPEP = OUT_CKVP + 8388608, OUT_STP = OUT_KPEP + 1048576, OUT_CKVS = OUT_STP + 2097152, OUT_KPES = OUT_CKVS + 262144, OUT_STS = OUT_KPES + 32768;
constexpr size_t OUT_TOTAL = OUT_STS + 4194304;

DI unsigned pk2(float lo, float hi) { f32x2_t v = {lo, hi}; bf16x2_t b = __builtin_convertvector(v, bf16x2_t); return __builtin_bit_cast(unsigned, b); }
DI unsigned short f2bf(float f) { return (unsigned short)(pk2(f, 0.f) & 0xffffu); }
DI float bf2f(unsigned short u) { return __uint_as_float((unsigned)u << 16); }
DI float bflo(unsigned w) { return __uint_as_float(w << 16); }
DI float bfhi(unsigned w) { return __uint_as_float(w & 0xffff0000u); }
DI float sigm(float x) { return 1.f / (1.f + __expf(-x)); }
DI float ex2(float x) { return __builtin_amdgcn_exp2f(x); }
DI float wave_sum(float v) {
#pragma unroll
    for (int o = 1; o < 64; o <<= 1) v += __shfl_xor(v, o);
    return v;
}
namespace pg8 {
#define PG8_LAS __attribute__((address_space(3)))
typedef unsigned short bf16_t;
typedef short bf16x8 __attribute__((ext_vector_type(8)));
typedef float f32x4 __attribute__((ext_vector_type(4)));
typedef unsigned u32x4 __attribute__((ext_vector_type(4)));
constexpr int BM = 256, BK = 64, HALF = 128, HTB = HALF * BK * 2  , STAGE_BYTES = 8 * HTB, NXCD = 8, WGM = 8;

__host__ __device__ __forceinline__ int lds_byte(int r, int c) { const int st = (r >> 4) * 2 + (c >> 5), rr = r & 15, cc = c & 31, ob = rr * 64 + cc * 2; return st * 1024 + (ob ^ (((ob >> 9) & 1) << 5)); }
__host__ __device__ __forceinline__ void stage_rc(int b, int& R, int& C) { const int st = b / 1024, sb = b % 1024, swz = sb ^ (((sb >> 9) & 1) << 5); R = (st >> 1) * 16 + swz / 64; C = (st & 1) * 32 + (swz % 64) / 2; }
__host__ __device__ __forceinline__ int perm32(int rho) { const int n = rho >> 4, i = rho & 15; return 8 * (i >> 2) + 4 * n + (i & 3); }

struct Unit { int pm, pn; };
struct Gemm { const bf16_t* A; const bf16_t* Bt; int M, N, K; };

struct StaticOrder {
    int nM, nN, nwg, G, c;
    __host__ __device__ void init(int M, int N, int G_, int c_) { nM = M / BM; nN = N / BM; nwg = nM * nN; G = G_; c = c_; }
    __host__ __device__ bool next(int i, Unit& u) const {
        const long L = (long)i * G + c; if (L >= nwg) return false;
        int wgid = (int)L; { const int q = nwg / NXCD, r = nwg % NXCD, xcd = wgid % NXCD, off = wgid / NXCD; wgid = (xcd < r ? xcd * (q + 1) : r * (q + 1) + (xcd - r) * q) + off; }
        const int nig = WGM * nN, gid = wgid / nig, fm = gid * WGM, gsz = (nM - fm) < WGM ? (nM - fm) : WGM;
        u.pm = fm + ((wgid % nig) % gsz); u.pn = (wgid % nig) / gsz; return true;
    }
    __device__ __forceinline__ void a_ready(const Unit&) const {}
    __device__ __forceinline__ void done(const Unit&) const {}
};

#define EPI_LOOP _Pragma("unroll") for (int ai = 0; ai < 2; ++ai) _Pragma("unroll") for (int m = 0; m < 4; ++m) _Pragma("unroll") for (int bj = 0; bj < 2; ++bj)
__device__ __forceinline__ u32x4 pack8f(const f32x4 a, const f32x4 b) { u32x4 w; w.x = pk2(a[0], a[1]); w.y = pk2(a[2], a[3]); w.z = pk2(b[0], b[1]); w.w = pk2(b[2], b[3]); return w; }

struct EpiWin {
    static constexpr bool PERM = true, AFTER_DRAIN = false;
    float* Zs; bf16_t *HQ, *HK, *HV, *HG, *GA, *GB; float* LF; const float* lb;
    __device__ __forceinline__ void operator()(const f32x4 (&acc)[2][2][4][2], const Unit& u, int wr, int wc, int fr, int fq) const {
        const int row0 = u.pm * 256 + wr * 64 + fr, ct = wc * 32 + 8 * fq, pn = u.pn;
        if (pn < 5) {
            EPI_LOOP { float* p = Zs + (size_t)(row0 + ai * 128 + m * 16) * ZSW + pn * 256 + ct + bj * 128; *(f32x4*)p = acc[ai][bj][m][0]; *(f32x4*)(p + 4) = acc[ai][bj][m][1]; }
            return;
        }
        const int seg = (pn - 5) >> 3, cseg = ((pn - 5) & 7) * 256 + ct;
        if (seg == 1) {
#pragma unroll
            for (int bj = 0; bj < 2; ++bj) {
                const f32x4 l0 = *(const f32x4*)(lb + cseg + bj * 128), l1 = *(const f32x4*)(lb + cseg + bj * 128 + 4);
#pragma unroll
                for (int ai = 0; ai < 2; ++ai)
#pragma unroll
                    for (int m = 0; m < 4; ++m) {
                        const size_t off = (size_t)(row0 + ai * 128 + m * 16) * 2048 + cseg + bj * 128;
                        f32x4 lf0, lf1, k0, k1;
#pragma unroll
                        for (int e = 0; e < 4; ++e) {
                            { const float z = acc[ai][bj][m][0][e], lbv = l0[e], ez = __expf(-z), sg = 1.f / (1.f + ez); lf0[e] = __logf(lbv + (1.f - lbv) * sg); k0[e] = (1.f - lbv) * ez * sg; }
                            { const float z = acc[ai][bj][m][1][e], lbv = l1[e], ez = __expf(-z), sg = 1.f / (1.f + ez); lf1[e] = __logf(lbv + (1.f - lbv) * sg); k1[e] = (1.f - lbv) * ez * sg; }
                        }
                        *(f32x4*)(LF + off) = lf0; *(f32x4*)(LF + off + 4) = lf1; *(u32x4*)(HK + off) = pack8f(k0, k1);
                    }
            }
            return;
        }
        bf16_t* O = seg == 0 ? HQ : seg == 2 ? HV : seg == 3 ? HG : seg == 4 ? GA : GB;
        const int act = (seg == 0 || seg == 3) ? 1 : (seg == 2 ? 0 : 2);
        EPI_LOOP {
            f32x4 a = acc[ai][bj][m][0], b = acc[ai][bj][m][1];
#pragma unroll
            for (int e = 0; e < 4; ++e) { const float sa = sigm(a[e]), sb = sigm(b[e]); a[e] = act == 0 ? a[e] : act == 1 ? a[e] * sa : sa; b[e] = act == 0 ? b[e] : act == 1 ? b[e] * sb : sb; }
            *(u32x4*)(O + (size_t)(row0 + ai * 128 + m * 16) * 2048 + cseg + bj * 128) = pack8f(a, b);
        }
    }
};

struct EpiQ {
    static constexpr bool PERM = true, AFTER_DRAIN = false;
    bf16_t* Q; const float* tbl;
    __device__ __forceinline__ void operator()(const f32x4 (&acc)[2][2][4][2], const Unit& u, int wr, int wc, int fr, int fq) const {
        const int row0 = u.pm * 256 + wr * 64 + fr, ct = wc * 32 + 8 * fq, pn = u.pn;
        if (pn < 8) {
            EPI_LOOP { const int col = pn * 256 + ct + bj * 128, h = col >> 7, i = col & 127;
                *(u32x4*)(Q + (size_t)(row0 + ai * 128 + m * 16) * 3072 + h * 192 + i) = pack8f(acc[ai][bj][m][0] * QSCALE, acc[ai][bj][m][1] * QSCALE); }
            return;
        }
        EPI_LOOP {
            const int row = row0 + ai * 128 + m * 16, p = row < MP ? (row & 2047) : 2048 + ((row - MP) & 31);
            const int c = (pn - 8) * 256 + ct + bj * 128, h = c >> 6, j0 = (c & 63) >> 1;
            const f32x4 t0 = *(const f32x4*)(tbl + (size_t)(p * 32 + j0) * 2), t1 = *(const f32x4*)(tbl + (size_t)(p * 32 + j0) * 2 + 4);
            const f32x4 x = acc[ai][bj][m][0] * QSCALE, y = acc[ai][bj][m][1] * QSCALE;
            const float a0 = x[0] * t0[0] - x[1] * t0[1], b0 = x[0] * t0[1] + x[1] * t0[0];
            const float a1 = x[2] * t0[2] - x[3] * t0[3], b1 = x[2] * t0[3] + x[3] * t0[2];
            const float a2 = y[0] * t1[0] - y[1] * t1[1], b2 = y[0] * t1[1] + y[1] * t1[0];
            const float a3 = y[2] * t1[2] - y[3] * t1[3], b3 = y[2] * t1[3] + y[3] * t1[2];
            bf16_t* q = Q + (size_t)row * 3072 + h * 192 + 128 + j0;
            u32x2 w1, w2; w1.x = pk2(a0, a1); w1.y = pk2(a2, a3); w2.x = pk2(b0, b1); w2.y = pk2(b2, b3);
            *(u32x2*)q = w1; *(u32x2*)(q + 32) = w2;
            if (bj == 1) asm volatile("" ::: "memory");
        }
    }
};

struct EpiPlain {
    static constexpr bool PERM = true, AFTER_DRAIN = false;
    bf16_t* O; int ldc;
    __device__ __forceinline__ void operator()(const f32x4 (&acc)[2][2][4][2], const Unit& u, int wr, int wc, int fr, int fq) const {
        const int row0 = u.pm * 256 + wr * 64 + fr, c0 = u.pn * 256 + wc * 32 + 8 * fq;
        EPI_LOOP { *(u32x4*)(O + (size_t)(row0 + ai * 128 + m * 16) * ldc + c0 + bj * 128) = pack8f(acc[ai][bj][m][0], acc[ai][bj][m][1]); }
    }
};
struct EpiF32 {
    static constexpr bool PERM = true, AFTER_DRAIN = false;
    float* O; int ldc;
    __device__ __forceinline__ void operator()(const f32x4 (&acc)[2][2][4][2], const Unit& u, int wr, int wc, int fr, int fq) const {
        const int row0 = u.pm * 256 + wr * 64 + fr, c0 = u.pn * 256 + wc * 32 + 8 * fq;
        EPI_LOOP { float* p = O + (size_t)(row0 + ai * 128 + m * 16) * ldc + c0 + bj * 128; *(f32x4*)p = acc[ai][bj][m][0]; *(f32x4*)(p + 4) = acc[ai][bj][m][1]; }
    }
};
struct EpiRelu2 {
    static constexpr bool PERM = true, AFTER_DRAIN = false;
    bf16_t* O; int ldc;
    __device__ __forceinline__ void operator()(const f32x4 (&acc)[2][2][4][2], const Unit& u, int wr, int wc, int fr, int fq) const {
        const int row0 = u.pm * 256 + wr * 64 + fr, c0 = u.pn * 256 + wc * 32 + 8 * fq;
        EPI_LOOP { f32x4 a = acc[ai][bj][m][0], b = acc[ai][bj][m][1];
#pragma unroll
            for (int e = 0; e < 4; ++e) { const float ra = fmaxf(a[e], 0.f), rb = fmaxf(b[e], 0.f); a[e] = ra * ra; b[e] = rb * rb; }
            *(u32x4*)(O + (size_t)(row0 + ai * 128 + m * 16) * ldc + c0 + bj * 128) = pack8f(a, b); }
    }
};
template <bool SECOND> struct EpiGate {
    static constexpr bool PERM = true, AFTER_DRAIN = false;
    const bf16_t* Gt; bf16_t* T;
    __device__ __forceinline__ void operator()(const f32x4 (&acc)[2][2][4][2], const Unit& u, int wr, int wc, int fr, int fq) const {
        const int row0 = u.pm * 256 + wr * 64 + fr, c0 = u.pn * 256 + wc * 32 + 8 * fq;
        EPI_LOOP { const size_t off = (size_t)(row0 + ai * 128 + m * 16) * 2048 + c0 + bj * 128;
            const u32x4 g = *(const u32x4*)(Gt + off); f32x4 a = acc[ai][bj][m][0], b = acc[ai][bj][m][1];
            a[0] *= bflo(g.x); a[1] *= bfhi(g.x); a[2] *= bflo(g.y); a[3] *= bfhi(g.y); b[0] *= bflo(g.z); b[1] *= bfhi(g.z); b[2] *= bflo(g.w); b[3] *= bfhi(g.w);
            if (SECOND) { const u32x4 t = *(const u32x4*)(T + off);
                a[0] += bflo(t.x); a[1] += bfhi(t.x); a[2] += bflo(t.y); a[3] += bfhi(t.y); b[0] += bflo(t.z); b[1] += bfhi(t.z); b[2] += bflo(t.w); b[3] += bfhi(t.w); }
            *(u32x4*)(T + off) = pack8f(a, b);
            if (bj == 1 && (m & 1)) asm volatile("" ::: "memory"); }
    }
};
template <class Epi, class Sched, bool ALIGN_EPI = false, bool SP2 = false>
__device__ __forceinline__ void gemm_phase(PG8_LAS unsigned char* lds, const Gemm g, const Sched& S, const Epi& E) {
    int tid_l = threadIdx.x; asm volatile("" : "+v"(tid_l));
    const int tid = tid_l, wid = __builtin_amdgcn_readfirstlane(tid >> 6), lane = tid & 63, wr = wid >> 2, wc = wid & 3, fr = lane & 15, fq = lane >> 4;
    const int K = g.K, nt = K / BK;
    unsigned voffA[2], voffB[2];
#pragma unroll
    for (int i = 0; i < 2; ++i) { int R, C; stage_rc(tid * 16 + i * 8192, R, C); const int Rb = Epi::PERM ? ((R & ~31) + perm32(R & 31)) : R;
        voffA[i] = (unsigned)(R * K + C) * 2u; voffB[i] = (unsigned)(Rb * K + C) * 2u; }
    const size_t kstep = (size_t)(BK * 2);
    const size_t hstep = (size_t)HALF * K * 2;
    const size_t tstep = 2 * hstep;
    const unsigned ldsw = (unsigned)wid * 1024u;
    const int aoff = lds_byte(wr * 64 + fr, fq * 8), boff = lds_byte(wc * 32 + fr, fq * 8);
#define PG8_SA(b, h) (((b) * 2 + (h)) * HTB)
#define PG8_SB(b, h) ((4 + (b) * 2 + (h)) * HTB)
#define PG8_STAGE(bufoff, gbase, voff) do { _Pragma("unroll") for (int _i = 0; _i < 2; ++_i) \
        __builtin_amdgcn_global_load_lds((const unsigned*)((const char*)(gbase) + (voff)[_i]), (PG8_LAS unsigned*)(lds + (bufoff) + ldsw + _i * 8192), 16, 0, 0); } while (0)
#define PG8_LDA(dst, b, h) do { _Pragma("unroll") for (int m = 0; m < 4; ++m) _Pragma("unroll") for (int k = 0; k < 2; ++k) dst[m][k] = *(const PG8_LAS bf16x8*)(lds + PG8_SA(b, h) + aoff + m * 2048 + k * 1024); } while (0)
#define PG8_LDB(dst, b, h) do { _Pragma("unroll") for (int n = 0; n < 2; ++n) _Pragma("unroll") for (int k = 0; k < 2; ++k) dst[n][k] = *(const PG8_LAS bf16x8*)(lds + PG8_SB(b, h) + boff + n * 2048 + k * 1024); } while (0)
#define PG8_MMA(ai, bj, At, Bt) do { __builtin_amdgcn_s_setprio(1); _Pragma("unroll") for (int m = 0; m < 4; ++m) _Pragma("unroll") for (int n = 0; n < 2; ++n) _Pragma("unroll") for (int k = 0; k < 2; ++k) \
        acc[ai][bj][m][n] = __builtin_amdgcn_mfma_f32_16x16x32_bf16(Bt[n][k], At[m][k], acc[ai][bj][m][n], 0, 0, 0); __builtin_amdgcn_s_setprio(0); } while (0)
#define PG8_WAIT_V(n) asm volatile("s_waitcnt vmcnt(" #n ")" ::: "memory")
#define PG8_WAIT_L(n) asm volatile("s_waitcnt lgkmcnt(" #n ")" ::: "memory")
#define PG8_BAR __builtin_amdgcn_s_barrier()
#define PG8_SCHED __builtin_amdgcn_sched_barrier(0)
    Unit cur, nxt; int ui = 0;
    if (!S.next(0, cur)) return;
    f32x4 acc[2][2][4][2];
#pragma unroll
    for (int a = 0; a < 2; ++a)
#pragma unroll
        for (int b = 0; b < 2; ++b)
#pragma unroll
            for (int m = 0; m < 4; ++m)
#pragma unroll
                for (int n = 0; n < 2; ++n) acc[a][b][m][n] = (f32x4){0.f, 0.f, 0.f, 0.f};
    bf16x8 At[4][2], B0[2][2], B1[2][2];
    const char* cA = (const char*)g.A + (size_t)cur.pm * tstep; const char* cB = (const char*)g.Bt + (size_t)cur.pn * tstep;
    S.a_ready(cur);
    if constexpr (SP2) {
        PG8_STAGE(PG8_SB(0, 0), cB, voffB); PG8_STAGE(PG8_SB(0, 1), cB + hstep, voffB); PG8_STAGE(PG8_SA(0, 0), cA, voffA); PG8_STAGE(PG8_SA(0, 1), cA + hstep, voffA);
        if (wr == 1) PG8_BAR;
        PG8_WAIT_V(2); PG8_BAR;
        PG8_STAGE(PG8_SB(1, 0), cB + kstep, voffB); PG8_STAGE(PG8_SA(1, 0), cA + kstep, voffA); PG8_STAGE(PG8_SB(1, 1), cB + hstep + kstep, voffB);
        PG8_WAIT_V(6); PG8_BAR;
    } else {
        PG8_STAGE(PG8_SB(0, 0), cB, voffB); PG8_STAGE(PG8_SA(0, 0), cA, voffA); PG8_STAGE(PG8_SB(0, 1), cB + hstep, voffB); PG8_STAGE(PG8_SA(0, 1), cA + hstep, voffA);
        if (wr == 1) PG8_BAR;
        PG8_WAIT_V(4); PG8_BAR;
        PG8_STAGE(PG8_SB(1, 0), cB + kstep, voffB); PG8_STAGE(PG8_SA(1, 0), cA + kstep, voffA); PG8_STAGE(PG8_SB(1, 1), cB + hstep + kstep, voffB);
        PG8_WAIT_V(6); PG8_BAR;
    }
    for (;;) {
        const bool has_next = S.next(ui + 1, nxt);
        const char* nA = has_next ? (const char*)g.A + (size_t)nxt.pm * tstep : cA; const char* nB = has_next ? (const char*)g.Bt + (size_t)nxt.pn * tstep : cB;
        for (int t = 0; t < nt; t += 2) {
            const bool last = (t == nt - 2);
            const char* a1 = cA + (size_t)(t + 1) * kstep;
            const char* a2 = last ? nA : cA + (size_t)(t + 2) * kstep; const char* b2 = last ? nB : cB + (size_t)(t + 2) * kstep;
            const char* a3 = a2 + kstep; const char* b3 = b2 + kstep;
            if (last && has_next) S.a_ready(nxt);
            if constexpr (SP2) {
            PG8_LDB(B0, 0, 0); PG8_LDB(B1, 0, 1); PG8_SCHED; PG8_LDA(At, 0, 0); PG8_STAGE(PG8_SA(1, 1), a1 + hstep, voffA);
            PG8_WAIT_V(8); PG8_WAIT_L(0); PG8_BAR; PG8_MMA(0, 0, At, B0); PG8_MMA(0, 1, At, B1); PG8_BAR; PG8_SCHED;
            PG8_LDA(At, 0, 1); PG8_STAGE(PG8_SB(0, 0), b2, voffB); PG8_STAGE(PG8_SB(0, 1), b2 + hstep, voffB); PG8_STAGE(PG8_SA(0, 0), a2, voffA);
            PG8_WAIT_V(8); PG8_WAIT_L(0); PG8_BAR; PG8_MMA(1, 0, At, B0); PG8_MMA(1, 1, At, B1); PG8_BAR; PG8_SCHED;
            PG8_LDB(B0, 1, 0); PG8_LDB(B1, 1, 1); PG8_SCHED; PG8_LDA(At, 1, 0); PG8_STAGE(PG8_SA(0, 1), a2 + hstep, voffA);
            PG8_WAIT_V(8); PG8_WAIT_L(0); PG8_BAR; PG8_MMA(0, 0, At, B0); PG8_MMA(0, 1, At, B1); PG8_BAR; PG8_SCHED;
            PG8_LDA(At, 1, 1); PG8_STAGE(PG8_SB(1, 0), b3, voffB); PG8_STAGE(PG8_SB(1, 1), b3 + hstep, voffB); PG8_STAGE(PG8_SA(1, 0), a3, voffA);
            PG8_WAIT_V(8); PG8_WAIT_L(0); PG8_BAR; PG8_MMA(1, 0, At, B0); PG8_MMA(1, 1, At, B1); PG8_BAR; PG8_SCHED;
            } else {
            PG8_LDB(B0, 0, 0); PG8_SCHED; PG8_LDA(At, 0, 0); PG8_STAGE(PG8_SA(1, 1), a1 + hstep, voffA);
            PG8_WAIT_L(8); PG8_BAR; PG8_WAIT_L(0); PG8_MMA(0, 0, At, B0); PG8_BAR; PG8_SCHED;
            PG8_LDB(B1, 0, 1); PG8_STAGE(PG8_SB(0, 0), b2, voffB);
            PG8_BAR; PG8_WAIT_L(0); PG8_MMA(0, 1, At, B1); PG8_BAR;
            PG8_LDA(At, 0, 1); PG8_STAGE(PG8_SA(0, 0), a2, voffA);
            PG8_BAR; PG8_WAIT_L(0); PG8_MMA(1, 0, At, B0); PG8_BAR; PG8_SCHED;
            PG8_STAGE(PG8_SB(0, 1), b2 + hstep, voffB);
            PG8_WAIT_V(6); PG8_BAR; PG8_MMA(1, 1, At, B1); PG8_BAR;
            PG8_LDB(B0, 1, 0); PG8_SCHED; PG8_LDA(At, 1, 0); PG8_STAGE(PG8_SA(0, 1), a2 + hstep, voffA);
            PG8_WAIT_L(8); PG8_BAR; PG8_WAIT_L(0); PG8_MMA(0, 0, At, B0); PG8_BAR; PG8_SCHED;
            PG8_LDB(B1, 1, 1); PG8_STAGE(PG8_SB(1, 0), b3, voffB);
            PG8_BAR; PG8_WAIT_L(0); PG8_MMA(0, 1, At, B1); PG8_BAR;
            PG8_LDA(At, 1, 1); PG8_STAGE(PG8_SA(1, 0), a3, voffA);
            PG8_BAR; PG8_WAIT_L(0); PG8_MMA(1, 0, At, B0); PG8_BAR; PG8_SCHED;
            PG8_STAGE(PG8_SB(1, 1), b3 + hstep, voffB);
            PG8_WAIT_V(6); PG8_BAR; PG8_MMA(1, 1, At, B1); PG8_BAR;
            }
        }
        if constexpr (ALIGN_EPI) { if (wr == 0) PG8_BAR; }
        if constexpr (!Epi::AFTER_DRAIN) { E(acc, cur, wr, wc, fr, fq); S.done(cur); }
        if (!has_next) break;
#pragma unroll
        for (int a = 0; a < 2; ++a)
#pragma unroll
            for (int b = 0; b < 2; ++b)
#pragma unroll
                for (int m = 0; m < 4; ++m)
#pragma unroll
                    for (int n = 0; n < 2; ++n) acc[a][b][m][n] = (f32x4){0.f, 0.f, 0.f, 0.f};
        cur = nxt; cA = nA; cB = nB; ++ui;
        if constexpr (ALIGN_EPI) { if (wr == 1) PG8_BAR; }
    }
    PG8_WAIT_V(0);
    if constexpr (!ALIGN_EPI) { if (wr == 0) PG8_BAR; }
    PG8_BAR;
    if constexpr (Epi::AFTER_DRAIN) { E.fused(acc, cur, wr, wc, fr, fq, lds, wid, lane); S.done(cur); }
#undef PG8_SA
#undef PG8_SB
#undef PG8_STAGE
#undef PG8_LDA
#undef PG8_LDB
#undef PG8_MMA
#undef PG8_WAIT_V
#undef PG8_WAIT_L
#undef PG8_BAR
#undef PG8_SCHED
}
}
using pg8::bf16_t;
#define MFMA32(a, b, c) __builtin_amdgcn_mfma_f32_32x32x16_bf16((a), (b), (c), 0, 0, 0)
#define LDS_WAIT() asm volatile("s_waitcnt lgkmcnt(0)" ::: "memory")
DI int crow(int i, int h) { return (i & 3) + 8 * (i >> 2) + 4 * h; }
template <int S> DI bf16x8 pack8(const f32x16& x) {
    u32x4 p; p.x = pk2(x[8 * S], x[8 * S + 1]); p.y = pk2(x[8 * S + 2], x[8 * S + 3]); p.z = pk2(x[8 * S + 4], x[8 * S + 5]); p.w = pk2(x[8 * S + 6], x[8 * S + 7]);
    return __builtin_bit_cast(bf16x8, p);
}
DI f32x16 zero16() { f32x16 z;
#pragma unroll
    for (int i = 0; i < 16; ++i) z[i] = 0.f; return z; }

struct Params { const float* in[22]; float* out; unsigned char* ws; };

enum { MAP_ID = 0, MAP_WIN = 1, MAP_WUQ = 2 };
template <int MAP> DI int dest_row(int n) {
    if (MAP == MAP_WIN) return n < 1088 ? n : n + 192;
    if (MAP == MAP_WUQ) { const int h = n / 192, i = n - h * 192; return i < 128 ? h * 128 + i : 2048 + h * 64 + 2 * ((i - 128) & 31) + ((i - 128) >> 5); }
    return n;
}
template <int MAP> DI void transpose_item(const float* __restrict__ W, int K, int N, bf16_t* __restrict__ WT, LAS float* scr, int item, int lane) {
    const int nblk = N / 32, kb = item / nblk, nb = item - kb * nblk, k0 = 64 * kb, n0 = 32 * nb;
#pragma unroll 8
    for (int i = 0; i < 32; ++i) { const int kk = 2 * i + (lane >> 5); scr[kk * 33 + (lane & 31)] = W[(size_t)(k0 + kk) * N + n0 + (lane & 31)]; }
    LDS_WAIT();
    const int c = lane & 7;
#pragma unroll
    for (int j = 0; j < 4; ++j) { const int n = (lane >> 3) + 8 * j; const LAS float* s = scr + (8 * c) * 33 + n;
        u32x4 o; o.x = pk2(s[0 * 33], s[1 * 33]); o.y = pk2(s[2 * 33], s[3 * 33]); o.z = pk2(s[4 * 33], s[5 * 33]); o.w = pk2(s[6 * 33], s[7 * 33]);
        *(u32x4*)(WT + (size_t)dest_row<MAP>(n0 + n) * K + k0 + 8 * c) = o; }
    LDS_WAIT();
}

DI void layer_prep(const Params& P, LAS unsigned char* lds, int l, int gw, int NGW, int gt, int NGT, int lane, int wave) {
    unsigned char* ws = P.ws;
    LAS float* scr = (LAS float*)(lds + wave * 16384);
    const float* w_in = P.in[6] + (size_t)l * 2048 * 13376; const float* w_uq = P.in[8] + (size_t)l * 512 * 3072;
    const float* w_uk = P.in[10] + (size_t)l * 512 * 2048;  const float* w_uv = P.in[11] + (size_t)l * 512 * 2048;
    const float* w_oa = P.in[12] + (size_t)l * 2048 * 2048; const float* w_ob = P.in[15] + (size_t)l * 2048 * 2048; const float* w_out = P.in[16] + (size_t)l * 2048 * 2048;
    const float* w_up = P.in[19] + (size_t)l * 2048 * 8192; const float* w_dn = P.in[20] + (size_t)l * 8192 * 2048;
    constexpr int I_IN = 32 * 418, I_UQ = 8 * 96, I_UK = 8 * 64, I_SQ = 32 * 64, I_UP = 32 * 256, I_DN = 128 * 64;
    constexpr int NIT = I_IN + I_UQ + 2 * I_UK + 3 * I_SQ + I_UP + I_DN;
    for (int it = gw; it < NIT; it += NGW) {
        int r = it;
        if (r < I_IN) { transpose_item<MAP_WIN>(w_in, 2048, 13376, (bf16_t*)(ws + WS_WIN), scr, r, lane); continue; } r -= I_IN;
        if (r < I_UQ) { transpose_item<MAP_WUQ>(w_uq, 512, 3072, (bf16_t*)(ws + WS_WUQ), scr, r, lane); continue; } r -= I_UQ;
        if (r < I_UK) { transpose_item<MAP_ID>(w_uk, 512, 2048, (bf16_t*)(ws + WS_WUK), scr, r, lane); continue; } r -= I_UK;
        if (r < I_UK) { transpose_item<MAP_ID>(w_uv, 512, 2048, (bf16_t*)(ws + WS_WUV), scr, r, lane); continue; } r -= I_UK;
        if (r < I_SQ) { transpose_item<MAP_ID>(w_oa, 2048, 2048, (bf16_t*)(ws + WS_WOA), scr, r, lane); continue; } r -= I_SQ;
        if (r < I_SQ) { transpose_item<MAP_ID>(w_ob, 2048, 2048, (bf16_t*)(ws + WS_WOB), scr, r, lane); continue; } r -= I_SQ;
        if (r < I_SQ) { transpose_item<MAP_ID>(w_out, 2048, 2048, (bf16_t*)(ws + WS_WOUT), scr, r, lane); continue; } r -= I_SQ;
        if (r < I_UP) { transpose_item<MAP_ID>(w_up, 2048, 8192, (bf16_t*)(ws + WS_WUP), scr, r, lane); continue; } r -= I_UP;
        transpose_item<MAP_ID>(w_dn, 8192, 2048, (bf16_t*)(ws + WS_WDN), scr, r, lane);
    }
    const u32x4 z4 = {0u, 0u, 0u, 0u};
    { u32x4* z = (u32x4*)((bf16_t*)(ws + WS_WIN) + (size_t)1088 * 2048); for (int i = gt; i < 192 * 2048 / 8; i += NGT) z[i] = z4; }
    bf16_t* CKV = (bf16_t*)(ws + WS_CKV); bf16_t* KPE = (bf16_t*)(ws + WS_KPE);
    const float* cc = P.in[2] + (size_t)l * 8 * 4096 * 512; const float* ck = P.in[3] + (size_t)l * 8 * 4096 * 64;
    for (int i = gt; i < 8 * 4096 * 512 / 8; i += NGT) { const int b = i >> 18, rem = i & 262143, t = rem >> 6, c8 = rem & 63;
        const f32x4 a = *(const f32x4*)(cc + (size_t)i * 8), bq = *(const f32x4*)(cc + (size_t)i * 8 + 4);
        u32x4 o; o.x = pk2(a[0], a[1]); o.y = pk2(a[2], a[3]); o.z = pk2(bq[0], bq[1]); o.w = pk2(bq[2], bq[3]);
        *(u32x4*)(CKV + (size_t)(MP + b * KVB + t) * 512 + c8 * 8) = o; }
    for (int i = gt; i < 8 * 4096 * 64 / 8; i += NGT) { const int b = i >> 15, rem = i & 32767, t = rem >> 3, c8 = rem & 7;
        const f32x4 a = *(const f32x4*)(ck + (size_t)i * 8), bq = *(const f32x4*)(ck + (size_t)i * 8 + 4);
        u32x4 o; o.x = pk2(a[0], a[1]); o.y = pk2(a[2], a[3]); o.z = pk2(bq[0], bq[1]); o.w = pk2(bq[2], bq[3]);
        *(u32x4*)(KPE + (size_t)(MP + b * KVB + t) * 64 + c8 * 8) = o; }
    for (int i = gt; i < 8 * 32 * 64; i += NGT) { const int b = i >> 11, rem = i & 2047; *(u32x4*)(CKV + (size_t)(MP + b * KVB + 4128) * 512 + rem * 8) = z4; }
    for (int i = gt; i < 8 * 32 * 8; i += NGT) { const int b = i >> 8, rem = i & 255; *(u32x4*)(KPE + (size_t)(MP + b * KVB + 4128) * 64 + rem * 8) = z4; }
    float* LB = (float*)(ws + WS_LB); const float* hl = P.in[13];
    for (int i = gt; i < 2048; i += NGT) LB[i] = l == 0 ? 0.f : 1.f / (1.f + expf(hl[i] - hl[2048 + i]));
}

DI void rope_table(const Params& P, int gt, int NGT) {
    float* T = (float*)(P.ws + WS_TBL);
    for (int i = gt; i < 2080 * 32; i += NGT) { const int p = i >> 5, j = i & 31; const int pos = p < 2048 ? p : 4096 + (p - 2048);
        const float inv = exp2f(-(float)j * (13.287712379549449f / 32.f)); const float ang = (float)pos * inv;
        const double a = (double)ang; const double kq = rint(a * 0.15915494309189535); const float rr = (float)(a - kq * 6.283185307179586);
        T[2 * i] = __cosf(rr); T[2 * i + 1] = __sinf(rr); }
}

DI void init_x(const Params& P, int gw, int NGW, int lane) {
    const float* g = P.in[5]; float* X = P.out; bf16_t* XN = (bf16_t*)(P.ws + WS_XN);
    for (int row = gw; row < MTOK; row += NGW) {
        const float* src = row < MP ? P.in[0] + (size_t)row * 2048 : P.in[1] + (size_t)(row - MP) * 2048;
        f32x4 v[8]; float ss = 0.f;
#pragma unroll
        for (int j = 0; j < 8; ++j) { v[j] = *(const f32x4*)(src + j * 256 + lane * 4); ss += v[j][0] * v[j][0] + v[j][1] * v[j][1] + v[j][2] * v[j][2] + v[j][3] * v[j][3]; }
        const float rs = rsqrtf(wave_sum(ss) * (1.f / 2048.f) + EPS);
#pragma unroll
        for (int j = 0; j < 8; ++j) { *(f32x4*)(X + (size_t)row * 2048 + j * 256 + lane * 4) = v[j];
            const f32x4 gg = *(const f32x4*)(g + j * 256 + lane * 4); u32x2 w; w.x = pk2(v[j][0] * rs * gg[0], v[j][1] * rs * gg[1]); w.y = pk2(v[j][2] * rs * gg[2], v[j][3] * rs * gg[3]);
            *(u32x2*)(XN + (size_t)row * 2048 + j * 256 + lane * 4) = w; }
    }
}
DI void resid_norm(const float* __restrict__ Y, const float* __restrict__ gY, float* X, const float* __restrict__ gN, bf16_t* XN, int gw, int NGW, int lane) {
    for (int row = gw; row < MTOK; row += NGW) {
        f32x4 y[8]; float ss = 0.f;
#pragma unroll
        for (int j = 0; j < 8; ++j) { y[j] = *(const f32x4*)(Y + (size_t)row * 2048 + j * 256 + lane * 4); ss += y[j][0] * y[j][0] + y[j][1] * y[j][1] + y[j][2] * y[j][2] + y[j][3] * y[j][3]; }
        const float rs = rsqrtf(wave_sum(ss) * (1.f / 2048.f) + EPS); float s2 = 0.f;
#pragma unroll
        for (int j = 0; j < 8; ++j) { const f32x4 gg = *(const f32x4*)(gY + j * 256 + lane * 4); const f32x4 x = *(const f32x4*)(X + (size_t)row * 2048 + j * 256 + lane * 4);
            y[j] = x + y[j] * rs * gg; *(f32x4*)(X + (size_t)row * 2048 + j * 256 + lane * 4) = y[j];
            s2 += y[j][0] * y[j][0] + y[j][1] * y[j][1] + y[j][2] * y[j][2] + y[j][3] * y[j][3]; }
        if (gN) {
            const float r2 = rsqrtf(wave_sum(s2) * (1.f / 2048.f) + EPS);
#pragma unroll
            for (int j = 0; j < 8; ++j) { const f32x4 gg = *(const f32x4*)(gN + j * 256 + lane * 4); u32x2 w; w.x = pk2(y[j][0] * r2 * gg[0], y[j][1] * r2 * gg[1]); w.y = pk2(y[j][2] * r2 * gg[2], y[j][3] * r2 * gg[3]);
                *(u32x2*)(XN + (size_t)row * 2048 + j * 256 + lane * 4) = w; }
        }
    }
}
DI void small_norms(const Params& P, int l, int gw, int NGW, int lane) {
    const float* Zs = (const float*)(P.ws + WS_ZS); bf16_t* QN = (bf16_t*)(P.ws + WS_QN); bf16_t* CKV = (bf16_t*)(P.ws + WS_CKV); bf16_t* KPE = (bf16_t*)(P.ws + WS_KPE);
    const float* tbl = (const float*)(P.ws + WS_TBL); const float* gq = P.in[7] + l * 512; const float* gkv = P.in[9] + l * 512;
    for (int row = gw; row < MTOK; row += NGW) {
        const float* z = Zs + (size_t)row * ZSW;
        const bool pr = row < MP; const int rs_ = row - MP;
        const int kvrow = pr ? row : MP + (rs_ >> 5) * KVB + 4096 + (rs_ & 31);
        const int p = pr ? (row & 2047) : 2048 + (rs_ & 31);
        float* oc = pr ? P.out + OUT_CKVP + ((size_t)l * MP + row) * 512 : P.out + OUT_CKVS + ((size_t)l * MS + rs_) * 512;
        float* ok = pr ? P.out + OUT_KPEP + ((size_t)l * MP + row) * 64 : P.out + OUT_KPES + ((size_t)l * MS + rs_) * 64;
        { const f32x4 a = *(const f32x4*)(z + lane * 8), b = *(const f32x4*)(z + lane * 8 + 4);
          const float ss = a[0] * a[0] + a[1] * a[1] + a[2] * a[2] + a[3] * a[3] + b[0] * b[0] + b[1] * b[1] + b[2] * b[2] + b[3] * b[3];
          const float rs = rsqrtf(wave_sum(ss) * (1.f / 512.f) + EPS); const f32x4 g0 = *(const f32x4*)(gq + lane * 8), g1 = *(const f32x4*)(gq + lane * 8 + 4);
          u32x4 o; o.x = pk2(a[0] * rs * g0[0], a[1] * rs * g0[1]); o.y = pk2(a[2] * rs * g0[2], a[3] * rs * g0[3]); o.z = pk2(b[0] * rs * g1[0], b[1] * rs * g1[1]); o.w = pk2(b[2] * rs * g1[2], b[3] * rs * g1[3]);
          *(u32x4*)(QN + (size_t)row * 512 + lane * 8) = o; }
        { const f32x4 a = *(const f32x4*)(z + 512 + lane * 8), b = *(const f32x4*)(z + 512 + lane * 8 + 4);
          const float ss = a[0] * a[0] + a[1] * a[1] + a[2] * a[2] + a[3] * a[3] + b[0] * b[0] + b[1] * b[1] + b[2] * b[2] + b[3] * b[3];
          const float rs = rsqrtf(wave_sum(ss) * (1.f / 512.f) + EPS); const f32x4 g0 = *(const f32x4*)(gkv + lane * 8), g1 = *(const f32x4*)(gkv + lane * 8 + 4);
          const f32x4 c0 = a * rs * g0, c1 = b * rs * g1;
          *(f32x4*)(oc + lane * 8) = c0; *(f32x4*)(oc + lane * 8 + 4) = c1;
          u32x4 o; o.x = pk2(c0[0], c0[1]); o.y = pk2(c0[2], c0[3]); o.z = pk2(c1[0], c1[1]); o.w = pk2(c1[2], c1[3]);
          *(u32x4*)(CKV + (size_t)kvrow * 512 + lane * 8) = o; }
        if (lane < 32) { const float x1 = z[1024 + lane], x2 = z[1056 + lane]; const float c = tbl[(size_t)(p * 32 + lane) * 2], s = tbl[(size_t)(p * 32 + lane) * 2 + 1];
          const float o1 = x1 * c - x2 * s, o2 = x1 * s + x2 * c; ok[lane] = o1; ok[32 + lane] = o2;
          KPE[(size_t)kvrow * 64 + lane] = f2bf(o1); KPE[(size_t)kvrow * 64 + 32 + lane] = f2bf(o2); }
    }
}

struct HUnit { int rowbase, nvalid, h; };
DI HUnit hunit(int u) { HUnit r; if (u < 2048) { const int sh = u >> 5, c = u & 31; r.h = sh & 15; r.rowbase = (sh >> 4) * 2048 + c * 64; r.nvalid = 64; } else { const int s = u - 2048; r.h = s & 15; r.rowbase = MP + (s >> 4) * 32; r.nvalid = 32; } return r; }
DI void hgrn_cumsum(const float* __restrict__ LF, LAS float* psum, const HUnit& hu, int k, int tq, float (&b)[16], float& b31, float& b63) {
    const float* p = LF + (size_t)(hu.rowbase + 16 * tq) * 2048 + hu.h * 128 + k; const bool valid = 16 * tq < hu.nvalid;
    float run = 0.f;
#pragma unroll
    for (int i = 0; i < 16; ++i) { const float v = valid ? p[(size_t)i * 2048] : 0.f; run += v; b[i] = run; }
    psum[tq * 128 + k] = run;
    __syncthreads();
    const float p0 = psum[k], p1 = psum[128 + k], p2 = psum[256 + k], p3 = psum[384 + k];
    const float off = (tq > 0 ? p0 : 0.f) + (tq > 1 ? p1 : 0.f) + (tq > 2 ? p2 : 0.f);
#pragma unroll
    for (int i = 0; i < 16; ++i) b[i] += off;
    b31 = p0 + p1; b63 = b31 + p2 + p3;
}
DI void hgrn_pass1(LAS unsigned char* lds, const float* __restrict__ LF, const bf16_t* __restrict__ HK, const bf16_t* __restrict__ HV, float* __restrict__ UT, float* __restrict__ Dv, int u, int tid) {
    LAS float* psum = (LAS float*)lds; LAS bf16_t* KhT = (LAS bf16_t*)(lds + 2048); LAS bf16_t* VTl = (LAS bf16_t*)(lds + 2048 + 18432);
    const HUnit hu = hunit(u); const int k = tid & 127, tq = tid >> 7; const bool valid = 16 * tq < hu.nvalid;
    float b[16], b31, b63; hgrn_cumsum(LF, psum, hu, k, tq, b, b31, b63);
    const size_t g0 = (size_t)(hu.rowbase + 16 * tq) * 2048 + hu.h * 128 + k;
    unsigned kw[8], vw[8];
#pragma unroll
    for (int i2 = 0; i2 < 8; ++i2) {
        float k0 = 0.f, k1 = 0.f; unsigned v0 = 0u, v1 = 0u;
        if (valid) { k0 = bf2f(HK[g0 + (size_t)(2 * i2) * 2048]) * __expf(b63 - b[2 * i2]); k1 = bf2f(HK[g0 + (size_t)(2 * i2 + 1) * 2048]) * __expf(b63 - b[2 * i2 + 1]);
                     v0 = HV[g0 + (size_t)(2 * i2) * 2048]; v1 = HV[g0 + (size_t)(2 * i2 + 1) * 2048]; }
        kw[i2] = pk2(k0, k1); vw[i2] = v0 | (v1 << 16);
    }
    { u32x4 a, c; a.x = kw[0]; a.y = kw[1]; a.z = kw[2]; a.w = kw[3]; c.x = kw[4]; c.y = kw[5]; c.z = kw[6]; c.w = kw[7];
      *(LAS u32x4*)(KhT + k * 72 + 16 * tq) = a; *(LAS u32x4*)(KhT + k * 72 + 16 * tq + 8) = c;
      a.x = vw[0]; a.y = vw[1]; a.z = vw[2]; a.w = vw[3]; c.x = vw[4]; c.y = vw[5]; c.z = vw[6]; c.w = vw[7];
      *(LAS u32x4*)(VTl + k * 72 + 16 * tq) = a; *(LAS u32x4*)(VTl + k * 72 + 16 * tq + 8) = c; }
    if (tq == 0) Dv[(size_t)u * 128 + k] = __expf(b63);
    __syncthreads();
    const int wave = tid >> 6, lane = tid & 63, r = lane & 31, hh = lane >> 5, vb = wave & 3, kg = wave >> 2;
#pragma unroll
    for (int kb2 = 0; kb2 < 2; ++kb2) {
        const int kbq = 2 * kg + kb2; f32x16 acc = zero16();
#pragma unroll
        for (int s = 0; s < 4; ++s) { const bf16x8 a = *(const LAS bf16x8*)(VTl + (32 * vb + r) * 72 + 16 * s + 8 * hh), bb = *(const LAS bf16x8*)(KhT + (32 * kbq + r) * 72 + 16 * s + 8 * hh); acc = MFMA32(a, bb, acc); }
        float* dst = UT + ((size_t)u * 128 + 32 * vb) * 128 + 32 * kbq + r;
#pragma unroll
        for (int i = 0; i < 16; ++i) dst[(size_t)crow(i, hh) * 128] = acc[i];
    }
    __syncthreads();
}
DI void hgrn_pass2(LAS unsigned char* lds, const Params& P, int l, int x, int tid) {
    const float* UT = (const float*)(P.ws + WS_UT); const float* Dv = (const float*)(P.ws + WS_D); bf16_t* SpT = (bf16_t*)(P.ws + WS_SPT);
    LAS float* tl = (LAS float*)lds;
    const bool sample = x >= 256; const int sidx = sample ? (x - 256) >> 2 : x >> 2, vq = x & 3;
    const int nch = sample ? 1 : 32, ubase = sample ? 2048 + sidx : sidx * 32;
    const int vloc = tid >> 4, k0 = (tid & 15) * 8, v = 32 * vq + vloc;
    const int kk = tid >> 2, vs = (tid & 3) * 8;
    float S[8];
#pragma unroll
    for (int i = 0; i < 8; ++i) S[i] = 0.f;
    if (sample) {
        const float* s0 = P.in[4] + ((size_t)l * 128 + sidx) * 16384 + (size_t)kk * 128 + 32 * vq + vs;
        const f32x4 a = *(const f32x4*)s0, b = *(const f32x4*)(s0 + 4);
#pragma unroll
        for (int i = 0; i < 4; ++i) { tl[kk * 33 + vs + i] = a[i]; tl[kk * 33 + vs + 4 + i] = b[i]; }
        __syncthreads();
#pragma unroll
        for (int i = 0; i < 8; ++i) S[i] = tl[(k0 + i) * 33 + vloc];
        __syncthreads();
    }
    size_t e = ((size_t)ubase * 128 + v) * 128 + k0;
    f32x4 u0 = *(const f32x4*)(UT + e), u1 = *(const f32x4*)(UT + e + 4), d0 = *(const f32x4*)(Dv + (size_t)ubase * 128 + k0), d1 = *(const f32x4*)(Dv + (size_t)ubase * 128 + k0 + 4);
    for (int c = 0; c < nch; ++c) {
        f32x4 nu0 = u0, nu1 = u1, nd0 = d0, nd1 = d1;
        if (c + 1 < nch) { const size_t e2 = e + 16384; nu0 = *(const f32x4*)(UT + e2); nu1 = *(const f32x4*)(UT + e2 + 4); nd0 = *(const f32x4*)(Dv + (size_t)(ubase + c + 1) * 128 + k0); nd1 = *(const f32x4*)(Dv + (size_t)(ubase + c + 1) * 128 + k0 + 4); }
        u32x4 o; o.x = pk2(S[0], S[1]); o.y = pk2(S[2], S[3]); o.z = pk2(S[4], S[5]); o.w = pk2(S[6], S[7]);
        *(u32x4*)(SpT + e) = o;
#pragma unroll
        for (int i = 0; i < 4; ++i) { S[i] = d0[i] * S[i] + u0[i]; S[4 + i] = d1[i] * S[4 + i] + u1[i]; }
        u0 = nu0; u1 = nu1; d0 = nd0; d1 = nd1; e += 16384;
    }
#pragma unroll
    for (int i = 0; i < 8; ++i) tl[(k0 + i) * 33 + vloc] = S[i];
    __syncthreads();
    float* o = (sample ? P.out + OUT_STS + ((size_t)l * 128 + sidx) * 16384 : P.out + OUT_STP + ((size_t)l * 64 + sidx) * 16384) + (size_t)kk * 128 + 32 * vq + vs;
    f32x4 a, b;
#pragma unroll
    for (int i = 0; i < 4; ++i) { a[i] = tl[kk * 33 + vs + i]; b[i] = tl[kk * 33 + vs + 4 + i]; }
    *(f32x4*)o = a; *(f32x4*)(o + 4) = b;
    __syncthreads();
}
DI void hgrn_pass3(LAS unsigned char* lds, const float* __restrict__ LF, const bf16_t* __restrict__ HQ, const bf16_t* __restrict__ HK, const bf16_t* __restrict__ HV, const bf16_t* __restrict__ HG,
                   const bf16_t* __restrict__ SpT, const float* __restrict__ gn, bf16_t* __restrict__ OH, int u, int tid) {
    LAS float* psum = (LAS float*)lds;
    LAS bf16_t* Qa = (LAS bf16_t*)(lds + 2048);
    LAS bf16_t* Qb = (LAS bf16_t*)(lds + 19456);
    LAS bf16_t* Ka = (LAS bf16_t*)(lds + 28160);
    LAS bf16_t* Kb = (LAS bf16_t*)(lds + 36864);
    LAS bf16_t* VTl = (LAS bf16_t*)(lds + 54272);
    LAS float* Ost = (LAS float*)(lds + 72704);
    const HUnit hu = hunit(u); const int k = tid & 127, tq = tid >> 7; const bool valid = 16 * tq < hu.nvalid;
    float b[16], b31, b63; hgrn_cumsum(LF, psum, hu, k, tq, b, b31, b63);
    const size_t g0 = (size_t)(hu.rowbase + 16 * tq) * 2048 + hu.h * 128 + k;
    unsigned vw[8];
#pragma unroll
    for (int i2 = 0; i2 < 8; ++i2) {
        unsigned vpair = 0u;
#pragma unroll
        for (int e = 0; e < 2; ++e) {
            const int i = 2 * i2 + e, t = 16 * tq + i;
            float q = 0.f, kk = 0.f; unsigned vv = 0u;
            if (valid) { q = bf2f(HQ[g0 + (size_t)i * 2048]); kk = bf2f(HK[g0 + (size_t)i * 2048]); vv = HV[g0 + (size_t)i * 2048]; }
            Qa[t * 136 + k] = f2bf(q * __expf(b[i]));
            if (tq >= 2) Qb[(t - 32) * 136 + k] = f2bf(q * __expf(b[i] - b31)); else Ka[t * 136 + k] = f2bf(kk * __expf(-b[i]));
            Kb[t * 136 + k] = f2bf(kk * __expf(b31 - b[i]));
            vpair |= vv << (16 * e);
        }
        vw[i2] = vpair;
    }
    { u32x4 a, c; a.x = vw[0]; a.y = vw[1]; a.z = vw[2]; a.w = vw[3]; c.x = vw[4]; c.y = vw[5]; c.z = vw[6]; c.w = vw[7];
      *(LAS u32x4*)(VTl + k * 72 + 16 * tq) = a; *(LAS u32x4*)(VTl + k * 72 + 16 * tq + 8) = c; }
    __syncthreads();
    const int wave = tid >> 6, lane = tid & 63, r = lane & 31, hh = lane >> 5, vb = wave & 3, tb = wave >> 2;
    f32x16 O = zero16();
    const LAS bf16_t* vrow = VTl + (32 * vb + r) * 72 + 4 * hh;
    if (tb == 0) {
        f32x16 A0 = zero16();
#pragma unroll
        for (int ks = 0; ks < 8; ++ks) { const bf16x8 a = *(const LAS bf16x8*)(Ka + r * 136 + 16 * ks + 8 * hh), q = *(const LAS bf16x8*)(Qa + r * 136 + 16 * ks + 8 * hh); A0 = MFMA32(a, q, A0); }
#pragma unroll
        for (int i = 0; i < 16; ++i) if (crow(i, hh) > r) A0[i] = 0.f;
        const bf16x8 p0 = pack8<0>(A0), p1 = pack8<1>(A0);
        { const s16x4 lo = *(const LAS s16x4*)(vrow), hi = *(const LAS s16x4*)(vrow + 8); O = MFMA32(__builtin_shufflevector(lo, hi, 0, 1, 2, 3, 4, 5, 6, 7), p0, O); }
        { const s16x4 lo = *(const LAS s16x4*)(vrow + 16), hi = *(const LAS s16x4*)(vrow + 24); O = MFMA32(__builtin_shufflevector(lo, hi, 0, 1, 2, 3, 4, 5, 6, 7), p1, O); }
    } else {
        f32x16 A0 = zero16(), A1 = zero16();
#pragma unroll
        for (int ks = 0; ks < 8; ++ks) { const bf16x8 q = *(const LAS bf16x8*)(Qb + r * 136 + 16 * ks + 8 * hh);
            const bf16x8 a0 = *(const LAS bf16x8*)(Kb + r * 136 + 16 * ks + 8 * hh), a1 = *(const LAS bf16x8*)(Kb + (32 + r) * 136 + 16 * ks + 8 * hh);
            A0 = MFMA32(a0, q, A0); A1 = MFMA32(a1, q, A1); }
#pragma unroll
        for (int i = 0; i < 16; ++i) if (crow(i, hh) > r) A1[i] = 0.f;
        const bf16x8 p0 = pack8<0>(A0), p1 = pack8<1>(A0), p2 = pack8<0>(A1), p3 = pack8<1>(A1);
        { const s16x4 lo = *(const LAS s16x4*)(vrow), hi = *(const LAS s16x4*)(vrow + 8); O = MFMA32(__builtin_shufflevector(lo, hi, 0, 1, 2, 3, 4, 5, 6, 7), p0, O); }
        { const s16x4 lo = *(const LAS s16x4*)(vrow + 16), hi = *(const LAS s16x4*)(vrow + 24); O = MFMA32(__builtin_shufflevector(lo, hi, 0, 1, 2, 3, 4, 5, 6, 7), p1, O); }
        { const s16x4 lo = *(const LAS s16x4*)(vrow + 32), hi = *(const LAS s16x4*)(vrow + 40); O = MFMA32(__builtin_shufflevector(lo, hi, 0, 1, 2, 3, 4, 5, 6, 7), p2, O); }
        { const s16x4 lo = *(const LAS s16x4*)(vrow + 48), hi = *(const LAS s16x4*)(vrow + 56); O = MFMA32(__builtin_shufflevector(lo, hi, 0, 1, 2, 3, 4, 5, 6, 7), p3, O); }
    }
    { const bf16_t* sp = SpT + ((size_t)u * 128 + 32 * vb + r) * 128 + 8 * hh;
#pragma unroll
      for (int ks = 0; ks < 8; ++ks) { const bf16x8 a = *(const bf16x8*)(sp + 16 * ks), q = *(const LAS bf16x8*)(Qa + (32 * tb + r) * 136 + 16 * ks + 8 * hh); O = MFMA32(a, q, O); } }
#pragma unroll
    for (int g = 0; g < 4; ++g) { f32x4 w; w[0] = O[4 * g]; w[1] = O[4 * g + 1]; w[2] = O[4 * g + 2]; w[3] = O[4 * g + 3]; *(LAS f32x4*)(Ost + (32 * tb + r) * 132 + 32 * vb + 8 * g + 4 * hh) = w; }
    __syncthreads();
    { const int t = tid >> 3, vs = (tid & 7) * 16;
      f32x4 x[4]; float ss = 0.f;
#pragma unroll
      for (int j = 0; j < 4; ++j) { x[j] = *(const LAS f32x4*)(Ost + t * 132 + vs + 4 * j); ss += x[j][0] * x[j][0] + x[j][1] * x[j][1] + x[j][2] * x[j][2] + x[j][3] * x[j][3]; }
      ss += __shfl_xor(ss, 1); ss += __shfl_xor(ss, 2); ss += __shfl_xor(ss, 4);
      const float rs = rsqrtf(ss * (1.f / 128.f) + EPS);
      if (t < hu.nvalid) {
          const size_t off = (size_t)(hu.rowbase + t) * 2048 + hu.h * 128 + vs;
          const u32x4 ga = *(const u32x4*)(HG + off), gb = *(const u32x4*)(HG + off + 8);
          const f32x4 n0 = *(const f32x4*)(gn + vs), n1 = *(const f32x4*)(gn + vs + 4), n2 = *(const f32x4*)(gn + vs + 8), n3 = *(const f32x4*)(gn + vs + 12);
          u32x4 oa, ob;
          oa.x = pk2(x[0][0] * rs * n0[0] * bflo(ga.x), x[0][1] * rs * n0[1] * bfhi(ga.x)); oa.y = pk2(x[0][2] * rs * n0[2] * bflo(ga.y), x[0][3] * rs * n0[3] * bfhi(ga.y));
          oa.z = pk2(x[1][0] * rs * n1[0] * bflo(ga.z), x[1][1] * rs * n1[1] * bfhi(ga.z)); oa.w = pk2(x[1][2] * rs * n1[2] * bflo(ga.w), x[1][3] * rs * n1[3] * bfhi(ga.w));
          ob.x = pk2(x[2][0] * rs * n2[0] * bflo(gb.x), x[2][1] * rs * n2[1] * bfhi(gb.x)); ob.y = pk2(x[2][2] * rs * n2[2] * bflo(gb.y), x[2][3] * rs * n2[3] * bfhi(gb.y));
          ob.z = pk2(x[3][0] * rs * n3[0] * bflo(gb.z), x[3][1] * rs * n3[1] * bfhi(gb.z)); ob.w = pk2(x[3][2] * rs * n3[2] * bflo(gb.w), x[3][3] * rs * n3[3] * bfhi(gb.w));
          *(u32x4*)(OH + off) = oa; *(u32x4*)(OH + off + 8) = ob;
      } }
    __syncthreads();
}

template <bool SAMPLE>
DI void attn_wave(const bf16_t* __restrict__ Qp, const bf16_t* __restrict__ Kn, const bf16_t* __restrict__ Kp, const bf16_t* __restrict__ Vt, int t0, int t1, int tstep, int nkeys,
                  float& m, float& l, f32x16 (&O)[4], int r, int hh) {
    bf16x8 qf[12];
#pragma unroll
    for (int s = 0; s < 12; ++s) qf[s] = *(const bf16x8*)(Qp + (size_t)r * 3072 + 16 * s + 8 * hh);
    m = -INFINITY; l = 0.f;
#pragma unroll
    for (int vb = 0; vb < 4; ++vb) O[vb] = zero16();
    for (int t = t0; t < t1; t += tstep) {
        const bf16_t* kn = Kn + (size_t)(64 * t + r) * 2048 + 8 * hh; const bf16_t* kp = Kp + (size_t)(64 * t + r) * 64 + 8 * hh;
        f32x16 S0 = zero16(), S1 = zero16();
#pragma unroll
        for (int s = 0; s < 8; ++s) { const bf16x8 a0 = *(const bf16x8*)(kn + 16 * s), a1 = *(const bf16x8*)(kn + 32 * 2048 + 16 * s); S0 = MFMA32(a0, qf[s], S0); S1 = MFMA32(a1, qf[s], S1); }
#pragma unroll
        for (int s = 0; s < 4; ++s) { const bf16x8 a0 = *(const bf16x8*)(kp + 16 * s), a1 = *(const bf16x8*)(kp + 32 * 64 + 16 * s); S0 = MFMA32(a0, qf[8 + s], S0); S1 = MFMA32(a1, qf[8 + s], S1); }
        if (SAMPLE) { if (64 * t + 64 > nkeys) {
#pragma unroll
            for (int i = 0; i < 16; ++i) { if (64 * t + crow(i, hh) >= nkeys) S0[i] = -INFINITY; if (64 * t + 32 + crow(i, hh) >= nkeys) S1[i] = -INFINITY; } } }
        float mx = fmaxf(S0[0], S1[0]);
#pragma unroll
        for (int i = 1; i < 16; ++i) mx = fmaxf(mx, fmaxf(S0[i], S1[i]));
        mx = fmaxf(mx, __shfl_xor(mx, 32));
        const float mn = fmaxf(m, mx), alpha = ex2(m - mn); m = mn;
        float ls = 0.f;
#pragma unroll
        for (int i = 0; i < 16; ++i) { S0[i] = ex2(S0[i] - mn); S1[i] = ex2(S1[i] - mn); ls += S0[i] + S1[i]; }
        l = l * alpha + ls;
#pragma unroll
        for (int vb = 0; vb < 4; ++vb) O[vb] = O[vb] * alpha;
        const bf16x8 p0 = pack8<0>(S0), p1 = pack8<1>(S0), p2 = pack8<0>(S1), p3 = pack8<1>(S1);
#pragma unroll
        for (int vb = 0; vb < 4; ++vb) {
            const bf16_t* vp = Vt + (size_t)(32 * vb + r) * KVR + 64 * t + 4 * hh;
            { const s16x4 lo = *(const s16x4*)(vp), hi = *(const s16x4*)(vp + 8); O[vb] = MFMA32(__builtin_shufflevector(lo, hi, 0, 1, 2, 3, 4, 5, 6, 7), p0, O[vb]); }
            { const s16x4 lo = *(const s16x4*)(vp + 16), hi = *(const s16x4*)(vp + 24); O[vb] = MFMA32(__builtin_shufflevector(lo, hi, 0, 1, 2, 3, 4, 5, 6, 7), p1, O[vb]); }
            { const s16x4 lo = *(const s16x4*)(vp + 32), hi = *(const s16x4*)(vp + 40); O[vb] = MFMA32(__builtin_shufflevector(lo, hi, 0, 1, 2, 3, 4, 5, 6, 7), p2, O[vb]); }
            { const s16x4 lo = *(const s16x4*)(vp + 48), hi = *(const s16x4*)(vp + 56); O[vb] = MFMA32(__builtin_shufflevector(lo, hi, 0, 1, 2, 3, 4, 5, 6, 7), p3, O[vb]); }
        }
    }
}
DI void attn_prompt_unit(const Params& P, int bh, int jq, int wave, int lane) {
    const bf16_t* Q = (const bf16_t*)(P.ws + WS_Q); const bf16_t* KN = (const bf16_t*)(P.ws + WS_KN); const bf16_t* KPE = (const bf16_t*)(P.ws + WS_KPE); const bf16_t* VT = (const bf16_t*)(P.ws + WS_VT);
    bf16_t* OA = (bf16_t*)(P.ws + WS_OA);
    const int b = bh >> 4, h = bh & 15, rb = 8 * jq + wave, row0 = b * 2048 + 32 * rb, kv0 = b * 2048, r = lane & 31, hh = lane >> 5;
    float m, l; f32x16 O[4];
    attn_wave<false>(Q + (size_t)row0 * 3072 + h * 192, KN + (size_t)kv0 * 2048 + h * 128, KPE + (size_t)kv0 * 64, VT + (size_t)(h * 128) * KVR + kv0, 0, (rb >> 1) + 1, 1, 0, m, l, O, r, hh);
    l += __shfl_xor(l, 32); const float inv = 1.f / l;
#pragma unroll
    for (int vb = 0; vb < 4; ++vb)
#pragma unroll
        for (int g = 0; g < 4; ++g) { u32x2 w; w.x = pk2(O[vb][4 * g] * inv, O[vb][4 * g + 1] * inv); w.y = pk2(O[vb][4 * g + 2] * inv, O[vb][4 * g + 3] * inv);
            *(u32x2*)(OA + (size_t)(row0 + r) * 2048 + h * 128 + 32 * vb + 8 * g + 4 * hh) = w; }
}
DI void attn_sample_unit(LAS unsigned char* lds, const Params& P, int su, int wave, int lane, int tid) {
    const bf16_t* Q = (const bf16_t*)(P.ws + WS_Q); const bf16_t* KN = (const bf16_t*)(P.ws + WS_KN); const bf16_t* KPE = (const bf16_t*)(P.ws + WS_KPE); const bf16_t* VT = (const bf16_t*)(P.ws + WS_VT);
    bf16_t* OA = (bf16_t*)(P.ws + WS_OA);
    const int b = su >> 4, h = su & 15, row0 = MP + b * 32, kv0 = MP + b * KVB, r = lane & 31, hh = lane >> 5;
    float m, l; f32x16 O[4];
    attn_wave<true>(Q + (size_t)row0 * 3072 + h * 192, KN + (size_t)kv0 * 2048 + h * 128, KPE + (size_t)kv0 * 64, VT + (size_t)(h * 128) * KVR + kv0, wave, 65, 8, 4128, m, l, O, r, hh);
    l += __shfl_xor(l, 32);
    LAS float* ml = (LAS float*)(lds + 131072);
    if (hh == 0) { ml[(wave * 32 + r) * 2] = m; ml[(wave * 32 + r) * 2 + 1] = l; }
    __syncthreads();
    float ms = -INFINITY;
#pragma unroll
    for (int w = 0; w < 8; ++w) ms = fmaxf(ms, ml[(w * 32 + r) * 2]);
    float L = 0.f;
#pragma unroll
    for (int w = 0; w < 8; ++w) L += ml[(w * 32 + r) * 2 + 1] * ex2(ml[(w * 32 + r) * 2] - ms);
    const float sc = ex2(m - ms) / L;
    LAS float* slot = (LAS float*)(lds + wave * 16384);
#pragma unroll
    for (int vb = 0; vb < 4; ++vb)
#pragma unroll
        for (int i = 0; i < 16; ++i) slot[(32 * vb + crow(i, hh)) * 32 + r] = O[vb][i] * sc;
    __syncthreads();
    { const int q = tid & 31, vg = tid >> 5; float a[8];
#pragma unroll
      for (int e = 0; e < 8; ++e) { float s = 0.f;
#pragma unroll
          for (int w = 0; w < 8; ++w) s += ((const LAS float*)(lds + w * 16384))[(8 * vg + e) * 32 + q];
          a[e] = s; }
      u32x4 o; o.x = pk2(a[0], a[1]); o.y = pk2(a[2], a[3]); o.z = pk2(a[4], a[5]); o.w = pk2(a[6], a[7]);
      *(u32x4*)(OA + (size_t)(row0 + q) * 2048 + h * 128 + 8 * vg) = o; }
    __syncthreads();
}

constexpr int LDS_BYTES = 147456;
template <class Epi> DI void run_gemm(LAS unsigned char* lds, const bf16_t* A, const bf16_t* Bt, int M_, int N_, int K_, int G, int c, const Epi& E) {
    pg8::Gemm g{A, Bt, M_, N_, K_}; pg8::StaticOrder S; S.init(M_, N_, G, c);
    pg8::gemm_phase<Epi, pg8::StaticOrder, true, true>(lds, g, S, E);
}

typedef const __attribute__((address_space(4))) Params CParams;
#define PHASE_BEGIN \
    Params P; { CParams* pp_ = (CParams*)__builtin_amdgcn_kernarg_segment_ptr(); asm volatile("" : "+s"(pp_)); _Pragma("unroll") for (int i_ = 0; i_ < 22; ++i_) P.in[i_] = pp_->in[i_]; P.out = pp_->out; P.ws = pp_->ws; } \
    int tid = threadIdx.x; asm volatile("" : "+v"(tid)); int G = gridDim.x, bx = blockIdx.x; asm volatile("" : "+s"(G), "+s"(bx)); \
    const int lane = tid & 63, wave = __builtin_amdgcn_readfirstlane(tid >> 6); \
    const int vcu = (G % 8 == 0) ? (bx % 8) * (G / 8) + bx / 8 : bx;       \
    const int gw = vcu * 8 + wave, NGW = G * 8, gt = bx * 512 + tid, NGT = G * 512; \
    unsigned char* ws = P.ws; (void)lane; (void)gw; (void)NGW; (void)gt; (void)NGT; (void)ws;

__global__ void __launch_bounds__(512, 2) fwd_kernel(Params Pk) {
    extern __shared__ __attribute__((aligned(16))) unsigned char lds_raw[];
    LAS unsigned char* lds = (LAS unsigned char*)lds_raw;
    cg::grid_group grid = cg::this_grid();
#define GSYNC() do { __threadfence(); grid.sync(); __threadfence(); } while (0)
    { PHASE_BEGIN
      layer_prep(P, lds, 0, gw, NGW, gt, NGT, lane, wave);
      rope_table(P, gt, NGT);
      init_x(P, gw, NGW, lane); }
    GSYNC();
    for (int l = 0; l < 2; ++l) {
        { PHASE_BEGIN
          pg8::EpiWin E{(float*)(ws + WS_ZS), (bf16_t*)(ws + WS_HQ), (bf16_t*)(ws + WS_HK), (bf16_t*)(ws + WS_HV), (bf16_t*)(ws + WS_HG), (bf16_t*)(ws + WS_GA), (bf16_t*)(ws + WS_GB), (float*)(ws + WS_LF), (const float*)(ws + WS_LB)};
          run_gemm(lds, (const bf16_t*)(ws + WS_XN), (const bf16_t*)(ws + WS_WIN), MTOK, DINP, 2048, G, bx, E); }
        GSYNC();
        { PHASE_BEGIN
          small_norms(P, l, gw, NGW, lane);
          for (int u = vcu; u < NU; u += G) hgrn_pass1(lds, (const float*)(ws + WS_LF), (const bf16_t*)(ws + WS_HK), (const bf16_t*)(ws + WS_HV), (float*)(ws + WS_UT), (float*)(ws + WS_D), u, tid); }
        GSYNC();
        { PHASE_BEGIN
          for (int x = vcu; x < 768; x += G) hgrn_pass2(lds, P, l, x, tid); }
        GSYNC();
        { PHASE_BEGIN
          for (int u = vcu; u < NU; u += G) hgrn_pass3(lds, (const float*)(ws + WS_LF), (const bf16_t*)(ws + WS_HQ), (const bf16_t*)(ws + WS_HK), (const bf16_t*)(ws + WS_HV), (const bf16_t*)(ws + WS_HG),
                                                       (const bf16_t*)(ws + WS_SPT), P.in[14] + l * 128, (bf16_t*)(ws + WS_OH), u, tid); }
        GSYNC();
        { PHASE_BEGIN
          pg8::EpiQ E{(bf16_t*)(ws + WS_Q), (const float*)(ws + WS_TBL)}; run_gemm(lds, (const bf16_t*)(ws + WS_QN), (const bf16_t*)(ws + WS_WUQ), MTOK, 3072, 512, G, bx, E); }
        { PHASE_BEGIN
          pg8::EpiPlain E{(bf16_t*)(ws + WS_KN), 2048}; run_gemm(lds, (const bf16_t*)(ws + WS_CKV), (const bf16_t*)(ws + WS_WUK), KVR, 2048, 512, G, bx, E); }
        { PHASE_BEGIN
          pg8::EpiPlain E{(bf16_t*)(ws + WS_VT), KVR}; run_gemm(lds, (const bf16_t*)(ws + WS_WUV), (const bf16_t*)(ws + WS_CKV), 2048, KVR, 512, G, bx, E); }
        GSYNC();
        { PHASE_BEGIN
          for (int x = vcu; x < 256; x += G) { const int bh = x >> 2, j = x & 3; attn_prompt_unit(P, bh, 7 - j, wave, lane); attn_prompt_unit(P, bh, j, wave, lane); }
          for (int x = vcu; x < 128; x += G) attn_sample_unit(lds, P, x, wave, lane, tid); }
        GSYNC();
        { PHASE_BEGIN
          pg8::EpiGate<false> E{(const bf16_t*)(ws + WS_GA), (bf16_t*)(ws + WS_T)}; run_gemm(lds, (const bf16_t*)(ws + WS_OA), (const bf16_t*)(ws + WS_WOA), MTOK, 2048, 2048, G, bx, E); }
        { PHASE_BEGIN
          pg8::EpiGate<true> E{(const bf16_t*)(ws + WS_GB), (bf16_t*)(ws + WS_T)}; run_gemm(lds, (const bf16_t*)(ws + WS_OH), (const bf16_t*)(ws + WS_WOB), MTOK, 2048, 2048, G, bx, E); }
        GSYNC();
        { PHASE_BEGIN
          pg8::EpiF32 E{(float*)(ws + WS_MIX), 2048}; run_gemm(lds, (const bf16_t*)(ws + WS_T), (const bf16_t*)(ws + WS_WOUT), MTOK, 2048, 2048, G, bx, E); }
        GSYNC();
        { PHASE_BEGIN
          resid_norm((const float*)(ws + WS_MIX), P.in[17] + l * 2048, P.out, P.in[18] + l * 2048, (bf16_t*)(ws + WS_XN), gw, NGW, lane); }
        GSYNC();
        { PHASE_BEGIN
          pg8::EpiRelu2 E{(bf16_t*)(ws + WS_H), FFN}; run_gemm(lds, (const bf16_t*)(ws + WS_XN), (const bf16_t*)(ws + WS_WUP), MTOK, FFN, 2048, G, bx, E); }
        GSYNC();
        { PHASE_BEGIN
          pg8::EpiF32 E{(float*)(ws + WS_M2), 2048}; run_gemm(lds, (const bf16_t*)(ws + WS_H), (const bf16_t*)(ws + WS_WDN), MTOK, 2048, FFN, G, bx, E); }
        GSYNC();
        { PHASE_BEGIN
          resid_norm((const float*)(ws + WS_M2), P.in[21] + l * 2048, P.out, l == 0 ? P.in[5] + 2048 : nullptr, (bf16_t*)(ws + WS_XN), gw, NGW, lane);
          if (l == 0) layer_prep(P, lds, 1, gw, NGW, gt, NGT, lane, wave); }
        if (l == 0) GSYNC();
    }
}

extern "C" void kernel_launch(void* const* d_in, const int* in_sizes, int n_in, void* d_out, int out_size, void* d_ws, size_t ws_size, hipStream_t stream) {
    static int grid = 0;
    if (grid == 0) {
        if (n_in != 22 || (size_t)out_size != OUT_TOTAL || ws_size < WS_END) { fprintf(stderr, "kernel_launch: unexpected shapes (n_in %d, out %d, ws %zu, need %zu)\n", n_in, out_size, ws_size, (size_t)WS_END); grid = -1; return; }
        int dev = 0, cus = 0, per_cu = 0;
        if (hipGetDevice(&dev) != hipSuccess || hipDeviceGetAttribute(&cus, hipDeviceAttributeMultiprocessorCount, dev) != hipSuccess) { grid = -1; return; }
        if (hipFuncSetAttribute((const void*)fwd_kernel, hipFuncAttributeMaxDynamicSharedMemorySize, LDS_BYTES) != hipSuccess) { fprintf(stderr, "kernel_launch: hipFuncSetAttribute failed\n"); grid = -1; return; }
        if (hipOccupancyMaxActiveBlocksPerMultiprocessor(&per_cu, (const void*)fwd_kernel, 512, LDS_BYTES) != hipSuccess || per_cu < 1) { fprintf(stderr, "kernel_launch: occupancy query failed (%d)\n", per_cu); per_cu = 1; }
        (void)hipGetLastError();
        grid = cus * per_cu;
    }
    if (grid < 0) return;
    Params p{};
    for (int i = 0; i < 22; ++i) p.in[i] = (const float*)d_in[i];
    p.out = (float*)d_out; p.ws = (unsigned char*)d_ws;
    void* args[] = {&p};
    hipError_t e = hipLaunchCooperativeKernel((const void*)fwd_kernel, dim3(grid), dim3(512), args, LDS_BYTES, stream);
    if (e != hipSuccess) fprintf(stderr, "kernel_launch: cooperative launch failed: %s (grid %d)\n", hipGetErrorString(e), grid);
}
```

```cpp
#include <hip/hip_runtime.h>
#include <hip/hip_cooperative_groups.h>
#include <cstdio>
#include <cstdint>
namespace cg = cooperative_groups;

#define DI __device__ __forceinline__
#define LAS __attribute__((address_space(3)))
typedef short bf16x8 __attribute__((ext_vector_type(8)));
typedef short s16x4 __attribute__((ext_vector_type(4)));
typedef float f32x4 __attribute__((ext_vector_type(4)));
typedef float f32x16 __attribute__((ext_vector_type(16)));
typedef unsigned u32x4 __attribute__((ext_vector_type(4)));
typedef unsigned u32x2 __attribute__((ext_vector_type(2)));
typedef float f32x2_t __attribute__((ext_vector_type(2)));
typedef __bf16 bf16x2_t __attribute__((ext_vector_type(2)));

constexpr int MP = 8192, MS = 256, MTOK = 8448, DM = 2048, DINP = 13568, ZSW = 1280, FFN = 8192;
constexpr int KVB = 4160;
constexpr int KVR = 8192 + 8 * KVB;
constexpr int NU = 2048 + 128;
constexpr float EPS = 1e-6f;
constexpr float QSCALE = 0.07216878364870322f * 1.4426950408889634f;

constexpr size_t MiB = 1u << 20;
constexpr size_t WS_WIN = 0, WS_WUQ = 53 * MiB, WS_WUK = 56 * MiB, WS_WUV = 58 * MiB, WS_WOA = 60 * MiB, WS_WOB = 68 * MiB, WS_WOUT = 76 * MiB, WS_WUP = 84 * MiB, WS_WDN = 116 * MiB;
constexpr size_t WS_XN = 148 * MiB, WS_HG = 181 * MiB, WS_GA = 214 * MiB, WS_GB = 247 * MiB, WS_QN = 280 * MiB, WS_Q = 289 * MiB, WS_OA = 339 * MiB, WS_OH = 372 * MiB;
constexpr size_t WS_CKV = 405 * MiB, WS_KPE = 446 * MiB, WS_TBL = 452 * MiB, WS_LB = 453 * MiB, WS_D = 454 * MiB, WS_R = 456 * MiB;
constexpr size_t WS_SPT = WS_Q;
constexpr size_t WS_ZS = WS_R, WS_HQ = WS_R + 42 * MiB, WS_HK = WS_R + 75 * MiB, WS_HV = WS_R + 108 * MiB, WS_LF = WS_R + 141 * MiB, WS_UT = WS_R + 207 * MiB;
constexpr size_t WS_KN = WS_R, WS_VT = WS_R + 162 * MiB;
constexpr size_t WS_T = WS_R, WS_MIX = WS_R + 33 * MiB, WS_H = WS_R + 99 * MiB, WS_M2 = WS_R + 231 * MiB;
constexpr size_t WS_CTL = WS_R + 343 * MiB;
constexpr size_t WS_END = WS_CTL + 1 * MiB;
static_assert((size_t)NU * 128 * 128 * 2 <= 83 * MiB && (size_t)NU * 65536 <= 136 * MiB && (size_t)KVR * 2048 * 2 <= 162 * MiB, "ws map");

constexpr size_t OUT_X = 0, OUT_CKVP = 17301504, OUT_KPEP = OUT_CKVP + 8388608, OUT_STP = OUT_KPEP + 1048576, OUT_CKVS = OUT_STP + 2097152, OUT_KPES = OUT_CKVS + 262144, OUT_STS = OUT_KPES + 32768;
constexpr size_t OUT_TOTAL = OUT_STS + 4194304;

DI unsigned pk2(float lo, float hi) { f32x2_t v = {lo, hi}; bf16x2_t b = __builtin_convertvector(v, bf16x2_t); return __builtin_bit_cast(unsigned, b); }
DI unsigned short f2bf(float f) { return (unsigned short)(pk2(f, 0.f) & 0xffffu); }
DI float bf2f(unsigned short u) { return __uint_as_float((unsigned)u << 16); }
DI float bflo(unsigned w) { return __uint_as_float(w << 16); }
DI float bfhi(unsigned w) { return __uint_as_float(w & 0xffff0000u); }
DI float sigm(float x) { return 1.f / (1.f + __expf(-x)); }
DI float ex2(float x) { return __builtin_amdgcn_exp2f(x); }
DI float wave_sum(float v) {
#pragma unroll
    for (int o = 1; o < 64; o <<= 1) v += __shfl_xor(v, o);
    return v;
}
namespace pg8 {
#define PG8_LAS __attribute__((address_space(3)))
typedef unsigned short bf16_t;
typedef short bf16x8 __attribute__((ext_vector_type(8)));
typedef float f32x4 __attribute__((ext_vector_type(4)));
typedef unsigned u32x4 __attribute__((ext_vector_type(4)));
constexpr int BM = 256, BK = 64, HALF = 128, HTB = HALF * BK * 2  , STAGE_BYTES = 8 * HTB, NXCD = 8, WGM = 8;

__host__ __device__ __forceinline__ int lds_byte(int r, int c) { const int st = (r >> 4) * 2 + (c >> 5), rr = r & 15, cc = c & 31, ob = rr * 64 + cc * 2; return st * 1024 + (ob ^ (((ob >> 9) & 1) << 5)); }
__host__ __device__ __forceinline__ void stage_rc(int b, int& R, int& C) { const int st = b / 1024, sb = b % 1024, swz = sb ^ (((sb >> 9) & 1) << 5); R = (st >> 1) * 16 + swz / 64; C = (st & 1) * 32 + (swz % 64) / 2; }
__host__ __device__ __forceinline__ int perm32(int rho) { const int n = rho >> 4, i = rho & 15; return 8 * (i >> 2) + 4 * n + (i & 3); }

struct Unit { int pm, pn; };
struct Gemm { const bf16_t* A; const bf16_t* Bt; int M, N, K; };

struct StaticOrder {
    int nM, nN, nwg, G, c;
    __host__ __device__ void init(int M, int N, int G_, int c_) { nM = M / BM; nN = N / BM; nwg = nM * nN; G = G_; c = c_; }
    __host__ __device__ bool next(int i, Unit& u) const {
        const long L = (long)i * G + c; if (L >= nwg) return false;
        int wgid = (int)L; { const int q = nwg / NXCD, r = nwg % NXCD, xcd = wgid % NXCD, off = wgid / NXCD; wgid = (xcd < r ? xcd * (q + 1) : r * (q + 1) + (xcd - r) * q) + off; }
        const int nig = WGM * nN, gid = wgid / nig, fm = gid * WGM, gsz = (nM - fm) < WGM ? (nM - fm) : WGM;
        u.pm = fm + ((wgid % nig) % gsz); u.pn = (wgid % nig) / gsz; return true;
    }
    __device__ __forceinline__ void a_ready(const Unit&) const {}
    __device__ __forceinline__ void done(const Unit&) const {}
};

#define EPI_LOOP _Pragma("unroll") for (int ai = 0; ai < 2; ++ai) _Pragma("unroll") for (int m = 0; m < 4; ++m) _Pragma("unroll") for (int bj = 0; bj < 2; ++bj)
__device__ __forceinline__ u32x4 pack8f(const f32x4 a, const f32x4 b) { u32x4 w; w.x = pk2(a[0], a[1]); w.y = pk2(a[2], a[3]); w.z = pk2(b[0], b[1]); w.w = pk2(b[2], b[3]); return w; }

struct EpiWin {
    static constexpr bool PERM = true, AFTER_DRAIN = false;
    float* Zs; bf16_t *HQ, *HK, *HV, *HG, *GA, *GB; float* LF; const float* lb;
    __device__ __forceinline__ void operator()(const f32x4 (&acc)[2][2][4][2], const Unit& u, int wr, int wc, int fr, int fq) const {
        const int row0 = u.pm * 256 + wr * 64 + fr, ct = wc * 32 + 8 * fq, pn = u.pn;
        if (pn < 5) {
            EPI_LOOP { float* p = Zs + (size_t)(row0 + ai * 128 + m * 16) * ZSW + pn * 256 + ct + bj * 128; *(f32x4*)p = acc[ai][bj][m][0]; *(f32x4*)(p + 4) = acc[ai][bj][m][1]; }
            return;
        }
        const int seg = (pn - 5) >> 3, cseg = ((pn - 5) & 7) * 256 + ct;
        if (seg == 1) {
#pragma unroll
            for (int bj = 0; bj < 2; ++bj) {
                const f32x4 l0 = *(const f32x4*)(lb + cseg + bj * 128), l1 = *(const f32x4*)(lb + cseg + bj * 128 + 4);
#pragma unroll
                for (int ai = 0; ai < 2; ++ai)
#pragma unroll
                    for (int m = 0; m < 4; ++m) {
                        const size_t off = (size_t)(row0 + ai * 128 + m * 16) * 2048 + cseg + bj * 128;
                        f32x4 lf0, lf1, k0, k1;
#pragma unroll
                        for (int e = 0; e < 4; ++e) {
                            { const float z = acc[ai][bj][m][0][e], lbv = l0[e], ez = __expf(-z), sg = 1.f / (1.f + ez); lf0[e] = __logf(lbv + (1.f - lbv) * sg); k0[e] = (1.f - lbv) * ez * sg; }
                            { const float z = acc[ai][bj][m][1][e], lbv = l1[e], ez = __expf(-z), sg = 1.f / (1.f + ez); lf1[e] = __logf(lbv + (1.f - lbv) * sg); k1[e] = (1.f - lbv) * ez * sg; }
                        }
                        *(f32x4*)(LF + off) = lf0; *(f32x4*)(LF + off + 4) = lf1; *(u32x4*)(HK + off) = pack8f(k0, k1);
                    }
            }
            return;
        }
        bf16_t* O = seg == 0 ? HQ : seg == 2 ? HV : seg == 3 ? HG : seg == 4 ? GA : GB;
        const int act = (seg == 0 || seg == 3) ? 1 : (seg == 2 ? 0 : 2);
        EPI_LOOP {
            f32x4 a = acc[ai][bj][m][0], b = acc[ai][bj][m][1];
#pragma unroll
            for (int e = 0; e < 4; ++e) { const float sa = sigm(a[e]), sb = sigm(b[e]); a[e] = act == 0 ? a[e] : act == 1 ? a[e] * sa : sa; b[e] = act == 0 ? b[e] : act == 1 ? b[e] * sb : sb; }
            *(u32x4*)(O + (size_t)(row0 + ai * 128 + m * 16) * 2048 + cseg + bj * 128) = pack8f(a, b);
        }
    }
};

struct EpiQ {
    static constexpr bool PERM = true, AFTER_DRAIN = false;
    bf16_t* Q; const float* tbl;
    __device__ __forceinline__ void operator()(const f32x4 (&acc)[2][2][4][2], const Unit& u, int wr, int wc, int fr, int fq) const {
        const int row0 = u.pm * 256 + wr * 64 + fr, ct = wc * 32 + 8 * fq, pn = u.pn;
        if (pn < 8) {
            EPI_LOOP { const int col = pn * 256 + ct + bj * 128, h = col >> 7, i = col & 127;
                *(u32x4*)(Q + (size_t)(row0 + ai * 128 + m * 16) * 3072 + h * 192 + i) = pack8f(acc[ai][bj][m][0] * QSCALE, acc[ai][bj][m][1] * QSCALE); }
            return;
        }
        EPI_LOOP {
            const int row = row0 + ai * 128 + m * 16, p = row < MP ? (row & 2047) : 2048 + ((row - MP) & 31);
            const int c = (pn - 8) * 256 + ct + bj * 128, h = c >> 6, j0 = (c & 63) >> 1;
            const f32x4 t0 = *(const f32x4*)(tbl + (size_t)(p * 32 + j0) * 2), t1 = *(const f32x4*)(tbl + (size_t)(p * 32 + j0) * 2 + 4);
            const f32x4 x = acc[ai][bj][m][0] * QSCALE, y = acc[ai][bj][m][1] * QSCALE;
            const float a0 = x[0] * t0[0] - x[1] * t0[1], b0 = x[0] * t0[1] + x[1] * t0[0];
            const float a1 = x[2] * t0[2] - x[3] * t0[3], b1 = x[2] * t0[3] + x[3] * t0[2];
            const float a2 = y[0] * t1[0] - y[1] * t1[1], b2 = y[0] * t1[1] + y[1] * t1[0];
            const float a3 = y[2] * t1[2] - y[3] * t1[3], b3 = y[2] * t1[3] + y[3] * t1[2];
            bf16_t* q = Q + (size_t)row * 3072 + h * 192 + 128 + j0;
            u32x2 w1, w2; w1.x = pk2(a0, a1); w1.y = pk2(a2, a3); w2.x = pk2(b0, b1); w2.y = pk2(b2, b3);
            *(u32x2*)q = w1; *(u32x2*)(q + 32) = w2;
            if (bj == 1) asm volatile("" ::: "memory");
        }
    }
};

struct EpiPlain {
    static constexpr bool PERM = true, AFTER_DRAIN = false;
    bf16_t* O; int ldc;
    __device__ __forceinline__ void operator()(const f32x4 (&acc)[2][2][4][2], const Unit& u, int wr, int wc, int fr, int fq) const {
        const int row0 = u.pm * 256 + wr * 64 + fr, c0 = u.pn * 256 + wc * 32 + 8 * fq;
        EPI_LOOP { *(u32x4*)(O + (size_t)(row0 + ai * 128 + m * 16) * ldc + c0 + bj * 128) = pack8f(acc[ai][bj][m][0], acc[ai][bj][m][1]); }
    }
};
struct EpiF32 {
    static constexpr bool PERM = true, AFTER_DRAIN = false;
    float* O; int ldc;
    __device__ __forceinline__ void operator()(const f32x4 (&acc)[2][2][4][2], const Unit& u, int wr, int wc, int fr, int fq) const {
        const int row0 = u.pm * 256 + wr * 64 + fr, c0 = u.pn * 256 + wc * 32 + 8 * fq;
        EPI_LOOP { float* p = O + (size_t)(row0 + ai * 128 + m * 16) * ldc + c0 + bj * 128; *(f32x4*)p = acc[ai][bj][m][0]; *(f32x4*)(p + 4) = acc[ai][bj][m][1]; }
    }
};
struct EpiRelu2 {
    static constexpr bool PERM = true, AFTER_DRAIN = false;
    bf16_t* O; int ldc;
    __device__ __forceinline__ void operator()(const f32x4 (&acc)[2][2][4][2], const Unit& u, int wr, int wc, int fr, int fq) const {
        const int row0 = u.pm * 256 + wr * 64 + fr, c0 = u.pn * 256 + wc * 32 + 8 * fq;
        EPI_LOOP { f32x4 a = acc[ai][bj][m][0], b = acc[ai][bj][m][1];
#pragma unroll
            for (int e = 0; e < 4; ++e) { const float ra = fmaxf(a[e], 0.f), rb = fmaxf(b[e], 0.f); a[e] = ra * ra; b[e] = rb * rb; }
            *(u32x4*)(O + (size_t)(row0 + ai * 128 + m * 16) * ldc + c0 + bj * 128) = pack8f(a, b); }
    }
};
template <bool SECOND> struct EpiGate {
    static constexpr bool PERM = true, AFTER_DRAIN = false;
    const bf16_t* Gt; bf16_t* T;
    __device__ __forceinline__ void operator()(const f32x4 (&acc)[2][2][4][2], const Unit& u, int wr, int wc, int fr, int fq) const {
        const int row0 = u.pm * 256 + wr * 64 + fr, c0 = u.pn * 256 + wc * 32 + 8 * fq;
        EPI_LOOP { const size_t off = (size_t)(row0 + ai * 128 + m * 16) * 2048 + c0 + bj * 128;
            const u32x4 g = *(const u32x4*)(Gt + off); f32x4 a = acc[ai][bj][m][0], b = acc[ai][bj][m][1];
            a[0] *= bflo(g.x); a[1] *= bfhi(g.x); a[2] *= bflo(g.y); a[3] *= bfhi(g.y); b[0] *= bflo(g.z); b[1] *= bfhi(g.z); b[2] *= bflo(g.w); b[3] *= bfhi(g.w);
            if (SECOND) { const u32x4 t = *(const u32x4*)(T + off);
                a[0] += bflo(t.x); a[1] += bfhi(t.x); a[2] += bflo(t.y); a[3] += bfhi(t.y); b[0] += bflo(t.z); b[1] += bfhi(t.z); b[2] += bflo(t.w); b[3] += bfhi(t.w); }
            *(u32x4*)(T + off) = pack8f(a, b);
            if (bj == 1 && (m & 1)) asm volatile("" ::: "memory"); }
    }
};
template <class Epi, class Sched, bool ALIGN_EPI = false, bool SP2 = false>
__device__ __forceinline__ void gemm_phase(PG8_LAS unsigned char* lds, const Gemm g, const Sched& S, const Epi& E) {
    int tid_l = threadIdx.x; asm volatile("" : "+v"(tid_l));
    const int tid = tid_l, wid = __builtin_amdgcn_readfirstlane(tid >> 6), lane = tid & 63, wr = wid >> 2, wc = wid & 3, fr = lane & 15, fq = lane >> 4;
    const int K = g.K, nt = K / BK;
    unsigned voffA[2], voffB[2];
#pragma unroll
    for (int i = 0; i < 2; ++i) { int R, C; stage_rc(tid * 16 + i * 8192, R, C); const int Rb = Epi::PERM ? ((R & ~31) + perm32(R & 31)) : R;
        voffA[i] = (unsigned)(R * K + C) * 2u; voffB[i] = (unsigned)(Rb * K + C) * 2u; }
    const size_t kstep = (size_t)(BK * 2);
    const size_t hstep = (size_t)HALF * K * 2;
    const size_t tstep = 2 * hstep;
    const unsigned ldsw = (unsigned)wid * 1024u;
    const int aoff = lds_byte(wr * 64 + fr, fq * 8), boff = lds_byte(wc * 32 + fr, fq * 8);
#define PG8_SA(b, h) (((b) * 2 + (h)) * HTB)
#define PG8_SB(b, h) ((4 + (b) * 2 + (h)) * HTB)
#define PG8_STAGE(bufoff, gbase, voff) do { _Pragma("unroll") for (int _i = 0; _i < 2; ++_i) \
        __builtin_amdgcn_global_load_lds((const unsigned*)((const char*)(gbase) + (voff)[_i]), (PG8_LAS unsigned*)(lds + (bufoff) + ldsw + _i * 8192), 16, 0, 0); } while (0)
#define PG8_LDA(dst, b, h) do { _Pragma("unroll") for (int m = 0; m < 4; ++m) _Pragma("unroll") for (int k = 0; k < 2; ++k) dst[m][k] = *(const PG8_LAS bf16x8*)(lds + PG8_SA(b, h) + aoff + m * 2048 + k * 1024); } while (0)
#define PG8_LDB(dst, b, h) do { _Pragma("unroll") for (int n = 0; n < 2; ++n) _Pragma("unroll") for (int k = 0; k < 2; ++k) dst[n][k] = *(const PG8_LAS bf16x8*)(lds + PG8_SB(b, h) + boff + n * 2048 + k * 1024); } while (0)
#define PG8_MMA(ai, bj, At, Bt) do { __builtin_amdgcn_s_setprio(1); _Pragma("unroll") for (int m = 0; m < 4; ++m) _Pragma("unroll") for (int n = 0; n < 2; ++n) _Pragma("unroll") for (int k = 0; k < 2; ++k) \
        acc[ai][bj][m][n] = __builtin_amdgcn_mfma_f32_16x16x32_bf16(Bt[n][k], At[m][k], acc[ai][bj][m][n], 0, 0, 0); __builtin_amdgcn_s_setprio(0); } while (0)
#define PG8_WAIT_V(n) asm volatile("s_waitcnt vmcnt(" #n ")" ::: "memory")
#define PG8_WAIT_L(n) asm volatile("s_waitcnt lgkmcnt(" #n ")" ::: "memory")
#define PG8_BAR __builtin_amdgcn_s_barrier()
#define PG8_SCHED __builtin_amdgcn_sched_barrier(0)
    Unit cur, nxt; int ui = 0;
    if (!S.next(0, cur)) return;
    f32x4 acc[2][2][4][2];
#pragma unroll
    for (int a = 0; a < 2; ++a)
#pragma unroll
        for (int b = 0; b < 2; ++b)
#pragma unroll
            for (int m = 0; m < 4; ++m)
#pragma unroll
                for (int n = 0; n < 2; ++n) acc[a][b][m][n] = (f32x4){0.f, 0.f, 0.f, 0.f};
    bf16x8 At[4][2], B0[2][2], B1[2][2];
    const char* cA = (const char*)g.A + (size_t)cur.pm * tstep; const char* cB = (const char*)g.Bt + (size_t)cur.pn * tstep;
    S.a_ready(cur);
    if constexpr (SP2) {
        PG8_STAGE(PG8_SB(0, 0), cB, voffB); PG8_STAGE(PG8_SB(0, 1), cB + hstep, voffB); PG8_STAGE(PG8_SA(0, 0), cA, voffA); PG8_STAGE(PG8_SA(0, 1), cA + hstep, voffA);
        if (wr == 1) PG8_BAR;
        PG8_WAIT_V(2); PG8_BAR;
        PG8_STAGE(PG8_SB(1, 0), cB + kstep, voffB); PG8_STAGE(PG8_SA(1, 0), cA + kstep, voffA); PG8_STAGE(PG8_SB(1, 1), cB + hstep + kstep, voffB);
        PG8_WAIT_V(6); PG8_BAR;
    } else {
        PG8_STAGE(PG8_SB(0, 0), cB, voffB); PG8_STAGE(PG8_SA(0, 0), cA, voffA); PG8_STAGE(PG8_SB(0, 1), cB + hstep, voffB); PG8_STAGE(PG8_SA(0, 1), cA + hstep, voffA);
        if (wr == 1) PG8_BAR;
        PG8_WAIT_V(4); PG8_BAR;
        PG8_STAGE(PG8_SB(1, 0), cB + kstep, voffB); PG8_STAGE(PG8_SA(1, 0), cA + kstep, voffA); PG8_STAGE(PG8_SB(1, 1), cB + hstep + kstep, voffB);
        PG8_WAIT_V(6); PG8_BAR;
    }
    for (;;) {
        const bool has_next = S.next(ui + 1, nxt);
        const char* nA = has_next ? (const char*)g.A + (size_t)nxt.pm * tstep : cA; const char* nB = has_next ? (const char*)g.Bt + (size_t)nxt.pn * tstep : cB;
        for (int t = 0; t < nt; t += 2) {
            const bool last = (t == nt - 2);
            const char* a1 = cA + (size_t)(t + 1) * kstep;
            const char* a2 = last ? nA : cA + (size_t)(t + 2) * kstep; const char* b2 = last ? nB : cB + (size_t)(t + 2) * kstep;
            const char* a3 = a2 + kstep; const char* b3 = b2 + kstep;
            if (last && has_next) S.a_ready(nxt);
            if constexpr (SP2) {
            PG8_LDB(B0, 0, 0); PG8_LDB(B1, 0, 1); PG8_SCHED; PG8_LDA(At, 0, 0); PG8_STAGE(PG8_SA(1, 1), a1 + hstep, voffA);
            PG8_WAIT_V(8); PG8_WAIT_L(0); PG8_BAR; PG8_MMA(0, 0, At, B0); PG8_MMA(0, 1, At, B1); PG8_BAR; PG8_SCHED;
            PG8_LDA(At, 0, 1); PG8_STAGE(PG8_SB(0, 0), b2, voffB); PG8_STAGE(PG8_SB(0, 1), b2 + hstep, voffB); PG8_STAGE(PG8_SA(0, 0), a2, voffA);
            PG8_WAIT_V(8); PG8_WAIT_L(0); PG8_BAR; PG8_MMA(1, 0, At, B0); PG8_MMA(1, 1, At, B1); PG8_BAR; PG8_SCHED;
            PG8_LDB(B0, 1, 0); PG8_LDB(B1, 1, 1); PG8_SCHED; PG8_LDA(At, 1, 0); PG8_STAGE(PG8_SA(0, 1), a2 + hstep, voffA);
            PG8_WAIT_V(8); PG8_WAIT_L(0); PG8_BAR; PG8_MMA(0, 0, At, B0); PG8_MMA(0, 1, At, B1); PG8_BAR; PG8_SCHED;
            PG8_LDA(At, 1, 1); PG8_STAGE(PG8_SB(1, 0), b3, voffB); PG8_STAGE(PG8_SB(1, 1), b3 + hstep, voffB); PG8_STAGE(PG8_SA(1, 0), a3, voffA);
            PG8_WAIT_V(8); PG8_WAIT_L(0); PG8_BAR; PG8_MMA(1, 0, At, B0); PG8_MMA(1, 1, At, B1); PG8_BAR; PG8_SCHED;
            } else {
            PG8_LDB(B0, 0, 0); PG8_SCHED; PG8_LDA(At, 0, 0); PG8_STAGE(PG8_SA(1, 1), a1 + hstep, voffA);
            PG8_WAIT_L(8); PG8_BAR; PG8_WAIT_L(0); PG8_MMA(0, 0, At, B0); PG8_BAR; PG8_SCHED;
            PG8_LDB(B1, 0, 1); PG8_STAGE(PG8_SB(0, 0), b2, voffB);
            PG8_BAR; PG8_WAIT_L(0); PG8_MMA(0, 1, At, B1); PG8_BAR;
            PG8_LDA(At, 0, 1); PG8_STAGE(PG8_SA(0, 0), a2, voffA);
            PG8_BAR; PG8_WAIT_L(0); PG8_MMA(1, 0, At, B0); PG8_BAR; PG8_SCHED;
            PG8_STAGE(PG8_SB(0, 1), b2 + hstep, voffB);
            PG8_WAIT_V(6); PG8_BAR; PG8_MMA(1, 1, At, B1); PG8_BAR;
            PG8_LDB(B0, 1, 0); PG8_SCHED; PG8_LDA(At, 1, 0); PG8_STAGE(PG8_SA(0, 1), a2 + hstep, voffA);
            PG8_WAIT_L(8); PG8_BAR; PG8_WAIT_L(0); PG8_MMA(0, 0, At, B0); PG8_BAR; PG8_SCHED;
            PG8_LDB(B1, 1, 1); PG8_STAGE(PG8_SB(1, 0), b3, voffB);
            PG8_BAR; PG8_WAIT_L(0); PG8_MMA(0, 1, At, B1); PG8_BAR;
            PG8_LDA(At, 1, 1); PG8_STAGE(PG8_SA(1, 0), a3, voffA);
            PG8_BAR; PG8_WAIT_L(0); PG8_MMA(1, 0, At, B0); PG8_BAR; PG8_SCHED;
            PG8_STAGE(PG8_SB(1, 1), b3 + hstep, voffB);
            PG8_WAIT_V(6); PG8_BAR; PG8_MMA(1, 1, At, B1); PG8_BAR;
            }
        }
        if constexpr (ALIGN_EPI) { if (wr == 0) PG8_BAR; }
        if constexpr (!Epi::AFTER_DRAIN) { E(acc, cur, wr, wc, fr, fq); S.done(cur); }
        if (!has_next) break;
#pragma unroll
        for (int a = 0; a < 2; ++a)
#pragma unroll
            for (int b = 0; b < 2; ++b)
#pragma unroll
                for (int m = 0; m < 4; ++m)
#pragma unroll
                    for (int n = 0; n < 2; ++n) acc[a][b][m][n] = (f32x4){0.f, 0.f, 0.f, 0.f};
        cur = nxt; cA = nA; cB = nB; ++ui;
        if constexpr (ALIGN_EPI) { if (wr == 1) PG8_BAR; }
    }
    PG8_WAIT_V(0);
    if constexpr (!ALIGN_EPI) { if (wr == 0) PG8_BAR; }
    PG8_BAR;
    if constexpr (Epi::AFTER_DRAIN) { E.fused(acc, cur, wr, wc, fr, fq, lds, wid, lane); S.done(cur); }
#undef PG8_SA
#undef PG8_SB
#undef PG8_STAGE
#undef PG8_LDA
#undef PG8_LDB
#undef PG8_MMA
#undef PG8_WAIT_V
#undef PG8_WAIT_L
#undef PG8_BAR
#undef PG8_SCHED
}
}
using pg8::bf16_t;
#define MFMA32(a, b, c) __builtin_amdgcn_mfma_f32_32x32x16_bf16((a), (b), (c), 0, 0, 0)
#define LDS_WAIT() asm volatile("s_waitcnt lgkmcnt(0)" ::: "memory")
DI int crow(int i, int h) { return (i & 3) + 8 * (i >> 2) + 4 * h; }
template <int S> DI bf16x8 pack8(const f32x16& x) {
    u32x4 p; p.x = pk2(x[8 * S], x[8 * S + 1]); p.y = pk2(x[8 * S + 2], x[8 * S + 3]); p.z = pk2(x[8 * S + 4], x[8 * S + 5]); p.w = pk2(x[8 * S + 6], x[8 * S + 7]);
    return __builtin_bit_cast(bf16x8, p);
}
DI f32x16 zero16() { f32x16 z;
#pragma unroll
    for (int i = 0; i < 16; ++i) z[i] = 0.f; return z; }

struct Params { const float* in[22]; float* out; unsigned char* ws; };

enum { MAP_ID = 0, MAP_WIN = 1, MAP_WUQ = 2 };
template <int MAP> DI int dest_row(int n) {
    if (MAP == MAP_WIN) return n < 1088 ? n : n + 192;
    if (MAP == MAP_WUQ) { const int h = n / 192, i = n - h * 192; return i < 128 ? h * 128 + i : 2048 + h * 64 + 2 * ((i - 128) & 31) + ((i - 128) >> 5); }
    return n;
}
template <int MAP> DI void transpose_item(const float* __restrict__ W, int K, int N, bf16_t* __restrict__ WT, LAS float* scr, int item, int lane) {
    const int nblk = N / 32, kb = item / nblk, nb = item - kb * nblk, k0 = 64 * kb, n0 = 32 * nb;
#pragma unroll 8
    for (int i = 0; i < 32; ++i) { const int kk = 2 * i + (lane >> 5); scr[kk * 33 + (lane & 31)] = W[(size_t)(k0 + kk) * N + n0 + (lane & 31)]; }
    LDS_WAIT();
    const int c = lane & 7;
#pragma unroll
    for (int j = 0; j < 4; ++j) { const int n = (lane >> 3) + 8 * j; const LAS float* s = scr + (8 * c) * 33 + n;
        u32x4 o; o.x = pk2(s[0 * 33], s[1 * 33]); o.y = pk2(s[2 * 33], s[3 * 33]); o.z = pk2(s[4 * 33], s[5 * 33]); o.w = pk2(s[6 * 33], s[7 * 33]);
        *(u32x4*)(WT + (size_t)dest_row<MAP>(n0 + n) * K + k0 + 8 * c) = o; }
    LDS_WAIT();
}

DI void layer_prep(const Params& P, LAS unsigned char* lds, int l, int gw, int NGW, int gt, int NGT, int lane, int wave) {
    unsigned char* ws = P.ws;
    LAS float* scr = (LAS float*)(lds + wave * 16384);
    const float* w_in = P.in[6] + (size_t)l * 2048 * 13376; const float* w_uq = P.in[8] + (size_t)l * 512 * 3072;
    const float* w_uk = P.in[10] + (size_t)l * 512 * 2048;  const float* w_uv = P.in[11] + (size_t)l * 512 * 2048;
    const float* w_oa = P.in[12] + (size_t)l * 2048 * 2048; const float* w_ob = P.in[15] + (size_t)l * 2048 * 2048; const float* w_out = P.in[16] + (size_t)l * 2048 * 2048;
    const float* w_up = P.in[19] + (size_t)l * 2048 * 8192; const float* w_dn = P.in[20] + (size_t)l * 8192 * 2048;
    constexpr int I_IN = 32 * 418, I_UQ = 8 * 96, I_UK = 8 * 64, I_SQ = 32 * 64, I_UP = 32 * 256, I_DN = 128 * 64;
    constexpr int NIT = I_IN + I_UQ + 2 * I_UK + 3 * I_SQ + I_UP + I_DN;
    for (int it = gw; it < NIT; it += NGW) {
        int r = it;
        if (r < I_IN) { transpose_item<MAP_WIN>(w_in, 2048, 13376, (bf16_t*)(ws + WS_WIN), scr, r, lane); continue; } r -= I_IN;
        if (r < I_UQ) { transpose_item<MAP_WUQ>(w_uq, 512, 3072, (bf16_t*)(ws + WS_WUQ), scr, r, lane); continue; } r -= I_UQ;
        if (r < I_UK) { transpose_item<MAP_ID>(w_uk, 512, 2048, (bf16_t*)(ws + WS_WUK), scr, r, lane); continue; } r -= I_UK;
        if (r < I_UK) { transpose_item<MAP_ID>(w_uv, 512, 2048, (bf16_t*)(ws + WS_WUV), scr, r, lane); continue; } r -= I_UK;
        if (r < I_SQ) { transpose_item<MAP_ID>(w_oa, 2048, 2048, (bf16_t*)(ws + WS_WOA), scr, r, lane); continue; } r -= I_SQ;
        if (r < I_SQ) { transpose_item<MAP_ID>(w_ob, 2048, 2048, (bf16_t*)(ws + WS_WOB), scr, r, lane); continue; } r -= I_SQ;
        if (r < I_SQ) { transpose_item<MAP_ID>(w_out, 2048, 2048, (bf16_t*)(ws + WS_WOUT), scr, r, lane); continue; } r -= I_SQ;
        if (r < I_UP) { transpose_item<MAP_ID>(w_up, 2048, 8192, (bf16_t*)(ws + WS_WUP), scr, r, lane); continue; } r -= I_UP;
        transpose_item<MAP_ID>(w_dn, 8192, 2048, (bf16_t*)(ws + WS_WDN), scr, r, lane);
    }
    const u32x4 z4 = {0u, 0u, 0u, 0u};
    { u32x4* z = (u32x4*)((bf16_t*)(ws + WS_WIN) + (size_t)1088 * 2048); for (int i = gt; i < 192 * 2048 / 8; i += NGT) z[i] = z4; }
    bf16_t* CKV = (bf16_t*)(ws + WS_CKV); bf16_t* KPE = (bf16_t*)(ws + WS_KPE);
    const float* cc = P.in[2] + (size_t)l * 8 * 4096 * 512; const float* ck = P.in[3] + (size_t)l * 8 * 4096 * 64;
    for (int i = gt; i < 8 * 4096 * 512 / 8; i += NGT) { const int b = i >> 18, rem = i & 262143, t = rem >> 6, c8 = rem & 63;
        const f32x4 a = *(const f32x4*)(cc + (size_t)i * 8), bq = *(const f32x4*)(cc + (size_t)i * 8 + 4);
        u32x4 o; o.x = pk2(a[0], a[1]); o.y = pk2(a[2], a[3]); o.z = pk2(bq[0], bq[1]); o.w = pk2(bq[2], bq[3]);
        *(u32x4*)(CKV + (size_t)(MP + b * KVB + t) * 512 + c8 * 8) = o; }
    for (int i = gt; i < 8 * 4096 * 64 / 8; i += NGT) { const int b = i >> 15, rem = i & 32767, t = rem >> 3, c8 = rem & 7;
        const f32x4 a = *(const f32x4*)(ck + (size_t)i * 8), bq = *(const f32x4*)(ck + (size_t)i * 8 + 4);
        u32x4 o; o.x = pk2(a[0], a[1]); o.y = pk2(a[2], a[3]); o.z = pk2(bq[0], bq[1]); o.w = pk2(bq[2], bq[3]);
        *(u32x4*)(KPE + (size_t)(MP + b * KVB + t) * 64 + c8 * 8) = o; }
    for (int i = gt; i < 8 * 32 * 64; i += NGT) { const int b = i >> 11, rem = i & 2047; *(u32x4*)(CKV + (size_t)(MP + b * KVB + 4128) * 512 + rem * 8) = z4; }
    for (int i = gt; i < 8 * 32 * 8; i += NGT) { const int b = i >> 8, rem = i & 255; *(u32x4*)(KPE + (size_t)(MP + b * KVB + 4128) * 64 + rem * 8) = z4; }
    float* LB = (float*)(ws + WS_LB); const float* hl = P.in[13];
    for (int i = gt; i < 2048; i += NGT) LB[i] = l == 0 ? 0.f : 1.f / (1.f + expf(hl[i] - hl[2048 + i]));
}

DI void rope_table(const Params& P, int gt, int NGT) {
    float* T = (float*)(P.ws + WS_TBL);
    for (int i = gt; i < 2080 * 32; i += NGT) { const int p = i >> 5, j = i & 31; const int pos = p < 2048 ? p : 4096 + (p - 2048);
        const float inv = exp2f(-(float)j * (13.287712379549449f / 32.f)); const float ang = (float)pos * inv;
        const double a = (double)ang; const double kq = rint(a * 0.15915494309189535); const float rr = (float)(a - kq * 6.283185307179586);
        T[2 * i] = __cosf(rr); T[2 * i + 1] = __sinf(rr); }
}

DI void init_x(const Params& P, int gw, int NGW, int lane) {
    const float* g = P.in[5]; float* X = P.out; bf16_t* XN = (bf16_t*)(P.ws + WS_XN);
    for (int row = gw; row < MTOK; row += NGW) {
        const float* src = row < MP ? P.in[0] + (size_t)row * 2048 : P.in[1] + (size_t)(row - MP) * 2048;
        f32x4 v[8]; float ss = 0.f;
#pragma unroll
        for (int j = 0; j < 8; ++j) { v[j] = *(const f32x4*)(src + j * 256 + lane * 4); ss += v[j][0] * v[j][0] + v[j][1] * v[j][1] + v[j][2] * v[j][2] + v[j][3] * v[j][3]; }
        const float rs = rsqrtf(wave_sum(ss) * (1.f / 2048.f) + EPS);
#pragma unroll
        for (int j = 0; j < 8; ++j) { *(f32x4*)(X + (size_t)row * 2048 + j * 256 + lane * 4) = v[j];
            const f32x4 gg = *(const f32x4*)(g + j * 256 + lane * 4); u32x2 w; w.x = pk2(v[j][0] * rs * gg[0], v[j][1] * rs * gg[1]); w.y = pk2(v[j][2] * rs * gg[2], v[j][3] * rs * gg[3]);
            *(u32x2*)(XN + (size_t)row * 2048 + j * 256 + lane * 4) = w; }
    }
}
DI void resid_norm(const float* __restrict__ Y, const float* __restrict__ gY, float* X, const float* __restrict__ gN, bf16_t* XN, int gw, int NGW, int lane) {
    for (int row = gw; row < MTOK; row += NGW) {
        f32x4 y[8]; float ss = 0.f;
#pragma unroll
        for (int j = 0; j < 8; ++j) { y[j] = *(const f32x4*)(Y + (size_t)row * 2048 + j * 256 + lane * 4); ss += y[j][0] * y[j][0] + y[j][1] * y[j][1] + y[j][2] * y[j][2] + y[j][3] * y[j][3]; }
        const float rs = rsqrtf(wave_sum(ss) * (1.f / 2048.f) + EPS); float s2 = 0.f;
#pragma unroll
        for (int j = 0; j < 8; ++j) { const f32x4 gg = *(const f32x4*)(gY + j * 256 + lane * 4); const f32x4 x = *(const f32x4*)(X + (size_t)row * 2048 + j * 256 + lane * 4);
            y[j] = x + y[j] * rs * gg; *(f32x4*)(X + (size_t)row * 2048 + j * 256 + lane * 4) = y[j];
            s2 += y[j][0] * y[j][0] + y[j][1] * y[j][1] + y[j][2] * y[j][2] + y[j][3] * y[j][3]; }
        if (gN) {
            const float r2 = rsqrtf(wave_sum(s2) * (1.f / 2048.f) + EPS);
#pragma unroll
            for (int j = 0; j < 8; ++j) { const f32x4 gg = *(const f32x4*)(gN + j * 256 + lane * 4); u32x2 w; w.x = pk2(y[j][0] * r2 * gg[0], y[j][1] * r2 * gg[1]); w.y = pk2(y[j][2] * r2 * gg[2], y[j][3] * r2 * gg[3]);
                *(u32x2*)(XN + (size_t)row * 2048 + j * 256 + lane * 4) = w; }
        }
    }
}
DI void small_norms(const Params& P, int l, int gw, int NGW, int lane) {
    const float* Zs = (const float*)(P.ws + WS_ZS); bf16_t* QN = (bf16_t*)(P.ws + WS_QN); bf16_t* CKV = (bf16_t*)(P.ws + WS_CKV); bf16_t* KPE = (bf16_t*)(P.ws + WS_KPE);
    const float* tbl = (const float*)(P.ws + WS_TBL); const float* gq = P.in[7] + l * 512; const float* gkv = P.in[9] + l * 512;
    for (int row = gw; row < MTOK; row += NGW) {
        const float* z = Zs + (size_t)row * ZSW;
        const bool pr = row < MP; const int rs_ = row - MP;
        const int kvrow = pr ? row : MP + (rs_ >> 5) * KVB + 4096 + (rs_ & 31);
        const int p = pr ? (row & 2047) : 2048 + (rs_ & 31);
        float* oc = pr ? P.out + OUT_CKVP + ((size_t)l * MP + row) * 512 : P.out + OUT_CKVS + ((size_t)l * MS + rs_) * 512;
        float* ok = pr ? P.out + OUT_KPEP + ((size_t)l * MP + row) * 64 : P.out + OUT_KPES + ((size_t)l * MS + rs_) * 64;
        { const f32x4 a = *(const f32x4*)(z + lane * 8), b = *(const f32x4*)(z + lane * 8 + 4);
          const float ss = a[0] * a[0] + a[1] * a[1] + a[2] * a[2] + a[3] * a[3] + b[0] * b[0] + b[1] * b[1] + b[2] * b[2] + b[3] * b[3];
          const float rs = rsqrtf(wave_sum(ss) * (1.f / 512.f) + EPS); const f32x4 g0 = *(const f32x4*)(gq + lane * 8), g1 = *(const f32x4*)(gq + lane * 8 + 4);
          u32x4 o; o.x = pk2(a[0] * rs * g0[0], a[1] * rs * g0[1]); o.y = pk2(a[2] * rs * g0[2], a[3] * rs * g0[3]); o.z = pk2(b[0] * rs * g1[0], b[1] * rs * g1[1]); o.w = pk2(b[2] * rs * g1[2], b[3] * rs * g1[3]);
          *(u32x4*)(QN + (size_t)row * 512 + lane * 8) = o; }
        { const f32x4 a = *(const f32x4*)(z + 512 + lane * 8), b = *(const f32x4*)(z + 512 + lane * 8 + 4);
          const float ss = a[0] * a[0] + a[1] * a[1] + a[2] * a[2] + a[3] * a[3] + b[0] * b[0] + b[1] * b[1] + b[2] * b[2] + b[3] * b[3];
          const float rs = rsqrtf(wave_sum(ss) * (1.f / 512.f) + EPS); const f32x4 g0 = *(const f32x4*)(gkv + lane * 8), g1 = *(const f32x4*)(gkv + lane * 8 + 4);
          const f32x4 c0 = a * rs * g0, c1 = b * rs * g1;
          *(f32x4*)(oc + lane * 8) = c0; *(f32x4*)(oc + lane * 8 + 4) = c1;
          u32x4 o; o.x = pk2(c0[0], c0[1]); o.y = pk2(c0[2], c0[3]); o.z = pk2(c1[0], c1[1]); o.w = pk2(c1[2], c1[3]);
          *(u32x4*)(CKV + (size_t)kvrow * 512 + lane * 8) = o; }
        if (lane < 32) { const float x1 = z[1024 + lane], x2 = z[1056 + lane]; const float c = tbl[(size_t)(p * 32 + lane) * 2], s = tbl[(size_t)(p * 32 + lane) * 2 + 1];
          const float o1 = x1 * c - x2 * s, o2 = x1 * s + x2 * c; ok[lane] = o1; ok[32 + lane] = o2;
          KPE[(size_t)kvrow * 64 + lane] = f2bf(o1); KPE[(size_t)kvrow * 64 + 32 + lane] = f2bf(o2); }
    }
}

struct HUnit { int rowbase, nvalid, h; };
DI HUnit hunit(int u) { HUnit r; if (u < 2048) { const int sh = u >> 5, c = u & 31; r.h = sh & 15; r.rowbase = (sh >> 4) * 2048 + c * 64; r.nvalid = 64; } else { const int s = u - 2048; r.h = s & 15; r.rowbase = MP + (s >> 4) * 32; r.nvalid = 32; } return r; }
DI void hgrn_cumsum(const float* __restrict__ LF, LAS float* psum, const HUnit& hu, int k, int tq, float (&b)[16], float& b31, float& b63) {
    const float* p = LF + (size_t)(hu.rowbase + 16 * tq) * 2048 + hu.h * 128 + k; const bool valid = 16 * tq < hu.nvalid;
    float run = 0.f;
#pragma unroll
    for (int i = 0; i < 16; ++i) { const float v = valid ? p[(size_t)i * 2048] : 0.f; run += v; b[i] = run; }
    psum[tq * 128 + k] = run;
    __syncthreads();
    const float p0 = psum[k], p1 = psum[128 + k], p2 = psum[256 + k], p3 = psum[384 + k];
    const float off = (tq > 0 ? p0 : 0.f) + (tq > 1 ? p1 : 0.f) + (tq > 2 ? p2 : 0.f);
#pragma unroll
    for (int i = 0; i < 16; ++i) b[i] += off;
    b31 = p0 + p1; b63 = b31 + p2 + p3;
}
DI void hgrn_pass1(LAS unsigned char* lds, const float* __restrict__ LF, const bf16_t* __restrict__ HK, const bf16_t* __restrict__ HV, float* __restrict__ UT, float* __restrict__ Dv, int u, int tid) {
    LAS float* psum = (LAS float*)lds; LAS bf16_t* KhT = (LAS bf16_t*)(lds + 2048); LAS bf16_t* VTl = (LAS bf16_t*)(lds + 2048 + 18432);
    const HUnit hu = hunit(u); const int k = tid & 127, tq = tid >> 7; const bool valid = 16 * tq < hu.nvalid;
    float b[16], b31, b63; hgrn_cumsum(LF, psum, hu, k, tq, b, b31, b63);
    const size_t g0 = (size_t)(hu.rowbase + 16 * tq) * 2048 + hu.h * 128 + k;
    unsigned kw[8], vw[8];
#pragma unroll
    for (int i2 = 0; i2 < 8; ++i2) {
        float k0 = 0.f, k1 = 0.f; unsigned v0 = 0u, v1 = 0u;
        if (valid) { k0 = bf2f(HK[g0 + (size_t)(2 * i2) * 2048]) * __expf(b63 - b[2 * i2]); k1 = bf2f(HK[g0 + (size_t)(2 * i2 + 1) * 2048]) * __expf(b63 - b[2 * i2 + 1]);
                     v0 = HV[g0 + (size_t)(2 * i2) * 2048]; v1 = HV[g0 + (size_t)(2 * i2 + 1) * 2048]; }
        kw[i2] = pk2(k0, k1); vw[i2] = v0 | (v1 << 16);
    }
    { u32x4 a, c; a.x = kw[0]; a.y = kw[1]; a.z = kw[2]; a.w = kw[3]; c.x = kw[4]; c.y = kw[5]; c.z = kw[6]; c.w = kw[7];
      *(LAS u32x4*)(KhT + k * 72 + 16 * tq) = a; *(LAS u32x4*)(KhT + k * 72 + 16 * tq + 8) = c;
      a.x = vw[0]; a.y = vw[1]; a.z = vw[2]; a.w = vw[3]; c.x = vw[4]; c.y = vw[5]; c.z = vw[6]; c.w = vw[7];
      *(LAS u32x4*)(VTl + k * 72 + 16 * tq) = a; *(LAS u32x4*)(VTl + k * 72 + 16 * tq + 8) = c; }
    if (tq == 0) Dv[(size_t)u * 128 + k] = __expf(b63);
    __syncthreads();
    const int wave = tid >> 6, lane = tid & 63, r = lane & 31, hh = lane >> 5, vb = wave & 3, kg = wave >> 2;
#pragma unroll
    for (int kb2 = 0; kb2 < 2; ++kb2) {
        const int kbq = 2 * kg + kb2; f32x16 acc = zero16();
#pragma unroll
        for (int s = 0; s < 4; ++s) { const bf16x8 a = *(const LAS bf16x8*)(VTl + (32 * vb + r) * 72 + 16 * s + 8 * hh), bb = *(const LAS bf16x8*)(KhT + (32 * kbq + r) * 72 + 16 * s + 8 * hh); acc = MFMA32(a, bb, acc); }
        float* dst = UT + ((size_t)u * 128 + 32 * vb) * 128 + 32 * kbq + r;
#pragma unroll
        for (int i = 0; i < 16; ++i) dst[(size_t)crow(i, hh) * 128] = acc[i];
    }
    __syncthreads();
}
DI void hgrn_pass2(LAS unsigned char* lds, const Params& P, int l, int x, int tid) {
    const float* UT = (const float*)(P.ws + WS_UT); const float* Dv = (const float*)(P.ws + WS_D); bf16_t* SpT = (bf16_t*)(P.ws + WS_SPT);
    LAS float* tl = (LAS float*)lds;
    const bool sample = x >= 256; const int sidx = sample ? (x - 256) >> 2 : x >> 2, vq = x & 3;
    const int nch = sample ? 1 : 32, ubase = sample ? 2048 + sidx : sidx * 32;
    const int vloc = tid >> 4, k0 = (tid & 15) * 8, v = 32 * vq + vloc;
    const int kk = tid >> 2, vs = (tid & 3) * 8;
    float S[8];
#pragma unroll
    for (int i = 0; i < 8; ++i) S[i] = 0.f;
    if (sample) {
        const float* s0 = P.in[4] + ((size_t)l * 128 + sidx) * 16384 + (size_t)kk * 128 + 32 * vq + vs;
        const f32x4 a = *(const f32x4*)s0, b = *(const f32x4*)(s0 + 4);
#pragma unroll
        for (int i = 0; i < 4; ++i) { tl[kk * 33 + vs + i] = a[i]; tl[kk * 33 + vs + 4 + i] = b[i]; }
        __syncthreads();
#pragma unroll
        for (int i = 0; i < 8; ++i) S[i] = tl[(k0 + i) * 33 + vloc];
        __syncthreads();
    }
    size_t e = ((size_t)ubase * 128 + v) * 128 + k0;
    f32x4 u0 = *(const f32x4*)(UT + e), u1 = *(const f32x4*)(UT + e + 4), d0 = *(const f32x4*)(Dv + (size_t)ubase * 128 + k0), d1 = *(const f32x4*)(Dv + (size_t)ubase * 128 + k0 + 4);
    for (int c = 0; c < nch; ++c) {
        f32x4 nu0 = u0, nu1 = u1, nd0 = d0, nd1 = d1;
        if (c + 1 < nch) { const size_t e2 = e + 16384; nu0 = *(const f32x4*)(UT + e2); nu1 = *(const f32x4*)(UT + e2 + 4); nd0 = *(const f32x4*)(Dv + (size_t)(ubase + c + 1) * 128 + k0); nd1 = *(const f32x4*)(Dv + (size_t)(ubase + c + 1) * 128 + k0 + 4); }
        u32x4 o; o.x = pk2(S[0], S[1]); o.y = pk2(S[2], S[3]); o.z = pk2(S[4], S[5]); o.w = pk2(S[6], S[7]);
        *(u32x4*)(SpT + e) = o;
#pragma unroll
        for (int i = 0; i < 4; ++i) { S[i] = d0[i] * S[i] + u0[i]; S[4 + i] = d1[i] * S[4 + i] + u1[i]; }
        u0 = nu0; u1 = nu1; d0 = nd0; d1 = nd1; e += 16384;
    }
#pragma unroll
    for (int i = 0; i < 8; ++i) tl[(k0 + i) * 33 + vloc] = S[i];
    __syncthreads();
    float* o = (sample ? P.out + OUT_STS + ((size_t)l * 128 + sidx) * 16384 : P.out + OUT_STP + ((size_t)l * 64 + sidx) * 16384) + (size_t)kk * 128 + 32 * vq + vs;
    f32x4 a, b;
#pragma unroll
    for (int i = 0; i < 4; ++i) { a[i] = tl[kk * 33 + vs + i]; b[i] = tl[kk * 33 + vs + 4 + i]; }
    *(f32x4*)o = a; *(f32x4*)(o + 4) = b;
    __syncthreads();
}
DI void hgrn_pass3(LAS unsigned char* lds, const float* __restrict__ LF, const bf16_t* __restrict__ HQ, const bf16_t* __restrict__ HK, const bf16_t* __restrict__ HV, const bf16_t* __restrict__ HG,
                   const bf16_t* __restrict__ SpT, const float* __restrict__ gn, bf16_t* __restrict__ OH, int u, int tid) {
    LAS float* psum = (LAS float*)lds;
    LAS bf16_t* Qa = (LAS bf16_t*)(lds + 2048);
    LAS bf16_t* Qb = (LAS bf16_t*)(lds + 19456);
    LAS bf16_t* Ka = (LAS bf16_t*)(lds + 28160);
    LAS bf16_t* Kb = (LAS bf16_t*)(lds + 36864);
    LAS bf16_t* VTl = (LAS bf16_t*)(lds + 54272);
    LAS float* Ost = (LAS float*)(lds + 72704);
    const HUnit hu = hunit(u); const int k = tid & 127, tq = tid >> 7; const bool valid = 16 * tq < hu.nvalid;
    float b[16], b31, b63; hgrn_cumsum(LF, psum, hu, k, tq, b, b31, b63);
    const size_t g0 = (size_t)(hu.rowbase + 16 * tq) * 2048 + hu.h * 128 + k;
    unsigned vw[8];
#pragma unroll
    for (int i2 = 0; i2 < 8; ++i2) {
        unsigned vpair = 0u;
#pragma unroll
        for (int e = 0; e < 2; ++e) {
            const int i = 2 * i2 + e, t = 16 * tq + i;
            float q = 0.f, kk = 0.f; unsigned vv = 0u;
            if (valid) { q = bf2f(HQ[g0 + (size_t)i * 2048]); kk = bf2f(HK[g0 + (size_t)i * 2048]); vv = HV[g0 + (size_t)i * 2048]; }
            Qa[t * 136 + k] = f2bf(q * __expf(b[i]));
            if (tq >= 2) Qb[(t - 32) * 136 + k] = f2bf(q * __expf(b[i] - b31)); else Ka[t * 136 + k] = f2bf(kk * __expf(-b[i]));
            Kb[t * 136 + k] = f2bf(kk * __expf(b31 - b[i]));
            vpair |= vv << (16 * e);
        }
        vw[i2] = vpair;
    }
    { u32x4 a, c; a.x = vw[0]; a.y = vw[1]; a.z = vw[2]; a.w = vw[3]; c.x = vw[4]; c.y = vw[5]; c.z = vw[6]; c.w = vw[7];
      *(LAS u32x4*)(VTl + k * 72 + 16 * tq) = a; *(LAS u32x4*)(VTl + k * 72 + 16 * tq + 8) = c; }
    __syncthreads();
    const int wave = tid >> 6, lane = tid & 63, r = lane & 31, hh = lane >> 5, vb = wave & 3, tb = wave >> 2;
    f32x16 O = zero16();
    const LAS bf16_t* vrow = VTl + (32 * vb + r) * 72 + 4 * hh;
    if (tb == 0) {
        f32x16 A0 = zero16();
#pragma unroll
        for (int ks = 0; ks < 8; ++ks) { const bf16x8 a = *(const LAS bf16x8*)(Ka + r * 136 + 16 * ks + 8 * hh), q = *(const LAS bf16x8*)(Qa + r * 136 + 16 * ks + 8 * hh); A0 = MFMA32(a, q, A0); }
#pragma unroll
        for (int i = 0; i < 16; ++i) if (crow(i, hh) > r) A0[i] = 0.f;
        const bf16x8 p0 = pack8<0>(A0), p1 = pack8<1>(A0);
        { const s16x4 lo = *(const LAS s16x4*)(vrow), hi = *(const LAS s16x4*)(vrow + 8); O = MFMA32(__builtin_shufflevector(lo, hi, 0, 1, 2, 3, 4, 5, 6, 7), p0, O); }
        { const s16x4 lo = *(const LAS s16x4*)(vrow + 16), hi = *(const LAS s16x4*)(vrow + 24); O = MFMA32(__builtin_shufflevector(lo, hi, 0, 1, 2, 3, 4, 5, 6, 7), p1, O); }
    } else {
        f32x16 A0 = zero16(), A1 = zero16();
#pragma unroll
        for (int ks = 0; ks < 8; ++ks) { const bf16x8 q = *(const LAS bf16x8*)(Qb + r * 136 + 16 * ks + 8 * hh);
            const bf16x8 a0 = *(const LAS bf16x8*)(Kb + r * 136 + 16 * ks + 8 * hh), a1 = *(const LAS bf16x8*)(Kb + (32 + r) * 136 + 16 * ks + 8 * hh);
            A0 = MFMA32(a0, q, A0); A1 = MFMA32(a1, q, A1); }
#pragma unroll
        for (int i = 0; i < 16; ++i) if (crow(i, hh) > r) A1[i] = 0.f;
        const bf16x8 p0 = pack8<0>(A0), p1 = pack8<1>(A0), p2 = pack8<0>(A1), p3 = pack8<1>(A1);
        { const s16x4 lo = *(const LAS s16x4*)(vrow), hi = *(const LAS s16x4*)(vrow + 8); O = MFMA32(__builtin_shufflevector(lo, hi, 0, 1, 2, 3, 4, 5, 6, 7), p0, O); }
        { const s16x4 lo = *(const LAS s16x4*)(vrow + 16), hi = *(const LAS s16x4*)(vrow + 24); O = MFMA32(__builtin_shufflevector(lo, hi, 0, 1, 2, 3, 4, 5, 6, 7), p1, O); }
        { const s16x4 lo = *(const LAS s16x4*)(vrow + 32), hi = *(const LAS s16x4*)(vrow + 40); O = MFMA32(__builtin_shufflevector(lo, hi, 0, 1, 2, 3, 4, 5, 6, 7), p2, O); }
        { const s16x4 lo = *(const LAS s16x4*)(vrow + 48), hi = *(const LAS s16x4*)(vrow + 56); O = MFMA32(__builtin_shufflevector(lo, hi, 0, 1, 2, 3, 4, 5, 6, 7), p3, O); }
    }
    { const bf16_t* sp = SpT + ((size_t)u * 128 + 32 * vb + r) * 128 + 8 * hh;
#pragma unroll
      for (int ks = 0; ks < 8; ++ks) { const bf16x8 a = *(const bf16x8*)(sp + 16 * ks), q = *(const LAS bf16x8*)(Qa + (32 * tb + r) * 136 + 16 * ks + 8 * hh); O = MFMA32(a, q, O); } }
#pragma unroll
    for (int g = 0; g < 4; ++g) { f32x4 w; w[0] = O[4 * g]; w[1] = O[4 * g + 1]; w[2] = O[4 * g + 2]; w[3] = O[4 * g + 3]; *(LAS f32x4*)(Ost + (32 * tb + r) * 132 + 32 * vb + 8 * g + 4 * hh) = w; }
    __syncthreads();
    { const int t = tid >> 3, vs = (tid & 7) * 16;
      f32x4 x[4]; float ss = 0.f;
#pragma unroll
      for (int j = 0; j < 4; ++j) { x[j] = *(const LAS f32x4*)(Ost + t * 132 + vs + 4 * j); ss += x[j][0] * x[j][0] + x[j][1] * x[j][1] + x[j][2] * x[j][2] + x[j][3] * x[j][3]; }
      ss += __shfl_xor(ss, 1); ss += __shfl_xor(ss, 2); ss += __shfl_xor(ss, 4);
      const float rs = rsqrtf(ss * (1.f / 128.f) + EPS);
      if (t < hu.nvalid) {
          const size_t off = (size_t)(hu.rowbase + t) * 2048 + hu.h * 128 + vs;
          const u32x4 ga = *(const u32x4*)(HG + off), gb = *(const u32x4*)(HG + off + 8);
          const f32x4 n0 = *(const f32x4*)(gn + vs), n1 = *(const f32x4*)(gn + vs + 4), n2 = *(const f32x4*)(gn + vs + 8), n3 = *(const f32x4*)(gn + vs + 12);
          u32x4 oa, ob;
          oa.x = pk2(x[0][0] * rs * n0[0] * bflo(ga.x), x[0][1] * rs * n0[1] * bfhi(ga.x)); oa.y = pk2(x[0][2] * rs * n0[2] * bflo(ga.y), x[0][3] * rs * n0[3] * bfhi(ga.y));
          oa.z = pk2(x[1][0] * rs * n1[0] * bflo(ga.z), x[1][1] * rs * n1[1] * bfhi(ga.z)); oa.w = pk2(x[1][2] * rs * n1[2] * bflo(ga.w), x[1][3] * rs * n1[3] * bfhi(ga.w));
          ob.x = pk2(x[2][0] * rs * n2[0] * bflo(gb.x), x[2][1] * rs * n2[1] * bfhi(gb.x)); ob.y = pk2(x[2][2] * rs * n2[2] * bflo(gb.y), x[2][3] * rs * n2[3] * bfhi(gb.y));
          ob.z = pk2(x[3][0] * rs * n3[0] * bflo(gb.z), x[3][1] * rs * n3[1] * bfhi(gb.z)); ob.w = pk2(x[3][2] * rs * n3[2] * bflo(gb.w), x[3][3] * rs * n3[3] * bfhi(gb.w));
          *(u32x4*)(OH + off) = oa; *(u32x4*)(OH + off + 8) = ob;
      } }
    __syncthreads();
}

template <bool SAMPLE>
DI void attn_wave(const bf16_t* __restrict__ Qp, const bf16_t* __restrict__ Kn, const bf16_t* __restrict__ Kp, const bf16_t* __restrict__ Vt, int t0, int t1, int tstep, int nkeys,
                  float& m, float& l, f32x16 (&O)[4], int r, int hh) {
    bf16x8 qf[12];
#pragma unroll
    for (int s = 0; s < 12; ++s) qf[s] = *(const bf16x8*)(Qp + (size_t)r * 3072 + 16 * s + 8 * hh);
    m = -INFINITY; l = 0.f;
#pragma unroll
    for (int vb = 0; vb < 4; ++vb) O[vb] = zero16();
    for (int t = t0; t < t1; t += tstep) {
        const bf16_t* kn = Kn + (size_t)(64 * t + r) * 2048 + 8 * hh; const bf16_t* kp = Kp + (size_t)(64 * t + r) * 64 + 8 * hh;
        f32x16 S0 = zero16(), S1 = zero16();
#pragma unroll
        for (int s = 0; s < 8; ++s) { const bf16x8 a0 = *(const bf16x8*)(kn + 16 * s), a1 = *(const bf16x8*)(kn + 32 * 2048 + 16 * s); S0 = MFMA32(a0, qf[s], S0); S1 = MFMA32(a1, qf[s], S1); }
#pragma unroll
        for (int s = 0; s < 4; ++s) { const bf16x8 a0 = *(const bf16x8*)(kp + 16 * s), a1 = *(const bf16x8*)(kp + 32 * 64 + 16 * s); S0 = MFMA32(a0, qf[8 + s], S0); S1 = MFMA32(a1, qf[8 + s], S1); }
        if (SAMPLE) { if (64 * t + 64 > nkeys) {
#pragma unroll
            for (int i = 0; i < 16; ++i) { if (64 * t + crow(i, hh) >= nkeys) S0[i] = -INFINITY; if (64 * t + 32 + crow(i, hh) >= nkeys) S1[i] = -INFINITY; } } }
        float mx = fmaxf(S0[0], S1[0]);
#pragma unroll
        for (int i = 1; i < 16; ++i) mx = fmaxf(mx, fmaxf(S0[i], S1[i]));
        mx = fmaxf(mx, __shfl_xor(mx, 32));
        const float mn = fmaxf(m, mx), alpha = ex2(m - mn); m = mn;
        float ls = 0.f;
#pragma unroll
        for (int i = 0; i < 16; ++i) { S0[i] = ex2(S0[i] - mn); S1[i] = ex2(S1[i] - mn); ls += S0[i] + S1[i]; }
        l = l * alpha + ls;
#pragma unroll
        for (int vb = 0; vb < 4; ++vb) O[vb] = O[vb] * alpha;
        const bf16x8 p0 = pack8<0>(S0), p1 = pack8<1>(S0), p2 = pack8<0>(S1), p3 = pack8<1>(S1);
#pragma unroll
        for (int vb = 0; vb < 4; ++vb) {
            const bf16_t* vp = Vt + (size_t)(32 * vb + r) * KVR + 64 * t + 4 * hh;
            { const s16x4 lo = *(const s16x4*)(vp), hi = *(const s16x4*)(vp + 8); O[vb] = MFMA32(__builtin_shufflevector(lo, hi, 0, 1, 2, 3, 4, 5, 6, 7), p0, O[vb]); }
            { const s16x4 lo = *(const s16x4*)(vp + 16), hi = *(const s16x4*)(vp + 24); O[vb] = MFMA32(__builtin_shufflevector(lo, hi, 0, 1, 2, 3, 4, 5, 6, 7), p1, O[vb]); }
            { const s16x4 lo = *(const s16x4*)(vp + 32), hi = *(const s16x4*)(vp + 40); O[vb] = MFMA32(__builtin_shufflevector(lo, hi, 0, 1, 2, 3, 4, 5, 6, 7), p2, O[vb]); }
            { const s16x4 lo = *(const s16x4*)(vp + 48), hi = *(const s16x4*)(vp + 56); O[vb] = MFMA32(__builtin_shufflevector(lo, hi, 0, 1, 2, 3, 4, 5, 6, 7), p3, O[vb]); }
        }
    }
}
DI void attn_prompt_unit(const Params& P, int bh, int jq, int wave, int lane) {
    const bf16_t* Q = (const bf16_t*)(P.ws + WS_Q); const bf16_t* KN = (const bf16_t*)(P.ws + WS_KN); const bf16_t* KPE = (const bf16_t*)(P.ws + WS_KPE); const bf16_t* VT = (const bf16_t*)(P.ws + WS_VT);
    bf16_t* OA = (bf16_t*)(P.ws + WS_OA);
    const int b = bh >> 4, h = bh & 15, rb = 8 * jq + wave, row0 = b * 2048 + 32 * rb, kv0 = b * 2048, r = lane & 31, hh = lane >> 5;
    float m, l; f32x16 O[4];
    attn_wave<false>(Q + (size_t)row0 * 3072 + h * 192, KN + (size_t)kv0 * 2048 + h * 128, KPE + (size_t)kv0 * 64, VT + (size_t)(h * 128) * KVR + kv0, 0, (rb >> 1) + 1, 1, 0, m, l, O, r, hh);
    l += __shfl_xor(l, 32); const float inv = 1.f / l;
#pragma unroll
    for (int vb = 0; vb < 4; ++vb)
#pragma unroll
        for (int g = 0; g < 4; ++g) { u32x2 w; w.x = pk2(O[vb][4 * g] * inv, O[vb][4 * g + 1] * inv); w.y = pk2(O[vb][4 * g + 2] * inv, O[vb][4 * g + 3] * inv);
            *(u32x2*)(OA + (size_t)(row0 + r) * 2048 + h * 128 + 32 * vb + 8 * g + 4 * hh) = w; }
}
DI void attn_sample_unit(LAS unsigned char* lds, const Params& P, int su, int wave, int lane, int tid) {
    const bf16_t* Q = (const bf16_t*)(P.ws + WS_Q); const bf16_t* KN = (const bf16_t*)(P.ws + WS_KN); const bf16_t* KPE = (const bf16_t*)(P.ws + WS_KPE); const bf16_t* VT = (const bf16_t*)(P.ws + WS_VT);
    bf16_t* OA = (bf16_t*)(P.ws + WS_OA);
    const int b = su >> 4, h = su & 15, row0 = MP + b * 32, kv0 = MP + b * KVB, r = lane & 31, hh = lane >> 5;
    float m, l; f32x16 O[4];
    attn_wave<true>(Q + (size_t)row0 * 3072 + h * 192, KN + (size_t)kv0 * 2048 + h * 128, KPE + (size_t)kv0 * 64, VT + (size_t)(h * 128) * KVR + kv0, wave, 65, 8, 4128, m, l, O, r, hh);
    l += __shfl_xor(l, 32);
    LAS float* ml = (LAS float*)(lds + 131072);
    if (hh == 0) { ml[(wave * 32 + r) * 2] = m; ml[(wave * 32 + r) * 2 + 1] = l; }
    __syncthreads();
    float ms = -INFINITY;
#pragma unroll
    for (int w = 0; w < 8; ++w) ms = fmaxf(ms, ml[(w * 32 + r) * 2]);
    float L = 0.f;
#pragma unroll
    for (int w = 0; w < 8; ++w) L += ml[(w * 32 + r) * 2 + 1] * ex2(ml[(w * 32 + r) * 2] - ms);
    const float sc = ex2(m - ms) / L;
    LAS float* slot = (LAS float*)(lds + wave * 16384);
#pragma unroll
    for (int vb = 0; vb < 4; ++vb)
#pragma unroll
        for (int i = 0; i < 16; ++i) slot[(32 * vb + crow(i, hh)) * 32 + r] = O[vb][i] * sc;
    __syncthreads();
    { const int q = tid & 31, vg = tid >> 5; float a[8];
#pragma unroll
      for (int e = 0; e < 8; ++e) { float s = 0.f;
#pragma unroll
          for (int w = 0; w < 8; ++w) s += ((const LAS float*)(lds + w * 16384))[(8 * vg + e) * 32 + q];
          a[e] = s; }
      u32x4 o; o.x = pk2(a[0], a[1]); o.y = pk2(a[2], a[3]); o.z = pk2(a[4], a[5]); o.w = pk2(a[6], a[7]);
      *(u32x4*)(OA + (size_t)(row0 + q) * 2048 + h * 128 + 8 * vg) = o; }
    __syncthreads();
}

#define XB_TMO      128
#define XB_XCNT(j)  (256  + 64 * (j))
#define XB_XSUB(j)  (1280 + 64 * (j))
#define XB_XGEN(j)  (2304 + 64 * (j))
#define XB_TOP      3328
#define XB_TOPGEN   3392
#define XCD_BAR_WORDS 3456
#define XB_SPIN_CAP (1u << 18)

__device__ __forceinline__ unsigned xb_ld(unsigned* p)              { return __hip_atomic_load(p, __ATOMIC_RELAXED, __HIP_MEMORY_SCOPE_AGENT); }
__device__ __forceinline__ unsigned xb_add(unsigned* p, unsigned v) { return __hip_atomic_fetch_add(p, v, __ATOMIC_RELAXED, __HIP_MEMORY_SCOPE_AGENT); }
__device__ __forceinline__ unsigned xb_xcc_id() { return (unsigned)__builtin_amdgcn_s_getreg((3 << 11) | 20) & 0xFu; }
#define XB_SPIN(cond, bar) do { unsigned _sp = 0; while (cond) { __builtin_amdgcn_s_sleep(1); \
    if ((++_sp & 255u) == 0u) { if (xb_ld(&(bar)[XB_TMO])) break; if (_sp > XB_SPIN_CAP) { atomicAdd(&(bar)[XB_TMO], 1u); break; } } } } while (0)

struct XcdBarrier {
    unsigned* bar; unsigned x;
    volatile LAS unsigned* st;
};

__device__ __forceinline__ XcdBarrier xcd_barrier_post(unsigned* bar, volatile LAS unsigned* st) {
    XcdBarrier b; b.bar = bar; b.x = xb_xcc_id(); b.st = st;
    if (threadIdx.x == 0) (void)xb_add(&bar[XB_XCNT(b.x)], 1u);
    return b;
}
__device__ __forceinline__ void xcd_barrier_complete(unsigned* bar, unsigned x, unsigned& nloc, unsigned& nx) {
    const unsigned G = gridDim.x * gridDim.y * gridDim.z;
    unsigned sum, cnt, mine, sp = 0u;
    for (;;) {
        sum = 0u; cnt = 0u; mine = 0u;
#pragma unroll
        for (unsigned j = 0; j < 16; ++j) { const unsigned c = xb_ld(&bar[XB_XCNT(j)]); sum += c; cnt += (c > 0u) ? 1u : 0u; mine = (j == x) ? c : mine; }
        if (sum == G) break;
        __builtin_amdgcn_s_sleep(1);
        if ((++sp & 255u) == 0u) { if (xb_ld(&bar[XB_TMO])) break; if (sp > XB_SPIN_CAP) { atomicAdd(&bar[XB_TMO], 1u); break; } }
    }
    nloc = mine > 0u ? mine : 1u; nx = cnt > 0u ? cnt : 1u;
}

__device__ __forceinline__ void xcd_barrier(const XcdBarrier& b) {
    asm volatile("s_waitcnt vmcnt(0)" ::: "memory");
    __syncthreads();
    if (threadIdx.x == 0) {
        unsigned* bar = b.bar;
        __builtin_amdgcn_s_waitcnt(0);
        unsigned nloc = b.st[0], nx = b.st[1];
        if (nloc == 0u) { xcd_barrier_complete(bar, b.x, nloc, nx); b.st[0] = nloc; b.st[1] = nx; }
        const unsigned old = xb_add(&bar[XB_XSUB(b.x)], 1u);
        const unsigned gen = old / nloc;
        if (old + 1u == (gen + 1u) * nloc) {
            __builtin_amdgcn_fence(__ATOMIC_RELEASE, "agent");
            asm volatile("s_waitcnt vmcnt(0)" ::: "memory");
            const unsigned og = xb_add(&bar[XB_TOP], 1u);
            const unsigned tg = og / nx;
            if (og + 1u == (tg + 1u) * nx) xb_add(&bar[XB_TOPGEN], 1u);
            else XB_SPIN(xb_ld(&bar[XB_TOPGEN]) == tg, bar);
            __builtin_amdgcn_fence(__ATOMIC_ACQUIRE, "agent");
            xb_add(&bar[XB_XGEN(b.x)], 1u);
            asm volatile("s_waitcnt vmcnt(0)" ::: "memory");
        } else {
            XB_SPIN(xb_ld(&bar[XB_XGEN(b.x)]) == gen, bar);
            __builtin_amdgcn_fence(__ATOMIC_ACQUIRE, "agent");
            asm volatile("s_waitcnt vmcnt(0)" ::: "memory");
        }
    }
    __syncthreads();
}

constexpr int LDS_BYTES = 147456;
template <class Epi> DI void run_gemm(LAS unsigned char* lds, const bf16_t* A, const bf16_t* Bt, int M_, int N_, int K_, int G, int c, const Epi& E) {
    pg8::Gemm g{A, Bt, M_, N_, K_}; pg8::StaticOrder S; S.init(M_, N_, G, c);
    pg8::gemm_phase<Epi, pg8::StaticOrder, true, true>(lds, g, S, E);
}

typedef const __attribute__((address_space(4))) Params CParams;
#define PHASE_BEGIN \
    Params P; { CParams* pp_ = (CParams*)__builtin_amdgcn_kernarg_segment_ptr(); asm volatile("" : "+s"(pp_)); _Pragma("unroll") for (int i_ = 0; i_ < 22; ++i_) P.in[i_] = pp_->in[i_]; P.out = pp_->out; P.ws = pp_->ws; } \
    int tid = threadIdx.x; asm volatile("" : "+v"(tid)); int G = gridDim.x, bx = blockIdx.x; asm volatile("" : "+s"(G), "+s"(bx)); \
    const int lane = tid & 63, wave = __builtin_amdgcn_readfirstlane(tid >> 6); \
    const int vcu = (G % 8 == 0) ? (bx % 8) * (G / 8) + bx / 8 : bx;       \
    const int gw = vcu * 8 + wave, NGW = G * 8, gt = bx * 512 + tid, NGT = G * 512; \
    unsigned char* ws = P.ws; (void)lane; (void)gw; (void)NGW; (void)gt; (void)NGT; (void)ws;

__global__ void __launch_bounds__(512, 2) fwd_kernel(Params Pk) {
    extern __shared__ __attribute__((aligned(16))) unsigned char lds_raw[];
    LAS unsigned char* lds = (LAS unsigned char*)lds_raw;
    cg::grid_group grid = cg::this_grid();
#ifndef PROBE
#define PROBE 0
#endif
#define GSYNC() do { for (int rs_ = 0; rs_ < ((PROBE & 4) ? 2 : 1); ++rs_) { xcd_barrier(xbar); } } while (0)
    for (int u_ = threadIdx.x; u_ < 64; u_ += 512) ((LAS unsigned*)(lds + 131072 + 8192))[u_] = 0u;
    __syncthreads();
    XcdBarrier xbar = xcd_barrier_post((unsigned*)(Pk.ws + WS_CTL), (volatile LAS unsigned*)(lds + 131072 + 8192));
    { PHASE_BEGIN
      for (int rep = 0; rep < ((PROBE & 8) ? 2 : 1); ++rep) {
      layer_prep(P, lds, 0, gw, NGW, gt, NGT, lane, wave);
      rope_table(P, gt, NGT);
      init_x(P, gw, NGW, lane); } }
    __threadfence(); grid.sync(); __threadfence();
    for (int l = 0; l < 2; ++l) {
        { PHASE_BEGIN
          pg8::EpiWin E{(float*)(ws + WS_ZS), (bf16_t*)(ws + WS_HQ), (bf16_t*)(ws + WS_HK), (bf16_t*)(ws + WS_HV), (bf16_t*)(ws + WS_HG), (bf16_t*)(ws + WS_GA), (bf16_t*)(ws + WS_GB), (float*)(ws + WS_LF), (const float*)(ws + WS_LB)};
          run_gemm(lds, (const bf16_t*)(ws + WS_XN), (const bf16_t*)(ws + WS_WIN), MTOK, DINP, 2048, G, bx, E); }
        GSYNC();
        { PHASE_BEGIN
          for (int rep = 0; rep < ((PROBE & 8) ? 2 : 1); ++rep) small_norms(P, l, gw, NGW, lane);
          for (int rep = 0; rep < ((PROBE & 2) ? 2 : 1); ++rep)
          for (int u = vcu; u < NU; u += G) hgrn_pass1(lds, (const float*)(ws + WS_LF), (const bf16_t*)(ws + WS_HK), (const bf16_t*)(ws + WS_HV), (float*)(ws + WS_UT), (float*)(ws + WS_D), u, tid); }
        GSYNC();
        { PHASE_BEGIN
          for (int rep = 0; rep < ((PROBE & 2) ? 2 : 1); ++rep)
          for (int x = vcu; x < 768; x += G) hgrn_pass2(lds, P, l, x, tid); }
        GSYNC();
        { PHASE_BEGIN
          for (int rep = 0; rep < ((PROBE & 2) ? 2 : 1); ++rep)
          for (int u = vcu; u < NU; u += G) hgrn_pass3(lds, (const float*)(ws + WS_LF), (const bf16_t*)(ws + WS_HQ), (const bf16_t*)(ws + WS_HK), (const bf16_t*)(ws + WS_HV), (const bf16_t*)(ws + WS_HG),
                                                       (const bf16_t*)(ws + WS_SPT), P.in[14] + l * 128, (bf16_t*)(ws + WS_OH), u, tid); }
        GSYNC();
        { PHASE_BEGIN
          pg8::EpiQ E{(bf16_t*)(ws + WS_Q), (const float*)(ws + WS_TBL)}; run_gemm(lds, (const bf16_t*)(ws + WS_QN), (const bf16_t*)(ws + WS_WUQ), MTOK, 3072, 512, G, bx, E); }
        { PHASE_BEGIN
          pg8::EpiPlain E{(bf16_t*)(ws + WS_KN), 2048}; run_gemm(lds, (const bf16_t*)(ws + WS_CKV), (const bf16_t*)(ws + WS_WUK), KVR, 2048, 512, G, bx, E); }
        { PHASE_BEGIN
          pg8::EpiPlain E{(bf16_t*)(ws + WS_VT), KVR}; run_gemm(lds, (const bf16_t*)(ws + WS_WUV), (const bf16_t*)(ws + WS_CKV), 2048, KVR, 512, G, bx, E); }
        GSYNC();
        { PHASE_BEGIN
          for (int rep = 0; rep < ((PROBE & 1) ? 2 : 1); ++rep) {
          for (int x = vcu; x < 256; x += G) { const int bh = x >> 2, j = x & 3; attn_prompt_unit(P, bh, 7 - j, wave, lane); attn_prompt_unit(P, bh, j, wave, lane); }
          for (int x = vcu; x < 128; x += G) attn_sample_unit(lds, P, x, wave, lane, tid); } }
        GSYNC();
        { PHASE_BEGIN
          pg8::EpiGate<false> E{(const bf16_t*)(ws + WS_GA), (bf16_t*)(ws + WS_T)}; run_gemm(lds, (const bf16_t*)(ws + WS_OA), (const bf16_t*)(ws + WS_WOA), MTOK, 2048, 2048, G, bx, E); }
        { PHASE_BEGIN
          pg8::EpiGate<true> E{(const bf16_t*)(ws + WS_GB), (bf16_t*)(ws + WS_T)}; run_gemm(lds, (const bf16_t*)(ws + WS_OH), (const bf16_t*)(ws + WS_WOB), MTOK, 2048, 2048, G, bx, E); }
        GSYNC();
        { PHASE_BEGIN
          pg8::EpiF32 E{(float*)(ws + WS_MIX), 2048}; run_gemm(lds, (const bf16_t*)(ws + WS_T), (const bf16_t*)(ws + WS_WOUT), MTOK, 2048, 2048, G, bx, E); }
        GSYNC();
        { PHASE_BEGIN
          resid_norm((const float*)(ws + WS_MIX), P.in[17] + l * 2048, P.out, P.in[18] + l * 2048, (bf16_t*)(ws + WS_XN), gw, NGW, lane); }
        GSYNC();
        { PHASE_BEGIN
          pg8::EpiRelu2 E{(bf16_t*)(ws + WS_H), FFN}; run_gemm(lds, (const bf16_t*)(ws + WS_XN), (const bf16_t*)(ws + WS_WUP), MTOK, FFN, 2048, G, bx, E); }
        GSYNC();
        { PHASE_BEGIN
          pg8::EpiF32 E{(float*)(ws + WS_M2), 2048}; run_gemm(lds, (const bf16_t*)(ws + WS_H), (const bf16_t*)(ws + WS_WDN), MTOK, 2048, FFN, G, bx, E); }
        GSYNC();
        { PHASE_BEGIN
          resid_norm((const float*)(ws + WS_M2), P.in[21] + l * 2048, P.out, l == 0 ? P.in[5] + 2048 : nullptr, (bf16_t*)(ws + WS_XN), gw, NGW, lane);
          if (l == 0) for (int rep = 0; rep < ((PROBE & 8) ? 2 : 1); ++rep) layer_prep(P, lds, 1, gw, NGW, gt, NGT, lane, wave); }
        if (l == 0) GSYNC();
    }
}

extern "C" void kernel_launch(void* const* d_in, const int* in_sizes, int n_in, void* d_out, int out_size, void* d_ws, size_t ws_size, hipStream_t stream) {
    static int grid = 0;
    if (grid == 0) {
        if (n_in != 22 || (size_t)out_size != OUT_TOTAL || ws_size < WS_END) { fprintf(stderr, "kernel_launch: unexpected shapes (n_in %d, out %d, ws %zu, need %zu)\n", n_in, out_size, ws_size, (size_t)WS_END); grid = -1; return; }
        int dev = 0, cus = 0, per_cu = 0;
        if (hipGetDevice(&dev) != hipSuccess || hipDeviceGetAttribute(&cus, hipDeviceAttributeMultiprocessorCount, dev) != hipSuccess) { grid = -1; return; }
        if (hipFuncSetAttribute((const void*)fwd_kernel, hipFuncAttributeMaxDynamicSharedMemorySize, LDS_BYTES) != hipSuccess) { fprintf(stderr, "kernel_launch: hipFuncSetAttribute failed\n"); grid = -1; return; }
        if (hipOccupancyMaxActiveBlocksPerMultiprocessor(&per_cu, (const void*)fwd_kernel, 512, LDS_BYTES) != hipSuccess || per_cu < 1) { fprintf(stderr, "kernel_launch: occupancy query failed (%d)\n", per_cu); per_cu = 1; }
        (void)hipGetLastError();
        grid = cus * per_cu;
    }
    if (grid < 0) return;
    if (hipMemsetAsync((char*)d_ws + WS_CTL, 0, 16384, stream) != hipSuccess) { fprintf(stderr, "kernel_launch: memset failed\n"); return; }
    Params p{};
    for (int i = 0; i < 22; ++i) p.in[i] = (const float*)d_in[i];
    p.out = (float*)d_out; p.ws = (unsigned char*)d_ws;
    void* args[] = {&p};
    hipError_t e = hipLaunchCooperativeKernel((const void*)fwd_kernel, dim3(grid), dim3(512), args, LDS_BYTES, stream);
    if (e != hipSuccess) fprintf(stderr, "kernel_launch: cooperative launch failed: %s (grid %d)\n", hipGetErrorString(e), grid);
}
```

```cpp
#include <hip/hip_runtime.h>
#include <hip/hip_cooperative_groups.h>
#include <cstdio>
#include <cstdint>
namespace cg = cooperative_groups;

#define DI __device__ __forceinline__
#define LAS __attribute__((address_space(3)))
typedef short bf16x8 __attribute__((ext_vector_type(8)));
typedef short s16x4 __attribute__((ext_vector_type(4)));
typedef float f32x4 __attribute__((ext_vector_type(4)));
typedef float f32x16 __attribute__((ext_vector_type(16)));
typedef unsigned u32x4 __attribute__((ext_vector_type(4)));
typedef unsigned u32x2 __attribute__((ext_vector_type(2)));
typedef float f32x2_t __attribute__((ext_vector_type(2)));
typedef __bf16 bf16x2_t __attribute__((ext_vector_type(2)));

constexpr int MP = 8192, MS = 256, MTOK = 8448, DM = 2048, DINP = 13568, ZSW = 1280, FFN = 8192;
constexpr int KVB = 4160;
constexpr int KVR = 8192 + 8 * KVB;
constexpr int NU = 2048 + 128;
constexpr float EPS = 1e-6f;
constexpr float QSCALE = 0.07216878364870322f * 1.4426950408889634f;

constexpr size_t MiB = 1u << 20;
constexpr size_t WS_WIN = 0, WS_WUQ = 53 * MiB, WS_WUK = 56 * MiB, WS_WUV = 58 * MiB, WS_WOA = 60 * MiB, WS_WOB = 68 * MiB, WS_WOUT = 76 * MiB, WS_WUP = 84 * MiB, WS_WDN = 116 * MiB;
constexpr size_t WS_XN = 148 * MiB, WS_HG = 181 * MiB, WS_GA = 214 * MiB, WS_GB = 247 * MiB, WS_QN = 280 * MiB, WS_Q = 289 * MiB, WS_OA = 339 * MiB, WS_OH = 372 * MiB;
constexpr size_t WS_CKV = 405 * MiB, WS_KPE = 446 * MiB, WS_TBL = 452 * MiB, WS_LB = 453 * MiB, WS_D = 454 * MiB, WS_R = 456 * MiB;
constexpr size_t WS_SPT = WS_Q;
constexpr size_t WS_ZS = WS_R, WS_HQ = WS_R + 42 * MiB, WS_HK = WS_R + 75 * MiB, WS_HV = WS_R + 108 * MiB, WS_LF = WS_R + 141 * MiB, WS_UT = WS_R + 207 * MiB;
constexpr size_t WS_KN = WS_R, WS_VT = WS_R + 162 * MiB;
constexpr size_t WS_T = WS_R, WS_MIX = WS_R + 33 * MiB, WS_H = WS_R + 99 * MiB, WS_M2 = WS_R + 231 * MiB;
constexpr size_t WS_CTL = WS_R + 343 * MiB;
constexpr size_t WS_END = WS_CTL + 1 * MiB;
static_assert((size_t)NU * 128 * 128 * 2 <= 83 * MiB && (size_t)NU * 65536 <= 136 * MiB && (size_t)KVR * 2048 * 2 <= 162 * MiB, "ws map");

constexpr size_t OUT_X = 0, OUT_CKVP = 17301504, OUT_KPEP = OUT_CKVP + 8388608, OUT_STP = OUT_KPEP + 1048576, OUT_CKVS = OUT_STP + 2097152, OUT_KPES = OUT_CKVS + 262144, OUT_STS = OUT_KPES + 32768;
constexpr size_t OUT_TOTAL = OUT_STS + 4194304;

DI unsigned pk2(float lo, float hi) { f32x2_t v = {lo, hi}; bf16x2_t b = __builtin_convertvector(v, bf16x2_t); return __builtin_bit_cast(unsigned, b); }
DI unsigned short f2bf(float f) { return (unsigned short)(pk2(f, 0.f) & 0xffffu); }
DI float bf2f(unsigned short u) { return __uint_as_float((unsigned)u << 16); }
DI float bflo(unsigned w) { return __uint_as_float(w << 16); }
DI float bfhi(unsigned w) { return __uint_as_float(w & 0xffff0000u); }
DI float sigm(float x) { return 1.f / (1.f + __expf(-x)); }
DI float ex2(float x) { return __builtin_amdgcn_exp2f(x); }
DI float wave_sum(float v) {
#pragma unroll
    for (int o = 1; o < 64; o <<= 1) v += __shfl_xor(v, o);
    return v;
}
namespace pg8 {
#define PG8_LAS __attribute__((address_space(3)))
typedef unsigned short bf16_t;
typedef short bf16x8 __attribute__((ext_vector_type(8)));
typedef float f32x4 __attribute__((ext_vector_type(4)));
typedef unsigned u32x4 __attribute__((ext_vector_type(4)));
constexpr int BM = 256, BK = 64, HALF = 128, HTB = HALF * BK * 2  , STAGE_BYTES = 8 * HTB, NXCD = 8, WGM = 8;

__host__ __device__ __forceinline__ int lds_byte(int r, int c) { const int st = (r >> 4) * 2 + (c >> 5), rr = r & 15, cc = c & 31, ob = rr * 64 + cc * 2; return st * 1024 + (ob ^ (((ob >> 9) & 1) << 5)); }
__host__ __device__ __forceinline__ void stage_rc(int b, int& R, int& C) { const int st = b / 1024, sb = b % 1024, swz = sb ^ (((sb >> 9) & 1) << 5); R = (st >> 1) * 16 + swz / 64; C = (st & 1) * 32 + (swz % 64) / 2; }
__host__ __device__ __forceinline__ int perm32(int rho) { const int n = rho >> 4, i = rho & 15; return 8 * (i >> 2) + 4 * n + (i & 3); }

struct Unit { int pm, pn; };
struct Gemm { const bf16_t* A; const bf16_t* Bt; int M, N, K; };

struct StaticOrder {
    int nM, nN, nwg, G, c;
    __host__ __device__ void init(int M, int N, int G_, int c_) { nM = M / BM; nN = N / BM; nwg = nM * nN; G = G_; c = c_; }
    __host__ __device__ bool next(int i, Unit& u) const {
        const long L = (long)i * G + c; if (L >= nwg) return false;
        int wgid = (int)L; { const int q = nwg / NXCD, r = nwg % NXCD, xcd = wgid % NXCD, off = wgid / NXCD; wgid = (xcd < r ? xcd * (q + 1) : r * (q + 1) + (xcd - r) * q) + off; }
        const int nig = WGM * nN, gid = wgid / nig, fm = gid * WGM, gsz = (nM - fm) < WGM ? (nM - fm) : WGM;
        u.pm = fm + ((wgid % nig) % gsz); u.pn = (wgid % nig) / gsz; return true;
    }
    __device__ __forceinline__ void a_ready(const Unit&) const {}
    __device__ __forceinline__ void done(const Unit&) const {}
};

#define EPI_LOOP _Pragma("unroll") for (int ai = 0; ai < 2; ++ai) _Pragma("unroll") for (int m = 0; m < 4; ++m) _Pragma("unroll") for (int bj = 0; bj < 2; ++bj)
__device__ __forceinline__ u32x4 pack8f(const f32x4 a, const f32x4 b) { u32x4 w; w.x = pk2(a[0], a[1]); w.y = pk2(a[2], a[3]); w.z = pk2(b[0], b[1]); w.w = pk2(b[2], b[3]); return w; }

struct EpiWin {
    static constexpr bool PERM = true, AFTER_DRAIN = false;
    float* Zs; bf16_t *HQ, *HK, *HV, *HG, *GA, *GB; float* LF; const float* lb;
    __device__ __forceinline__ void operator()(const f32x4 (&acc)[2][2][4][2], const Unit& u, int wr, int wc, int fr, int fq) const {
        const int row0 = u.pm * 256 + wr * 64 + fr, ct = wc * 32 + 8 * fq, pn = u.pn;
        if (pn < 5) {
            EPI_LOOP { float* p = Zs + (size_t)(row0 + ai * 128 + m * 16) * ZSW + pn * 256 + ct + bj * 128; *(f32x4*)p = acc[ai][bj][m][0]; *(f32x4*)(p + 4) = acc[ai][bj][m][1]; }
            return;
        }
        const int seg = (pn - 5) >> 3, cseg = ((pn - 5) & 7) * 256 + ct;
        if (seg == 1) {
#pragma unroll
            for (int bj = 0; bj < 2; ++bj) {
                const f32x4 l0 = *(const f32x4*)(lb + cseg + bj * 128), l1 = *(const f32x4*)(lb + cseg + bj * 128 + 4);
#pragma unroll
                for (int ai = 0; ai < 2; ++ai)
#pragma unroll
                    for (int m = 0; m < 4; ++m) {
                        const size_t off = (size_t)(row0 + ai * 128 + m * 16) * 2048 + cseg + bj * 128;
                        f32x4 lf0, lf1, k0, k1;
#pragma unroll
                        for (int e = 0; e < 4; ++e) {
                            { const float z = acc[ai][bj][m][0][e], lbv = l0[e], ez = __expf(-z), sg = 1.f / (1.f + ez); lf0[e] = __logf(lbv + (1.f - lbv) * sg); k0[e] = (1.f - lbv) * ez * sg; }
                            { const float z = acc[ai][bj][m][1][e], lbv = l1[e], ez = __expf(-z), sg = 1.f / (1.f + ez); lf1[e] = __logf(lbv + (1.f - lbv) * sg); k1[e] = (1.f - lbv) * ez * sg; }
                        }
                        *(f32x4*)(LF + off) = lf0; *(f32x4*)(LF + off + 4) = lf1; *(u32x4*)(HK + off) = pack8f(k0, k1);
                    }
            }
            return;
        }
        bf16_t* O = seg == 0 ? HQ : seg == 2 ? HV : seg == 3 ? HG : seg == 4 ? GA : GB;
        const int act = (seg == 0 || seg == 3) ? 1 : (seg == 2 ? 0 : 2);
        EPI_LOOP {
            f32x4 a = acc[ai][bj][m][0], b = acc[ai][bj][m][1];
#pragma unroll
            for (int e = 0; e < 4; ++e) { const float sa = sigm(a[e]), sb = sigm(b[e]); a[e] = act == 0 ? a[e] : act == 1 ? a[e] * sa : sa; b[e] = act == 0 ? b[e] : act == 1 ? b[e] * sb : sb; }
            *(u32x4*)(O + (size_t)(row0 + ai * 128 + m * 16) * 2048 + cseg + bj * 128) = pack8f(a, b);
        }
    }
};

struct EpiQ {
    static constexpr bool PERM = true, AFTER_DRAIN = false;
    bf16_t* Q; const float* tbl;
    __device__ __forceinline__ void operator()(const f32x4 (&acc)[2][2][4][2], const Unit& u, int wr, int wc, int fr, int fq) const {
        const int row0 = u.pm * 256 + wr * 64 + fr, ct = wc * 32 + 8 * fq, pn = u.pn;
        if (pn < 8) {
            EPI_LOOP { const int col = pn * 256 + ct + bj * 128, h = col >> 7, i = col & 127;
                *(u32x4*)(Q + (size_t)(row0 + ai * 128 + m * 16) * 3072 + h * 192 + i) = pack8f(acc[ai][bj][m][0] * QSCALE, acc[ai][bj][m][1] * QSCALE); }
            return;
        }
        EPI_LOOP {
            const int row = row0 + ai * 128 + m * 16, p = row < MP ? (row & 2047) : 2048 + ((row - MP) & 31);
            const int c = (pn - 8) * 256 + ct + bj * 128, h = c >> 6, j0 = (c & 63) >> 1;
            const f32x4 t0 = *(const f32x4*)(tbl + (size_t)(p * 32 + j0) * 2), t1 = *(const f32x4*)(tbl + (size_t)(p * 32 + j0) * 2 + 4);
            const f32x4 x = acc[ai][bj][m][0] * QSCALE, y = acc[ai][bj][m][1] * QSCALE;
            const float a0 = x[0] * t0[0] - x[1] * t0[1], b0 = x[0] * t0[1] + x[1] * t0[0];
            const float a1 = x[2] * t0[2] - x[3] * t0[3], b1 = x[2] * t0[3] + x[3] * t0[2];
            const float a2 = y[0] * t1[0] - y[1] * t1[1], b2 = y[0] * t1[1] + y[1] * t1[0];
            const float a3 = y[2] * t1[2] - y[3] * t1[3], b3 = y[2] * t1[3] + y[3] * t1[2];
            bf16_t* q = Q + (size_t)row * 3072 + h * 192 + 128 + j0;
            u32x2 w1, w2; w1.x = pk2(a0, a1); w1.y = pk2(a2, a3); w2.x = pk2(b0, b1); w2.y = pk2(b2, b3);
            *(u32x2*)q = w1; *(u32x2*)(q + 32) = w2;
            if (bj == 1) asm volatile("" ::: "memory");
        }
    }
};

struct EpiPlain {
    static constexpr bool PERM = true, AFTER_DRAIN = false;
    bf16_t* O; int ldc;
    __device__ __forceinline__ void operator()(const f32x4 (&acc)[2][2][4][2], const Unit& u, int wr, int wc, int fr, int fq) const {
        const int row0 = u.pm * 256 + wr * 64 + fr, c0 = u.pn * 256 + wc * 32 + 8 * fq;
        EPI_LOOP { *(u32x4*)(O + (size_t)(row0 + ai * 128 + m * 16) * ldc + c0 + bj * 128) = pack8f(acc[ai][bj][m][0], acc[ai][bj][m][1]); }
    }
};
struct EpiF32 {
    static constexpr bool PERM = true, AFTER_DRAIN = false;
    float* O; int ldc;
    __device__ __forceinline__ void operator()(const f32x4 (&acc)[2][2][4][2], const Unit& u, int wr, int wc, int fr, int fq) const {
        const int row0 = u.pm * 256 + wr * 64 + fr, c0 = u.pn * 256 + wc * 32 + 8 * fq;
        EPI_LOOP { float* p = O + (size_t)(row0 + ai * 128 + m * 16) * ldc + c0 + bj * 128; *(f32x4*)p = acc[ai][bj][m][0]; *(f32x4*)(p + 4) = acc[ai][bj][m][1]; }
    }
};
struct EpiRelu2 {
    static constexpr bool PERM = true, AFTER_DRAIN = false;
    bf16_t* O; int ldc;
    __device__ __forceinline__ void operator()(const f32x4 (&acc)[2][2][4][2], const Unit& u, int wr, int wc, int fr, int fq) const {
        const int row0 = u.pm * 256 + wr * 64 + fr, c0 = u.pn * 256 + wc * 32 + 8 * fq;
        EPI_LOOP { f32x4 a = acc[ai][bj][m][0], b = acc[ai][bj][m][1];
#pragma unroll
            for (int e = 0; e < 4; ++e) { const float ra = fmaxf(a[e], 0.f), rb = fmaxf(b[e], 0.f); a[e] = ra * ra; b[e] = rb * rb; }
            *(u32x4*)(O + (size_t)(row0 + ai * 128 + m * 16) * ldc + c0 + bj * 128) = pack8f(a, b); }
    }
};
template <bool SECOND> struct EpiGate {
    static constexpr bool PERM = true, AFTER_DRAIN = false;
    const bf16_t* Gt; bf16_t* T;
    __device__ __forceinline__ void operator()(const f32x4 (&acc)[2][2][4][2], const Unit& u, int wr, int wc, int fr, int fq) const {
        const int row0 = u.pm * 256 + wr * 64 + fr, c0 = u.pn * 256 + wc * 32 + 8 * fq;
        EPI_LOOP { const size_t off = (size_t)(row0 + ai * 128 + m * 16) * 2048 + c0 + bj * 128;
            const u32x4 g = *(const u32x4*)(Gt + off); f32x4 a = acc[ai][bj][m][0], b = acc[ai][bj][m][1];
            a[0] *= bflo(g.x); a[1] *= bfhi(g.x); a[2] *= bflo(g.y); a[3] *= bfhi(g.y); b[0] *= bflo(g.z); b[1] *= bfhi(g.z); b[2] *= bflo(g.w); b[3] *= bfhi(g.w);
            if (SECOND) { const u32x4 t = *(const u32x4*)(T + off);
                a[0] += bflo(t.x); a[1] += bfhi(t.x); a[2] += bflo(t.y); a[3] += bfhi(t.y); b[0] += bflo(t.z); b[1] += bfhi(t.z); b[2] += bflo(t.w); b[3] += bfhi(t.w); }
            *(u32x4*)(T + off) = pack8f(a, b);
            if (bj == 1 && (m & 1)) asm volatile("" ::: "memory"); }
    }
};
template <class Epi, class Sched, bool ALIGN_EPI = false, bool SP2 = false>
__device__ __forceinline__ void gemm_phase(PG8_LAS unsigned char* lds, const Gemm g, const Sched& S, const Epi& E) {
    int tid_l = threadIdx.x; asm volatile("" : "+v"(tid_l));
    const int tid = tid_l, wid = __builtin_amdgcn_readfirstlane(tid >> 6), lane = tid & 63, wr = wid >> 2, wc = wid & 3, fr = lane & 15, fq = lane >> 4;
    const int K = g.K, nt = K / BK;
    unsigned voffA[2], voffB[2];
#pragma unroll
    for (int i = 0; i < 2; ++i) { int R, C; stage_rc(tid * 16 + i * 8192, R, C); const int Rb = Epi::PERM ? ((R & ~31) + perm32(R & 31)) : R;
        voffA[i] = (unsigned)(R * K + C) * 2u; voffB[i] = (unsigned)(Rb * K + C) * 2u; }
    const size_t kstep = (size_t)(BK * 2);
    const size_t hstep = (size_t)HALF * K * 2;
    const size_t tstep = 2 * hstep;
    const unsigned ldsw = (unsigned)wid * 1024u;
    const int aoff = lds_byte(wr * 64 + fr, fq * 8), boff = lds_byte(wc * 32 + fr, fq * 8);
#define PG8_SA(b, h) (((b) * 2 + (h)) * HTB)
#define PG8_SB(b, h) ((4 + (b) * 2 + (h)) * HTB)
#define PG8_STAGE(bufoff, gbase, voff) do { _Pragma("unroll") for (int _i = 0; _i < 2; ++_i) \
        __builtin_amdgcn_global_load_lds((const unsigned*)((const char*)(gbase) + (voff)[_i]), (PG8_LAS unsigned*)(lds + (bufoff) + ldsw + _i * 8192), 16, 0, 0); } while (0)
#define PG8_LDA(dst, b, h) do { _Pragma("unroll") for (int m = 0; m < 4; ++m) _Pragma("unroll") for (int k = 0; k < 2; ++k) dst[m][k] = *(const PG8_LAS bf16x8*)(lds + PG8_SA(b, h) + aoff + m * 2048 + k * 1024); } while (0)
#define PG8_LDB(dst, b, h) do { _Pragma("unroll") for (int n = 0; n < 2; ++n) _Pragma("unroll") for (int k = 0; k < 2; ++k) dst[n][k] = *(const PG8_LAS bf16x8*)(lds + PG8_SB(b, h) + boff + n * 2048 + k * 1024); } while (0)
#define PG8_MMA(ai, bj, At, Bt) do { __builtin_amdgcn_s_setprio(1); _Pragma("unroll") for (int m = 0; m < 4; ++m) _Pragma("unroll") for (int n = 0; n < 2; ++n) _Pragma("unroll") for (int k = 0; k < 2; ++k) \
        acc[ai][bj][m][n] = __builtin_amdgcn_mfma_f32_16x16x32_bf16(Bt[n][k], At[m][k], acc[ai][bj][m][n], 0, 0, 0); __builtin_amdgcn_s_setprio(0); } while (0)
#define PG8_WAIT_V(n) asm volatile("s_waitcnt vmcnt(" #n ")" ::: "memory")
#define PG8_WAIT_L(n) asm volatile("s_waitcnt lgkmcnt(" #n ")" ::: "memory")
#define PG8_BAR __builtin_amdgcn_s_barrier()
#define PG8_SCHED __builtin_amdgcn_sched_barrier(0)
    Unit cur, nxt; int ui = 0;
    if (!S.next(0, cur)) return;
    f32x4 acc[2][2][4][2];
#pragma unroll
    for (int a = 0; a < 2; ++a)
#pragma unroll
        for (int b = 0; b < 2; ++b)
#pragma unroll
            for (int m = 0; m < 4; ++m)
#pragma unroll
                for (int n = 0; n < 2; ++n) acc[a][b][m][n] = (f32x4){0.f, 0.f, 0.f, 0.f};
    bf16x8 At[4][2], B0[2][2], B1[2][2];
    const char* cA = (const char*)g.A + (size_t)cur.pm * tstep; const char* cB = (const char*)g.Bt + (size_t)cur.pn * tstep;
    S.a_ready(cur);
    if constexpr (SP2) {
        PG8_STAGE(PG8_SB(0, 0), cB, voffB); PG8_STAGE(PG8_SB(0, 1), cB + hstep, voffB); PG8_STAGE(PG8_SA(0, 0), cA, voffA); PG8_STAGE(PG8_SA(0, 1), cA + hstep, voffA);
        if (wr == 1) PG8_BAR;
        PG8_WAIT_V(2); PG8_BAR;
        PG8_STAGE(PG8_SB(1, 0), cB + kstep, voffB); PG8_STAGE(PG8_SA(1, 0), cA + kstep, voffA); PG8_STAGE(PG8_SB(1, 1), cB + hstep + kstep, voffB);
        PG8_WAIT_V(6); PG8_BAR;
    } else {
        PG8_STAGE(PG8_SB(0, 0), cB, voffB); PG8_STAGE(PG8_SA(0, 0), cA, voffA); PG8_STAGE(PG8_SB(0, 1), cB + hstep, voffB); PG8_STAGE(PG8_SA(0, 1), cA + hstep, voffA);
        if (wr == 1) PG8_BAR;
        PG8_WAIT_V(4); PG8_BAR;
        PG8_STAGE(PG8_SB(1, 0), cB + kstep, voffB); PG8_STAGE(PG8_SA(1, 0), cA + kstep, voffA); PG8_STAGE(PG8_SB(1, 1), cB + hstep + kstep, voffB);
        PG8_WAIT_V(6); PG8_BAR;
    }
    for (;;) {
        const bool has_next = S.next(ui + 1, nxt);
        const char* nA = has_next ? (const char*)g.A + (size_t)nxt.pm * tstep : cA; const char* nB = has_next ? (const char*)g.Bt + (size_t)nxt.pn * tstep : cB;
        for (int t = 0; t < nt; t += 2) {
            const bool last = (t == nt - 2);
            const char* a1 = cA + (size_t)(t + 1) * kstep;
            const char* a2 = last ? nA : cA + (size_t)(t + 2) * kstep; const char* b2 = last ? nB : cB + (size_t)(t + 2) * kstep;
            const char* a3 = a2 + kstep; const char* b3 = b2 + kstep;
            if (last && has_next) S.a_ready(nxt);
            if constexpr (SP2) {
            PG8_LDB(B0, 0, 0); PG8_LDB(B1, 0, 1); PG8_SCHED; PG8_LDA(At, 0, 0); PG8_STAGE(PG8_SA(1, 1), a1 + hstep, voffA);
            PG8_WAIT_V(8); PG8_WAIT_L(0); PG8_BAR; PG8_MMA(0, 0, At, B0); PG8_MMA(0, 1, At, B1); PG8_BAR; PG8_SCHED;
            PG8_LDA(At, 0, 1); PG8_STAGE(PG8_SB(0, 0), b2, voffB); PG8_STAGE(PG8_SB(0, 1), b2 + hstep, voffB); PG8_STAGE(PG8_SA(0, 0), a2, voffA);
            PG8_WAIT_V(8); PG8_WAIT_L(0); PG8_BAR; PG8_MMA(1, 0, At, B0); PG8_MMA(1, 1, At, B1); PG8_BAR; PG8_SCHED;
            PG8_LDB(B0, 1, 0); PG8_LDB(B1, 1, 1); PG8_SCHED; PG8_LDA(At, 1, 0); PG8_STAGE(PG8_SA(0, 1), a2 + hstep, voffA);
            PG8_WAIT_V(8); PG8_WAIT_L(0); PG8_BAR; PG8_MMA(0, 0, At, B0); PG8_MMA(0, 1, At, B1); PG8_BAR; PG8_SCHED;
            PG8_LDA(At, 1, 1); PG8_STAGE(PG8_SB(1, 0), b3, voffB); PG8_STAGE(PG8_SB(1, 1), b3 + hstep, voffB); PG8_STAGE(PG8_SA(1, 0), a3, voffA);
            PG8_WAIT_V(8); PG8_WAIT_L(0); PG8_BAR; PG8_MMA(1, 0, At, B0); PG8_MMA(1, 1, At, B1); PG8_BAR; PG8_SCHED;
            } else {
            PG8_LDB(B0, 0, 0); PG8_SCHED; PG8_LDA(At, 0, 0); PG8_STAGE(PG8_SA(1, 1), a1 + hstep, voffA);
            PG8_WAIT_L(8); PG8_BAR; PG8_WAIT_L(0); PG8_MMA(0, 0, At, B0); PG8_BAR; PG8_SCHED;
            PG8_LDB(B1, 0, 1); PG8_STAGE(PG8_SB(0, 0), b2, voffB);
            PG8_BAR; PG8_WAIT_L(0); PG8_MMA(0, 1, At, B1); PG8_BAR;
            PG8_LDA(At, 0, 1); PG8_STAGE(PG8_SA(0, 0), a2, voffA);
            PG8_BAR; PG8_WAIT_L(0); PG8_MMA(1, 0, At, B0); PG8_BAR; PG8_SCHED;
            PG8_STAGE(PG8_SB(0, 1), b2 + hstep, voffB);
            PG8_WAIT_V(6); PG8_BAR; PG8_MMA(1, 1, At, B1); PG8_BAR;
            PG8_LDB(B0, 1, 0); PG8_SCHED; PG8_LDA(At, 1, 0); PG8_STAGE(PG8_SA(0, 1), a2 + hstep, voffA);
            PG8_WAIT_L(8); PG8_BAR; PG8_WAIT_L(0); PG8_MMA(0, 0, At, B0); PG8_BAR; PG8_SCHED;
            PG8_LDB(B1, 1, 1); PG8_STAGE(PG8_SB(1, 0), b3, voffB);
            PG8_BAR; PG8_WAIT_L(0); PG8_MMA(0, 1, At, B1); PG8_BAR;
            PG8_LDA(At, 1, 1); PG8_STAGE(PG8_SA(1, 0), a3, voffA);
            PG8_BAR; PG8_WAIT_L(0); PG8_MMA(1, 0, At, B0); PG8_BAR; PG8_SCHED;
            PG8_STAGE(PG8_SB(1, 1), b3 + hstep, voffB);
            PG8_WAIT_V(6); PG8_BAR; PG8_MMA(1, 1, At, B1); PG8_BAR;
            }
        }
        if constexpr (ALIGN_EPI) { if (wr == 0) PG8_BAR; }
        if constexpr (!Epi::AFTER_DRAIN) { E(acc, cur, wr, wc, fr, fq); S.done(cur); }
        if (!has_next) break;
#pragma unroll
        for (int a = 0; a < 2; ++a)
#pragma unroll
            for (int b = 0; b < 2; ++b)
#pragma unroll
                for (int m = 0; m < 4; ++m)
#pragma unroll
                    for (int n = 0; n < 2; ++n) acc[a][b][m][n] = (f32x4){0.f, 0.f, 0.f, 0.f};
        cur = nxt; cA = nA; cB = nB; ++ui;
        if constexpr (ALIGN_EPI) { if (wr == 1) PG8_BAR; }
    }
    PG8_WAIT_V(0);
    if constexpr (!ALIGN_EPI) { if (wr == 0) PG8_BAR; }
    PG8_BAR;
    if constexpr (Epi::AFTER_DRAIN) { E.fused(acc, cur, wr, wc, fr, fq, lds, wid, lane); S.done(cur); }
#undef PG8_SA
#undef PG8_SB
#undef PG8_STAGE
#undef PG8_LDA
#undef PG8_LDB
#undef PG8_MMA
#undef PG8_WAIT_V
#undef PG8_WAIT_L
#undef PG8_BAR
#undef PG8_SCHED
}
}
using pg8::bf16_t;
#define MFMA32(a, b, c) __builtin_amdgcn_mfma_f32_32x32x16_bf16((a), (b), (c), 0, 0, 0)
#define LDS_WAIT() asm volatile("s_waitcnt lgkmcnt(0)" ::: "memory")
DI int crow(int i, int h) { return (i & 3) + 8 * (i >> 2) + 4 * h; }
template <int S> DI bf16x8 pack8(const f32x16& x) {
    u32x4 p; p.x = pk2(x[8 * S], x[8 * S + 1]); p.y = pk2(x[8 * S + 2], x[8 * S + 3]); p.z = pk2(x[8 * S + 4], x[8 * S + 5]); p.w = pk2(x[8 * S + 6], x[8 * S + 7]);
    return __builtin_bit_cast(bf16x8, p);
}
DI f32x16 zero16() { f32x16 z;
#pragma unroll
    for (int i = 0; i < 16; ++i) z[i] = 0.f; return z; }

struct Params { const float* in[22]; float* out; unsigned char* ws; };

enum { MAP_ID = 0, MAP_WIN = 1, MAP_WUQ = 2 };
template <int MAP> DI int dest_row(int n) {
    if (MAP == MAP_WIN) return n < 1088 ? n : n + 192;
    if (MAP == MAP_WUQ) { const int h = n / 192, i = n - h * 192; return i < 128 ? h * 128 + i : 2048 + h * 64 + 2 * ((i - 128) & 31) + ((i - 128) >> 5); }
    return n;
}
template <int MAP> DI void transpose_item(const float* __restrict__ W, int K, int N, bf16_t* __restrict__ WT, LAS float* scr, int item, int lane) {
    const int nblk = N / 32, kb = item / nblk, nb = item - kb * nblk, k0 = 64 * kb, n0 = 32 * nb;
#pragma unroll 8
    for (int i = 0; i < 32; ++i) { const int kk = 2 * i + (lane >> 5); scr[kk * 33 + (lane & 31)] = W[(size_t)(k0 + kk) * N + n0 + (lane & 31)]; }
    LDS_WAIT();
    const int c = lane & 7;
#pragma unroll
    for (int j = 0; j < 4; ++j) { const int n = (lane >> 3) + 8 * j; const LAS float* s = scr + (8 * c) * 33 + n;
        u32x4 o; o.x = pk2(s[0 * 33], s[1 * 33]); o.y = pk2(s[2 * 33], s[3 * 33]); o.z = pk2(s[4 * 33], s[5 * 33]); o.w = pk2(s[6 * 33], s[7 * 33]);
        *(u32x4*)(WT + (size_t)dest_row<MAP>(n0 + n) * K + k0 + 8 * c) = o; }
    LDS_WAIT();
}

DI void layer_prep(const Params& P, LAS unsigned char* lds, int l, int gw, int NGW, int gt, int NGT, int lane, int wave) {
    unsigned char* ws = P.ws;
    LAS float* scr = (LAS float*)(lds + wave * 16384);
    const float* w_in = P.in[6] + (size_t)l * 2048 * 13376; const float* w_uq = P.in[8] + (size_t)l * 512 * 3072;
    const float* w_uk = P.in[10] + (size_t)l * 512 * 2048;  const float* w_uv = P.in[11] + (size_t)l * 512 * 2048;
    const float* w_oa = P.in[12] + (size_t)l * 2048 * 2048; const float* w_ob = P.in[15] + (size_t)l * 2048 * 2048; const float* w_out = P.in[16] + (size_t)l * 2048 * 2048;
    const float* w_up = P.in[19] + (size_t)l * 2048 * 8192; const float* w_dn = P.in[20] + (size_t)l * 8192 * 2048;
    constexpr int I_IN = 32 * 418, I_UQ = 8 * 96, I_UK = 8 * 64, I_SQ = 32 * 64, I_UP = 32 * 256, I_DN = 128 * 64;
    constexpr int NIT = I_IN + I_UQ + 2 * I_UK + 3 * I_SQ + I_UP + I_DN;
    for (int it = gw; it < NIT; it += NGW) {
        int r = it;
        if (r < I_IN) { transpose_item<MAP_WIN>(w_in, 2048, 13376, (bf16_t*)(ws + WS_WIN), scr, r, lane); continue; } r -= I_IN;
        if (r < I_UQ) { transpose_item<MAP_WUQ>(w_uq, 512, 3072, (bf16_t*)(ws + WS_WUQ), scr, r, lane); continue; } r -= I_UQ;
        if (r < I_UK) { transpose_item<MAP_ID>(w_uk, 512, 2048, (bf16_t*)(ws + WS_WUK), scr, r, lane); continue; } r -= I_UK;
        if (r < I_UK) { transpose_item<MAP_ID>(w_uv, 512, 2048, (bf16_t*)(ws + WS_WUV), scr, r, lane); continue; } r -= I_UK;
        if (r < I_SQ) { transpose_item<MAP_ID>(w_oa, 2048, 2048, (bf16_t*)(ws + WS_WOA), scr, r, lane); continue; } r -= I_SQ;
        if (r < I_SQ) { transpose_item<MAP_ID>(w_ob, 2048, 2048, (bf16_t*)(ws + WS_WOB), scr, r, lane); continue; } r -= I_SQ;
        if (r < I_SQ) { transpose_item<MAP_ID>(w_out, 2048, 2048, (bf16_t*)(ws + WS_WOUT), scr, r, lane); continue; } r -= I_SQ;
        if (r < I_UP) { transpose_item<MAP_ID>(w_up, 2048, 8192, (bf16_t*)(ws + WS_WUP), scr, r, lane); continue; } r -= I_UP;
        transpose_item<MAP_ID>(w_dn, 8192, 2048, (bf16_t*)(ws + WS_WDN), scr, r, lane);
    }
    const u32x4 z4 = {0u, 0u, 0u, 0u};
    { u32x4* z = (u32x4*)((bf16_t*)(ws + WS_WIN) + (size_t)1088 * 2048); for (int i = gt; i < 192 * 2048 / 8; i += NGT) z[i] = z4; }
    bf16_t* CKV = (bf16_t*)(ws + WS_CKV); bf16_t* KPE = (bf16_t*)(ws + WS_KPE);
    const float* cc = P.in[2] + (size_t)l * 8 * 4096 * 512; const float* ck = P.in[3] + (size_t)l * 8 * 4096 * 64;
    for (int i = gt; i < 8 * 4096 * 512 / 8; i += NGT) { const int b = i >> 18, rem = i & 262143, t = rem >> 6, c8 = rem & 63;
        const f32x4 a = *(const f32x4*)(cc + (size_t)i * 8), bq = *(const f32x4*)(cc + (size_t)i * 8 + 4);
        u32x4 o; o.x = pk2(a[0], a[1]); o.y = pk2(a[2], a[3]); o.z = pk2(bq[0], bq[1]); o.w = pk2(bq[2], bq[3]);
        *(u32x4*)(CKV + (size_t)(MP + b * KVB + t) * 512 + c8 * 8) = o; }
    for (int i = gt; i < 8 * 4096 * 64 / 8; i += NGT) { const int b = i >> 15, rem = i & 32767, t = rem >> 3, c8 = rem & 7;
        const f32x4 a = *(const f32x4*)(ck + (size_t)i * 8), bq = *(const f32x4*)(ck + (size_t)i * 8 + 4);
        u32x4 o; o.x = pk2(a[0], a[1]); o.y = pk2(a[2], a[3]); o.z = pk2(bq[0], bq[1]); o.w = pk2(bq[2], bq[3]);
        *(u32x4*)(KPE + (size_t)(MP + b * KVB + t) * 64 + c8 * 8) = o; }
    for (int i = gt; i < 8 * 32 * 64; i += NGT) { const int b = i >> 11, rem = i & 2047; *(u32x4*)(CKV + (size_t)(MP + b * KVB + 4128) * 512 + rem * 8) = z4; }
    for (int i = gt; i < 8 * 32 * 8; i += NGT) { const int b = i >> 8, rem = i & 255; *(u32x4*)(KPE + (size_t)(MP + b * KVB + 4128) * 64 + rem * 8) = z4; }
    float* LB = (float*)(ws + WS_LB); const float* hl = P.in[13];
    for (int i = gt; i < 2048; i += NGT) LB[i] = l == 0 ? 0.f : 1.f / (1.f + expf(hl[i] - hl[2048 + i]));
}

DI void rope_table(const Params& P, int gt, int NGT) {
    float* T = (float*)(P.ws + WS_TBL);
    for (int i = gt; i < 2080 * 32; i += NGT) { const int p = i >> 5, j = i & 31; const int pos = p < 2048 ? p : 4096 + (p - 2048);
        const float inv = exp2f(-(float)j * (13.287712379549449f / 32.f)); const float ang = (float)pos * inv;
        const double a = (double)ang; const double kq = rint(a * 0.15915494309189535); const float rr = (float)(a - kq * 6.283185307179586);
        T[2 * i] = __cosf(rr); T[2 * i + 1] = __sinf(rr); }
}

DI void init_x(const Params& P, int gw, int NGW, int lane) {
    const float* g = P.in[5]; float* X = P.out; bf16_t* XN = (bf16_t*)(P.ws + WS_XN);
    for (int row = gw; row < MTOK; row += NGW) {
        const float* src = row < MP ? P.in[0] + (size_t)row * 2048 : P.in[1] + (size_t)(row - MP) * 2048;
        f32x4 v[8]; float ss = 0.f;
#pragma unroll
        for (int j = 0; j < 8; ++j) { v[j] = *(const f32x4*)(src + j * 256 + lane * 4); ss += v[j][0] * v[j][0] + v[j][1] * v[j][1] + v[j][2] * v[j][2] + v[j][3] * v[j][3]; }
        const float rs = rsqrtf(wave_sum(ss) * (1.f / 2048.f) + EPS);
#pragma unroll
        for (int j = 0; j < 8; ++j) { *(f32x4*)(X + (size_t)row * 2048 + j * 256 + lane * 4) = v[j];
            const f32x4 gg = *(const f32x4*)(g + j * 256 + lane * 4); u32x2 w; w.x = pk2(v[j][0] * rs * gg[0], v[j][1] * rs * gg[1]); w.y = pk2(v[j][2] * rs * gg[2], v[j][3] * rs * gg[3]);
            *(u32x2*)(XN + (size_t)row * 2048 + j * 256 + lane * 4) = w; }
    }
}
DI void resid_norm(const float* __restrict__ Y, const float* __restrict__ gY, float* X, const float* __restrict__ gN, bf16_t* XN, int gw, int NGW, int lane) {
    for (int row = gw; row < MTOK; row += NGW) {
        f32x4 y[8]; float ss = 0.f;
#pragma unroll
        for (int j = 0; j < 8; ++j) { y[j] = *(const f32x4*)(Y + (size_t)row * 2048 + j * 256 + lane * 4); ss += y[j][0] * y[j][0] + y[j][1] * y[j][1] + y[j][2] * y[j][2] + y[j][3] * y[j][3]; }
        const float rs = rsqrtf(wave_sum(ss) * (1.f / 2048.f) + EPS); float s2 = 0.f;
#pragma unroll
        for (int j = 0; j < 8; ++j) { const f32x4 gg = *(const f32x4*)(gY + j * 256 + lane * 4); const f32x4 x = *(const f32x4*)(X + (size_t)row * 2048 + j * 256 + lane * 4);
            y[j] = x + y[j] * rs * gg; *(f32x4*)(X + (size_t)row * 2048 + j * 256 + lane * 4) = y[j];
            s2 += y[j][0] * y[j][0] + y[j][1] * y[j][1] + y[j][2] * y[j][2] + y[j][3] * y[j][3]; }
        if (gN) {
            const float r2 = rsqrtf(wave_sum(s2) * (1.f / 2048.f) + EPS);
#pragma unroll
            for (int j = 0; j < 8; ++j) { const f32x4 gg = *(const f32x4*)(gN + j * 256 + lane * 4); u32x2 w; w.x = pk2(y[j][0] * r2 * gg[0], y[j][1] * r2 * gg[1]); w.y = pk2(y[j][2] * r2 * gg[2], y[j][3] * r2 * gg[3]);
                *(u32x2*)(XN + (size_t)row * 2048 + j * 256 + lane * 4) = w; }
        }
    }
}
DI void small_norms(const Params& P, int l, int gw, int NGW, int lane) {
    const float* Zs = (const float*)(P.ws + WS_ZS); bf16_t* QN = (bf16_t*)(P.ws + WS_QN); bf16_t* CKV = (bf16_t*)(P.ws + WS_CKV); bf16_t* KPE = (bf16_t*)(P.ws + WS_KPE);
    const float* tbl = (const float*)(P.ws + WS_TBL); const float* gq = P.in[7] + l * 512; const float* gkv = P.in[9] + l * 512;
    for (int row = gw; row < MTOK; row += NGW) {
        const float* z = Zs + (size_t)row * ZSW;
        const bool pr = row < MP; const int rs_ = row - MP;
        const int kvrow = pr ? row : MP + (rs_ >> 5) * KVB + 4096 + (rs_ & 31);
        const int p = pr ? (row & 2047) : 2048 + (rs_ & 31);
        float* oc = pr ? P.out + OUT_CKVP + ((size_t)l * MP + row) * 512 : P.out + OUT_CKVS + ((size_t)l * MS + rs_) * 512;
        float* ok = pr ? P.out + OUT_KPEP + ((size_t)l * MP + row) * 64 : P.out + OUT_KPES + ((size_t)l * MS + rs_) * 64;
        { const f32x4 a = *(const f32x4*)(z + lane * 8), b = *(const f32x4*)(z + lane * 8 + 4);
          const float ss = a[0] * a[0] + a[1] * a[1] + a[2] * a[2] + a[3] * a[3] + b[0] * b[0] + b[1] * b[1] + b[2] * b[2] + b[3] * b[3];
          const float rs = rsqrtf(wave_sum(ss) * (1.f / 512.f) + EPS); const f32x4 g0 = *(const f32x4*)(gq + lane * 8), g1 = *(const f32x4*)(gq + lane * 8 + 4);
          u32x4 o; o.x = pk2(a[0] * rs * g0[0], a[1] * rs * g0[1]); o.y = pk2(a[2] * rs * g0[2], a[3] * rs * g0[3]); o.z = pk2(b[0] * rs * g1[0], b[1] * rs * g1[1]); o.w = pk2(b[2] * rs * g1[2], b[3] * rs * g1[3]);
          *(u32x4*)(QN + (size_t)row * 512 + lane * 8) = o; }
        { const f32x4 a = *(const f32x4*)(z + 512 + lane * 8), b = *(const f32x4*)(z + 512 + lane * 8 + 4);
          const float ss = a[0] * a[0] + a[1] * a[1] + a[2] * a[2] + a[3] * a[3] + b[0] * b[0] + b[1] * b[1] + b[2] * b[2] + b[3] * b[3];
          const float rs = rsqrtf(wave_sum(ss) * (1.f / 512.f) + EPS); const f32x4 g0 = *(const f32x4*)(gkv + lane * 8), g1 = *(const f32x4*)(gkv + lane * 8 + 4);
          const f32x4 c0 = a * rs * g0, c1 = b * rs * g1;
          *(f32x4*)(oc + lane * 8) = c0; *(f32x4*)(oc + lane * 8 + 4) = c1;
          u32x4 o; o.x = pk2(c0[0], c0[1]); o.y = pk2(c0[2], c0[3]); o.z = pk2(c1[0], c1[1]); o.w = pk2(c1[2], c1[3]);
          *(u32x4*)(CKV + (size_t)kvrow * 512 + lane * 8) = o; }
        if (lane < 32) { const float x1 = z[1024 + lane], x2 = z[1056 + lane]; const float c = tbl[(size_t)(p * 32 + lane) * 2], s = tbl[(size_t)(p * 32 + lane) * 2 + 1];
          const float o1 = x1 * c - x2 * s, o2 = x1 * s + x2 * c; ok[lane] = o1; ok[32 + lane] = o2;
          KPE[(size_t)kvrow * 64 + lane] = f2bf(o1); KPE[(size_t)kvrow * 64 + 32 + lane] = f2bf(o2); }
    }
}

struct HUnit { int rowbase, nvalid, h; };
DI HUnit hunit(int u) { HUnit r; if (u < 2048) { const int sh = u >> 5, c = u & 31; r.h = sh & 15; r.rowbase = (sh >> 4) * 2048 + c * 64; r.nvalid = 64; } else { const int s = u - 2048; r.h = s & 15; r.rowbase = MP + (s >> 4) * 32; r.nvalid = 32; } return r; }
DI void hgrn_cumsum(const float* __restrict__ LF, LAS float* psum, const HUnit& hu, int k, int tq, float (&b)[16], float& b31, float& b63) {
    const float* p = LF + (size_t)(hu.rowbase + 16 * tq) * 2048 + hu.h * 128 + k; const bool valid = 16 * tq < hu.nvalid;
    float run = 0.f;
#pragma unroll
    for (int i = 0; i < 16; ++i) { const float v = valid ? p[(size_t)i * 2048] : 0.f; run += v; b[i] = run; }
    psum[tq * 128 + k] = run;
    __syncthreads();
    const float p0 = psum[k], p1 = psum[128 + k], p2 = psum[256 + k], p3 = psum[384 + k];
    const float off = (tq > 0 ? p0 : 0.f) + (tq > 1 ? p1 : 0.f) + (tq > 2 ? p2 : 0.f);
#pragma unroll
    for (int i = 0; i < 16; ++i) b[i] += off;
    b31 = p0 + p1; b63 = b31 + p2 + p3;
}
DI void hgrn_pass1(LAS unsigned char* lds, const float* __restrict__ LF, const bf16_t* __restrict__ HK, const bf16_t* __restrict__ HV, float* __restrict__ UT, float* __restrict__ Dv, int u, int tid) {
    LAS float* psum = (LAS float*)lds; LAS bf16_t* KhT = (LAS bf16_t*)(lds + 2048); LAS bf16_t* VTl = (LAS bf16_t*)(lds + 2048 + 18432);
    const HUnit hu = hunit(u); const int k = tid & 127, tq = tid >> 7; const bool valid = 16 * tq < hu.nvalid;
    float b[16], b31, b63; hgrn_cumsum(LF, psum, hu, k, tq, b, b31, b63);
    const size_t g0 = (size_t)(hu.rowbase + 16 * tq) * 2048 + hu.h * 128 + k;
    unsigned kw[8], vw[8];
#pragma unroll
    for (int i2 = 0; i2 < 8; ++i2) {
        float k0 = 0.f, k1 = 0.f; unsigned v0 = 0u, v1 = 0u;
        if (valid) { k0 = bf2f(HK[g0 + (size_t)(2 * i2) * 2048]) * __expf(b63 - b[2 * i2]); k1 = bf2f(HK[g0 + (size_t)(2 * i2 + 1) * 2048]) * __expf(b63 - b[2 * i2 + 1]);
                     v0 = HV[g0 + (size_t)(2 * i2) * 2048]; v1 = HV[g0 + (size_t)(2 * i2 + 1) * 2048]; }
        kw[i2] = pk2(k0, k1); vw[i2] = v0 | (v1 << 16);
    }
    { u32x4 a, c; a.x = kw[0]; a.y = kw[1]; a.z = kw[2]; a.w = kw[3]; c.x = kw[4]; c.y = kw[5]; c.z = kw[6]; c.w = kw[7];
      *(LAS u32x4*)(KhT + k * 72 + 16 * tq) = a; *(LAS u32x4*)(KhT + k * 72 + 16 * tq + 8) = c;
      a.x = vw[0]; a.y = vw[1]; a.z = vw[2]; a.w = vw[3]; c.x = vw[4]; c.y = vw[5]; c.z = vw[6]; c.w = vw[7];
      *(LAS u32x4*)(VTl + k * 72 + 16 * tq) = a; *(LAS u32x4*)(VTl + k * 72 + 16 * tq + 8) = c; }
    if (tq == 0) Dv[(size_t)u * 128 + k] = __expf(b63);
    __syncthreads();
    const int wave = tid >> 6, lane = tid & 63, r = lane & 31, hh = lane >> 5, vb = wave & 3, kg = wave >> 2;
#pragma unroll
    for (int kb2 = 0; kb2 < 2; ++kb2) {
        const int kbq = 2 * kg + kb2; f32x16 acc = zero16();
#pragma unroll
        for (int s = 0; s < 4; ++s) { const bf16x8 a = *(const LAS bf16x8*)(VTl + (32 * vb + r) * 72 + 16 * s + 8 * hh), bb = *(const LAS bf16x8*)(KhT + (32 * kbq + r) * 72 + 16 * s + 8 * hh); acc = MFMA32(a, bb, acc); }
        float* dst = UT + ((size_t)u * 128 + 32 * vb) * 128 + 32 * kbq + r;
#pragma unroll
        for (int i = 0; i < 16; ++i) dst[(size_t)crow(i, hh) * 128] = acc[i];
    }
    __syncthreads();
}
DI void hgrn_pass2(LAS unsigned char* lds, const Params& P, int l, int x, int tid) {
    const float* UT = (const float*)(P.ws + WS_UT); const float* Dv = (const float*)(P.ws + WS_D); bf16_t* SpT = (bf16_t*)(P.ws + WS_SPT);
    LAS float* tl = (LAS float*)lds;
    const bool sample = x >= 256; const int sidx = sample ? (x - 256) >> 2 : x >> 2, vq = x & 3;
    const int nch = sample ? 1 : 32, ubase = sample ? 2048 + sidx : sidx * 32;
    const int vloc = tid >> 4, k0 = (tid & 15) * 8, v = 32 * vq + vloc;
    const int kk = tid >> 2, vs = (tid & 3) * 8;
    float S[8];
#pragma unroll
    for (int i = 0; i < 8; ++i) S[i] = 0.f;
    if (sample) {
        const float* s0 = P.in[4] + ((size_t)l * 128 + sidx) * 16384 + (size_t)kk * 128 + 32 * vq + vs;
        const f32x4 a = *(const f32x4*)s0, b = *(const f32x4*)(s0 + 4);
#pragma unroll
        for (int i = 0; i < 4; ++i) { tl[kk * 33 + vs + i] = a[i]; tl[kk * 33 + vs + 4 + i] = b[i]; }
        __syncthreads();
#pragma unroll
        for (int i = 0; i < 8; ++i) S[i] = tl[(k0 + i) * 33 + vloc];
        __syncthreads();
    }
    size_t e = ((size_t)ubase * 128 + v) * 128 + k0;
    f32x4 u0 = *(const f32x4*)(UT + e), u1 = *(const f32x4*)(UT + e + 4), d0 = *(const f32x4*)(Dv + (size_t)ubase * 128 + k0), d1 = *(const f32x4*)(Dv + (size_t)ubase * 128 + k0 + 4);
    for (int c = 0; c < nch; ++c) {
        f32x4 nu0 = u0, nu1 = u1, nd0 = d0, nd1 = d1;
        if (c + 1 < nch) { const size_t e2 = e + 16384; nu0 = *(const f32x4*)(UT + e2); nu1 = *(const f32x4*)(UT + e2 + 4); nd0 = *(const f32x4*)(Dv + (size_t)(ubase + c + 1) * 128 + k0); nd1 = *(const f32x4*)(Dv + (size_t)(ubase + c + 1) * 128 + k0 + 4); }
        u32x4 o; o.x = pk2(S[0], S[1]); o.y = pk2(S[2], S[3]); o.z = pk2(S[4], S[5]); o.w = pk2(S[6], S[7]);
        *(u32x4*)(SpT + e) = o;
#pragma unroll
        for (int i = 0; i < 4; ++i) { S[i] = d0[i] * S[i] + u0[i]; S[4 + i] = d1[i] * S[4 + i] + u1[i]; }
        u0 = nu0; u1 = nu1; d0 = nd0; d1 = nd1; e += 16384;
    }
#pragma unroll
    for (int i = 0; i < 8; ++i) tl[(k0 + i) * 33 + vloc] = S[i];
    __syncthreads();
    float* o = (sample ? P.out + OUT_STS + ((size_t)l * 128 + sidx) * 16384 : P.out + OUT_STP + ((size_t)l * 64 + sidx) * 16384) + (size_t)kk * 128 + 32 * vq + vs;
    f32x4 a, b;
#pragma unroll
    for (int i = 0; i < 4; ++i) { a[i] = tl[kk * 33 + vs + i]; b[i] = tl[kk * 33 + vs + 4 + i]; }
    *(f32x4*)o = a; *(f32x4*)(o + 4) = b;
    __syncthreads();
}
DI void hgrn_pass3(LAS unsigned char* lds, const float* __restrict__ LF, const bf16_t* __restrict__ HQ, const bf16_t* __restrict__ HK, const bf16_t* __restrict__ HV, const bf16_t* __restrict__ HG,
                   const bf16_t* __restrict__ SpT, const float* __restrict__ gn, bf16_t* __restrict__ OH, int u, int tid) {
    LAS float* psum = (LAS float*)lds;
    LAS bf16_t* Qa = (LAS bf16_t*)(lds + 2048);
    LAS bf16_t* Qb = (LAS bf16_t*)(lds + 19456);
    LAS bf16_t* Ka = (LAS bf16_t*)(lds + 28160);
    LAS bf16_t* Kb = (LAS bf16_t*)(lds + 36864);
    LAS bf16_t* VTl = (LAS bf16_t*)(lds + 54272);
    LAS float* Ost = (LAS float*)(lds + 72704);
    const HUnit hu = hunit(u); const int k = tid & 127, tq = tid >> 7; const bool valid = 16 * tq < hu.nvalid;
    float b[16], b31, b63; hgrn_cumsum(LF, psum, hu, k, tq, b, b31, b63);
    const size_t g0 = (size_t)(hu.rowbase + 16 * tq) * 2048 + hu.h * 128 + k;
    unsigned vw[8];
#pragma unroll
    for (int i2 = 0; i2 < 8; ++i2) {
        unsigned vpair = 0u;
#pragma unroll
        for (int e = 0; e < 2; ++e) {
            const int i = 2 * i2 + e, t = 16 * tq + i;
            float q = 0.f, kk = 0.f; unsigned vv = 0u;
            if (valid) { q = bf2f(HQ[g0 + (size_t)i * 2048]); kk = bf2f(HK[g0 + (size_t)i * 2048]); vv = HV[g0 + (size_t)i * 2048]; }
            Qa[t * 136 + k] = f2bf(q * __expf(b[i]));
            if (tq >= 2) Qb[(t - 32) * 136 + k] = f2bf(q * __expf(b[i] - b31)); else Ka[t * 136 + k] = f2bf(kk * __expf(-b[i]));
            Kb[t * 136 + k] = f2bf(kk * __expf(b31 - b[i]));
            vpair |= vv << (16 * e);
        }
        vw[i2] = vpair;
    }
    { u32x4 a, c; a.x = vw[0]; a.y = vw[1]; a.z = vw[2]; a.w = vw[3]; c.x = vw[4]; c.y = vw[5]; c.z = vw[6]; c.w = vw[7];
      *(LAS u32x4*)(VTl + k * 72 + 16 * tq) = a; *(LAS u32x4*)(VTl + k * 72 + 16 * tq + 8) = c; }
    __syncthreads();
    const int wave = tid >> 6, lane = tid & 63, r = lane & 31, hh = lane >> 5, vb = wave & 3, tb = wave >> 2;
    f32x16 O = zero16();
    const LAS bf16_t* vrow = VTl + (32 * vb + r) * 72 + 4 * hh;
    if (tb == 0) {
        f32x16 A0 = zero16();
#pragma unroll
        for (int ks = 0; ks < 8; ++ks) { const bf16x8 a = *(const LAS bf16x8*)(Ka + r * 136 + 16 * ks + 8 * hh), q = *(const LAS bf16x8*)(Qa + r * 136 + 16 * ks + 8 * hh); A0 = MFMA32(a, q, A0); }
#pragma unroll
        for (int i = 0; i < 16; ++i) if (crow(i, hh) > r) A0[i] = 0.f;
        const bf16x8 p0 = pack8<0>(A0), p1 = pack8<1>(A0);
        { const s16x4 lo = *(const LAS s16x4*)(vrow), hi = *(const LAS s16x4*)(vrow + 8); O = MFMA32(__builtin_shufflevector(lo, hi, 0, 1, 2, 3, 4, 5, 6, 7), p0, O); }
        { const s16x4 lo = *(const LAS s16x4*)(vrow + 16), hi = *(const LAS s16x4*)(vrow + 24); O = MFMA32(__builtin_shufflevector(lo, hi, 0, 1, 2, 3, 4, 5, 6, 7), p1, O); }
    } else {
        f32x16 A0 = zero16(), A1 = zero16();
#pragma unroll
        for (int ks = 0; ks < 8; ++ks) { const bf16x8 q = *(const LAS bf16x8*)(Qb + r * 136 + 16 * ks + 8 * hh);
            const bf16x8 a0 = *(const LAS bf16x8*)(Kb + r * 136 + 16 * ks + 8 * hh), a1 = *(const LAS bf16x8*)(Kb + (32 + r) * 136 + 16 * ks + 8 * hh);
            A0 = MFMA32(a0, q, A0); A1 = MFMA32(a1, q, A1); }
#pragma unroll
        for (int i = 0; i < 16; ++i) if (crow(i, hh) > r) A1[i] = 0.f;
        const bf16x8 p0 = pack8<0>(A0), p1 = pack8<1>(A0), p2 = pack8<0>(A1), p3 = pack8<1>(A1);
        { const s16x4 lo = *(const LAS s16x4*)(vrow), hi = *(const LAS s16x4*)(vrow + 8); O = MFMA32(__builtin_shufflevector(lo, hi, 0, 1, 2, 3, 4, 5, 6, 7), p0, O); }
        { const s16x4 lo = *(const LAS s16x4*)(vrow + 16), hi = *(const LAS s16x4*)(vrow + 24); O = MFMA32(__builtin_shufflevector(lo, hi, 0, 1, 2, 3, 4, 5, 6, 7), p1, O); }
        { const s16x4 lo = *(const LAS s16x4*)(vrow + 32), hi = *(const LAS s16x4*)(vrow + 40); O = MFMA32(__builtin_shufflevector(lo, hi, 0, 1, 2, 3, 4, 5, 6, 7), p2, O); }
        { const s16x4 lo = *(const LAS s16x4*)(vrow + 48), hi = *(const LAS s16x4*)(vrow + 56); O = MFMA32(__builtin_shufflevector(lo, hi, 0, 1, 2, 3, 4, 5, 6, 7), p3, O); }
    }
    { const bf16_t* sp = SpT + ((size_t)u * 128 + 32 * vb + r) * 128 + 8 * hh;
#pragma unroll
      for (int ks = 0; ks < 8; ++ks) { const bf16x8 a = *(const bf16x8*)(sp + 16 * ks), q = *(const LAS bf16x8*)(Qa + (32 * tb + r) * 136 + 16 * ks + 8 * hh); O = MFMA32(a, q, O); } }
#pragma unroll
    for (int g = 0; g < 4; ++g) { f32x4 w; w[0] = O[4 * g]; w[1] = O[4 * g + 1]; w[2] = O[4 * g + 2]; w[3] = O[4 * g + 3]; *(LAS f32x4*)(Ost + (32 * tb + r) * 132 + 32 * vb + 8 * g + 4 * hh) = w; }
    __syncthreads();
    { const int t = tid >> 3, vs = (tid & 7) * 16;
      f32x4 x[4]; float ss = 0.f;
#pragma unroll
      for (int j = 0; j < 4; ++j) { x[j] = *(const LAS f32x4*)(Ost + t * 132 + vs + 4 * j); ss += x[j][0] * x[j][0] + x[j][1] * x[j][1] + x[j][2] * x[j][2] + x[j][3] * x[j][3]; }
      ss += __shfl_xor(ss, 1); ss += __shfl_xor(ss, 2); ss += __shfl_xor(ss, 4);
      const float rs = rsqrtf(ss * (1.f / 128.f) + EPS);
      if (t < hu.nvalid) {
          const size_t off = (size_t)(hu.rowbase + t) * 2048 + hu.h * 128 + vs;
          const u32x4 ga = *(const u32x4*)(HG + off), gb = *(const u32x4*)(HG + off + 8);
          const f32x4 n0 = *(const f32x4*)(gn + vs), n1 = *(const f32x4*)(gn + vs + 4), n2 = *(const f32x4*)(gn + vs + 8), n3 = *(const f32x4*)(gn + vs + 12);
          u32x4 oa, ob;
          oa.x = pk2(x[0][0] * rs * n0[0] * bflo(ga.x), x[0][1] * rs * n0[1] * bfhi(ga.x)); oa.y = pk2(x[0][2] * rs * n0[2] * bflo(ga.y), x[0][3] * rs * n0[3] * bfhi(ga.y));
          oa.z = pk2(x[1][0] * rs * n1[0] * bflo(ga.z), x[1][1] * rs * n1[1] * bfhi(ga.z)); oa.w = pk2(x[1][2] * rs * n1[2] * bflo(ga.w), x[1][3] * rs * n1[3] * bfhi(ga.w));
          ob.x = pk2(x[2][0] * rs * n2[0] * bflo(gb.x), x[2][1] * rs * n2[1] * bfhi(gb.x)); ob.y = pk2(x[2][2] * rs * n2[2] * bflo(gb.y), x[2][3] * rs * n2[3] * bfhi(gb.y));
          ob.z = pk2(x[3][0] * rs * n3[0] * bflo(gb.z), x[3][1] * rs * n3[1] * bfhi(gb.z)); ob.w = pk2(x[3][2] * rs * n3[2] * bflo(gb.w), x[3][3] * rs * n3[3] * bfhi(gb.w));
          *(u32x4*)(OH + off) = oa; *(u32x4*)(OH + off + 8) = ob;
      } }
    __syncthreads();
}

template <bool SAMPLE>
DI void attn_wave(const bf16_t* __restrict__ Qp, const bf16_t* __restrict__ Kn, const bf16_t* __restrict__ Kp, const bf16_t* __restrict__ Vt, int t0, int t1, int tstep, int nkeys,
                  float& m, float& l, f32x16 (&O)[4], int r, int hh) {
    bf16x8 qf[12];
#pragma unroll
    for (int s = 0; s < 12; ++s) qf[s] = *(const bf16x8*)(Qp + (size_t)r * 3072 + 16 * s + 8 * hh);
    m = -INFINITY; l = 0.f;
#pragma unroll
    for (int vb = 0; vb < 4; ++vb) O[vb] = zero16();
    for (int t = t0; t < t1; t += tstep) {
        const bf16_t* kn = Kn + (size_t)(64 * t + r) * 2048 + 8 * hh; const bf16_t* kp = Kp + (size_t)(64 * t + r) * 64 + 8 * hh;
        f32x16 S0 = zero16(), S1 = zero16();
#pragma unroll
        for (int s = 0; s < 8; ++s) { const bf16x8 a0 = *(const bf16x8*)(kn + 16 * s), a1 = *(const bf16x8*)(kn + 32 * 2048 + 16 * s); S0 = MFMA32(a0, qf[s], S0); S1 = MFMA32(a1, qf[s], S1); }
#pragma unroll
        for (int s = 0; s < 4; ++s) { const bf16x8 a0 = *(const bf16x8*)(kp + 16 * s), a1 = *(const bf16x8*)(kp + 32 * 64 + 16 * s); S0 = MFMA32(a0, qf[8 + s], S0); S1 = MFMA32(a1, qf[8 + s], S1); }
        if (SAMPLE) { if (64 * t + 64 > nkeys) {
#pragma unroll
            for (int i = 0; i < 16; ++i) { if (64 * t + crow(i, hh) >= nkeys) S0[i] = -INFINITY; if (64 * t + 32 + crow(i, hh) >= nkeys) S1[i] = -INFINITY; } } }
        float mx = fmaxf(S0[0], S1[0]);
#pragma unroll
        for (int i = 1; i < 16; ++i) mx = fmaxf(mx, fmaxf(S0[i], S1[i]));
        mx = fmaxf(mx, __shfl_xor(mx, 32));
        const float mn = fmaxf(m, mx), alpha = ex2(m - mn); m = mn;
        float ls = 0.f;
#pragma unroll
        for (int i = 0; i < 16; ++i) { S0[i] = ex2(S0[i] - mn); S1[i] = ex2(S1[i] - mn); ls += S0[i] + S1[i]; }
        l = l * alpha + ls;
#pragma unroll
        for (int vb = 0; vb < 4; ++vb) O[vb] = O[vb] * alpha;
        const bf16x8 p0 = pack8<0>(S0), p1 = pack8<1>(S0), p2 = pack8<0>(S1), p3 = pack8<1>(S1);
#pragma unroll
        for (int vb = 0; vb < 4; ++vb) {
            const bf16_t* vp = Vt + (size_t)(32 * vb + r) * KVR + 64 * t + 4 * hh;
            { const s16x4 lo = *(const s16x4*)(vp), hi = *(const s16x4*)(vp + 8); O[vb] = MFMA32(__builtin_shufflevector(lo, hi, 0, 1, 2, 3, 4, 5, 6, 7), p0, O[vb]); }
            { const s16x4 lo = *(const s16x4*)(vp + 16), hi = *(const s16x4*)(vp + 24); O[vb] = MFMA32(__builtin_shufflevector(lo, hi, 0, 1, 2, 3, 4, 5, 6, 7), p1, O[vb]); }
            { const s16x4 lo = *(const s16x4*)(vp + 32), hi = *(const s16x4*)(vp + 40); O[vb] = MFMA32(__builtin_shufflevector(lo, hi, 0, 1, 2, 3, 4, 5, 6, 7), p2, O[vb]); }
            { const s16x4 lo = *(const s16x4*)(vp + 48), hi = *(const s16x4*)(vp + 56); O[vb] = MFMA32(__builtin_shufflevector(lo, hi, 0, 1, 2, 3, 4, 5, 6, 7), p3, O[vb]); }
        }
    }
}
DI void attn_prompt_unit(const Params& P, int bh, int jq, int wave, int lane) {
    const bf16_t* Q = (const bf16_t*)(P.ws + WS_Q); const bf16_t* KN = (const bf16_t*)(P.ws + WS_KN); const bf16_t* KPE = (const bf16_t*)(P.ws + WS_KPE); const bf16_t* VT = (const bf16_t*)(P.ws + WS_VT);
    bf16_t* OA = (bf16_t*)(P.ws + WS_OA);
    const int b = bh >> 4, h = bh & 15, rb = 8 * jq + wave, row0 = b * 2048 + 32 * rb, kv0 = b * 2048, r = lane & 31, hh = lane >> 5;
    float m, l; f32x16 O[4];
    attn_wave<false>(Q + (size_t)row0 * 3072 + h * 192, KN + (size_t)kv0 * 2048 + h * 128, KPE + (size_t)kv0 * 64, VT + (size_t)(h * 128) * KVR + kv0, 0, (rb >> 1) + 1, 1, 0, m, l, O, r, hh);
    l += __shfl_xor(l, 32); const float inv = 1.f / l;
#pragma unroll
    for (int vb = 0; vb < 4; ++vb)
#pragma unroll
        for (int g = 0; g < 4; ++g) { u32x2 w; w.x = pk2(O[vb][4 * g] * inv, O[vb][4 * g + 1] * inv); w.y = pk2(O[vb][4 * g + 2] * inv, O[vb][4 * g + 3] * inv);
            *(u32x2*)(OA + (size_t)(row0 + r) * 2048 + h * 128 + 32 * vb + 8 * g + 4 * hh) = w; }
}
constexpr int ATT_KB = 64 * 400, ATT_VB = 128 * 136, ATT_BUF = ATT_KB + ATT_VB;
DI void attn_prompt_lds(LAS unsigned char* lds, const Params& P, int bh, int jq, int wave, int lane, int tid) {
    const bf16_t* Q = (const bf16_t*)(P.ws + WS_Q); const bf16_t* KN = (const bf16_t*)(P.ws + WS_KN); const bf16_t* KPE = (const bf16_t*)(P.ws + WS_KPE); const bf16_t* VT = (const bf16_t*)(P.ws + WS_VT);
    bf16_t* OA = (bf16_t*)(P.ws + WS_OA);
    const int b = bh >> 4, h = bh & 15, rb = 8 * jq + wave, row0 = b * 2048 + 32 * rb, kv0 = b * 2048, r = lane & 31, hh = lane >> 5;
    const int ntiles = 4 * jq + 4, mytiles = (rb >> 1) + 1;
    const bf16_t* gk0 = KN + (size_t)(kv0 + (tid >> 4)) * 2048 + h * 128 + (tid & 15) * 8;
    const bf16_t* gkp = KPE + (size_t)(kv0 + (tid >> 3)) * 64 + (tid & 7) * 8;
    const bf16_t* gv0 = VT + (size_t)(h * 128 + (tid >> 3)) * KVR + kv0 + (tid & 7) * 8;
    const int lk0 = (tid >> 4) * 400 + (tid & 15) * 16, lkp = (tid >> 3) * 400 + 256 + (tid & 7) * 16, lv0 = ATT_KB + (tid >> 3) * 136 + (tid & 7) * 16;
    u32x4 sk0, sk1, skp, sv0, sv1;
#define ATT_LOAD(t) do { const size_t ko = (size_t)(64 * (t)) * 2048, po = (size_t)(64 * (t)) * 64, vo = (size_t)(64 * (t)); \
        sk0 = *(const u32x4*)(gk0 + ko); sk1 = *(const u32x4*)(gk0 + ko + 32 * 2048); skp = *(const u32x4*)(gkp + po); sv0 = *(const u32x4*)(gv0 + vo); sv1 = *(const u32x4*)(gv0 + vo + (size_t)64 * KVR); } while (0)
#define ATT_STORE(buf) do { LAS unsigned char* bb = lds + (buf) * ATT_BUF; \
        *(LAS u32x4*)(bb + lk0) = sk0; *(LAS u32x4*)(bb + lk0 + 32 * 400) = sk1; *(LAS u32x4*)(bb + lkp) = skp; \
        { u32x2 a_, b_; a_.x = sv0.x; a_.y = sv0.y; b_.x = sv0.z; b_.y = sv0.w; *(LAS u32x2*)(bb + lv0) = a_; *(LAS u32x2*)(bb + lv0 + 8) = b_; \
          a_.x = sv1.x; a_.y = sv1.y; b_.x = sv1.z; b_.y = sv1.w; *(LAS u32x2*)(bb + lv0 + 64 * 136) = a_; *(LAS u32x2*)(bb + lv0 + 64 * 136 + 8) = b_; } } while (0)
    ATT_LOAD(0);
    bf16x8 qf[12];
    { const bf16_t* Qp = Q + (size_t)row0 * 3072 + h * 192;
#pragma unroll
      for (int s = 0; s < 12; ++s) qf[s] = *(const bf16x8*)(Qp + (size_t)r * 3072 + 16 * s + 8 * hh); }
    float m = -INFINITY, l = 0.f; f32x16 O[4];
#pragma unroll
    for (int vb = 0; vb < 4; ++vb) O[vb] = zero16();
    ATT_STORE(0);
    __syncthreads();
    for (int t = 0; t < ntiles; ++t) {
        if (t + 1 < ntiles) ATT_LOAD(t + 1);
        if (t < mytiles) {
            const LAS unsigned char* kb_ = lds + (t & 1) * ATT_BUF; const LAS unsigned char* vb_ = kb_ + ATT_KB;
            const LAS bf16_t* kr = (const LAS bf16_t*)(kb_ + r * 400 + 16 * hh);
            f32x16 S0 = zero16(), S1 = zero16();
#pragma unroll
            for (int s = 0; s < 12; ++s) { const bf16x8 a0 = *(const LAS bf16x8*)(kr + 16 * s), a1 = *(const LAS bf16x8*)(kr + 32 * 200 + 16 * s); S0 = MFMA32(a0, qf[s], S0); S1 = MFMA32(a1, qf[s], S1); }
            float mx = fmaxf(S0[0], S1[0]);
#pragma unroll
            for (int i = 1; i < 16; ++i) mx = fmaxf(mx, fmaxf(S0[i], S1[i]));
            mx = fmaxf(mx, __shfl_xor(mx, 32));
            const float mn = fmaxf(m, mx), alpha = ex2(m - mn); m = mn;
            float ls = 0.f;
#pragma unroll
            for (int i = 0; i < 16; ++i) { S0[i] = ex2(S0[i] - mn); S1[i] = ex2(S1[i] - mn); ls += S0[i] + S1[i]; }
            l = l * alpha + ls;
#pragma unroll
            for (int vb = 0; vb < 4; ++vb) O[vb] = O[vb] * alpha;
            const bf16x8 p0 = pack8<0>(S0), p1 = pack8<1>(S0), p2 = pack8<0>(S1), p3 = pack8<1>(S1);
#pragma unroll
            for (int vb = 0; vb < 4; ++vb) {
                const LAS bf16_t* vp = (const LAS bf16_t*)(vb_ + (32 * vb + r) * 136 + 8 * hh);
                { const s16x4 lo = *(const LAS s16x4*)(vp), hi = *(const LAS s16x4*)(vp + 8); O[vb] = MFMA32(__builtin_shufflevector(lo, hi, 0, 1, 2, 3, 4, 5, 6, 7), p0, O[vb]); }
                { const s16x4 lo = *(const LAS s16x4*)(vp + 16), hi = *(const LAS s16x4*)(vp + 24); O[vb] = MFMA32(__builtin_shufflevector(lo, hi, 0, 1, 2, 3, 4, 5, 6, 7), p1, O[vb]); }
                { const s16x4 lo = *(const LAS s16x4*)(vp + 32), hi = *(const LAS s16x4*)(vp + 40); O[vb] = MFMA32(__builtin_shufflevector(lo, hi, 0, 1, 2, 3, 4, 5, 6, 7), p2, O[vb]); }
                { const s16x4 lo = *(const LAS s16x4*)(vp + 48), hi = *(const LAS s16x4*)(vp + 56); O[vb] = MFMA32(__builtin_shufflevector(lo, hi, 0, 1, 2, 3, 4, 5, 6, 7), p3, O[vb]); }
            }
        }
        if (t + 1 < ntiles) ATT_STORE((t + 1) & 1);
        __syncthreads();
    }
#undef ATT_LOAD
#undef ATT_STORE
    l += __shfl_xor(l, 32); const float inv = 1.f / l;
#pragma unroll
    for (int vb = 0; vb < 4; ++vb)
#pragma unroll
        for (int g = 0; g < 4; ++g) { u32x2 w; w.x = pk2(O[vb][4 * g] * inv, O[vb][4 * g + 1] * inv); w.y = pk2(O[vb][4 * g + 2] * inv, O[vb][4 * g + 3] * inv);
            *(u32x2*)(OA + (size_t)(row0 + r) * 2048 + h * 128 + 32 * vb + 8 * g + 4 * hh) = w; }
}
DI void attn_sample_unit(LAS unsigned char* lds, const Params& P, int su, int wave, int lane, int tid) {
    const bf16_t* Q = (const bf16_t*)(P.ws + WS_Q); const bf16_t* KN = (const bf16_t*)(P.ws + WS_KN); const bf16_t* KPE = (const bf16_t*)(P.ws + WS_KPE); const bf16_t* VT = (const bf16_t*)(P.ws + WS_VT);
    bf16_t* OA = (bf16_t*)(P.ws + WS_OA);
    const int b = su >> 4, h = su & 15, row0 = MP + b * 32, kv0 = MP + b * KVB, r = lane & 31, hh = lane >> 5;
    float m, l; f32x16 O[4];
    attn_wave<true>(Q + (size_t)row0 * 3072 + h * 192, KN + (size_t)kv0 * 2048 + h * 128, KPE + (size_t)kv0 * 64, VT + (size_t)(h * 128) * KVR + kv0, wave, 65, 8, 4128, m, l, O, r, hh);
    l += __shfl_xor(l, 32);
    LAS float* ml = (LAS float*)(lds + 131072);
    if (hh == 0) { ml[(wave * 32 + r) * 2] = m; ml[(wave * 32 + r) * 2 + 1] = l; }
    __syncthreads();
    float ms = -INFINITY;
#pragma unroll
    for (int w = 0; w < 8; ++w) ms = fmaxf(ms, ml[(w * 32 + r) * 2]);
    float L = 0.f;
#pragma unroll
    for (int w = 0; w < 8; ++w) L += ml[(w * 32 + r) * 2 + 1] * ex2(ml[(w * 32 + r) * 2] - ms);
    const float sc = ex2(m - ms) / L;
    LAS float* slot = (LAS float*)(lds + wave * 16384);
#pragma unroll
    for (int vb = 0; vb < 4; ++vb)
#pragma unroll
        for (int i = 0; i < 16; ++i) slot[(32 * vb + crow(i, hh)) * 32 + r] = O[vb][i] * sc;
    __syncthreads();
    { const int q = tid & 31, vg = tid >> 5; float a[8];
#pragma unroll
      for (int e = 0; e < 8; ++e) { float s = 0.f;
#pragma unroll
          for (int w = 0; w < 8; ++w) s += ((const LAS float*)(lds + w * 16384))[(8 * vg + e) * 32 + q];
          a[e] = s; }
      u32x4 o; o.x = pk2(a[0], a[1]); o.y = pk2(a[2], a[3]); o.z = pk2(a[4], a[5]); o.w = pk2(a[6], a[7]);
      *(u32x4*)(OA + (size_t)(row0 + q) * 2048 + h * 128 + 8 * vg) = o; }
    __syncthreads();
}

#define XB_TMO      128
#define XB_XCNT(j)  (256  + 64 * (j))
#define XB_XSUB(j)  (1280 + 64 * (j))
#define XB_XGEN(j)  (2304 + 64 * (j))
#define XB_TOP      3328
#define XB_TOPGEN   3392
#define XCD_BAR_WORDS 3456
#define XB_SPIN_CAP (1u << 18)

__device__ __forceinline__ unsigned xb_ld(unsigned* p)              { return __hip_atomic_load(p, __ATOMIC_RELAXED, __HIP_MEMORY_SCOPE_AGENT); }
__device__ __forceinline__ unsigned xb_add(unsigned* p, unsigned v) { return __hip_atomic_fetch_add(p, v, __ATOMIC_RELAXED, __HIP_MEMORY_SCOPE_AGENT); }
__device__ __forceinline__ unsigned xb_xcc_id() { return (unsigned)__builtin_amdgcn_s_getreg((3 << 11) | 20) & 0xFu; }
#define XB_SPIN(cond, bar) do { unsigned _sp = 0; while (cond) { __builtin_amdgcn_s_sleep(1); \
    if ((++_sp & 255u) == 0u) { if (xb_ld(&(bar)[XB_TMO])) break; if (_sp > XB_SPIN_CAP) { atomicAdd(&(bar)[XB_TMO], 1u); break; } } } } while (0)

struct XcdBarrier {
    unsigned* bar; unsigned x;
    volatile LAS unsigned* st;
};

__device__ __forceinline__ XcdBarrier xcd_barrier_post(unsigned* bar, volatile LAS unsigned* st) {
    XcdBarrier b; b.bar = bar; b.x = xb_xcc_id(); b.st = st;
    if (threadIdx.x == 0) (void)xb_add(&bar[XB_XCNT(b.x)], 1u);
    return b;
}
__device__ __forceinline__ void xcd_barrier_complete(unsigned* bar, unsigned x, unsigned& nloc, unsigned& nx) {
    const unsigned G = gridDim.x * gridDim.y * gridDim.z;
    unsigned sum, cnt, mine, sp = 0u;
    for (;;) {
        sum = 0u; cnt = 0u; mine = 0u;
#pragma unroll
        for (unsigned j = 0; j < 16; ++j) { const unsigned c = xb_ld(&bar[XB_XCNT(j)]); sum += c; cnt += (c > 0u) ? 1u : 0u; mine = (j == x) ? c : mine; }
        if (sum == G) break;
        __builtin_amdgcn_s_sleep(1);
        if ((++sp & 255u) == 0u) { if (xb_ld(&bar[XB_TMO])) break; if (sp > XB_SPIN_CAP) { atomicAdd(&bar[XB_TMO], 1u); break; } }
    }
    nloc = mine > 0u ? mine : 1u; nx = cnt > 0u ? cnt : 1u;
}

__device__ __forceinline__ void xcd_barrier(const XcdBarrier& b) {
    asm volatile("s_waitcnt vmcnt(0)" ::: "memory");
    __syncthreads();
    if (threadIdx.x == 0) {
        unsigned* bar = b.bar;
        __builtin_amdgcn_s_waitcnt(0);
        unsigned nloc = b.st[0], nx = b.st[1];
        if (nloc == 0u) { xcd_barrier_complete(bar, b.x, nloc, nx); b.st[0] = nloc; b.st[1] = nx; }
        const unsigned old = xb_add(&bar[XB_XSUB(b.x)], 1u);
        const unsigned gen = old / nloc;
        if (old + 1u == (gen + 1u) * nloc) {
            __builtin_amdgcn_fence(__ATOMIC_RELEASE, "agent");
            asm volatile("s_waitcnt vmcnt(0)" ::: "memory");
            const unsigned og = xb_add(&bar[XB_TOP], 1u);
            const unsigned tg = og / nx;
            if (og + 1u == (tg + 1u) * nx) xb_add(&bar[XB_TOPGEN], 1u);
            else XB_SPIN(xb_ld(&bar[XB_TOPGEN]) == tg, bar);
            __builtin_amdgcn_fence(__ATOMIC_ACQUIRE, "agent");
            xb_add(&bar[XB_XGEN(b.x)], 1u);
            asm volatile("s_waitcnt vmcnt(0)" ::: "memory");
        } else {
            XB_SPIN(xb_ld(&bar[XB_XGEN(b.x)]) == gen, bar);
            __builtin_amdgcn_fence(__ATOMIC_ACQUIRE, "agent");
            asm volatile("s_waitcnt vmcnt(0)" ::: "memory");
        }
    }
    __syncthreads();
}

constexpr int LDS_BYTES = 147456;
template <class Epi> DI void run_gemm(LAS unsigned char* lds, const bf16_t* A, const bf16_t* Bt, int M_, int N_, int K_, int G, int c, const Epi& E) {
    pg8::Gemm g{A, Bt, M_, N_, K_}; pg8::StaticOrder S; S.init(M_, N_, G, c);
    pg8::gemm_phase<Epi, pg8::StaticOrder, true, true>(lds, g, S, E);
}

typedef const __attribute__((address_space(4))) Params CParams;
#define PHASE_BEGIN \
    Params P; { CParams* pp_ = (CParams*)__builtin_amdgcn_kernarg_segment_ptr(); asm volatile("" : "+s"(pp_)); _Pragma("unroll") for (int i_ = 0; i_ < 22; ++i_) P.in[i_] = pp_->in[i_]; P.out = pp_->out; P.ws = pp_->ws; } \
    int tid = threadIdx.x; asm volatile("" : "+v"(tid)); int G = gridDim.x, bx = blockIdx.x; asm volatile("" : "+s"(G), "+s"(bx)); \
    const int lane = tid & 63, wave = __builtin_amdgcn_readfirstlane(tid >> 6); \
    const int vcu = (G % 8 == 0) ? (bx % 8) * (G / 8) + bx / 8 : bx;       \
    const int gw = vcu * 8 + wave, NGW = G * 8, gt = bx * 512 + tid, NGT = G * 512; \
    unsigned char* ws = P.ws; (void)lane; (void)gw; (void)NGW; (void)gt; (void)NGT; (void)ws;

__global__ void __launch_bounds__(512, 2) fwd_kernel(Params Pk) {
    extern __shared__ __attribute__((aligned(16))) unsigned char lds_raw[];
    LAS unsigned char* lds = (LAS unsigned char*)lds_raw;
    cg::grid_group grid = cg::this_grid();
#ifndef PROBE
#define PROBE 0
#endif
#define GSYNC() do { for (int rs_ = 0; rs_ < ((PROBE & 4) ? 2 : 1); ++rs_) { xcd_barrier(xbar); } } while (0)
    for (int u_ = threadIdx.x; u_ < 64; u_ += 512) ((LAS unsigned*)(lds + 131072 + 8192))[u_] = 0u;
    __syncthreads();
    XcdBarrier xbar = xcd_barrier_post((unsigned*)(Pk.ws + WS_CTL), (volatile LAS unsigned*)(lds + 131072 + 8192));
    { PHASE_BEGIN
      for (int rep = 0; rep < ((PROBE & 8) ? 2 : 1); ++rep) {
      layer_prep(P, lds, 0, gw, NGW, gt, NGT, lane, wave);
      rope_table(P, gt, NGT);
      init_x(P, gw, NGW, lane); } }
    __threadfence(); grid.sync(); __threadfence();
    for (int l = 0; l < 2; ++l) {
        { PHASE_BEGIN
          pg8::EpiWin E{(float*)(ws + WS_ZS), (bf16_t*)(ws + WS_HQ), (bf16_t*)(ws + WS_HK), (bf16_t*)(ws + WS_HV), (bf16_t*)(ws + WS_HG), (bf16_t*)(ws + WS_GA), (bf16_t*)(ws + WS_GB), (float*)(ws + WS_LF), (const float*)(ws + WS_LB)};
          run_gemm(lds, (const bf16_t*)(ws + WS_XN), (const bf16_t*)(ws + WS_WIN), MTOK, DINP, 2048, G, bx, E); }
        GSYNC();
        { PHASE_BEGIN
          for (int rep = 0; rep < ((PROBE & 8) ? 2 : 1); ++rep) small_norms(P, l, gw, NGW, lane);
          for (int rep = 0; rep < ((PROBE & 2) ? 2 : 1); ++rep)
          for (int u = vcu; u < NU; u += G) hgrn_pass1(lds, (const float*)(ws + WS_LF), (const bf16_t*)(ws + WS_HK), (const bf16_t*)(ws + WS_HV), (float*)(ws + WS_UT), (float*)(ws + WS_D), u, tid); }
        GSYNC();
        { PHASE_BEGIN
          for (int rep = 0; rep < ((PROBE & 2) ? 2 : 1); ++rep)
          for (int x = vcu; x < 768; x += G) hgrn_pass2(lds, P, l, x, tid); }
        GSYNC();
        { PHASE_BEGIN
          for (int rep = 0; rep < ((PROBE & 2) ? 2 : 1); ++rep)
          for (int u = vcu; u < NU; u += G) hgrn_pass3(lds, (const float*)(ws + WS_LF), (const bf16_t*)(ws + WS_HQ), (const bf16_t*)(ws + WS_HK), (const bf16_t*)(ws + WS_HV), (const bf16_t*)(ws + WS_HG),
                                                       (const bf16_t*)(ws + WS_SPT), P.in[14] + l * 128, (bf16_t*)(ws + WS_OH), u, tid); }
        GSYNC();
        { PHASE_BEGIN
          pg8::EpiQ E{(bf16_t*)(ws + WS_Q), (const float*)(ws + WS_TBL)}; run_gemm(lds, (const bf16_t*)(ws + WS_QN), (const bf16_t*)(ws + WS_WUQ), MTOK, 3072, 512, G, bx, E); }
        { PHASE_BEGIN
          pg8::EpiPlain E{(bf16_t*)(ws + WS_KN), 2048}; run_gemm(lds, (const bf16_t*)(ws + WS_CKV), (const bf16_t*)(ws + WS_WUK), KVR, 2048, 512, G, bx, E); }
        { PHASE_BEGIN
          pg8::EpiPlain E{(bf16_t*)(ws + WS_VT), KVR}; run_gemm(lds, (const bf16_t*)(ws + WS_WUV), (const bf16_t*)(ws + WS_CKV), 2048, KVR, 512, G, bx, E); }
        GSYNC();
        { PHASE_BEGIN
          for (int rep = 0; rep < ((PROBE & 1) ? 2 : 1); ++rep) {
          for (int x = vcu; x < 256; x += G) { const int bh = x >> 2, j = x & 3; attn_prompt_lds(lds, P, bh, 7 - j, wave, lane, tid); attn_prompt_lds(lds, P, bh, j, wave, lane, tid); }
          for (int x = vcu; x < 128; x += G) attn_sample_unit(lds, P, x, wave, lane, tid); } }
        GSYNC();
        { PHASE_BEGIN
          pg8::EpiGate<false> E{(const bf16_t*)(ws + WS_GA), (bf16_t*)(ws + WS_T)}; run_gemm(lds, (const bf16_t*)(ws + WS_OA), (const bf16_t*)(ws + WS_WOA), MTOK, 2048, 2048, G, bx, E); }
        { PHASE_BEGIN
          pg8::EpiGate<true> E{(const bf16_t*)(ws + WS_GB), (bf16_t*)(ws + WS_T)}; run_gemm(lds, (const bf16_t*)(ws + WS_OH), (const bf16_t*)(ws + WS_WOB), MTOK, 2048, 2048, G, bx, E); }
        GSYNC();
        { PHASE_BEGIN
          pg8::EpiF32 E{(float*)(ws + WS_MIX), 2048}; run_gemm(lds, (const bf16_t*)(ws + WS_T), (const bf16_t*)(ws + WS_WOUT), MTOK, 2048, 2048, G, bx, E); }
        GSYNC();
        { PHASE_BEGIN
          resid_norm((const float*)(ws + WS_MIX), P.in[17] + l * 2048, P.out, P.in[18] + l * 2048, (bf16_t*)(ws + WS_XN), gw, NGW, lane); }
        GSYNC();
        { PHASE_BEGIN
          pg8::EpiRelu2 E{(bf16_t*)(ws + WS_H), FFN}; run_gemm(lds, (const bf16_t*)(ws + WS_XN), (const bf16_t*)(ws + WS_WUP), MTOK, FFN, 2048, G, bx, E); }
        GSYNC();
        { PHASE_BEGIN
          pg8::EpiF32 E{(float*)(ws + WS_M2), 2048}; run_gemm(lds, (const bf16_t*)(ws + WS_H), (const bf16_t*)(ws + WS_WDN), MTOK, 2048, FFN, G, bx, E); }
        GSYNC();
        { PHASE_BEGIN
          resid_norm((const float*)(ws + WS_M2), P.in[21] + l * 2048, P.out, l == 0 ? P.in[5] + 2048 : nullptr, (bf16_t*)(ws + WS_XN), gw, NGW, lane);
          if (l == 0) for (int rep = 0; rep < ((PROBE & 8) ? 2 : 1); ++rep) layer_prep(P, lds, 1, gw, NGW, gt, NGT, lane, wave); }
        if (l == 0) GSYNC();
    }
}

extern "C" void kernel_launch(void* const* d_in, const int* in_sizes, int n_in, void* d_out, int out_size, void* d_ws, size_t ws_size, hipStream_t stream) {
    static int grid = 0;
    if (grid == 0) {
        if (n_in != 22 || (size_t)out_size != OUT_TOTAL || ws_size < WS_END) { fprintf(stderr, "kernel_launch: unexpected shapes (n_in %d, out %d, ws %zu, need %zu)\n", n_in, out_size, ws_size, (size_t)WS_END); grid = -1; return; }
        int dev = 0, cus = 0, per_cu = 0;
        if (hipGetDevice(&dev) != hipSuccess || hipDeviceGetAttribute(&cus, hipDeviceAttributeMultiprocessorCount, dev) != hipSuccess) { grid = -1; return; }
        if (hipFuncSetAttribute((const void*)fwd_kernel, hipFuncAttributeMaxDynamicSharedMemorySize, LDS_BYTES) != hipSuccess) { fprintf(stderr, "kernel_launch: hipFuncSetAttribute failed\n"); grid = -1; return; }
        if (hipOccupancyMaxActiveBlocksPerMultiprocessor(&per_cu, (const void*)fwd_kernel, 512, LDS_BYTES) != hipSuccess || per_cu < 1) { fprintf(stderr, "kernel_launch: occupancy query failed (%d)\n", per_cu); per_cu = 1; }
        (void)hipGetLastError();
        grid = cus * per_cu;
    }
    if (grid < 0) return;
    if (hipMemsetAsync((char*)d_ws + WS_CTL, 0, 16384, stream) != hipSuccess) { fprintf(stderr, "kernel_launch: memset failed\n"); return; }
    Params p{};
    for (int i = 0; i < 22; ++i) p.in[i] = (const float*)d_in[i];
    p.out = (float*)d_out; p.ws = (unsigned char*)d_ws;
    void* args[] = {&p};
    hipError_t e = hipLaunchCooperativeKernel((const void*)fwd_kernel, dim3(grid), dim3(512), args, LDS_BYTES, stream);
    if (e != hipSuccess) fprintf(stderr, "kernel_launch: cooperative launch failed: %s (grid %d)\n", hipGetErrorString(e), grid);
}
```

```cpp
#include <hip/hip_runtime.h>
#include <hip/hip_cooperative_groups.h>
#include <cstdio>
#include <cstdint>
namespace cg = cooperative_groups;

#define DI __device__ __forceinline__
#define LAS __attribute__((address_space(3)))
typedef short bf16x8 __attribute__((ext_vector_type(8)));
typedef short s16x4 __attribute__((ext_vector_type(4)));
typedef float f32x4 __attribute__((ext_vector_type(4)));
typedef float f32x16 __attribute__((ext_vector_type(16)));
typedef unsigned u32x4 __attribute__((ext_vector_type(4)));
typedef unsigned u32x2 __attribute__((ext_vector_type(2)));
typedef float f32x2_t __attribute__((ext_vector_type(2)));
typedef __bf16 bf16x2_t __attribute__((ext_vector_type(2)));

constexpr int MP = 8192, MS = 256, MTOK = 8448, DM = 2048, DINP = 13568, ZSW = 1280, FFN = 8192;
constexpr int KVB = 4160;
constexpr int KVR = 8192 + 8 * KVB;
constexpr int NU = 2048 + 128;
constexpr float EPS = 1e-6f;
constexpr float QSCALE = 0.07216878364870322f * 1.4426950408889634f;

constexpr size_t MiB = 1u << 20;
constexpr size_t WS_WIN = 0, WS_WUQ = 53 * MiB, WS_WUK = 56 * MiB, WS_WUV = 58 * MiB, WS_WOA = 60 * MiB, WS_WOB = 68 * MiB, WS_WOUT = 76 * MiB, WS_WUP = 84 * MiB, WS_WDN = 116 * MiB;
constexpr size_t WS_XN = 148 * MiB, WS_HG = 181 * MiB, WS_GA = 214 * MiB, WS_GB = 247 * MiB, WS_QN = 280 * MiB, WS_Q = 289 * MiB, WS_OA = 339 * MiB, WS_OH = 372 * MiB;
constexpr size_t WS_CKV = 405 * MiB, WS_KPE = 446 * MiB, WS_TBL = 452 * MiB, WS_LB = 453 * MiB, WS_D = 454 * MiB, WS_R = 456 * MiB;
constexpr size_t WS_SPT = WS_Q;
constexpr size_t WS_ZS = WS_R, WS_HQ = WS_R + 42 * MiB, WS_HK = WS_R + 75 * MiB, WS_HV = WS_R + 108 * MiB, WS_LF = WS_R + 141 * MiB, WS_UT = WS_R + 207 * MiB;
constexpr size_t WS_KN = WS_R, WS_VT = WS_R + 162 * MiB;
constexpr size_t WS_T = WS_R, WS_MIX = WS_R + 33 * MiB, WS_H = WS_R + 99 * MiB, WS_M2 = WS_R + 231 * MiB;
constexpr size_t WS_SLAB0 = WS_Q, WS_SLAB1 = WS_R + 297 * MiB;
constexpr size_t WS_CTL = WS_R + 343 * MiB;
constexpr size_t WS_END = WS_CTL + 1 * MiB;
static_assert((size_t)NU * 128 * 128 * 2 <= 83 * MiB && (size_t)NU * 65536 <= 136 * MiB && (size_t)KVR * 2048 * 2 <= 162 * MiB, "ws map");

constexpr size_t OUT_X = 0, OUT_CKVP = 17301504, OUT_KPEP = OUT_CKVP + 8388608, OUT_STP = OUT_KPEP + 1048576, OUT_CKVS = OUT_STP + 2097152, OUT_KPES = OUT_CKVS + 262144, OUT_STS = OUT_KPES + 32768;
constexpr size_t OUT_TOTAL = OUT_STS + 4194304;

DI unsigned pk2(float lo, float hi) { f32x2_t v = {lo, hi}; bf16x2_t b = __builtin_convertvector(v, bf16x2_t); return __builtin_bit_cast(unsigned, b); }
DI unsigned short f2bf(float f) { return (unsigned short)(pk2(f, 0.f) & 0xffffu); }
DI float bf2f(unsigned short u) { return __uint_as_float((unsigned)u << 16); }
DI float bflo(unsigned w) { return __uint_as_float(w << 16); }
DI float bfhi(unsigned w) { return __uint_as_float(w & 0xffff0000u); }
DI float sigm(float x) { return 1.f / (1.f + __expf(-x)); }
DI float ex2(float x) { return __builtin_amdgcn_exp2f(x); }
DI float shflx(float v, int mask, int lane) { return __int_as_float(__builtin_amdgcn_ds_bpermute((lane ^ mask) << 2, __float_as_int(v))); }
DI float wave_sum(float v, int lane) {
#pragma unroll
    for (int o = 1; o < 64; o <<= 1) v += shflx(v, o, lane);
    return v;
}
namespace pg8 {
#define PG8_LAS __attribute__((address_space(3)))
typedef unsigned short bf16_t;
typedef short bf16x8 __attribute__((ext_vector_type(8)));
typedef float f32x4 __attribute__((ext_vector_type(4)));
typedef unsigned u32x4 __attribute__((ext_vector_type(4)));
constexpr int BM = 256, BK = 64, HALF = 128, HTB = HALF * BK * 2  , STAGE_BYTES = 8 * HTB, NXCD = 8, WGM = 8;

__host__ __device__ __forceinline__ int lds_byte(int r, int c) { const int st = (r >> 4) * 2 + (c >> 5), rr = r & 15, cc = c & 31, ob = rr * 64 + cc * 2; return st * 1024 + (ob ^ (((ob >> 9) & 1) << 5)); }
__host__ __device__ __forceinline__ void stage_rc(int b, int& R, int& C) { const int st = b / 1024, sb = b % 1024, swz = sb ^ (((sb >> 9) & 1) << 5); R = (st >> 1) * 16 + swz / 64; C = (st & 1) * 32 + (swz % 64) / 2; }
__host__ __device__ __forceinline__ int perm32(int rho) { const int n = rho >> 4, i = rho & 15; return 8 * (i >> 2) + 4 * n + (i & 3); }

struct Unit { int pm, pn, koff, mask; };
struct Gemm { const bf16_t* A; const bf16_t* Bt; int M, N, K, kext; };

struct StaticOrder {
    int nM, nN, nwg, G, c;
    __host__ __device__ void init(int M, int N, int G_, int c_) { nM = M / BM; nN = N / BM; nwg = nM * nN; G = G_; c = c_; }
    __host__ __device__ bool next(int i, Unit& u) const {
        const long L = (long)i * G + c; if (L >= nwg) return false;
        int wgid = (int)L; { const int q = nwg / NXCD, r = nwg % NXCD, xcd = wgid % NXCD, off = wgid / NXCD; wgid = (xcd < r ? xcd * (q + 1) : r * (q + 1) + (xcd - r) * q) + off; }
        const int nig = WGM * nN, gid = wgid / nig, fm = gid * WGM, gsz = (nM - fm) < WGM ? (nM - fm) : WGM;
        u.pm = fm + ((wgid % nig) % gsz); u.pn = (wgid % nig) / gsz; u.koff = 0; u.mask = 0xff; return true;
    }
    __device__ __forceinline__ void a_ready(const Unit&) const {}
    __device__ __forceinline__ void done(const Unit&) const {}
};

struct TailOrder {
    int pm, nN, KS, kext, G, c;
    __host__ __device__ bool next(int i, Unit& u) const { const int L = i * G + c; if (L >= nN * KS) return false; u.pm = pm; u.pn = L / KS; u.koff = (L - u.pn * KS) * kext; u.mask = 0xff; return true; }
    __device__ __forceinline__ void a_ready(const Unit&) const {}
    __device__ __forceinline__ void done(const Unit&) const {}
};
#define EPI_LOOP _Pragma("unroll") for (int ai = 0; ai < 2; ++ai) _Pragma("unroll") for (int m = 0; m < 4; ++m) if ((u.mask >> (ai * 4 + m)) & 1) _Pragma("unroll") for (int bj = 0; bj < 2; ++bj)
__device__ __forceinline__ u32x4 pack8f(const f32x4 a, const f32x4 b) { u32x4 w; w.x = pk2(a[0], a[1]); w.y = pk2(a[2], a[3]); w.z = pk2(b[0], b[1]); w.w = pk2(b[2], b[3]); return w; }

struct EpiWin {
    static constexpr bool PERM = true, AFTER_DRAIN = false;
    float* Zs; bf16_t *HQ, *HK, *HV, *HG, *GA, *GB; float* LF; const float* lb;
    __device__ __forceinline__ void operator()(const f32x4 (&acc)[2][2][4][2], const Unit& u, int wr, int wc, int fr, int fq) const {
        const int row0 = u.pm * 256 + wr * 64 + fr, ct = wc * 32 + 8 * fq, pn = u.pn;
        if (pn < 5) {
            EPI_LOOP { float* p = Zs + (size_t)(row0 + ai * 128 + m * 16) * ZSW + pn * 256 + ct + bj * 128; *(f32x4*)p = acc[ai][bj][m][0]; *(f32x4*)(p + 4) = acc[ai][bj][m][1]; }
            return;
        }
        const int seg = (pn - 5) >> 3, cseg = ((pn - 5) & 7) * 256 + ct;
        if (seg == 1) {
#pragma unroll
            for (int bj = 0; bj < 2; ++bj) {
                const f32x4 l0 = *(const f32x4*)(lb + cseg + bj * 128), l1 = *(const f32x4*)(lb + cseg + bj * 128 + 4);
#pragma unroll
                for (int ai = 0; ai < 2; ++ai)
#pragma unroll
                    for (int m = 0; m < 4; ++m) {
                        const size_t off = (size_t)(row0 + ai * 128 + m * 16) * 2048 + cseg + bj * 128;
                        f32x4 lf0, lf1, k0, k1;
#pragma unroll
                        for (int e = 0; e < 4; ++e) {
                            { const float z = acc[ai][bj][m][0][e], lbv = l0[e], ez = __expf(-z), sg = 1.f / (1.f + ez); lf0[e] = __logf(lbv + (1.f - lbv) * sg); k0[e] = (1.f - lbv) * ez * sg; }
                            { const float z = acc[ai][bj][m][1][e], lbv = l1[e], ez = __expf(-z), sg = 1.f / (1.f + ez); lf1[e] = __logf(lbv + (1.f - lbv) * sg); k1[e] = (1.f - lbv) * ez * sg; }
                        }
                        *(f32x4*)(LF + off) = lf0; *(f32x4*)(LF + off + 4) = lf1; *(u32x4*)(HK + off) = pack8f(k0, k1);
                    }
            }
            return;
        }
        bf16_t* O = seg == 0 ? HQ : seg == 2 ? HV : seg == 3 ? HG : seg == 4 ? GA : GB;
        const int act = (seg == 0 || seg == 3) ? 1 : (seg == 2 ? 0 : 2);
        EPI_LOOP {
            f32x4 a = acc[ai][bj][m][0], b = acc[ai][bj][m][1];
#pragma unroll
            for (int e = 0; e < 4; ++e) { const float sa = sigm(a[e]), sb = sigm(b[e]); a[e] = act == 0 ? a[e] : act == 1 ? a[e] * sa : sa; b[e] = act == 0 ? b[e] : act == 1 ? b[e] * sb : sb; }
            *(u32x4*)(O + (size_t)(row0 + ai * 128 + m * 16) * 2048 + cseg + bj * 128) = pack8f(a, b);
        }
    }
};

struct EpiQ {
    static constexpr bool PERM = true, AFTER_DRAIN = false;
    bf16_t* Q; const float* tbl;
    __device__ __forceinline__ void operator()(const f32x4 (&acc)[2][2][4][2], const Unit& u, int wr, int wc, int fr, int fq) const {
        const int row0 = u.pm * 256 + wr * 64 + fr, ct = wc * 32 + 8 * fq, pn = u.pn;
        if (pn < 8) {
            EPI_LOOP { const int col = pn * 256 + ct + bj * 128, h = col >> 7, i = col & 127;
                *(u32x4*)(Q + (size_t)(row0 + ai * 128 + m * 16) * 3072 + h * 192 + i) = pack8f(acc[ai][bj][m][0] * QSCALE, acc[ai][bj][m][1] * QSCALE); }
            return;
        }
        EPI_LOOP {
            const int row = row0 + ai * 128 + m * 16, p = row < MP ? (row & 2047) : 2048 + ((row - MP) & 31);
            const int c = (pn - 8) * 256 + ct + bj * 128, h = c >> 6, j0 = (c & 63) >> 1;
            const f32x4 t0 = *(const f32x4*)(tbl + (size_t)(p * 32 + j0) * 2), t1 = *(const f32x4*)(tbl + (size_t)(p * 32 + j0) * 2 + 4);
            const f32x4 x = acc[ai][bj][m][0] * QSCALE, y = acc[ai][bj][m][1] * QSCALE;
            const float a0 = x[0] * t0[0] - x[1] * t0[1], b0 = x[0] * t0[1] + x[1] * t0[0];
            const float a1 = x[2] * t0[2] - x[3] * t0[3], b1 = x[2] * t0[3] + x[3] * t0[2];
            const float a2 = y[0] * t1[0] - y[1] * t1[1], b2 = y[0] * t1[1] + y[1] * t1[0];
            const float a3 = y[2] * t1[2] - y[3] * t1[3], b3 = y[2] * t1[3] + y[3] * t1[2];
            bf16_t* q = Q + (size_t)row * 3072 + h * 192 + 128 + j0;
            u32x2 w1, w2; w1.x = pk2(a0, a1); w1.y = pk2(a2, a3); w2.x = pk2(b0, b1); w2.y = pk2(b2, b3);
            *(u32x2*)q = w1; *(u32x2*)(q + 32) = w2;
            if (bj == 1) asm volatile("" ::: "memory");
        }
    }
};

struct EpiPlain {
    static constexpr bool PERM = true, AFTER_DRAIN = false;
    bf16_t* O; int ldc;
    __device__ __forceinline__ void operator()(const f32x4 (&acc)[2][2][4][2], const Unit& u, int wr, int wc, int fr, int fq) const {
        const int row0 = u.pm * 256 + wr * 64 + fr, c0 = u.pn * 256 + wc * 32 + 8 * fq;
        EPI_LOOP { *(u32x4*)(O + (size_t)(row0 + ai * 128 + m * 16) * ldc + c0 + bj * 128) = pack8f(acc[ai][bj][m][0], acc[ai][bj][m][1]); }
    }
};
struct EpiF32 {
    static constexpr bool PERM = true, AFTER_DRAIN = false;
    float* O; int ldc;
    __device__ __forceinline__ void operator()(const f32x4 (&acc)[2][2][4][2], const Unit& u, int wr, int wc, int fr, int fq) const {
        const int row0 = u.pm * 256 + wr * 64 + fr, c0 = u.pn * 256 + wc * 32 + 8 * fq;
        EPI_LOOP { float* p = O + (size_t)(row0 + ai * 128 + m * 16) * ldc + c0 + bj * 128; *(f32x4*)p = acc[ai][bj][m][0]; *(f32x4*)(p + 4) = acc[ai][bj][m][1]; }
    }
};
struct EpiRelu2 {
    static constexpr bool PERM = true, AFTER_DRAIN = false;
    bf16_t* O; int ldc;
    __device__ __forceinline__ void operator()(const f32x4 (&acc)[2][2][4][2], const Unit& u, int wr, int wc, int fr, int fq) const {
        const int row0 = u.pm * 256 + wr * 64 + fr, c0 = u.pn * 256 + wc * 32 + 8 * fq;
        EPI_LOOP { f32x4 a = acc[ai][bj][m][0], b = acc[ai][bj][m][1];
#pragma unroll
            for (int e = 0; e < 4; ++e) { const float ra = fmaxf(a[e], 0.f), rb = fmaxf(b[e], 0.f); a[e] = ra * ra; b[e] = rb * rb; }
            *(u32x4*)(O + (size_t)(row0 + ai * 128 + m * 16) * ldc + c0 + bj * 128) = pack8f(a, b); }
    }
};
template <bool SECOND> struct EpiGate {
    static constexpr bool PERM = true, AFTER_DRAIN = false;
    const bf16_t* Gt; bf16_t* T;
    __device__ __forceinline__ void operator()(const f32x4 (&acc)[2][2][4][2], const Unit& u, int wr, int wc, int fr, int fq) const {
        const int row0 = u.pm * 256 + wr * 64 + fr, c0 = u.pn * 256 + wc * 32 + 8 * fq;
        EPI_LOOP { const size_t off = (size_t)(row0 + ai * 128 + m * 16) * 2048 + c0 + bj * 128;
            const u32x4 g = *(const u32x4*)(Gt + off); f32x4 a = acc[ai][bj][m][0], b = acc[ai][bj][m][1];
            a[0] *= bflo(g.x); a[1] *= bfhi(g.x); a[2] *= bflo(g.y); a[3] *= bfhi(g.y); b[0] *= bflo(g.z); b[1] *= bfhi(g.z); b[2] *= bflo(g.w); b[3] *= bfhi(g.w);
            if (SECOND) { const u32x4 t = *(const u32x4*)(T + off);
                a[0] += bflo(t.x); a[1] += bfhi(t.x); a[2] += bflo(t.y); a[3] += bfhi(t.y); b[0] += bflo(t.z); b[1] += bfhi(t.z); b[2] += bflo(t.w); b[3] += bfhi(t.w); }
            *(u32x4*)(T + off) = pack8f(a, b);
            if (bj == 1 && (m & 1)) asm volatile("" ::: "memory"); }
    }
};

struct EpiSlab {
    static constexpr bool PERM = true, AFTER_DRAIN = false;
    float* slab; int ldc, kext;
    __device__ __forceinline__ void operator()(const f32x4 (&acc)[2][2][4][2], const Unit& u, int wr, int wc, int fr, int fq) const {
        const int kp = u.koff / kext, r0 = wr * 64 + fr, c0 = u.pn * 256 + wc * 32 + 8 * fq;
        EPI_LOOP { float* p = slab + ((size_t)kp * 256 + r0 + ai * 128 + m * 16) * ldc + c0 + bj * 128; *(f32x4*)p = acc[ai][bj][m][0]; *(f32x4*)(p + 4) = acc[ai][bj][m][1]; }
    }
};
template <class Epi> __device__ __forceinline__ void tail_fixup(const float* slab, int KS, int ldc, int pm, int pn, int mask, const Epi& E, int tid_in) {
    Unit u; u.pm = pm; u.pn = pn; u.koff = 0; u.mask = mask;
    int tid_l = tid_in; asm volatile("" : "+v"(tid_l));
    const int wid = tid_l >> 6, lane = tid_l & 63, wr = wid >> 2, wc = wid & 3, fr = lane & 15, fq = lane >> 4;
    const int r0 = wr * 64 + fr, c0 = pn * 256 + wc * 32 + 8 * fq;
    f32x4 acc[2][2][4][2];
    EPI_LOOP { acc[ai][bj][m][0] = (f32x4){0.f, 0.f, 0.f, 0.f}; acc[ai][bj][m][1] = (f32x4){0.f, 0.f, 0.f, 0.f}; }
    const char* sb = (const char*)slab; unsigned off = ((unsigned)r0 * (unsigned)ldc + (unsigned)c0) * 4u;
    for (int kp = 0; kp < KS; ++kp) {
        EPI_LOOP { const char* p = sb + (off + (unsigned)((ai * 128 + m * 16) * ldc + bj * 128) * 4u); acc[ai][bj][m][0] += *(const f32x4*)p; acc[ai][bj][m][1] += *(const f32x4*)(p + 16); }
        off += 256u * (unsigned)ldc * 4u;
    }
    E(acc, u, wr, wc, fr, fq);
}
template <class Epi, class Sched, bool ALIGN_EPI = false, bool SP2 = false>
__device__ __forceinline__ void gemm_phase(PG8_LAS unsigned char* lds, const Gemm g, const Sched& S, const Epi& E, int tid_in) {
    int tid_l = tid_in; asm volatile("" : "+v"(tid_l));
    const int tid = tid_l, wid = __builtin_amdgcn_readfirstlane(tid >> 6), lane = tid & 63, wr = wid >> 2, wc = wid & 3, fr = lane & 15, fq = lane >> 4;
    const int K = g.K, nt = g.kext / BK;
    unsigned voffA[2], voffB[2];
#pragma unroll
    for (int i = 0; i < 2; ++i) { int R, C; stage_rc(tid * 16 + i * 8192, R, C); const int Rb = Epi::PERM ? ((R & ~31) + perm32(R & 31)) : R;
        voffA[i] = (unsigned)(R * K + C) * 2u; voffB[i] = (unsigned)(Rb * K + C) * 2u; }
    const size_t kstep = (size_t)(BK * 2);
    const size_t hstep = (size_t)HALF * K * 2;
    const size_t tstep = 2 * hstep;
    const unsigned ldsw = (unsigned)wid * 1024u;
    const int aoff = lds_byte(wr * 64 + fr, fq * 8), boff = lds_byte(wc * 32 + fr, fq * 8);
#define PG8_SA(b, h) (((b) * 2 + (h)) * HTB)
#define PG8_SB(b, h) ((4 + (b) * 2 + (h)) * HTB)
#define PG8_STAGE(bufoff, gbase, voff) do { _Pragma("unroll") for (int _i = 0; _i < 2; ++_i) \
        __builtin_amdgcn_global_load_lds((const unsigned*)((const char*)(gbase) + (voff)[_i]), (PG8_LAS unsigned*)(lds + (bufoff) + ldsw + _i * 8192), 16, 0, 0); } while (0)
#define PG8_LDA(dst, b, h) do { _Pragma("unroll") for (int m = 0; m < 4; ++m) _Pragma("unroll") for (int k = 0; k < 2; ++k) dst[m][k] = *(const PG8_LAS bf16x8*)(lds + PG8_SA(b, h) + aoff + m * 2048 + k * 1024); } while (0)
#define PG8_LDB(dst, b, h) do { _Pragma("unroll") for (int n = 0; n < 2; ++n) _Pragma("unroll") for (int k = 0; k < 2; ++k) dst[n][k] = *(const PG8_LAS bf16x8*)(lds + PG8_SB(b, h) + boff + n * 2048 + k * 1024); } while (0)
#define PG8_MMA(ai, bj, At, Bt) do { __builtin_amdgcn_s_setprio(1); _Pragma("unroll") for (int m = 0; m < 4; ++m) _Pragma("unroll") for (int n = 0; n < 2; ++n) _Pragma("unroll") for (int k = 0; k < 2; ++k) \
        acc[ai][bj][m][n] = __builtin_amdgcn_mfma_f32_16x16x32_bf16(Bt[n][k], At[m][k], acc[ai][bj][m][n], 0, 0, 0); __builtin_amdgcn_s_setprio(0); } while (0)
#define PG8_WAIT_V(n) asm volatile("s_waitcnt vmcnt(" #n ")" ::: "memory")
#define PG8_WAIT_L(n) asm volatile("s_waitcnt lgkmcnt(" #n ")" ::: "memory")
#define PG8_BAR __builtin_amdgcn_s_barrier()
#define PG8_SCHED __builtin_amdgcn_sched_barrier(0)
    Unit cur, nxt; int ui = 0;
    if (!S.next(0, cur)) return;
    f32x4 acc[2][2][4][2];
#pragma unroll
    for (int a = 0; a < 2; ++a)
#pragma unroll
        for (int b = 0; b < 2; ++b)
#pragma unroll
            for (int m = 0; m < 4; ++m)
#pragma unroll
                for (int n = 0; n < 2; ++n) acc[a][b][m][n] = (f32x4){0.f, 0.f, 0.f, 0.f};
    bf16x8 At[4][2], B0[2][2], B1[2][2];
    const char* cA = (const char*)g.A + (size_t)cur.pm * tstep + (size_t)cur.koff * 2; const char* cB = (const char*)g.Bt + (size_t)cur.pn * tstep + (size_t)cur.koff * 2;
    S.a_ready(cur);
    if constexpr (SP2) {
        PG8_STAGE(PG8_SB(0, 0), cB, voffB); PG8_STAGE(PG8_SB(0, 1), cB + hstep, voffB); PG8_STAGE(PG8_SA(0, 0), cA, voffA); PG8_STAGE(PG8_SA(0, 1), cA + hstep, voffA);
        if (wr == 1) PG8_BAR;
        PG8_WAIT_V(2); PG8_BAR;
        PG8_STAGE(PG8_SB(1, 0), cB + kstep, voffB); PG8_STAGE(PG8_SA(1, 0), cA + kstep, voffA); PG8_STAGE(PG8_SB(1, 1), cB + hstep + kstep, voffB);
        PG8_WAIT_V(6); PG8_BAR;
    } else {
        PG8_STAGE(PG8_SB(0, 0), cB, voffB); PG8_STAGE(PG8_SA(0, 0), cA, voffA); PG8_STAGE(PG8_SB(0, 1), cB + hstep, voffB); PG8_STAGE(PG8_SA(0, 1), cA + hstep, voffA);
        if (wr == 1) PG8_BAR;
        PG8_WAIT_V(4); PG8_BAR;
        PG8_STAGE(PG8_SB(1, 0), cB + kstep, voffB); PG8_STAGE(PG8_SA(1, 0), cA + kstep, voffA); PG8_STAGE(PG8_SB(1, 1), cB + hstep + kstep, voffB);
        PG8_WAIT_V(6); PG8_BAR;
    }
    for (;;) {
        const bool has_next = S.next(ui + 1, nxt);
        const char* nA = has_next ? (const char*)g.A + (size_t)nxt.pm * tstep + (size_t)nxt.koff * 2 : cA; const char* nB = has_next ? (const char*)g.Bt + (size_t)nxt.pn * tstep + (size_t)nxt.koff * 2 : cB;
        for (int t = 0; t < nt; t += 2) {
            const bool last = (t == nt - 2);
            const char* a1 = cA + (size_t)(t + 1) * kstep;
            const char* a2 = last ? nA : cA + (size_t)(t + 2) * kstep; const char* b2 = last ? nB : cB + (size_t)(t + 2) * kstep;
            const char* a3 = a2 + kstep; const char* b3 = b2 + kstep;
            if (last && has_next) S.a_ready(nxt);
            if constexpr (SP2) {
            PG8_LDB(B0, 0, 0); PG8_LDB(B1, 0, 1); PG8_SCHED; PG8_LDA(At, 0, 0); PG8_STAGE(PG8_SA(1, 1), a1 + hstep, voffA);
            PG8_WAIT_V(8); PG8_WAIT_L(0); PG8_BAR; PG8_MMA(0, 0, At, B0); PG8_MMA(0, 1, At, B1); PG8_BAR; PG8_SCHED;
            PG8_LDA(At, 0, 1); PG8_STAGE(PG8_SB(0, 0), b2, voffB); PG8_STAGE(PG8_SB(0, 1), b2 + hstep, voffB); PG8_STAGE(PG8_SA(0, 0), a2, voffA);
            PG8_WAIT_V(8); PG8_WAIT_L(0); PG8_BAR; PG8_MMA(1, 0, At, B0); PG8_MMA(1, 1, At, B1); PG8_BAR; PG8_SCHED;
            PG8_LDB(B0, 1, 0); PG8_LDB(B1, 1, 1); PG8_SCHED; PG8_LDA(At, 1, 0); PG8_STAGE(PG8_SA(0, 1), a2 + hstep, voffA);
            PG8_WAIT_V(8); PG8_WAIT_L(0); PG8_BAR; PG8_MMA(0, 0, At, B0); PG8_MMA(0, 1, At, B1); PG8_BAR; PG8_SCHED;
            PG8_LDA(At, 1, 1); PG8_STAGE(PG8_SB(1, 0), b3, voffB); PG8_STAGE(PG8_SB(1, 1), b3 + hstep, voffB); PG8_STAGE(PG8_SA(1, 0), a3, voffA);
            PG8_WAIT_V(8); PG8_WAIT_L(0); PG8_BAR; PG8_MMA(1, 0, At, B0); PG8_MMA(1, 1, At, B1); PG8_BAR; PG8_SCHED;
            } else {
            PG8_LDB(B0, 0, 0); PG8_SCHED; PG8_LDA(At, 0, 0); PG8_STAGE(PG8_SA(1, 1), a1 + hstep, voffA);
            PG8_WAIT_L(8); PG8_BAR; PG8_WAIT_L(0); PG8_MMA(0, 0, At, B0); PG8_BAR; PG8_SCHED;
            PG8_LDB(B1, 0, 1); PG8_STAGE(PG8_SB(0, 0), b2, voffB);
            PG8_BAR; PG8_WAIT_L(0); PG8_MMA(0, 1, At, B1); PG8_BAR;
            PG8_LDA(At, 0, 1); PG8_STAGE(PG8_SA(0, 0), a2, voffA);
            PG8_BAR; PG8_WAIT_L(0); PG8_MMA(1, 0, At, B0); PG8_BAR; PG8_SCHED;
            PG8_STAGE(PG8_SB(0, 1), b2 + hstep, voffB);
            PG8_WAIT_V(6); PG8_BAR; PG8_MMA(1, 1, At, B1); PG8_BAR;
            PG8_LDB(B0, 1, 0); PG8_SCHED; PG8_LDA(At, 1, 0); PG8_STAGE(PG8_SA(0, 1), a2 + hstep, voffA);
            PG8_WAIT_L(8); PG8_BAR; PG8_WAIT_L(0); PG8_MMA(0, 0, At, B0); PG8_BAR; PG8_SCHED;
            PG8_LDB(B1, 1, 1); PG8_STAGE(PG8_SB(1, 0), b3, voffB);
            PG8_BAR; PG8_WAIT_L(0); PG8_MMA(0, 1, At, B1); PG8_BAR;
            PG8_LDA(At, 1, 1); PG8_STAGE(PG8_SA(1, 0), a3, voffA);
            PG8_BAR; PG8_WAIT_L(0); PG8_MMA(1, 0, At, B0); PG8_BAR; PG8_SCHED;
            PG8_STAGE(PG8_SB(1, 1), b3 + hstep, voffB);
            PG8_WAIT_V(6); PG8_BAR; PG8_MMA(1, 1, At, B1); PG8_BAR;
            }
        }
        if constexpr (ALIGN_EPI) { if (wr == 0) PG8_BAR; }
        if constexpr (!Epi::AFTER_DRAIN) { E(acc, cur, wr, wc, fr, fq); S.done(cur); }
        if (!has_next) break;
#pragma unroll
        for (int a = 0; a < 2; ++a)
#pragma unroll
            for (int b = 0; b < 2; ++b)
#pragma unroll
                for (int m = 0; m < 4; ++m)
#pragma unroll
                    for (int n = 0; n < 2; ++n) acc[a][b][m][n] = (f32x4){0.f, 0.f, 0.f, 0.f};
        cur = nxt; cA = nA; cB = nB; ++ui;
        if constexpr (ALIGN_EPI) { if (wr == 1) PG8_BAR; }
    }
    PG8_WAIT_V(0);
    if constexpr (!ALIGN_EPI) { if (wr == 0) PG8_BAR; }
    PG8_BAR;
    if constexpr (Epi::AFTER_DRAIN) { E.fused(acc, cur, wr, wc, fr, fq, lds, wid, lane); S.done(cur); }
#undef PG8_SA
#undef PG8_SB
#undef PG8_STAGE
#undef PG8_LDA
#undef PG8_LDB
#undef PG8_MMA
#undef PG8_WAIT_V
#undef PG8_WAIT_L
#undef PG8_BAR
#undef PG8_SCHED
}
}
using pg8::bf16_t;
#define MFMA32(a, b, c) __builtin_amdgcn_mfma_f32_32x32x16_bf16((a), (b), (c), 0, 0, 0)
#define LDS_WAIT() asm volatile("s_waitcnt lgkmcnt(0)" ::: "memory")
DI int crow(int i, int h) { return (i & 3) + 8 * (i >> 2) + 4 * h; }
template <int S> DI bf16x8 pack8(const f32x16& x) {
    u32x4 p; p.x = pk2(x[8 * S], x[8 * S + 1]); p.y = pk2(x[8 * S + 2], x[8 * S + 3]); p.z = pk2(x[8 * S + 4], x[8 * S + 5]); p.w = pk2(x[8 * S + 6], x[8 * S + 7]);
    return __builtin_bit_cast(bf16x8, p);
}
DI f32x16 zero16() { f32x16 z;
#pragma unroll
    for (int i = 0; i < 16; ++i) z[i] = 0.f; return z; }

struct Params { const float* in[22]; float* out; unsigned char* ws; };

enum { MAP_ID = 0, MAP_WIN = 1, MAP_WUQ = 2 };
template <int MAP> DI int dest_row(int n) {
    if (MAP == MAP_WIN) return n < 1088 ? n : n + 192;
    if (MAP == MAP_WUQ) { const int h = n / 192, i = n - h * 192; return i < 128 ? h * 128 + i : 2048 + h * 64 + 2 * ((i - 128) & 31) + ((i - 128) >> 5); }
    return n;
}
template <int MAP> DI void transpose_item(const float* __restrict__ W, int K, int N, bf16_t* __restrict__ WT, LAS float* scr, int item, int lane) {
    const int nblk = N / 32, kb = item / nblk, nb = item - kb * nblk, k0 = 64 * kb, n0 = 32 * nb;
#pragma unroll 8
    for (int i = 0; i < 32; ++i) { const int kk = 2 * i + (lane >> 5); scr[kk * 33 + (lane & 31)] = W[(size_t)(k0 + kk) * N + n0 + (lane & 31)]; }
    LDS_WAIT();
    const int c = lane & 7;
#pragma unroll
    for (int j = 0; j < 4; ++j) { const int n = (lane >> 3) + 8 * j; const LAS float* s = scr + (8 * c) * 33 + n;
        u32x4 o; o.x = pk2(s[0 * 33], s[1 * 33]); o.y = pk2(s[2 * 33], s[3 * 33]); o.z = pk2(s[4 * 33], s[5 * 33]); o.w = pk2(s[6 * 33], s[7 * 33]);
        *(u32x4*)(WT + (size_t)dest_row<MAP>(n0 + n) * K + k0 + 8 * c) = o; }
    LDS_WAIT();
}

DI void layer_prep(const Params& P, LAS unsigned char* lds, int l, int gw, int NGW, int gt, int NGT, int lane, int wave) {
    unsigned char* ws = P.ws;
    LAS float* scr = (LAS float*)(lds + wave * 16384);
    const float* w_in = P.in[6] + (size_t)l * 2048 * 13376; const float* w_uq = P.in[8] + (size_t)l * 512 * 3072;
    const float* w_uk = P.in[10] + (size_t)l * 512 * 2048;  const float* w_uv = P.in[11] + (size_t)l * 512 * 2048;
    const float* w_oa = P.in[12] + (size_t)l * 2048 * 2048; const float* w_ob = P.in[15] + (size_t)l * 2048 * 2048; const float* w_out = P.in[16] + (size_t)l * 2048 * 2048;
    const float* w_up = P.in[19] + (size_t)l * 2048 * 8192; const float* w_dn = P.in[20] + (size_t)l * 8192 * 2048;
    constexpr int I_IN = 32 * 418, I_UQ = 8 * 96, I_UK = 8 * 64, I_SQ = 32 * 64, I_UP = 32 * 256, I_DN = 128 * 64;
    constexpr int NIT = I_IN + I_UQ + 2 * I_UK + 3 * I_SQ + I_UP + I_DN;
    for (int it = gw; it < NIT; it += NGW) {
        int r = it;
        if (r < I_IN) { transpose_item<MAP_WIN>(w_in, 2048, 13376, (bf16_t*)(ws + WS_WIN), scr, r, lane); continue; } r -= I_IN;
        if (r < I_UQ) { transpose_item<MAP_WUQ>(w_uq, 512, 3072, (bf16_t*)(ws + WS_WUQ), scr, r, lane); continue; } r -= I_UQ;
        if (r < I_UK) { transpose_item<MAP_ID>(w_uk, 512, 2048, (bf16_t*)(ws + WS_WUK), scr, r, lane); continue; } r -= I_UK;
        if (r < I_UK) { transpose_item<MAP_ID>(w_uv, 512, 2048, (bf16_t*)(ws + WS_WUV), scr, r, lane); continue; } r -= I_UK;
        if (r < I_SQ) { transpose_item<MAP_ID>(w_oa, 2048, 2048, (bf16_t*)(ws + WS_WOA), scr, r, lane); continue; } r -= I_SQ;
        if (r < I_SQ) { transpose_item<MAP_ID>(w_ob, 2048, 2048, (bf16_t*)(ws + WS_WOB), scr, r, lane); continue; } r -= I_SQ;
        if (r < I_SQ) { transpose_item<MAP_ID>(w_out, 2048, 2048, (bf16_t*)(ws + WS_WOUT), scr, r, lane); continue; } r -= I_SQ;
        if (r < I_UP) { transpose_item<MAP_ID>(w_up, 2048, 8192, (bf16_t*)(ws + WS_WUP), scr, r, lane); continue; } r -= I_UP;
        transpose_item<MAP_ID>(w_dn, 8192, 2048, (bf16_t*)(ws + WS_WDN), scr, r, lane);
    }
    u32x4 z4; { unsigned z_; asm volatile("v_mov_b32 %0, 0" : "=v"(z_)); z4.x = z_; z4.y = z_; z4.z = z_; z4.w = z_; }
    { u32x4* z = (u32x4*)((bf16_t*)(ws + WS_WIN) + (size_t)1088 * 2048); for (int i = gt; i < 192 * 2048 / 8; i += NGT) z[i] = z4; }
    bf16_t* CKV = (bf16_t*)(ws + WS_CKV); bf16_t* KPE = (bf16_t*)(ws + WS_KPE);
    const float* cc = P.in[2] + (size_t)l * 8 * 4096 * 512; const float* ck = P.in[3] + (size_t)l * 8 * 4096 * 64;
    for (int i = gt; i < 8 * 4096 * 512 / 8; i += NGT) { const int b = i >> 18, rem = i & 262143, t = rem >> 6, c8 = rem & 63;
        const f32x4 a = *(const f32x4*)(cc + (size_t)i * 8), bq = *(const f32x4*)(cc + (size_t)i * 8 + 4);
        u32x4 o; o.x = pk2(a[0], a[1]); o.y = pk2(a[2], a[3]); o.z = pk2(bq[0], bq[1]); o.w = pk2(bq[2], bq[3]);
        *(u32x4*)(CKV + (size_t)(MP + b * KVB + t) * 512 + c8 * 8) = o; }
    for (int i = gt; i < 8 * 4096 * 64 / 8; i += NGT) { const int b = i >> 15, rem = i & 32767, t = rem >> 3, c8 = rem & 7;
        const f32x4 a = *(const f32x4*)(ck + (size_t)i * 8), bq = *(const f32x4*)(ck + (size_t)i * 8 + 4);
        u32x4 o; o.x = pk2(a[0], a[1]); o.y = pk2(a[2], a[3]); o.z = pk2(bq[0], bq[1]); o.w = pk2(bq[2], bq[3]);
        *(u32x4*)(KPE + (size_t)(MP + b * KVB + t) * 64 + c8 * 8) = o; }
    for (int i = gt; i < 8 * 32 * 64; i += NGT) { const int b = i >> 11, rem = i & 2047; *(u32x4*)(CKV + (size_t)(MP + b * KVB + 4128) * 512 + rem * 8) = z4; }
    for (int i = gt; i < 8 * 32 * 8; i += NGT) { const int b = i >> 8, rem = i & 255; *(u32x4*)(KPE + (size_t)(MP + b * KVB + 4128) * 64 + rem * 8) = z4; }
    float* LB = (float*)(ws + WS_LB); const float* hl = P.in[13];
    for (int i = gt; i < 2048; i += NGT) LB[i] = l == 0 ? 0.f : 1.f / (1.f + expf(hl[i] - hl[2048 + i]));
}

DI void rope_table(const Params& P, int gt, int NGT) {
    float* T = (float*)(P.ws + WS_TBL);
    for (int i = gt; i < 2080 * 32; i += NGT) { const int p = i >> 5, j = i & 31; const int pos = p < 2048 ? p : 4096 + (p - 2048);
        const float inv = exp2f(-(float)j * (13.287712379549449f / 32.f)); const float ang = (float)pos * inv;
        const double a = (double)ang; const double kq = rint(a * 0.15915494309189535); const float rr = (float)(a - kq * 6.283185307179586);
        T[2 * i] = __cosf(rr); T[2 * i + 1] = __sinf(rr); }
}

DI void init_x(const Params& P, int gw, int NGW, int lane) {
    const float* g = P.in[5]; float* X = P.out; bf16_t* XN = (bf16_t*)(P.ws + WS_XN);
    for (int row = gw; row < MTOK; row += NGW) {
        const float* src = row < MP ? P.in[0] + (size_t)row * 2048 : P.in[1] + (size_t)(row - MP) * 2048;
        f32x4 v[8]; float ss = 0.f;
#pragma unroll
        for (int j = 0; j < 8; ++j) { v[j] = *(const f32x4*)(src + j * 256 + lane * 4); ss += v[j][0] * v[j][0] + v[j][1] * v[j][1] + v[j][2] * v[j][2] + v[j][3] * v[j][3]; }
        const float rs = rsqrtf(wave_sum(ss, lane) * (1.f / 2048.f) + EPS);
#pragma unroll
        for (int j = 0; j < 8; ++j) { *(f32x4*)(X + (size_t)row * 2048 + j * 256 + lane * 4) = v[j];
            const f32x4 gg = *(const f32x4*)(g + j * 256 + lane * 4); u32x2 w; w.x = pk2(v[j][0] * rs * gg[0], v[j][1] * rs * gg[1]); w.y = pk2(v[j][2] * rs * gg[2], v[j][3] * rs * gg[3]);
            *(u32x2*)(XN + (size_t)row * 2048 + j * 256 + lane * 4) = w; }
    }
}
DI void resid_norm(const float* __restrict__ Y, const float* __restrict__ gY, float* X, const float* __restrict__ gN, bf16_t* XN, int gw, int NGW, int lane) {
    for (int row = gw; row < MTOK; row += NGW) {
        f32x4 y[8]; float ss = 0.f;
#pragma unroll
        for (int j = 0; j < 8; ++j) { y[j] = *(const f32x4*)(Y + (size_t)row * 2048 + j * 256 + lane * 4); ss += y[j][0] * y[j][0] + y[j][1] * y[j][1] + y[j][2] * y[j][2] + y[j][3] * y[j][3]; }
        const float rs = rsqrtf(wave_sum(ss, lane) * (1.f / 2048.f) + EPS); float s2 = 0.f;
#pragma unroll
        for (int j = 0; j < 8; ++j) { const f32x4 gg = *(const f32x4*)(gY + j * 256 + lane * 4); const f32x4 x = *(const f32x4*)(X + (size_t)row * 2048 + j * 256 + lane * 4);
            y[j] = x + y[j] * rs * gg; *(f32x4*)(X + (size_t)row * 2048 + j * 256 + lane * 4) = y[j];
            s2 += y[j][0] * y[j][0] + y[j][1] * y[j][1] + y[j][2] * y[j][2] + y[j][3] * y[j][3]; }
        if (gN) {
            const float r2 = rsqrtf(wave_sum(s2, lane) * (1.f / 2048.f) + EPS);
#pragma unroll
            for (int j = 0; j < 8; ++j) { const f32x4 gg = *(const f32x4*)(gN + j * 256 + lane * 4); u32x2 w; w.x = pk2(y[j][0] * r2 * gg[0], y[j][1] * r2 * gg[1]); w.y = pk2(y[j][2] * r2 * gg[2], y[j][3] * r2 * gg[3]);
                *(u32x2*)(XN + (size_t)row * 2048 + j * 256 + lane * 4) = w; }
        }
    }
}
DI void small_norms(const Params& P, int l, int gw, int NGW, int lane) {
    const float* Zs = (const float*)(P.ws + WS_ZS); bf16_t* QN = (bf16_t*)(P.ws + WS_QN); bf16_t* CKV = (bf16_t*)(P.ws + WS_CKV); bf16_t* KPE = (bf16_t*)(P.ws + WS_KPE);
    const float* tbl = (const float*)(P.ws + WS_TBL); const float* gq = P.in[7] + l * 512; const float* gkv = P.in[9] + l * 512;
    for (int row = gw; row < MTOK; row += NGW) {
        const float* z = Zs + (size_t)row * ZSW;
        const bool pr = row < MP; const int rs_ = row - MP;
        const int kvrow = pr ? row : MP + (rs_ >> 5) * KVB + 4096 + (rs_ & 31);
        const int p = pr ? (row & 2047) : 2048 + (rs_ & 31);
        float* oc = pr ? P.out + OUT_CKVP + ((size_t)l * MP + row) * 512 : P.out + OUT_CKVS + ((size_t)l * MS + rs_) * 512;
        float* ok = pr ? P.out + OUT_KPEP + ((size_t)l * MP + row) * 64 : P.out + OUT_KPES + ((size_t)l * MS + rs_) * 64;
        { const f32x4 a = *(const f32x4*)(z + lane * 8), b = *(const f32x4*)(z + lane * 8 + 4);
          const float ss = a[0] * a[0] + a[1] * a[1] + a[2] * a[2] + a[3] * a[3] + b[0] * b[0] + b[1] * b[1] + b[2] * b[2] + b[3] * b[3];
          const float rs = rsqrtf(wave_sum(ss, lane) * (1.f / 512.f) + EPS); const f32x4 g0 = *(const f32x4*)(gq + lane * 8), g1 = *(const f32x4*)(gq + lane * 8 + 4);
          u32x4 o; o.x = pk2(a[0] * rs * g0[0], a[1] * rs * g0[1]); o.y = pk2(a[2] * rs * g0[2], a[3] * rs * g0[3]); o.z = pk2(b[0] * rs * g1[0], b[1] * rs * g1[1]); o.w = pk2(b[2] * rs * g1[2], b[3] * rs * g1[3]);
          *(u32x4*)(QN + (size_t)row * 512 + lane * 8) = o; }
        { const f32x4 a = *(const f32x4*)(z + 512 + lane * 8), b = *(const f32x4*)(z + 512 + lane * 8 + 4);
          const float ss = a[0] * a[0] + a[1] * a[1] + a[2] * a[2] + a[3] * a[3] + b[0] * b[0] + b[1] * b[1] + b[2] * b[2] + b[3] * b[3];
          const float rs = rsqrtf(wave_sum(ss, lane) * (1.f / 512.f) + EPS); const f32x4 g0 = *(const f32x4*)(gkv + lane * 8), g1 = *(const f32x4*)(gkv + lane * 8 + 4);
          const f32x4 c0 = a * rs * g0, c1 = b * rs * g1;
          *(f32x4*)(oc + lane * 8) = c0; *(f32x4*)(oc + lane * 8 + 4) = c1;
          u32x4 o; o.x = pk2(c0[0], c0[1]); o.y = pk2(c0[2], c0[3]); o.z = pk2(c1[0], c1[1]); o.w = pk2(c1[2], c1[3]);
          *(u32x4*)(CKV + (size_t)kvrow * 512 + lane * 8) = o; }
        if (lane < 32) { const float x1 = z[1024 + lane], x2 = z[1056 + lane]; const float c = tbl[(size_t)(p * 32 + lane) * 2], s = tbl[(size_t)(p * 32 + lane) * 2 + 1];
          const float o1 = x1 * c - x2 * s, o2 = x1 * s + x2 * c; ok[lane] = o1; ok[32 + lane] = o2;
          KPE[(size_t)kvrow * 64 + lane] = f2bf(o1); KPE[(size_t)kvrow * 64 + 32 + lane] = f2bf(o2); }
    }
}

struct HUnit { int rowbase, nvalid, h; };
DI HUnit hunit(int u) { HUnit r; if (u < 2048) { const int sh = u >> 5, c = u & 31; r.h = sh & 15; r.rowbase = (sh >> 4) * 2048 + c * 64; r.nvalid = 64; } else { const int s = u - 2048; r.h = s & 15; r.rowbase = MP + (s >> 4) * 32; r.nvalid = 32; } return r; }
DI void hgrn_cumsum(const float* __restrict__ LF, LAS float* psum, const HUnit& hu, int k, int tq, float (&b)[16], float& b31, float& b63) {
    const float* p = LF + (size_t)(hu.rowbase + 16 * tq) * 2048 + hu.h * 128 + k; const bool valid = 16 * tq < hu.nvalid;
    float run = 0.f;
#pragma unroll
    for (int i = 0; i < 16; ++i) { const float v = valid ? p[(size_t)i * 2048] : 0.f; run += v; b[i] = run; }
    psum[tq * 128 + k] = run;
    __syncthreads();
    const float p0 = psum[k], p1 = psum[128 + k], p2 = psum[256 + k], p3 = psum[384 + k];
    const float off = (tq > 0 ? p0 : 0.f) + (tq > 1 ? p1 : 0.f) + (tq > 2 ? p2 : 0.f);
#pragma unroll
    for (int i = 0; i < 16; ++i) b[i] += off;
    b31 = p0 + p1; b63 = b31 + p2 + p3;
}
DI void hgrn_pass1(LAS unsigned char* lds, const float* __restrict__ LF, const bf16_t* __restrict__ HK, const bf16_t* __restrict__ HV, float* __restrict__ UT, float* __restrict__ Dv, int u, int tid) {
    LAS float* psum = (LAS float*)lds; LAS bf16_t* KhT = (LAS bf16_t*)(lds + 2048); LAS bf16_t* VTl = (LAS bf16_t*)(lds + 2048 + 18432);
    const HUnit hu = hunit(u); const int k = tid & 127, tq = tid >> 7; const bool valid = 16 * tq < hu.nvalid;
    const size_t g0 = (size_t)(hu.rowbase + 16 * tq) * 2048 + hu.h * 128 + k;
    unsigned kraw[8], vw[8];
#pragma unroll
    for (int i2 = 0; i2 < 8; ++i2) { unsigned k0 = 0u, k1 = 0u, v0 = 0u, v1 = 0u;
        if (valid) { k0 = HK[g0 + (size_t)(2 * i2) * 2048]; k1 = HK[g0 + (size_t)(2 * i2 + 1) * 2048]; v0 = HV[g0 + (size_t)(2 * i2) * 2048]; v1 = HV[g0 + (size_t)(2 * i2 + 1) * 2048]; }
        kraw[i2] = k0 | (k1 << 16); vw[i2] = v0 | (v1 << 16); }
    float b[16], b31, b63; hgrn_cumsum(LF, psum, hu, k, tq, b, b31, b63);
    unsigned kw[8];
#pragma unroll
    for (int i2 = 0; i2 < 8; ++i2) kw[i2] = pk2(bflo(kraw[i2]) * __expf(b63 - b[2 * i2]), bfhi(kraw[i2]) * __expf(b63 - b[2 * i2 + 1]));
    { u32x4 a, c; a.x = kw[0]; a.y = kw[1]; a.z = kw[2]; a.w = kw[3]; c.x = kw[4]; c.y = kw[5]; c.z = kw[6]; c.w = kw[7];
      *(LAS u32x4*)(KhT + k * 72 + 16 * tq) = a; *(LAS u32x4*)(KhT + k * 72 + 16 * tq + 8) = c;
      a.x = vw[0]; a.y = vw[1]; a.z = vw[2]; a.w = vw[3]; c.x = vw[4]; c.y = vw[5]; c.z = vw[6]; c.w = vw[7];
      *(LAS u32x4*)(VTl + k * 72 + 16 * tq) = a; *(LAS u32x4*)(VTl + k * 72 + 16 * tq + 8) = c; }
    if (tq == 0) Dv[(size_t)u * 128 + k] = __expf(b63);
    __syncthreads();
    const int wave = tid >> 6, lane = tid & 63, r = lane & 31, hh = lane >> 5, vb = wave & 3, kg = wave >> 2;
#pragma unroll
    for (int kb2 = 0; kb2 < 2; ++kb2) {
        const int kbq = 2 * kg + kb2; f32x16 acc = zero16();
#pragma unroll
        for (int s = 0; s < 4; ++s) { const bf16x8 a = *(const LAS bf16x8*)(VTl + (32 * vb + r) * 72 + 16 * s + 8 * hh), bb = *(const LAS bf16x8*)(KhT + (32 * kbq + r) * 72 + 16 * s + 8 * hh); acc = MFMA32(a, bb, acc); }
        float* dst = UT + ((size_t)u * 128 + 32 * vb) * 128 + 32 * kbq + r;
#pragma unroll
        for (int i = 0; i < 16; ++i) dst[(size_t)crow(i, hh) * 128] = acc[i];
    }
    __syncthreads();
}
DI void hgrn_pass2(LAS unsigned char* lds, const Params& P, int l, int x, int tid) {
    const float* UT = (const float*)(P.ws + WS_UT); const float* Dv = (const float*)(P.ws + WS_D); bf16_t* SpT = (bf16_t*)(P.ws + WS_SPT);
    LAS float* tl = (LAS float*)lds;
    const bool sample = x >= 256; const int sidx = sample ? (x - 256) >> 2 : x >> 2, vq = x & 3;
    const int nch = sample ? 1 : 32, ubase = sample ? 2048 + sidx : sidx * 32;
    const int vloc = tid >> 4, k0 = (tid & 15) * 8, v = 32 * vq + vloc;
    const int kk = tid >> 2, vs = (tid & 3) * 8;
    float S[8];
#pragma unroll
    for (int i = 0; i < 8; ++i) S[i] = 0.f;
    if (sample) {
        const float* s0 = P.in[4] + ((size_t)l * 128 + sidx) * 16384 + (size_t)kk * 128 + 32 * vq + vs;
        const f32x4 a = *(const f32x4*)s0, b = *(const f32x4*)(s0 + 4);
#pragma unroll
        for (int i = 0; i < 4; ++i) { tl[kk * 33 + vs + i] = a[i]; tl[kk * 33 + vs + 4 + i] = b[i]; }
        __syncthreads();
#pragma unroll
        for (int i = 0; i < 8; ++i) S[i] = tl[(k0 + i) * 33 + vloc];
        __syncthreads();
    }
    size_t e = ((size_t)ubase * 128 + v) * 128 + k0;
    f32x4 u0 = *(const f32x4*)(UT + e), u1 = *(const f32x4*)(UT + e + 4), d0 = *(const f32x4*)(Dv + (size_t)ubase * 128 + k0), d1 = *(const f32x4*)(Dv + (size_t)ubase * 128 + k0 + 4);
    for (int c = 0; c < nch; ++c) {
        f32x4 nu0 = u0, nu1 = u1, nd0 = d0, nd1 = d1;
        if (c + 1 < nch) { const size_t e2 = e + 16384; nu0 = *(const f32x4*)(UT + e2); nu1 = *(const f32x4*)(UT + e2 + 4); nd0 = *(const f32x4*)(Dv + (size_t)(ubase + c + 1) * 128 + k0); nd1 = *(const f32x4*)(Dv + (size_t)(ubase + c + 1) * 128 + k0 + 4); }
        u32x4 o; o.x = pk2(S[0], S[1]); o.y = pk2(S[2], S[3]); o.z = pk2(S[4], S[5]); o.w = pk2(S[6], S[7]);
        *(u32x4*)(SpT + e) = o;
#pragma unroll
        for (int i = 0; i < 4; ++i) { S[i] = d0[i] * S[i] + u0[i]; S[4 + i] = d1[i] * S[4 + i] + u1[i]; }
        u0 = nu0; u1 = nu1; d0 = nd0; d1 = nd1; e += 16384;
    }
#pragma unroll
    for (int i = 0; i < 8; ++i) tl[(k0 + i) * 33 + vloc] = S[i];
    __syncthreads();
    float* o = (sample ? P.out + OUT_STS + ((size_t)l * 128 + sidx) * 16384 : P.out + OUT_STP + ((size_t)l * 64 + sidx) * 16384) + (size_t)kk * 128 + 32 * vq + vs;
    f32x4 a, b;
#pragma unroll
    for (int i = 0; i < 4; ++i) { a[i] = tl[kk * 33 + vs + i]; b[i] = tl[kk * 33 + vs + 4 + i]; }
    *(f32x4*)o = a; *(f32x4*)(o + 4) = b;
    __syncthreads();
}
DI void hgrn_pass3(LAS unsigned char* lds, const float* __restrict__ LF, const bf16_t* __restrict__ HQ, const bf16_t* __restrict__ HK, const bf16_t* __restrict__ HV, const bf16_t* __restrict__ HG,
                   const bf16_t* __restrict__ SpT, const float* __restrict__ gn, bf16_t* __restrict__ OH, int u, int tid) {
    LAS float* psum = (LAS float*)lds;
    LAS bf16_t* Qa = (LAS bf16_t*)(lds + 2048);
    LAS bf16_t* Qb = (LAS bf16_t*)(lds + 19456);
    LAS bf16_t* Ka = (LAS bf16_t*)(lds + 28160);
    LAS bf16_t* Kb = (LAS bf16_t*)(lds + 36864);
    LAS bf16_t* VTl = (LAS bf16_t*)(lds + 54272);
    LAS float* Ost = (LAS float*)(lds + 72704);
    const HUnit hu = hunit(u); const int k = tid & 127, tq = tid >> 7; const bool valid = 16 * tq < hu.nvalid;
    const size_t g0 = (size_t)(hu.rowbase + 16 * tq) * 2048 + hu.h * 128 + k;
    unsigned vw[8], qk[16];
#pragma unroll
    for (int i2 = 0; i2 < 8; ++i2) {
        unsigned vpair = 0u;
#pragma unroll
        for (int e = 0; e < 2; ++e) { const int i = 2 * i2 + e; unsigned q = 0u, kk = 0u, vv = 0u;
            if (valid) { q = HQ[g0 + (size_t)i * 2048]; kk = HK[g0 + (size_t)i * 2048]; vv = HV[g0 + (size_t)i * 2048]; }
            qk[i] = q | (kk << 16); vpair |= vv << (16 * e); }
        vw[i2] = vpair;
    }
    float b[16], b31, b63; hgrn_cumsum(LF, psum, hu, k, tq, b, b31, b63);
#pragma unroll
    for (int i = 0; i < 16; ++i) {
        const int t = 16 * tq + i; const float q = bflo(qk[i]), kk = bfhi(qk[i]);
        Qa[t * 136 + k] = f2bf(q * __expf(b[i]));
        if (tq >= 2) Qb[(t - 32) * 136 + k] = f2bf(q * __expf(b[i] - b31)); else Ka[t * 136 + k] = f2bf(kk * __expf(-b[i]));
        Kb[t * 136 + k] = f2bf(kk * __expf(b31 - b[i]));
    }
    { u32x4 a, c; a.x = vw[0]; a.y = vw[1]; a.z = vw[2]; a.w = vw[3]; c.x = vw[4]; c.y = vw[5]; c.z = vw[6]; c.w = vw[7];
      *(LAS u32x4*)(VTl + k * 72 + 16 * tq) = a; *(LAS u32x4*)(VTl + k * 72 + 16 * tq + 8) = c; }
    __syncthreads();
    const int wave = tid >> 6, lane = tid & 63, r = lane & 31, hh = lane >> 5, vb = wave & 3, tb = wave >> 2;
    f32x16 O = zero16();
    const LAS bf16_t* vrow = VTl + (32 * vb + r) * 72 + 4 * hh;
    if (tb == 0) {
        f32x16 A0 = zero16();
#pragma unroll
        for (int ks = 0; ks < 8; ++ks) { const bf16x8 a = *(const LAS bf16x8*)(Ka + r * 136 + 16 * ks + 8 * hh), q = *(const LAS bf16x8*)(Qa + r * 136 + 16 * ks + 8 * hh); A0 = MFMA32(a, q, A0); }
#pragma unroll
        for (int i = 0; i < 16; ++i) if (crow(i, hh) > r) A0[i] = 0.f;
        const bf16x8 p0 = pack8<0>(A0), p1 = pack8<1>(A0);
        { const s16x4 lo = *(const LAS s16x4*)(vrow), hi = *(const LAS s16x4*)(vrow + 8); O = MFMA32(__builtin_shufflevector(lo, hi, 0, 1, 2, 3, 4, 5, 6, 7), p0, O); }
        { const s16x4 lo = *(const LAS s16x4*)(vrow + 16), hi = *(const LAS s16x4*)(vrow + 24); O = MFMA32(__builtin_shufflevector(lo, hi, 0, 1, 2, 3, 4, 5, 6, 7), p1, O); }
    } else {
        f32x16 A0 = zero16(), A1 = zero16();
#pragma unroll
        for (int ks = 0; ks < 8; ++ks) { const bf16x8 q = *(const LAS bf16x8*)(Qb + r * 136 + 16 * ks + 8 * hh);
            const bf16x8 a0 = *(const LAS bf16x8*)(Kb + r * 136 + 16 * ks + 8 * hh), a1 = *(const LAS bf16x8*)(Kb + (32 + r) * 136 + 16 * ks + 8 * hh);
            A0 = MFMA32(a0, q, A0); A1 = MFMA32(a1, q, A1); }
#pragma unroll
        for (int i = 0; i < 16; ++i) if (crow(i, hh) > r) A1[i] = 0.f;
        const bf16x8 p0 = pack8<0>(A0), p1 = pack8<1>(A0), p2 = pack8<0>(A1), p3 = pack8<1>(A1);
        { const s16x4 lo = *(const LAS s16x4*)(vrow), hi = *(const LAS s16x4*)(vrow + 8); O = MFMA32(__builtin_shufflevector(lo, hi, 0, 1, 2, 3, 4, 5, 6, 7), p0, O); }
        { const s16x4 lo = *(const LAS s16x4*)(vrow + 16), hi = *(const LAS s16x4*)(vrow + 24); O = MFMA32(__builtin_shufflevector(lo, hi, 0, 1, 2, 3, 4, 5, 6, 7), p1, O); }
        { const s16x4 lo = *(const LAS s16x4*)(vrow + 32), hi = *(const LAS s16x4*)(vrow + 40); O = MFMA32(__builtin_shufflevector(lo, hi, 0, 1, 2, 3, 4, 5, 6, 7), p2, O); }
        { const s16x4 lo = *(const LAS s16x4*)(vrow + 48), hi = *(const LAS s16x4*)(vrow + 56); O = MFMA32(__builtin_shufflevector(lo, hi, 0, 1, 2, 3, 4, 5, 6, 7), p3, O); }
    }
    { const bf16_t* sp = SpT + ((size_t)u * 128 + 32 * vb + r) * 128 + 8 * hh;
#pragma unroll
      for (int ks = 0; ks < 8; ++ks) { const bf16x8 a = *(const bf16x8*)(sp + 16 * ks), q = *(const LAS bf16x8*)(Qa + (32 * tb + r) * 136 + 16 * ks + 8 * hh); O = MFMA32(a, q, O); } }
#pragma unroll
    for (int g = 0; g < 4; ++g) { f32x4 w; w[0] = O[4 * g]; w[1] = O[4 * g + 1]; w[2] = O[4 * g + 2]; w[3] = O[4 * g + 3]; *(LAS f32x4*)(Ost + (32 * tb + r) * 132 + 32 * vb + 8 * g + 4 * hh) = w; }
    __syncthreads();
    { const int t = tid >> 3, vs = (tid & 7) * 16;
      f32x4 x[4]; float ss = 0.f;
#pragma unroll
      for (int j = 0; j < 4; ++j) { x[j] = *(const LAS f32x4*)(Ost + t * 132 + vs + 4 * j); ss += x[j][0] * x[j][0] + x[j][1] * x[j][1] + x[j][2] * x[j][2] + x[j][3] * x[j][3]; }
      ss += shflx(ss, 1, lane); ss += shflx(ss, 2, lane); ss += shflx(ss, 4, lane);
      const float rs = rsqrtf(ss * (1.f / 128.f) + EPS);
      if (t < hu.nvalid) {
          const size_t off = (size_t)(hu.rowbase + t) * 2048 + hu.h * 128 + vs;
          const u32x4 ga = *(const u32x4*)(HG + off), gb = *(const u32x4*)(HG + off + 8);
          const f32x4 n0 = *(const f32x4*)(gn + vs), n1 = *(const f32x4*)(gn + vs + 4), n2 = *(const f32x4*)(gn + vs + 8), n3 = *(const f32x4*)(gn + vs + 12);
          u32x4 oa, ob;
          oa.x = pk2(x[0][0] * rs * n0[0] * bflo(ga.x), x[0][1] * rs * n0[1] * bfhi(ga.x)); oa.y = pk2(x[0][2] * rs * n0[2] * bflo(ga.y), x[0][3] * rs * n0[3] * bfhi(ga.y));
          oa.z = pk2(x[1][0] * rs * n1[0] * bflo(ga.z), x[1][1] * rs * n1[1] * bfhi(ga.z)); oa.w = pk2(x[1][2] * rs * n1[2] * bflo(ga.w), x[1][3] * rs * n1[3] * bfhi(ga.w));
          ob.x = pk2(x[2][0] * rs * n2[0] * bflo(gb.x), x[2][1] * rs * n2[1] * bfhi(gb.x)); ob.y = pk2(x[2][2] * rs * n2[2] * bflo(gb.y), x[2][3] * rs * n2[3] * bfhi(gb.y));
          ob.z = pk2(x[3][0] * rs * n3[0] * bflo(gb.z), x[3][1] * rs * n3[1] * bfhi(gb.z)); ob.w = pk2(x[3][2] * rs * n3[2] * bflo(gb.w), x[3][3] * rs * n3[3] * bfhi(gb.w));
          *(u32x4*)(OH + off) = oa; *(u32x4*)(OH + off + 8) = ob;
      } }
    __syncthreads();
}

template <bool SAMPLE>
DI void attn_wave(const bf16_t* __restrict__ Qp, const bf16_t* __restrict__ Kn, const bf16_t* __restrict__ Kp, const bf16_t* __restrict__ Vt, int t0, int t1, int tstep, int nkeys,
                  float& m, float& l, f32x16 (&O)[4], int r, int hh) {
    const int lane = r + 32 * hh;
    bf16x8 qf[12];
#pragma unroll
    for (int s = 0; s < 12; ++s) qf[s] = *(const bf16x8*)(Qp + (size_t)r * 3072 + 16 * s + 8 * hh);
    m = -INFINITY; l = 0.f;
#pragma unroll
    for (int vb = 0; vb < 4; ++vb) O[vb] = zero16();
    for (int t = t0; t < t1; t += tstep) {
        const bf16_t* kn = Kn + (size_t)(64 * t + r) * 2048 + 8 * hh; const bf16_t* kp = Kp + (size_t)(64 * t + r) * 64 + 8 * hh;
        f32x16 S0 = zero16(), S1 = zero16();
#pragma unroll
        for (int s = 0; s < 8; ++s) { const bf16x8 a0 = *(const bf16x8*)(kn + 16 * s), a1 = *(const bf16x8*)(kn + 32 * 2048 + 16 * s); S0 = MFMA32(a0, qf[s], S0); S1 = MFMA32(a1, qf[s], S1); }
#pragma unroll
        for (int s = 0; s < 4; ++s) { const bf16x8 a0 = *(const bf16x8*)(kp + 16 * s), a1 = *(const bf16x8*)(kp + 32 * 64 + 16 * s); S0 = MFMA32(a0, qf[8 + s], S0); S1 = MFMA32(a1, qf[8 + s], S1); }
        if (SAMPLE) { if (64 * t + 64 > nkeys) {
#pragma unroll
            for (int i = 0; i < 16; ++i) { if (64 * t + crow(i, hh) >= nkeys) S0[i] = -INFINITY; if (64 * t + 32 + crow(i, hh) >= nkeys) S1[i] = -INFINITY; } } }
        float mx = fmaxf(S0[0], S1[0]);
#pragma unroll
        for (int i = 1; i < 16; ++i) mx = fmaxf(mx, fmaxf(S0[i], S1[i]));
        mx = fmaxf(mx, shflx(mx, 32, lane));
        const float mn = fmaxf(m, mx), alpha = ex2(m - mn); m = mn;
        float ls = 0.f;
#pragma unroll
        for (int i = 0; i < 16; ++i) { S0[i] = ex2(S0[i] - mn); S1[i] = ex2(S1[i] - mn); ls += S0[i] + S1[i]; }
        l = l * alpha + ls;
#pragma unroll
        for (int vb = 0; vb < 4; ++vb) O[vb] = O[vb] * alpha;
        const bf16x8 p0 = pack8<0>(S0), p1 = pack8<1>(S0), p2 = pack8<0>(S1), p3 = pack8<1>(S1);
#pragma unroll
        for (int vb = 0; vb < 4; ++vb) {
            const bf16_t* vp = Vt + (size_t)(32 * vb + r) * KVR + 64 * t + 4 * hh;
            { const s16x4 lo = *(const s16x4*)(vp), hi = *(const s16x4*)(vp + 8); O[vb] = MFMA32(__builtin_shufflevector(lo, hi, 0, 1, 2, 3, 4, 5, 6, 7), p0, O[vb]); }
            { const s16x4 lo = *(const s16x4*)(vp + 16), hi = *(const s16x4*)(vp + 24); O[vb] = MFMA32(__builtin_shufflevector(lo, hi, 0, 1, 2, 3, 4, 5, 6, 7), p1, O[vb]); }
            { const s16x4 lo = *(const s16x4*)(vp + 32), hi = *(const s16x4*)(vp + 40); O[vb] = MFMA32(__builtin_shufflevector(lo, hi, 0, 1, 2, 3, 4, 5, 6, 7), p2, O[vb]); }
            { const s16x4 lo = *(const s16x4*)(vp + 48), hi = *(const s16x4*)(vp + 56); O[vb] = MFMA32(__builtin_shufflevector(lo, hi, 0, 1, 2, 3, 4, 5, 6, 7), p3, O[vb]); }
        }
    }
}
DI void attn_prompt_unit(const Params& P, int bh, int jq, int wave, int lane) {
    const bf16_t* Q = (const bf16_t*)(P.ws + WS_Q); const bf16_t* KN = (const bf16_t*)(P.ws + WS_KN); const bf16_t* KPE = (const bf16_t*)(P.ws + WS_KPE); const bf16_t* VT = (const bf16_t*)(P.ws + WS_VT);
    bf16_t* OA = (bf16_t*)(P.ws + WS_OA);
    const int b = bh >> 4, h = bh & 15, rb = 8 * jq + wave, row0 = b * 2048 + 32 * rb, kv0 = b * 2048, r = lane & 31, hh = lane >> 5;
    float m, l; f32x16 O[4];
    attn_wave<false>(Q + (size_t)row0 * 3072 + h * 192, KN + (size_t)kv0 * 2048 + h * 128, KPE + (size_t)kv0 * 64, VT + (size_t)(h * 128) * KVR + kv0, 0, (rb >> 1) + 1, 1, 0, m, l, O, r, hh);
    l += shflx(l, 32, lane); const float inv = 1.f / l;
#pragma unroll
    for (int vb = 0; vb < 4; ++vb)
#pragma unroll
        for (int g = 0; g < 4; ++g) { u32x2 w; w.x = pk2(O[vb][4 * g] * inv, O[vb][4 * g + 1] * inv); w.y = pk2(O[vb][4 * g + 2] * inv, O[vb][4 * g + 3] * inv);
            *(u32x2*)(OA + (size_t)(row0 + r) * 2048 + h * 128 + 32 * vb + 8 * g + 4 * hh) = w; }
}
constexpr int ATT_KB = 64 * 400, ATT_VB = 128 * 136, ATT_BUF = ATT_KB + ATT_VB;
DI void attn_prompt_lds(LAS unsigned char* lds, const Params& P, int bh, int jq, int wave, int lane, int tid) {
    const bf16_t* Q = (const bf16_t*)(P.ws + WS_Q); const bf16_t* KN = (const bf16_t*)(P.ws + WS_KN); const bf16_t* KPE = (const bf16_t*)(P.ws + WS_KPE); const bf16_t* VT = (const bf16_t*)(P.ws + WS_VT);
    bf16_t* OA = (bf16_t*)(P.ws + WS_OA);
    const int b = bh >> 4, h = bh & 15, rb = 8 * jq + wave, row0 = b * 2048 + 32 * rb, kv0 = b * 2048, r = lane & 31, hh = lane >> 5;
    const int ntiles = 4 * jq + 4, mytiles = (rb >> 1) + 1;
    const bf16_t* gk0 = KN + (size_t)(kv0 + (tid >> 4)) * 2048 + h * 128 + (tid & 15) * 8;
    const bf16_t* gkp = KPE + (size_t)(kv0 + (tid >> 3)) * 64 + (tid & 7) * 8;
    const bf16_t* gv0 = VT + (size_t)(h * 128 + (tid >> 3)) * KVR + kv0 + (tid & 7) * 8;
    const int lk0 = (tid >> 4) * 400 + (tid & 15) * 16, lkp = (tid >> 3) * 400 + 256 + (tid & 7) * 16, lv0 = ATT_KB + (tid >> 3) * 136 + (tid & 7) * 16;
    u32x4 sk0, sk1, skp, sv0, sv1;
#define ATT_LOAD(t) do { const size_t ko = (size_t)(64 * (t)) * 2048, po = (size_t)(64 * (t)) * 64, vo = (size_t)(64 * (t)); \
        sk0 = *(const u32x4*)(gk0 + ko); sk1 = *(const u32x4*)(gk0 + ko + 32 * 2048); skp = *(const u32x4*)(gkp + po); sv0 = *(const u32x4*)(gv0 + vo); sv1 = *(const u32x4*)(gv0 + vo + (size_t)64 * KVR); } while (0)
#define ATT_STORE(buf) do { LAS unsigned char* bb = lds + (buf) * ATT_BUF; \
        *(LAS u32x4*)(bb + lk0) = sk0; *(LAS u32x4*)(bb + lk0 + 32 * 400) = sk1; *(LAS u32x4*)(bb + lkp) = skp; \
        { u32x2 a_, b_; a_.x = sv0.x; a_.y = sv0.y; b_.x = sv0.z; b_.y = sv0.w; *(LAS u32x2*)(bb + lv0) = a_; *(LAS u32x2*)(bb + lv0 + 8) = b_; \
          a_.x = sv1.x; a_.y = sv1.y; b_.x = sv1.z; b_.y = sv1.w; *(LAS u32x2*)(bb + lv0 + 64 * 136) = a_; *(LAS u32x2*)(bb + lv0 + 64 * 136 + 8) = b_; } } while (0)
    ATT_LOAD(0);
    bf16x8 qf[12];
    { const bf16_t* Qp = Q + (size_t)row0 * 3072 + h * 192;
#pragma unroll
      for (int s = 0; s < 12; ++s) qf[s] = *(const bf16x8*)(Qp + (size_t)r * 3072 + 16 * s + 8 * hh); }
    float m = -INFINITY, l = 0.f; f32x16 O[4];
#pragma unroll
    for (int vb = 0; vb < 4; ++vb) O[vb] = zero16();
    ATT_STORE(0);
    __syncthreads();
    for (int t = 0; t < ntiles; ++t) {
        if (t + 1 < ntiles) ATT_LOAD(t + 1);
        if (t < mytiles) {
            const LAS unsigned char* kb_ = lds + (t & 1) * ATT_BUF; const LAS unsigned char* vb_ = kb_ + ATT_KB;
            const LAS bf16_t* kr = (const LAS bf16_t*)(kb_ + r * 400 + 16 * hh);
            f32x16 S0 = zero16(), S1 = zero16();
#pragma unroll
            for (int s = 0; s < 12; ++s) { const bf16x8 a0 = *(const LAS bf16x8*)(kr + 16 * s), a1 = *(const LAS bf16x8*)(kr + 32 * 200 + 16 * s); S0 = MFMA32(a0, qf[s], S0); S1 = MFMA32(a1, qf[s], S1); }
            float mx = fmaxf(S0[0], S1[0]);
#pragma unroll
            for (int i = 1; i < 16; ++i) mx = fmaxf(mx, fmaxf(S0[i], S1[i]));
            mx = fmaxf(mx, shflx(mx, 32, lane));
            const float mn = fmaxf(m, mx), alpha = ex2(m - mn); m = mn;
            float ls = 0.f;
#pragma unroll
            for (int i = 0; i < 16; ++i) { S0[i] = ex2(S0[i] - mn); S1[i] = ex2(S1[i] - mn); ls += S0[i] + S1[i]; }
            l = l * alpha + ls;
#pragma unroll
            for (int vb = 0; vb < 4; ++vb) O[vb] = O[vb] * alpha;
            const bf16x8 p0 = pack8<0>(S0), p1 = pack8<1>(S0), p2 = pack8<0>(S1), p3 = pack8<1>(S1);
#pragma unroll
            for (int vb = 0; vb < 4; ++vb) {
                const LAS bf16_t* vp = (const LAS bf16_t*)(vb_ + (32 * vb + r) * 136 + 8 * hh);
                { const s16x4 lo = *(const LAS s16x4*)(vp), hi = *(const LAS s16x4*)(vp + 8); O[vb] = MFMA32(__builtin_shufflevector(lo, hi, 0, 1, 2, 3, 4, 5, 6, 7), p0, O[vb]); }
                { const s16x4 lo = *(const LAS s16x4*)(vp + 16), hi = *(const LAS s16x4*)(vp + 24); O[vb] = MFMA32(__builtin_shufflevector(lo, hi, 0, 1, 2, 3, 4, 5, 6, 7), p1, O[vb]); }
                { const s16x4 lo = *(const LAS s16x4*)(vp + 32), hi = *(const LAS s16x4*)(vp + 40); O[vb] = MFMA32(__builtin_shufflevector(lo, hi, 0, 1, 2, 3, 4, 5, 6, 7), p2, O[vb]); }
                { const s16x4 lo = *(const LAS s16x4*)(vp + 48), hi = *(const LAS s16x4*)(vp + 56); O[vb] = MFMA32(__builtin_shufflevector(lo, hi, 0, 1, 2, 3, 4, 5, 6, 7), p3, O[vb]); }
            }
        }
        if (t + 1 < ntiles) ATT_STORE((t + 1) & 1);
        __syncthreads();
    }
#undef ATT_LOAD
#undef ATT_STORE
    l += shflx(l, 32, lane); const float inv = 1.f / l;
#pragma unroll
    for (int vb = 0; vb < 4; ++vb)
#pragma unroll
        for (int g = 0; g < 4; ++g) { u32x2 w; w.x = pk2(O[vb][4 * g] * inv, O[vb][4 * g + 1] * inv); w.y = pk2(O[vb][4 * g + 2] * inv, O[vb][4 * g + 3] * inv);
            *(u32x2*)(OA + (size_t)(row0 + r) * 2048 + h * 128 + 32 * vb + 8 * g + 4 * hh) = w; }
}
DI void attn_sample_unit(LAS unsigned char* lds, const Params& P, int su, int wave, int lane, int tid) {
    const bf16_t* Q = (const bf16_t*)(P.ws + WS_Q); const bf16_t* KN = (const bf16_t*)(P.ws + WS_KN); const bf16_t* KPE = (const bf16_t*)(P.ws + WS_KPE); const bf16_t* VT = (const bf16_t*)(P.ws + WS_VT);
    bf16_t* OA = (bf16_t*)(P.ws + WS_OA);
    const int b = su >> 4, h = su & 15, row0 = MP + b * 32, kv0 = MP + b * KVB, r = lane & 31, hh = lane >> 5;
    float m, l; f32x16 O[4];
    attn_wave<true>(Q + (size_t)row0 * 3072 + h * 192, KN + (size_t)kv0 * 2048 + h * 128, KPE + (size_t)kv0 * 64, VT + (size_t)(h * 128) * KVR + kv0, wave, 65, 8, 4128, m, l, O, r, hh);
    l += shflx(l, 32, lane);
    LAS float* ml = (LAS float*)(lds + 131072);
    if (hh == 0) { ml[(wave * 32 + r) * 2] = m; ml[(wave * 32 + r) * 2 + 1] = l; }
    __syncthreads();
    float ms = -INFINITY;
#pragma unroll
    for (int w = 0; w < 8; ++w) ms = fmaxf(ms, ml[(w * 32 + r) * 2]);
    float L = 0.f;
#pragma unroll
    for (int w = 0; w < 8; ++w) L += ml[(w * 32 + r) * 2 + 1] * ex2(ml[(w * 32 + r) * 2] - ms);
    const float sc = ex2(m - ms) / L;
    LAS float* slot = (LAS float*)(lds + wave * 16384);
#pragma unroll
    for (int vb = 0; vb < 4; ++vb)
#pragma unroll
        for (int i = 0; i < 16; ++i) slot[(32 * vb + crow(i, hh)) * 32 + r] = O[vb][i] * sc;
    __syncthreads();
    { const int q = tid & 31, vg = tid >> 5; float a[8];
#pragma unroll
      for (int e = 0; e < 8; ++e) { float s = 0.f;
#pragma unroll
          for (int w = 0; w < 8; ++w) s += ((const LAS float*)(lds + w * 16384))[(8 * vg + e) * 32 + q];
          a[e] = s; }
      u32x4 o; o.x = pk2(a[0], a[1]); o.y = pk2(a[2], a[3]); o.z = pk2(a[4], a[5]); o.w = pk2(a[6], a[7]);
      *(u32x4*)(OA + (size_t)(row0 + q) * 2048 + h * 128 + 8 * vg) = o; }
    __syncthreads();
}

#define XB_TMO      128
#define XB_XCNT(j)  (256  + 64 * (j))
#define XB_XSUB(j)  (1280 + 64 * (j))
#define XB_XGEN(j)  (2304 + 64 * (j))
#define XB_TOP      3328
#define XB_TOPGEN   3392
#define XCD_BAR_WORDS 3456
#define XB_SPIN_CAP (1u << 18)

__device__ __forceinline__ unsigned xb_ld(unsigned* p)              { return __hip_atomic_load(p, __ATOMIC_RELAXED, __HIP_MEMORY_SCOPE_AGENT); }
__device__ __forceinline__ unsigned xb_add(unsigned* p, unsigned v) { return __hip_atomic_fetch_add(p, v, __ATOMIC_RELAXED, __HIP_MEMORY_SCOPE_AGENT); }
__device__ __forceinline__ unsigned xb_xcc_id() { return (unsigned)__builtin_amdgcn_s_getreg((3 << 11) | 20) & 0xFu; }
#define XB_SPIN(cond, bar) do { unsigned _sp = 0; while (cond) { __builtin_amdgcn_s_sleep(1); \
    if ((++_sp & 255u) == 0u) { if (xb_ld(&(bar)[XB_TMO])) break; if (_sp > XB_SPIN_CAP) { atomicAdd(&(bar)[XB_TMO], 1u); break; } } } } while (0)

struct XcdBarrier {
    unsigned* bar; unsigned x;
    volatile LAS unsigned* st;
};

__device__ __forceinline__ XcdBarrier xcd_barrier_post(unsigned* bar, volatile LAS unsigned* st, bool t0) {
    XcdBarrier b; b.bar = bar; b.x = xb_xcc_id(); b.st = st;
    if (t0) (void)xb_add(&bar[XB_XCNT(b.x)], 1u);
    return b;
}
__device__ __forceinline__ void xcd_barrier_complete(unsigned* bar, unsigned x, unsigned& nloc, unsigned& nx) {
    const unsigned G = gridDim.x * gridDim.y * gridDim.z;
    unsigned sum, cnt, mine, sp = 0u;
    for (;;) {
        sum = 0u; cnt = 0u; mine = 0u;
#pragma unroll
        for (unsigned j = 0; j < 16; ++j) { const unsigned c = xb_ld(&bar[XB_XCNT(j)]); sum += c; cnt += (c > 0u) ? 1u : 0u; mine = (j == x) ? c : mine; }
        if (sum == G) break;
        __builtin_amdgcn_s_sleep(1);
        if ((++sp & 255u) == 0u) { if (xb_ld(&bar[XB_TMO])) break; if (sp > XB_SPIN_CAP) { atomicAdd(&bar[XB_TMO], 1u); break; } }
    }
    nloc = mine > 0u ? mine : 1u; nx = cnt > 0u ? cnt : 1u;
}

__device__ __forceinline__ void xcd_barrier(const XcdBarrier& b, bool t0) {
    asm volatile("s_waitcnt vmcnt(0)" ::: "memory");
    __syncthreads();
    if (t0) {
        unsigned* bar = b.bar;
        __builtin_amdgcn_s_waitcnt(0);
        unsigned nloc = b.st[0], nx = b.st[1];
        if (nloc == 0u) { xcd_barrier_complete(bar, b.x, nloc, nx); b.st[0] = nloc; b.st[1] = nx; }
        const unsigned old = xb_add(&bar[XB_XSUB(b.x)], 1u);
        const unsigned gen = old / nloc;
        if (old + 1u == (gen + 1u) * nloc) {
            __builtin_amdgcn_fence(__ATOMIC_RELEASE, "agent");
            asm volatile("s_waitcnt vmcnt(0)" ::: "memory");
            const unsigned og = xb_add(&bar[XB_TOP], 1u);
            const unsigned tg = og / nx;
            if (og + 1u == (tg + 1u) * nx) xb_add(&bar[XB_TOPGEN], 1u);
            else XB_SPIN(xb_ld(&bar[XB_TOPGEN]) == tg, bar);
            __builtin_amdgcn_fence(__ATOMIC_ACQUIRE, "agent");
            xb_add(&bar[XB_XGEN(b.x)], 1u);
            asm volatile("s_waitcnt vmcnt(0)" ::: "memory");
        } else {
            XB_SPIN(xb_ld(&bar[XB_XGEN(b.x)]) == gen, bar);
            __builtin_amdgcn_fence(__ATOMIC_ACQUIRE, "agent");
            asm volatile("s_waitcnt vmcnt(0)" ::: "memory");
        }
    }
    __syncthreads();
}

constexpr int LDS_BYTES = 147456;
template <class Epi> DI void run_gemm_(LAS unsigned char* lds, const bf16_t* A, const bf16_t* Bt, int M_, int N_, int K_, int G, int c, const Epi& E, int tid) {
    pg8::Gemm g{A, Bt, M_, N_, K_, K_}; pg8::StaticOrder S; S.init(M_, N_, G, c);
    pg8::gemm_phase<Epi, pg8::StaticOrder, true, true>(lds, g, S, E, tid);
}
DI void run_tail_(LAS unsigned char* lds, const bf16_t* A, const bf16_t* Bt, int N_, int K_, int KS, float* slab, int G, int c, int tid) {
    pg8::Gemm g{A, Bt, MTOK, N_, K_, K_ / KS}; pg8::TailOrder S{MP / 256, N_ / 256, KS, K_ / KS, G, c}; pg8::EpiSlab E{slab, N_, K_ / KS};
    pg8::gemm_phase<pg8::EpiSlab, pg8::TailOrder, true, true>(lds, g, S, E, tid);
}

#define run_gemm(...) run_gemm_(__VA_ARGS__, tid)
#define run_tail(...) run_tail_(__VA_ARGS__, tid)
typedef const __attribute__((address_space(4))) Params CParams;
#define PHASE_BEGIN \
    Params P; { CParams* pp_ = (CParams*)__builtin_amdgcn_kernarg_segment_ptr(); asm volatile("" : "+s"(pp_)); _Pragma("unroll") for (int i_ = 0; i_ < 22; ++i_) P.in[i_] = pp_->in[i_]; P.out = pp_->out; P.ws = pp_->ws; } \
    int lane_l; asm volatile("v_mbcnt_lo_u32_b32 %0, -1, 0\n\tv_mbcnt_hi_u32_b32 %0, -1, %0" : "=v"(lane_l)); int wave_l = wave_s; asm volatile("" : "+s"(wave_l)); \
    const int tid = wave_l * 64 + lane_l; int G = gridDim.x, bx = blockIdx.x; asm volatile("" : "+s"(G), "+s"(bx)); \
    const int lane = lane_l, wave = wave_l; \
    const int vcu = (G % 8 == 0) ? (bx % 8) * (G / 8) + bx / 8 : bx;       \
    const int gw = vcu * 8 + wave, NGW = G * 8, gt = bx * 512 + tid, NGT = G * 512; \
    unsigned char* ws = P.ws; (void)lane; (void)gw; (void)NGW; (void)gt; (void)NGT; (void)ws;

__global__ void __launch_bounds__(512, 2) fwd_kernel(Params Pk) {
    extern __shared__ __attribute__((aligned(16))) unsigned char lds_raw[];
    LAS unsigned char* lds = (LAS unsigned char*)lds_raw;
    cg::grid_group grid = cg::this_grid();
    const int wave_s = __builtin_amdgcn_readfirstlane((int)threadIdx.x >> 6);
#ifndef PROBE
#define PROBE 0
#endif
#define GSYNC() do { for (int rs_ = 0; rs_ < ((PROBE & 4) ? 2 : 1); ++rs_) { XcdBarrier xb_ = xbar; asm volatile("" : "+s"(xb_.bar)); int ln_; asm volatile("v_mbcnt_lo_u32_b32 %0, -1, 0\n\tv_mbcnt_hi_u32_b32 %0, -1, %0" : "=v"(ln_)); xcd_barrier(xb_, wave_s == 0 && ln_ == 0); } } while (0)
    const int tid0_ = threadIdx.x;
    if (tid0_ < 64) ((LAS unsigned*)(lds + 131072 + 8192))[tid0_] = 0u;
    __syncthreads();
    XcdBarrier xbar = xcd_barrier_post((unsigned*)(Pk.ws + WS_CTL), (volatile LAS unsigned*)(lds + 131072 + 8192), tid0_ == 0);
    { PHASE_BEGIN
      for (int rep = 0; rep < ((PROBE & 8) ? 2 : 1); ++rep) {
      layer_prep(P, lds, 0, gw, NGW, gt, NGT, lane, wave);
      rope_table(P, gt, NGT);
      init_x(P, gw, NGW, lane); } }
    __threadfence(); grid.sync(); __threadfence();
    for (int l = 0; l < 2; ++l) {
        { PHASE_BEGIN
          pg8::EpiWin E{(float*)(ws + WS_ZS), (bf16_t*)(ws + WS_HQ), (bf16_t*)(ws + WS_HK), (bf16_t*)(ws + WS_HV), (bf16_t*)(ws + WS_HG), (bf16_t*)(ws + WS_GA), (bf16_t*)(ws + WS_GB), (float*)(ws + WS_LF), (const float*)(ws + WS_LB)};
          run_gemm(lds, (const bf16_t*)(ws + WS_XN), (const bf16_t*)(ws + WS_WIN), MTOK, DINP, 2048, G, bx, E); }
        GSYNC();
        { PHASE_BEGIN
          for (int rep = 0; rep < ((PROBE & 8) ? 2 : 1); ++rep) small_norms(P, l, gw, NGW, lane);
          for (int rep = 0; rep < ((PROBE & 2) ? 2 : 1); ++rep)
          for (int u = vcu; u < NU; u += G) hgrn_pass1(lds, (const float*)(ws + WS_LF), (const bf16_t*)(ws + WS_HK), (const bf16_t*)(ws + WS_HV), (float*)(ws + WS_UT), (float*)(ws + WS_D), u, tid); }
        GSYNC();
        { PHASE_BEGIN
          for (int rep = 0; rep < ((PROBE & 2) ? 2 : 1); ++rep)
          for (int x = vcu; x < 768; x += G) hgrn_pass2(lds, P, l, x, tid); }
        GSYNC();
        { PHASE_BEGIN
          for (int rep = 0; rep < ((PROBE & 2) ? 2 : 1); ++rep)
          for (int u = vcu; u < NU; u += G) hgrn_pass3(lds, (const float*)(ws + WS_LF), (const bf16_t*)(ws + WS_HQ), (const bf16_t*)(ws + WS_HK), (const bf16_t*)(ws + WS_HV), (const bf16_t*)(ws + WS_HG),
                                                       (const bf16_t*)(ws + WS_SPT), P.in[14] + l * 128, (bf16_t*)(ws + WS_OH), u, tid); }
        GSYNC();
        { PHASE_BEGIN
          pg8::EpiQ E{(bf16_t*)(ws + WS_Q), (const float*)(ws + WS_TBL)}; run_gemm(lds, (const bf16_t*)(ws + WS_QN), (const bf16_t*)(ws + WS_WUQ), MTOK, 3072, 512, G, bx, E); }
        { PHASE_BEGIN
          pg8::EpiPlain E{(bf16_t*)(ws + WS_KN), 2048}; run_gemm(lds, (const bf16_t*)(ws + WS_CKV), (const bf16_t*)(ws + WS_WUK), KVR, 2048, 512, G, bx, E); }
        { PHASE_BEGIN
          pg8::EpiPlain E{(bf16_t*)(ws + WS_VT), KVR}; run_gemm(lds, (const bf16_t*)(ws + WS_WUV), (const bf16_t*)(ws + WS_CKV), 2048, KVR, 512, G, (bx + G / 2) % G, E); }
        GSYNC();
        { PHASE_BEGIN
          for (int rep = 0; rep < ((PROBE & 1) ? 2 : 1); ++rep) {
          for (int x = vcu; x < 256; x += G) { const int bh = x >> 2, j = x & 3; attn_prompt_lds(lds, P, bh, 7 - j, wave, lane, tid); attn_prompt_lds(lds, P, bh, j, wave, lane, tid); }
          for (int x = vcu; x < 128; x += G) attn_sample_unit(lds, P, x, wave, lane, tid); } }
        GSYNC();
        { PHASE_BEGIN
          pg8::EpiGate<false> E{(const bf16_t*)(ws + WS_GA), (bf16_t*)(ws + WS_T)}; run_gemm(lds, (const bf16_t*)(ws + WS_OA), (const bf16_t*)(ws + WS_WOA), MP, 2048, 2048, G, bx, E); }
        { PHASE_BEGIN
          run_tail(lds, (const bf16_t*)(ws + WS_OA), (const bf16_t*)(ws + WS_WOA), 2048, 2048, 16, (float*)(ws + WS_SLAB0), G, bx); }
        { PHASE_BEGIN
          pg8::EpiGate<true> E{(const bf16_t*)(ws + WS_GB), (bf16_t*)(ws + WS_T)}; run_gemm(lds, (const bf16_t*)(ws + WS_OH), (const bf16_t*)(ws + WS_WOB), MP, 2048, 2048, G, bx, E); }
        { PHASE_BEGIN
          run_tail(lds, (const bf16_t*)(ws + WS_OH), (const bf16_t*)(ws + WS_WOB), 2048, 2048, 16, (float*)(ws + WS_SLAB1), G, (bx + G / 2) % G); }
        GSYNC();
        { PHASE_BEGIN
          for (int x = vcu; x < 64; x += G) { const int pn = x >> 3, mk = 1 << (x & 7);
              { pg8::EpiGate<false> E{(const bf16_t*)(ws + WS_GA), (bf16_t*)(ws + WS_T)}; pg8::tail_fixup(( const float*)(ws + WS_SLAB0), 16, 2048, MP / 256, pn, mk, E, tid); }
              { pg8::EpiGate<true> E{(const bf16_t*)(ws + WS_GB), (bf16_t*)(ws + WS_T)}; pg8::tail_fixup((const float*)(ws + WS_SLAB1), 16, 2048, MP / 256, pn, mk, E, tid); } } }
        GSYNC();
        for (int repI = 0; repI < ((PROBE & 32) ? 2 : 1); ++repI) {
        { PHASE_BEGIN
          pg8::EpiF32 E{(float*)(ws + WS_MIX), 2048}; run_gemm(lds, (const bf16_t*)(ws + WS_T), (const bf16_t*)(ws + WS_WOUT), MP, 2048, 2048, G, bx, E); }
        { PHASE_BEGIN
          run_tail(lds, (const bf16_t*)(ws + WS_T), (const bf16_t*)(ws + WS_WOUT), 2048, 2048, 16, (float*)(ws + WS_SLAB0), G, bx); }
        GSYNC();
        { PHASE_BEGIN
          for (int x = vcu; x < 64; x += G) { pg8::EpiF32 E{(float*)(ws + WS_MIX), 2048}; pg8::tail_fixup((const float*)(ws + WS_SLAB0), 16, 2048, MP / 256, x >> 3, 1 << (x & 7), E, tid); } }
        GSYNC();
        }
        { PHASE_BEGIN
          resid_norm((const float*)(ws + WS_MIX), P.in[17] + l * 2048, P.out, P.in[18] + l * 2048, (bf16_t*)(ws + WS_XN), gw, NGW, lane); }
        GSYNC();
        for (int repK = 0; repK < ((PROBE & 16) ? 2 : 1); ++repK) {
        { PHASE_BEGIN
          pg8::EpiRelu2 E{(bf16_t*)(ws + WS_H), FFN}; run_gemm(lds, (const bf16_t*)(ws + WS_XN), (const bf16_t*)(ws + WS_WUP), MP, FFN, 2048, G, bx, E); }
        { PHASE_BEGIN
          run_tail(lds, (const bf16_t*)(ws + WS_XN), (const bf16_t*)(ws + WS_WUP), FFN, 2048, 4, (float*)(ws + WS_SLAB0), G, bx); }
        GSYNC();
        { PHASE_BEGIN
          for (int x = vcu; x < 256; x += G) { pg8::EpiRelu2 E{(bf16_t*)(ws + WS_H), FFN}; pg8::tail_fixup((const float*)(ws + WS_SLAB0), 4, FFN, MP / 256, x >> 3, 1 << (x & 7), E, tid); } }
        GSYNC();
        }
        { PHASE_BEGIN
          pg8::EpiF32 E{(float*)(ws + WS_M2), 2048}; run_gemm(lds, (const bf16_t*)(ws + WS_H), (const bf16_t*)(ws + WS_WDN), MP, 2048, FFN, G, bx, E); }
        { PHASE_BEGIN
          run_tail(lds, (const bf16_t*)(ws + WS_H), (const bf16_t*)(ws + WS_WDN), 2048, FFN, 16, (float*)(ws + WS_SLAB0), G, bx); }
        GSYNC();
        { PHASE_BEGIN
          for (int x = vcu; x < 64; x += G) { pg8::EpiF32 E{(float*)(ws + WS_M2), 2048}; pg8::tail_fixup((const float*)(ws + WS_SLAB0), 16, 2048, MP / 256, x >> 3, 1 << (x & 7), E, tid); } }
        GSYNC();
        { PHASE_BEGIN
          resid_norm((const float*)(ws + WS_M2), P.in[21] + l * 2048, P.out, l == 0 ? P.in[5] + 2048 : nullptr, (bf16_t*)(ws + WS_XN), gw, NGW, lane);
          if (l == 0) for (int rep = 0; rep < ((PROBE & 8) ? 2 : 1); ++rep) layer_prep(P, lds, 1, gw, NGW, gt, NGT, lane, wave); }
        if (l == 0) GSYNC();
    }
}

extern "C" void kernel_launch(void* const* d_in, const int* in_sizes, int n_in, void* d_out, int out_size, void* d_ws, size_t ws_size, hipStream_t stream) {
    static int grid = 0;
    if (grid == 0) {
        if (n_in != 22 || (size_t)out_size != OUT_TOTAL || ws_size < WS_END) { fprintf(stderr, "kernel_launch: unexpected shapes (n_in %d, out %d, ws %zu, need %zu)\n", n_in, out_size, ws_size, (size_t)WS_END); grid = -1; return; }
        int dev = 0, cus = 0, per_cu = 0;
        if (hipGetDevice(&dev) != hipSuccess || hipDeviceGetAttribute(&cus, hipDeviceAttributeMultiprocessorCount, dev) != hipSuccess) { grid = -1; return; }
        if (hipFuncSetAttribute((const void*)fwd_kernel, hipFuncAttributeMaxDynamicSharedMemorySize, LDS_BYTES) != hipSuccess) { fprintf(stderr, "kernel_launch: hipFuncSetAttribute failed\n"); grid = -1; return; }
        if (hipOccupancyMaxActiveBlocksPerMultiprocessor(&per_cu, (const void*)fwd_kernel, 512, LDS_BYTES) != hipSuccess || per_cu < 1) { fprintf(stderr, "kernel_launch: occupancy query failed (%d)\n", per_cu); per_cu = 1; }
        (void)hipGetLastError();
        grid = cus * per_cu;
    }
    if (grid < 0) return;
    if (hipMemsetAsync((char*)d_ws + WS_CTL, 0, 16384, stream) != hipSuccess) { fprintf(stderr, "kernel_launch: memset failed\n"); return; }
    Params p{};
    for (int i = 0; i < 22; ++i) p.in[i] = (const float*)d_in[i];
    p.out = (float*)d_out; p.ws = (unsigned char*)d_ws;
    void* args[] = {&p};
    hipError_t e = hipLaunchCooperativeKernel((const void*)fwd_kernel, dim3(grid), dim3(512), args, LDS_BYTES, stream);
    if (e != hipSuccess) fprintf(stderr, "kernel_launch: cooperative launch failed: %s (grid %d)\n", hipGetErrorString(e), grid);
}
```

```cpp
#include <hip/hip_runtime.h>
#include <hip/hip_cooperative_groups.h>
#include <cstdio>
#include <cstdint>
namespace cg = cooperative_groups;

#define DI __device__ __forceinline__
#define LAS __attribute__((address_space(3)))
typedef short bf16x8 __attribute__((ext_vector_type(8)));
typedef short s16x4 __attribute__((ext_vector_type(4)));
typedef float f32x4 __attribute__((ext_vector_type(4)));
typedef float f32x16 __attribute__((ext_vector_type(16)));
typedef unsigned u32x4 __attribute__((ext_vector_type(4)));
typedef unsigned u32x2 __attribute__((ext_vector_type(2)));
typedef float f32x2_t __attribute__((ext_vector_type(2)));
typedef __bf16 bf16x2_t __attribute__((ext_vector_type(2)));

constexpr int MP = 8192, MS = 256, MTOK = 8448, DM = 2048, DINP = 13568, ZSW = 1280, FFN = 8192;
constexpr int KVB = 4160;
constexpr int KVR = 8192 + 8 * KVB;
constexpr int NU = 2048 + 128;
constexpr float EPS = 1e-6f;
constexpr float QSCALE = 0.07216878364870322f * 1.4426950408889634f;

constexpr size_t MiB = 1u << 20;
constexpr size_t WS_WIN = 0, WS_WUQ = 53 * MiB, WS_WUK = 56 * MiB, WS_WUV = 58 * MiB, WS_WOA = 60 * MiB, WS_WOB = 68 * MiB, WS_WOUT = 76 * MiB, WS_WUP = 84 * MiB, WS_WDN = 116 * MiB;
constexpr size_t WS_XN = 148 * MiB, WS_HG = 181 * MiB, WS_GA = 214 * MiB, WS_GB = 247 * MiB, WS_QN = 280 * MiB, WS_Q = 289 * MiB, WS_OA = 339 * MiB, WS_OH = 372 * MiB;
constexpr size_t WS_CKV = 405 * MiB, WS_KPE = 446 * MiB, WS_TBL = 452 * MiB, WS_LB = 453 * MiB, WS_D = 454 * MiB, WS_R = 456 * MiB;
constexpr size_t WS_SPT = WS_Q;
constexpr size_t WS_ZS = WS_R, WS_HQ = WS_R + 42 * MiB, WS_HK = WS_R + 75 * MiB, WS_HV = WS_R + 108 * MiB, WS_LF = WS_R + 141 * MiB, WS_UT = WS_R + 207 * MiB;
constexpr size_t WS_KN = WS_R, WS_VT = WS_R + 162 * MiB;
constexpr size_t WS_T = WS_R, WS_MIX = WS_R + 33 * MiB, WS_H = WS_R + 99 * MiB, WS_M2 = WS_R + 231 * MiB;
constexpr size_t WS_SLAB0 = WS_Q, WS_SLAB1 = WS_R + 297 * MiB;
constexpr size_t WS_CTL = WS_R + 343 * MiB;
constexpr size_t WS_END = WS_CTL + 1 * MiB;
static_assert((size_t)NU * 128 * 128 * 2 <= 83 * MiB && (size_t)NU * 65536 <= 136 * MiB && (size_t)KVR * 2048 * 2 <= 162 * MiB, "ws map");

constexpr size_t OUT_X = 0, OUT_CKVP = 17301504, OUT_KPEP = OUT_CKVP + 8388608, OUT_STP = OUT_KPEP + 1048576, OUT_CKVS = OUT_STP + 2097152, OUT_KPES = OUT_CKVS + 262144, OUT_STS = OUT_KPES + 32768;
constexpr size_t OUT_TOTAL = OUT_STS + 4194304;

DI unsigned pk2(float lo, float hi) { f32x2_t v = {lo, hi}; bf16x2_t b = __builtin_convertvector(v, bf16x2_t); return __builtin_bit_cast(unsigned, b); }
DI unsigned short f2bf(float f) { return (unsigned short)(pk2(f, 0.f) & 0xffffu); }
DI float bf2f(unsigned short u) { return __uint_as_float((unsigned)u << 16); }
DI float bflo(unsigned w) { return __uint_as_float(w << 16); }
DI float bfhi(unsigned w) { return __uint_as_float(w & 0xffff0000u); }
DI float sigm(float x) { return 1.f / (1.f + __expf(-x)); }
DI float ex2(float x) { return __builtin_amdgcn_exp2f(x); }
DI float shflx(float v, int mask, int lane) { return __int_as_float(__builtin_amdgcn_ds_bpermute((lane ^ mask) << 2, __float_as_int(v))); }
DI float wave_sum(float v, int lane) {
#pragma unroll
    for (int o = 1; o < 64; o <<= 1) v += shflx(v, o, lane);
    return v;
}
namespace pg8 {
#define PG8_LAS __attribute__((address_space(3)))
typedef unsigned short bf16_t;
typedef short bf16x8 __attribute__((ext_vector_type(8)));
typedef float f32x4 __attribute__((ext_vector_type(4)));
typedef unsigned u32x4 __attribute__((ext_vector_type(4)));
constexpr int BM = 256, BK = 64, HALF = 128, HTB = HALF * BK * 2  , STAGE_BYTES = 8 * HTB, NXCD = 8, WGM = 8;

__host__ __device__ __forceinline__ int lds_byte(int r, int c) { const int st = (r >> 4) * 2 + (c >> 5), rr = r & 15, cc = c & 31, ob = rr * 64 + cc * 2; return st * 1024 + (ob ^ (((ob >> 9) & 1) << 5)); }
__host__ __device__ __forceinline__ void stage_rc(int b, int& R, int& C) { const int st = b / 1024, sb = b % 1024, swz = sb ^ (((sb >> 9) & 1) << 5); R = (st >> 1) * 16 + swz / 64; C = (st & 1) * 32 + (swz % 64) / 2; }
__host__ __device__ __forceinline__ int perm32(int rho) { const int n = rho >> 4, i = rho & 15; return 8 * (i >> 2) + 4 * n + (i & 3); }

struct Unit { int pm, pn, koff, mask; };
struct Gemm { const bf16_t* A; const bf16_t* Bt; int M, N, K, kext; };

struct StaticOrder {
    int nM, nN, nwg, G, c;
    __host__ __device__ void init(int M, int N, int G_, int c_) { nM = M / BM; nN = N / BM; nwg = nM * nN; G = G_; c = c_; }
    __host__ __device__ bool next(int i, Unit& u) const {
        const long L = (long)i * G + c; if (L >= nwg) return false;
        int wgid = (int)L; { const int q = nwg / NXCD, r = nwg % NXCD, xcd = wgid % NXCD, off = wgid / NXCD; wgid = (xcd < r ? xcd * (q + 1) : r * (q + 1) + (xcd - r) * q) + off; }
        const int nig = WGM * nN, gid = wgid / nig, fm = gid * WGM, gsz = (nM - fm) < WGM ? (nM - fm) : WGM;
        u.pm = fm + ((wgid % nig) % gsz); u.pn = (wgid % nig) / gsz; u.koff = 0; u.mask = 0xff; return true;
    }
    __device__ __forceinline__ void a_ready(const Unit&) const {}
    __device__ __forceinline__ void done(const Unit&) const {}
};

struct TailOrder {
    int pm, nN, KS, kext, G, c;
    __host__ __device__ bool next(int i, Unit& u) const { const int L = i * G + c; if (L >= nN * KS) return false; u.pm = pm; u.pn = L / KS; u.koff = (L - u.pn * KS) * kext; u.mask = 0xff; return true; }
    __device__ __forceinline__ void a_ready(const Unit&) const {}
    __device__ __forceinline__ void done(const Unit&) const {}
};
#define EPI_LOOP _Pragma("unroll") for (int ai = 0; ai < 2; ++ai) _Pragma("unroll") for (int m = 0; m < 4; ++m) if ((u.mask >> (ai * 4 + m)) & 1) _Pragma("unroll") for (int bj = 0; bj < 2; ++bj)
__device__ __forceinline__ u32x4 pack8f(const f32x4 a, const f32x4 b) { u32x4 w; w.x = pk2(a[0], a[1]); w.y = pk2(a[2], a[3]); w.z = pk2(b[0], b[1]); w.w = pk2(b[2], b[3]); return w; }

struct EpiWin {
    static constexpr bool PERM = true, AFTER_DRAIN = false;
    float* Zs; bf16_t *HQ, *HK, *HV, *HG, *GA, *GB; float* LF; const float* lb;
    __device__ __forceinline__ void operator()(const f32x4 (&acc)[2][2][4][2], const Unit& u, int wr, int wc, int fr, int fq) const {
        const int row0 = u.pm * 256 + wr * 64 + fr, ct = wc * 32 + 8 * fq, pn = u.pn;
        if (pn < 5) {
            EPI_LOOP { float* p = Zs + (size_t)(row0 + ai * 128 + m * 16) * ZSW + pn * 256 + ct + bj * 128; *(f32x4*)p = acc[ai][bj][m][0]; *(f32x4*)(p + 4) = acc[ai][bj][m][1]; }
            return;
        }
        const int seg = (pn - 5) >> 3, cseg = ((pn - 5) & 7) * 256 + ct;
        if (seg == 1) {
#pragma unroll
            for (int bj = 0; bj < 2; ++bj) {
                const f32x4 l0 = *(const f32x4*)(lb + cseg + bj * 128), l1 = *(const f32x4*)(lb + cseg + bj * 128 + 4);
#pragma unroll
                for (int ai = 0; ai < 2; ++ai)
#pragma unroll
                    for (int m = 0; m < 4; ++m) {
                        const size_t off = (size_t)(row0 + ai * 128 + m * 16) * 2048 + cseg + bj * 128;
                        f32x4 lf0, lf1, k0, k1;
#pragma unroll
                        for (int e = 0; e < 4; ++e) {
                            { const float z = acc[ai][bj][m][0][e], lbv = l0[e], ez = __expf(-z), sg = 1.f / (1.f + ez); lf0[e] = __logf(lbv + (1.f - lbv) * sg); k0[e] = (1.f - lbv) * ez * sg; }
                            { const float z = acc[ai][bj][m][1][e], lbv = l1[e], ez = __expf(-z), sg = 1.f / (1.f + ez); lf1[e] = __logf(lbv + (1.f - lbv) * sg); k1[e] = (1.f - lbv) * ez * sg; }
                        }
                        *(f32x4*)(LF + off) = lf0; *(f32x4*)(LF + off + 4) = lf1; *(u32x4*)(HK + off) = pack8f(k0, k1);
                    }
            }
            return;
        }
        bf16_t* O = seg == 0 ? HQ : seg == 2 ? HV : seg == 3 ? HG : seg == 4 ? GA : GB;
        const int act = (seg == 0 || seg == 3) ? 1 : (seg == 2 ? 0 : 2);
        EPI_LOOP {
            f32x4 a = acc[ai][bj][m][0], b = acc[ai][bj][m][1];
#pragma unroll
            for (int e = 0; e < 4; ++e) { const float sa = sigm(a[e]), sb = sigm(b[e]); a[e] = act == 0 ? a[e] : act == 1 ? a[e] * sa : sa; b[e] = act == 0 ? b[e] : act == 1 ? b[e] * sb : sb; }
            *(u32x4*)(O + (size_t)(row0 + ai * 128 + m * 16) * 2048 + cseg + bj * 128) = pack8f(a, b);
        }
    }
};

struct EpiQ {
    static constexpr bool PERM = true, AFTER_DRAIN = false;
    bf16_t* Q; const float* tbl;
    __device__ __forceinline__ void operator()(const f32x4 (&acc)[2][2][4][2], const Unit& u, int wr, int wc, int fr, int fq) const {
        const int row0 = u.pm * 256 + wr * 64 + fr, ct = wc * 32 + 8 * fq, pn = u.pn;
        if (pn < 8) {
            EPI_LOOP { const int col = pn * 256 + ct + bj * 128, h = col >> 7, i = col & 127;
                *(u32x4*)(Q + (size_t)(row0 + ai * 128 + m * 16) * 3072 + h * 192 + i) = pack8f(acc[ai][bj][m][0] * QSCALE, acc[ai][bj][m][1] * QSCALE); }
            return;
        }
        EPI_LOOP {
            const int row = row0 + ai * 128 + m * 16, p = row < MP ? (row & 2047) : 2048 + ((row - MP) & 31);
            const int c = (pn - 8) * 256 + ct + bj * 128, h = c >> 6, j0 = (c & 63) >> 1;
            const f32x4 t0 = *(const f32x4*)(tbl + (size_t)(p * 32 + j0) * 2), t1 = *(const f32x4*)(tbl + (size_t)(p * 32 + j0) * 2 + 4);
            const f32x4 x = acc[ai][bj][m][0] * QSCALE, y = acc[ai][bj][m][1] * QSCALE;
            const float a0 = x[0] * t0[0] - x[1] * t0[1], b0 = x[0] * t0[1] + x[1] * t0[0];
            const float a1 = x[2] * t0[2] - x[3] * t0[3], b1 = x[2] * t0[3] + x[3] * t0[2];
            const float a2 = y[0] * t1[0] - y[1] * t1[1], b2 = y[0] * t1[1] + y[1] * t1[0];
            const float a3 = y[2] * t1[2] - y[3] * t1[3], b3 = y[2] * t1[3] + y[3] * t1[2];
            bf16_t* q = Q + (size_t)row * 3072 + h * 192 + 128 + j0;
            u32x2 w1, w2; w1.x = pk2(a0, a1); w1.y = pk2(a2, a3); w2.x = pk2(b0, b1); w2.y = pk2(b2, b3);
            *(u32x2*)q = w1; *(u32x2*)(q + 32) = w2;
            if (bj == 1) asm volatile("" ::: "memory");
        }
    }
};

struct EpiPlain {
    static constexpr bool PERM = true, AFTER_DRAIN = false;
    bf16_t* O; int ldc;
    __device__ __forceinline__ void operator()(const f32x4 (&acc)[2][2][4][2], const Unit& u, int wr, int wc, int fr, int fq) const {
        const int row0 = u.pm * 256 + wr * 64 + fr, c0 = u.pn * 256 + wc * 32 + 8 * fq;
        EPI_LOOP { *(u32x4*)(O + (size_t)(row0 + ai * 128 + m * 16) * ldc + c0 + bj * 128) = pack8f(acc[ai][bj][m][0], acc[ai][bj][m][1]); }
    }
};
struct EpiF32 {
    static constexpr bool PERM = true, AFTER_DRAIN = false;
    float* O; int ldc;
    __device__ __forceinline__ void operator()(const f32x4 (&acc)[2][2][4][2], const Unit& u, int wr, int wc, int fr, int fq) const {
        const int row0 = u.pm * 256 + wr * 64 + fr, c0 = u.pn * 256 + wc * 32 + 8 * fq;
        EPI_LOOP { float* p = O + (size_t)(row0 + ai * 128 + m * 16) * ldc + c0 + bj * 128; *(f32x4*)p = acc[ai][bj][m][0]; *(f32x4*)(p + 4) = acc[ai][bj][m][1]; }
    }
};
struct EpiRelu2 {
    static constexpr bool PERM = true, AFTER_DRAIN = false;
    bf16_t* O; int ldc;
    __device__ __forceinline__ void operator()(const f32x4 (&acc)[2][2][4][2], const Unit& u, int wr, int wc, int fr, int fq) const {
        const int row0 = u.pm * 256 + wr * 64 + fr, c0 = u.pn * 256 + wc * 32 + 8 * fq;
        EPI_LOOP { f32x4 a = acc[ai][bj][m][0], b = acc[ai][bj][m][1];
#pragma unroll
            for (int e = 0; e < 4; ++e) { const float ra = fmaxf(a[e], 0.f), rb = fmaxf(b[e], 0.f); a[e] = ra * ra; b[e] = rb * rb; }
            *(u32x4*)(O + (size_t)(row0 + ai * 128 + m * 16) * ldc + c0 + bj * 128) = pack8f(a, b); }
    }
};
template <bool SECOND> struct EpiGate {
    static constexpr bool PERM = true, AFTER_DRAIN = false;
    const bf16_t* Gt; bf16_t* T;
    __device__ __forceinline__ void operator()(const f32x4 (&acc)[2][2][4][2], const Unit& u, int wr, int wc, int fr, int fq) const {
        const int row0 = u.pm * 256 + wr * 64 + fr, c0 = u.pn * 256 + wc * 32 + 8 * fq;
        EPI_LOOP { const size_t off = (size_t)(row0 + ai * 128 + m * 16) * 2048 + c0 + bj * 128;
            const u32x4 g = *(const u32x4*)(Gt + off); f32x4 a = acc[ai][bj][m][0], b = acc[ai][bj][m][1];
            a[0] *= bflo(g.x); a[1] *= bfhi(g.x); a[2] *= bflo(g.y); a[3] *= bfhi(g.y); b[0] *= bflo(g.z); b[1] *= bfhi(g.z); b[2] *= bflo(g.w); b[3] *= bfhi(g.w);
            if (SECOND) { const u32x4 t = *(const u32x4*)(T + off);
                a[0] += bflo(t.x); a[1] += bfhi(t.x); a[2] += bflo(t.y); a[3] += bfhi(t.y); b[0] += bflo(t.z); b[1] += bfhi(t.z); b[2] += bflo(t.w); b[3] += bfhi(t.w); }
            *(u32x4*)(T + off) = pack8f(a, b);
            if (bj == 1 && (m & 1)) asm volatile("" ::: "memory"); }
    }
};

struct EpiSlab {
    static constexpr bool PERM = true, AFTER_DRAIN = false;
    float* slab; int ldc, kext;
    __device__ __forceinline__ void operator()(const f32x4 (&acc)[2][2][4][2], const Unit& u, int wr, int wc, int fr, int fq) const {
        const int kp = u.koff / kext, r0 = wr * 64 + fr, c0 = u.pn * 256 + wc * 32 + 8 * fq;
        EPI_LOOP { float* p = slab + ((size_t)kp * 256 + r0 + ai * 128 + m * 16) * ldc + c0 + bj * 128; *(f32x4*)p = acc[ai][bj][m][0]; *(f32x4*)(p + 4) = acc[ai][bj][m][1]; }
    }
};
template <class Epi> __device__ __forceinline__ void tail_fixup(const float* slab, int KS, int ldc, int pm, int pn, int mask, const Epi& E, int tid_in) {
    Unit u; u.pm = pm; u.pn = pn; u.koff = 0; u.mask = mask;
    int tid_l = tid_in; asm volatile("" : "+v"(tid_l));
    const int wid = tid_l >> 6, lane = tid_l & 63, wr = wid >> 2, wc = wid & 3, fr = lane & 15, fq = lane >> 4;
    const int r0 = wr * 64 + fr, c0 = pn * 256 + wc * 32 + 8 * fq;
    f32x4 acc[2][2][4][2];
    EPI_LOOP { acc[ai][bj][m][0] = (f32x4){0.f, 0.f, 0.f, 0.f}; acc[ai][bj][m][1] = (f32x4){0.f, 0.f, 0.f, 0.f}; }
    const char* sb = (const char*)slab; unsigned off = ((unsigned)r0 * (unsigned)ldc + (unsigned)c0) * 4u;
    for (int kp = 0; kp < KS; ++kp) {
        EPI_LOOP { const char* p = sb + (off + (unsigned)((ai * 128 + m * 16) * ldc + bj * 128) * 4u); acc[ai][bj][m][0] += *(const f32x4*)p; acc[ai][bj][m][1] += *(const f32x4*)(p + 16); }
        off += 256u * (unsigned)ldc * 4u;
    }
    E(acc, u, wr, wc, fr, fq);
}
template <class Epi, class Sched, bool ALIGN_EPI = false, bool SP2 = false>
__device__ __forceinline__ void gemm_phase(PG8_LAS unsigned char* lds, const Gemm g, const Sched& S, const Epi& E, int tid_in) {
    int tid_l = tid_in; asm volatile("" : "+v"(tid_l));
    const int tid = tid_l, wid = __builtin_amdgcn_readfirstlane(tid >> 6), lane = tid & 63, wr = wid >> 2, wc = wid & 3, fr = lane & 15, fq = lane >> 4;
    const int K = g.K, nt = g.kext / BK;
    unsigned voffA[2], voffB[2];
#pragma unroll
    for (int i = 0; i < 2; ++i) { int R, C; stage_rc(tid * 16 + i * 8192, R, C); const int Rb = Epi::PERM ? ((R & ~31) + perm32(R & 31)) : R;
        voffA[i] = (unsigned)(R * K + C) * 2u; voffB[i] = (unsigned)(Rb * K + C) * 2u; }
    const size_t kstep = (size_t)(BK * 2);
    const size_t hstep = (size_t)HALF * K * 2;
    const size_t tstep = 2 * hstep;
    const unsigned ldsw = (unsigned)wid * 1024u;
    const int aoff = lds_byte(wr * 64 + fr, fq * 8), boff = lds_byte(wc * 32 + fr, fq * 8);
#define PG8_SA(b, h) (((b) * 2 + (h)) * HTB)
#define PG8_SB(b, h) ((4 + (b) * 2 + (h)) * HTB)
#define PG8_STAGE(bufoff, gbase, voff) do { _Pragma("unroll") for (int _i = 0; _i < 2; ++_i) \
        __builtin_amdgcn_global_load_lds((const unsigned*)((const char*)(gbase) + (voff)[_i]), (PG8_LAS unsigned*)(lds + (bufoff) + ldsw + _i * 8192), 16, 0, 0); } while (0)
#define PG8_LDA(dst, b, h) do { _Pragma("unroll") for (int m = 0; m < 4; ++m) _Pragma("unroll") for (int k = 0; k < 2; ++k) dst[m][k] = *(const PG8_LAS bf16x8*)(lds + PG8_SA(b, h) + aoff + m * 2048 + k * 1024); } while (0)
#define PG8_LDB(dst, b, h) do { _Pragma("unroll") for (int n = 0; n < 2; ++n) _Pragma("unroll") for (int k = 0; k < 2; ++k) dst[n][k] = *(const PG8_LAS bf16x8*)(lds + PG8_SB(b, h) + boff + n * 2048 + k * 1024); } while (0)
#define PG8_MMA(ai, bj, At, Bt) do { __builtin_amdgcn_s_setprio(1); _Pragma("unroll") for (int m = 0; m < 4; ++m) _Pragma("unroll") for (int n = 0; n < 2; ++n) _Pragma("unroll") for (int k = 0; k < 2; ++k) \
        acc[ai][bj][m][n] = __builtin_amdgcn_mfma_f32_16x16x32_bf16(Bt[n][k], At[m][k], acc[ai][bj][m][n], 0, 0, 0); __builtin_amdgcn_s_setprio(0); } while (0)
#define PG8_WAIT_V(n) asm volatile("s_waitcnt vmcnt(" #n ")" ::: "memory")
#define PG8_WAIT_L(n) asm volatile("s_waitcnt lgkmcnt(" #n ")" ::: "memory")
#define PG8_BAR __builtin_amdgcn_s_barrier()
#define PG8_SCHED __builtin_amdgcn_sched_barrier(0)
    Unit cur, nxt; int ui = 0;
    if (!S.next(0, cur)) return;
    f32x4 acc[2][2][4][2];
#pragma unroll
    for (int a = 0; a < 2; ++a)
#pragma unroll
        for (int b = 0; b < 2; ++b)
#pragma unroll
            for (int m = 0; m < 4; ++m)
#pragma unroll
                for (int n = 0; n < 2; ++n) acc[a][b][m][n] = (f32x4){0.f, 0.f, 0.f, 0.f};
    bf16x8 At[4][2], B0[2][2], B1[2][2];
    const char* cA = (const char*)g.A + (size_t)cur.pm * tstep + (size_t)cur.koff * 2; const char* cB = (const char*)g.Bt + (size_t)cur.pn * tstep + (size_t)cur.koff * 2;
    S.a_ready(cur);
    if constexpr (SP2) {
        PG8_STAGE(PG8_SB(0, 0), cB, voffB); PG8_STAGE(PG8_SB(0, 1), cB + hstep, voffB); PG8_STAGE(PG8_SA(0, 0), cA, voffA); PG8_STAGE(PG8_SA(0, 1), cA + hstep, voffA);
        if (wr == 1) PG8_BAR;
        PG8_WAIT_V(2); PG8_BAR;
        PG8_STAGE(PG8_SB(1, 0), cB + kstep, voffB); PG8_STAGE(PG8_SA(1, 0), cA + kstep, voffA); PG8_STAGE(PG8_SB(1, 1), cB + hstep + kstep, voffB);
        PG8_WAIT_V(6); PG8_BAR;
    } else {
        PG8_STAGE(PG8_SB(0, 0), cB, voffB); PG8_STAGE(PG8_SA(0, 0), cA, voffA); PG8_STAGE(PG8_SB(0, 1), cB + hstep, voffB); PG8_STAGE(PG8_SA(0, 1), cA + hstep, voffA);
        if (wr == 1) PG8_BAR;
        PG8_WAIT_V(4); PG8_BAR;
        PG8_STAGE(PG8_SB(1, 0), cB + kstep, voffB); PG8_STAGE(PG8_SA(1, 0), cA + kstep, voffA); PG8_STAGE(PG8_SB(1, 1), cB + hstep + kstep, voffB);
        PG8_WAIT_V(6); PG8_BAR;
    }
    for (;;) {
        const bool has_next = S.next(ui + 1, nxt);
        const char* nA = has_next ? (const char*)g.A + (size_t)nxt.pm * tstep + (size_t)nxt.koff * 2 : cA; const char* nB = has_next ? (const char*)g.Bt + (size_t)nxt.pn * tstep + (size_t)nxt.koff * 2 : cB;
        for (int t = 0; t < nt; t += 2) {
            const bool last = (t == nt - 2);
            const char* a1 = cA + (size_t)(t + 1) * kstep;
            const char* a2 = last ? nA : cA + (size_t)(t + 2) * kstep; const char* b2 = last ? nB : cB + (size_t)(t + 2) * kstep;
            const char* a3 = a2 + kstep; const char* b3 = b2 + kstep;
            if (last && has_next) S.a_ready(nxt);
            if constexpr (SP2) {
            PG8_LDB(B0, 0, 0); PG8_LDB(B1, 0, 1); PG8_SCHED; PG8_LDA(At, 0, 0); PG8_STAGE(PG8_SA(1, 1), a1 + hstep, voffA);
            PG8_WAIT_V(8); PG8_WAIT_L(0); PG8_BAR; PG8_MMA(0, 0, At, B0); PG8_MMA(0, 1, At, B1); PG8_BAR; PG8_SCHED;
            PG8_LDA(At, 0, 1); PG8_STAGE(PG8_SB(0, 0), b2, voffB); PG8_STAGE(PG8_SB(0, 1), b2 + hstep, voffB); PG8_STAGE(PG8_SA(0, 0), a2, voffA);
            PG8_WAIT_V(8); PG8_WAIT_L(0); PG8_BAR; PG8_MMA(1, 0, At, B0); PG8_MMA(1, 1, At, B1); PG8_BAR; PG8_SCHED;
            PG8_LDB(B0, 1, 0); PG8_LDB(B1, 1, 1); PG8_SCHED; PG8_LDA(At, 1, 0); PG8_STAGE(PG8_SA(0, 1), a2 + hstep, voffA);
            PG8_WAIT_V(8); PG8_WAIT_L(0); PG8_BAR; PG8_MMA(0, 0, At, B0); PG8_MMA(0, 1, At, B1); PG8_BAR; PG8_SCHED;
            PG8_LDA(At, 1, 1); PG8_STAGE(PG8_SB(1, 0), b3, voffB); PG8_STAGE(PG8_SB(1, 1), b3 + hstep, voffB); PG8_STAGE(PG8_SA(1, 0), a3, voffA);
            PG8_WAIT_V(8); PG8_WAIT_L(0); PG8_BAR; PG8_MMA(1, 0, At, B0); PG8_MMA(1, 1, At, B1); PG8_BAR; PG8_SCHED;
            } else {
            PG8_LDB(B0, 0, 0); PG8_SCHED; PG8_LDA(At, 0, 0); PG8_STAGE(PG8_SA(1, 1), a1 + hstep, voffA);
            PG8_WAIT_L(8); PG8_BAR; PG8_WAIT_L(0); PG8_MMA(0, 0, At, B0); PG8_BAR; PG8_SCHED;
            PG8_LDB(B1, 0, 1); PG8_STAGE(PG8_SB(0, 0), b2, voffB);
            PG8_BAR; PG8_WAIT_L(0); PG8_MMA(0, 1, At, B1); PG8_BAR;
            PG8_LDA(At, 0, 1); PG8_STAGE(PG8_SA(0, 0), a2, voffA);
            PG8_BAR; PG8_WAIT_L(0); PG8_MMA(1, 0, At, B0); PG8_BAR; PG8_SCHED;
            PG8_STAGE(PG8_SB(0, 1), b2 + hstep, voffB);
            PG8_WAIT_V(6); PG8_BAR; PG8_MMA(1, 1, At, B1); PG8_BAR;
            PG8_LDB(B0, 1, 0); PG8_SCHED; PG8_LDA(At, 1, 0); PG8_STAGE(PG8_SA(0, 1), a2 + hstep, voffA);
            PG8_WAIT_L(8); PG8_BAR; PG8_WAIT_L(0); PG8_MMA(0, 0, At, B0); PG8_BAR; PG8_SCHED;
            PG8_LDB(B1, 1, 1); PG8_STAGE(PG8_SB(1, 0), b3, voffB);
            PG8_BAR; PG8_WAIT_L(0); PG8_MMA(0, 1, At, B1); PG8_BAR;
            PG8_LDA(At, 1, 1); PG8_STAGE(PG8_SA(1, 0), a3, voffA);
            PG8_BAR; PG8_WAIT_L(0); PG8_MMA(1, 0, At, B0); PG8_BAR; PG8_SCHED;
            PG8_STAGE(PG8_SB(1, 1), b3 + hstep, voffB);
            PG8_WAIT_V(6); PG8_BAR; PG8_MMA(1, 1, At, B1); PG8_BAR;
            }
        }
        if constexpr (ALIGN_EPI) { if (wr == 0) PG8_BAR; }
        if constexpr (!Epi::AFTER_DRAIN) { E(acc, cur, wr, wc, fr, fq); S.done(cur); }
        if (!has_next) break;
#pragma unroll
        for (int a = 0; a < 2; ++a)
#pragma unroll
            for (int b = 0; b < 2; ++b)
#pragma unroll
                for (int m = 0; m < 4; ++m)
#pragma unroll
                    for (int n = 0; n < 2; ++n) acc[a][b][m][n] = (f32x4){0.f, 0.f, 0.f, 0.f};
        cur = nxt; cA = nA; cB = nB; ++ui;
        if constexpr (ALIGN_EPI) { if (wr == 1) PG8_BAR; }
    }
    PG8_WAIT_V(0);
    if constexpr (!ALIGN_EPI) { if (wr == 0) PG8_BAR; }
    PG8_BAR;
    if constexpr (Epi::AFTER_DRAIN) { E.fused(acc, cur, wr, wc, fr, fq, lds, wid, lane); S.done(cur); }
#undef PG8_SA
#undef PG8_SB
#undef PG8_STAGE
#undef PG8_LDA
#undef PG8_LDB
#undef PG8_MMA
#undef PG8_WAIT_V
#undef PG8_WAIT_L
#undef PG8_BAR
#undef PG8_SCHED
}
}
using pg8::bf16_t;
#define MFMA32(a, b, c) __builtin_amdgcn_mfma_f32_32x32x16_bf16((a), (b), (c), 0, 0, 0)
#define LDS_WAIT() asm volatile("s_waitcnt lgkmcnt(0)" ::: "memory")
DI int crow(int i, int h) { return (i & 3) + 8 * (i >> 2) + 4 * h; }
template <int S> DI bf16x8 pack8(const f32x16& x) {
    u32x4 p; p.x = pk2(x[8 * S], x[8 * S + 1]); p.y = pk2(x[8 * S + 2], x[8 * S + 3]); p.z = pk2(x[8 * S + 4], x[8 * S + 5]); p.w = pk2(x[8 * S + 6], x[8 * S + 7]);
    return __builtin_bit_cast(bf16x8, p);
}
DI f32x16 zero16() { f32x16 z;
#pragma unroll
    for (int i = 0; i < 16; ++i) z[i] = 0.f; return z; }

struct Params { const float* in[22]; float* out; unsigned char* ws; };

enum { MAP_ID = 0, MAP_WIN = 1, MAP_WUQ = 2 };
template <int MAP> DI int dest_row(int n) {
    if (MAP == MAP_WIN) return n < 1088 ? n : n + 192;
    if (MAP == MAP_WUQ) { const int h = n / 192, i = n - h * 192; return i < 128 ? h * 128 + i : 2048 + h * 64 + 2 * ((i - 128) & 31) + ((i - 128) >> 5); }
    return n;
}
template <int MAP> DI void transpose_item(const float* __restrict__ W, int K, int N, bf16_t* __restrict__ WT, LAS float* scr, int item, int lane) {
    const int nblk = N / 32, kb = item / nblk, nb = item - kb * nblk, k0 = 64 * kb, n0 = 32 * nb;
    float wv[32];
#pragma unroll
    for (int i = 0; i < 32; ++i) wv[i] = W[(size_t)(k0 + 2 * i + (lane >> 5)) * N + n0 + (lane & 31)];
#pragma unroll
    for (int i = 0; i < 32; ++i) scr[(2 * i + (lane >> 5)) * 33 + (lane & 31)] = wv[i];
    LDS_WAIT();
    const int c = lane & 7;
#pragma unroll
    for (int j = 0; j < 4; ++j) { const int n = (lane >> 3) + 8 * j; const LAS float* s = scr + (8 * c) * 33 + n;
        u32x4 o; o.x = pk2(s[0 * 33], s[1 * 33]); o.y = pk2(s[2 * 33], s[3 * 33]); o.z = pk2(s[4 * 33], s[5 * 33]); o.w = pk2(s[6 * 33], s[7 * 33]);
        *(u32x4*)(WT + (size_t)dest_row<MAP>(n0 + n) * K + k0 + 8 * c) = o; }
    LDS_WAIT();
}

DI void layer_prep(const Params& P, LAS unsigned char* lds, int l, int gw, int NGW, int gt, int NGT, int lane, int wave) {
    unsigned char* ws = P.ws;
    LAS float* scr = (LAS float*)(lds + wave * 16384);
    const float* w_in = P.in[6] + (size_t)l * 2048 * 13376; const float* w_uq = P.in[8] + (size_t)l * 512 * 3072;
    const float* w_uk = P.in[10] + (size_t)l * 512 * 2048;  const float* w_uv = P.in[11] + (size_t)l * 512 * 2048;
    const float* w_oa = P.in[12] + (size_t)l * 2048 * 2048; const float* w_ob = P.in[15] + (size_t)l * 2048 * 2048; const float* w_out = P.in[16] + (size_t)l * 2048 * 2048;
    const float* w_up = P.in[19] + (size_t)l * 2048 * 8192; const float* w_dn = P.in[20] + (size_t)l * 8192 * 2048;
    constexpr int I_IN = 32 * 418, I_UQ = 8 * 96, I_UK = 8 * 64, I_SQ = 32 * 64, I_UP = 32 * 256, I_DN = 128 * 64;
    constexpr int NIT = I_IN + I_UQ + 2 * I_UK + 3 * I_SQ + I_UP + I_DN;
    for (int it = gw; it < NIT; it += NGW) {
        int r = it;
        if (r < I_IN) { transpose_item<MAP_WIN>(w_in, 2048, 13376, (bf16_t*)(ws + WS_WIN), scr, r, lane); continue; } r -= I_IN;
        if (r < I_UQ) { transpose_item<MAP_WUQ>(w_uq, 512, 3072, (bf16_t*)(ws + WS_WUQ), scr, r, lane); continue; } r -= I_UQ;
        if (r < I_UK) { transpose_item<MAP_ID>(w_uk, 512, 2048, (bf16_t*)(ws + WS_WUK), scr, r, lane); continue; } r -= I_UK;
        if (r < I_UK) { transpose_item<MAP_ID>(w_uv, 512, 2048, (bf16_t*)(ws + WS_WUV), scr, r, lane); continue; } r -= I_UK;
        if (r < I_SQ) { transpose_item<MAP_ID>(w_oa, 2048, 2048, (bf16_t*)(ws + WS_WOA), scr, r, lane); continue; } r -= I_SQ;
        if (r < I_SQ) { transpose_item<MAP_ID>(w_ob, 2048, 2048, (bf16_t*)(ws + WS_WOB), scr, r, lane); continue; } r -= I_SQ;
        if (r < I_SQ) { transpose_item<MAP_ID>(w_out, 2048, 2048, (bf16_t*)(ws + WS_WOUT), scr, r, lane); continue; } r -= I_SQ;
        if (r < I_UP) { transpose_item<MAP_ID>(w_up, 2048, 8192, (bf16_t*)(ws + WS_WUP), scr, r, lane); continue; } r -= I_UP;
        transpose_item<MAP_ID>(w_dn, 8192, 2048, (bf16_t*)(ws + WS_WDN), scr, r, lane);
    }
    u32x4 z4; { unsigned z_; asm volatile("v_mov_b32 %0, 0" : "=v"(z_)); z4.x = z_; z4.y = z_; z4.z = z_; z4.w = z_; }
    { u32x4* z = (u32x4*)((bf16_t*)(ws + WS_WIN) + (size_t)1088 * 2048); for (int i = gt; i < 192 * 2048 / 8; i += NGT) z[i] = z4; }
    bf16_t* CKV = (bf16_t*)(ws + WS_CKV); bf16_t* KPE = (bf16_t*)(ws + WS_KPE);
    const float* cc = P.in[2] + (size_t)l * 8 * 4096 * 512; const float* ck = P.in[3] + (size_t)l * 8 * 4096 * 64;
#pragma unroll 4
    for (int i = gt; i < 8 * 4096 * 512 / 8; i += NGT) { const int b = i >> 18, rem = i & 262143, t = rem >> 6, c8 = rem & 63;
        const f32x4 a = *(const f32x4*)(cc + (size_t)i * 8), bq = *(const f32x4*)(cc + (size_t)i * 8 + 4);
        u32x4 o; o.x = pk2(a[0], a[1]); o.y = pk2(a[2], a[3]); o.z = pk2(bq[0], bq[1]); o.w = pk2(bq[2], bq[3]);
        *(u32x4*)(CKV + (size_t)(MP + b * KVB + t) * 512 + c8 * 8) = o; }
#pragma unroll 2
    for (int i = gt; i < 8 * 4096 * 64 / 8; i += NGT) { const int b = i >> 15, rem = i & 32767, t = rem >> 3, c8 = rem & 7;
        const f32x4 a = *(const f32x4*)(ck + (size_t)i * 8), bq = *(const f32x4*)(ck + (size_t)i * 8 + 4);
        u32x4 o; o.x = pk2(a[0], a[1]); o.y = pk2(a[2], a[3]); o.z = pk2(bq[0], bq[1]); o.w = pk2(bq[2], bq[3]);
        *(u32x4*)(KPE + (size_t)(MP + b * KVB + t) * 64 + c8 * 8) = o; }
    for (int i = gt; i < 8 * 32 * 64; i += NGT) { const int b = i >> 11, rem = i & 2047; *(u32x4*)(CKV + (size_t)(MP + b * KVB + 4128) * 512 + rem * 8) = z4; }
    for (int i = gt; i < 8 * 32 * 8; i += NGT) { const int b = i >> 8, rem = i & 255; *(u32x4*)(KPE + (size_t)(MP + b * KVB + 4128) * 64 + rem * 8) = z4; }
    float* LB = (float*)(ws + WS_LB); const float* hl = P.in[13];
    for (int i = gt; i < 2048; i += NGT) LB[i] = l == 0 ? 0.f : 1.f / (1.f + expf(hl[i] - hl[2048 + i]));
}

DI void rope_table(const Params& P, int gt, int NGT) {
    float* T = (float*)(P.ws + WS_TBL);
    for (int i = gt; i < 2080 * 32; i += NGT) { const int p = i >> 5, j = i & 31; const int pos = p < 2048 ? p : 4096 + (p - 2048);
        const float inv = exp2f(-(float)j * (13.287712379549449f / 32.f)); const float ang = (float)pos * inv;
        const double a = (double)ang; const double kq = rint(a * 0.15915494309189535); const float rr = (float)(a - kq * 6.283185307179586);
        T[2 * i] = __cosf(rr); T[2 * i + 1] = __sinf(rr); }
}

DI void init_x(const Params& P, int gw, int NGW, int lane) {
    const float* g = P.in[5]; float* X = P.out; bf16_t* XN = (bf16_t*)(P.ws + WS_XN);
    for (int row = gw; row < MTOK; row += NGW) {
        const float* src = row < MP ? P.in[0] + (size_t)row * 2048 : P.in[1] + (size_t)(row - MP) * 2048;
        f32x4 v[8]; float ss = 0.f;
#pragma unroll
        for (int j = 0; j < 8; ++j) { v[j] = *(const f32x4*)(src + j * 256 + lane * 4); ss += v[j][0] * v[j][0] + v[j][1] * v[j][1] + v[j][2] * v[j][2] + v[j][3] * v[j][3]; }
        const float rs = rsqrtf(wave_sum(ss, lane) * (1.f / 2048.f) + EPS);
#pragma unroll
        for (int j = 0; j < 8; ++j) { *(f32x4*)(X + (size_t)row * 2048 + j * 256 + lane * 4) = v[j];
            const f32x4 gg = *(const f32x4*)(g + j * 256 + lane * 4); u32x2 w; w.x = pk2(v[j][0] * rs * gg[0], v[j][1] * rs * gg[1]); w.y = pk2(v[j][2] * rs * gg[2], v[j][3] * rs * gg[3]);
            *(u32x2*)(XN + (size_t)row * 2048 + j * 256 + lane * 4) = w; }
    }
}
DI void resid_norm(const float* __restrict__ Y, const float* __restrict__ gY, float* X, const float* __restrict__ gN, bf16_t* XN, int gw, int NGW, int lane) {
    for (int row = gw; row < MTOK; row += NGW) {
        f32x4 y[8]; float ss = 0.f;
#pragma unroll
        for (int j = 0; j < 8; ++j) { y[j] = *(const f32x4*)(Y + (size_t)row * 2048 + j * 256 + lane * 4); ss += y[j][0] * y[j][0] + y[j][1] * y[j][1] + y[j][2] * y[j][2] + y[j][3] * y[j][3]; }
        const float rs = rsqrtf(wave_sum(ss, lane) * (1.f / 2048.f) + EPS); float s2 = 0.f;
#pragma unroll
        for (int j = 0; j < 8; ++j) { const f32x4 gg = *(const f32x4*)(gY + j * 256 + lane * 4); const f32x4 x = *(const f32x4*)(X + (size_t)row * 2048 + j * 256 + lane * 4);
            y[j] = x + y[j] * rs * gg; *(f32x4*)(X + (size_t)row * 2048 + j * 256 + lane * 4) = y[j];
            s2 += y[j][0] * y[j][0] + y[j][1] * y[j][1] + y[j][2] * y[j][2] + y[j][3] * y[j][3]; }
        if (gN) {
            const float r2 = rsqrtf(wave_sum(s2, lane) * (1.f / 2048.f) + EPS);
#pragma unroll
            for (int j = 0; j < 8; ++j) { const f32x4 gg = *(const f32x4*)(gN + j * 256 + lane * 4); u32x2 w; w.x = pk2(y[j][0] * r2 * gg[0], y[j][1] * r2 * gg[1]); w.y = pk2(y[j][2] * r2 * gg[2], y[j][3] * r2 * gg[3]);
                *(u32x2*)(XN + (size_t)row * 2048 + j * 256 + lane * 4) = w; }
        }
    }
}
DI void small_norms(const Params& P, int l, int gw, int NGW, int lane) {
    const float* Zs = (const float*)(P.ws + WS_ZS); bf16_t* QN = (bf16_t*)(P.ws + WS_QN); bf16_t* CKV = (bf16_t*)(P.ws + WS_CKV); bf16_t* KPE = (bf16_t*)(P.ws + WS_KPE);
    const float* tbl = (const float*)(P.ws + WS_TBL); const float* gq = P.in[7] + l * 512; const float* gkv = P.in[9] + l * 512;
    for (int row = gw; row < MTOK; row += NGW) {
        const float* z = Zs + (size_t)row * ZSW;
        const bool pr = row < MP; const int rs_ = row - MP;
        const int kvrow = pr ? row : MP + (rs_ >> 5) * KVB + 4096 + (rs_ & 31);
        const int p = pr ? (row & 2047) : 2048 + (rs_ & 31);
        float* oc = pr ? P.out + OUT_CKVP + ((size_t)l * MP + row) * 512 : P.out + OUT_CKVS + ((size_t)l * MS + rs_) * 512;
        float* ok = pr ? P.out + OUT_KPEP + ((size_t)l * MP + row) * 64 : P.out + OUT_KPES + ((size_t)l * MS + rs_) * 64;
        { const f32x4 a = *(const f32x4*)(z + lane * 8), b = *(const f32x4*)(z + lane * 8 + 4);
          const float ss = a[0] * a[0] + a[1] * a[1] + a[2] * a[2] + a[3] * a[3] + b[0] * b[0] + b[1] * b[1] + b[2] * b[2] + b[3] * b[3];
          const float rs = rsqrtf(wave_sum(ss, lane) * (1.f / 512.f) + EPS); const f32x4 g0 = *(const f32x4*)(gq + lane * 8), g1 = *(const f32x4*)(gq + lane * 8 + 4);
          u32x4 o; o.x = pk2(a[0] * rs * g0[0], a[1] * rs * g0[1]); o.y = pk2(a[2] * rs * g0[2], a[3] * rs * g0[3]); o.z = pk2(b[0] * rs * g1[0], b[1] * rs * g1[1]); o.w = pk2(b[2] * rs * g1[2], b[3] * rs * g1[3]);
          *(u32x4*)(QN + (size_t)row * 512 + lane * 8) = o; }
        { const f32x4 a = *(const f32x4*)(z + 512 + lane * 8), b = *(const f32x4*)(z + 512 + lane * 8 + 4);
          const float ss = a[0] * a[0] + a[1] * a[1] + a[2] * a[2] + a[3] * a[3] + b[0] * b[0] + b[1] * b[1] + b[2] * b[2] + b[3] * b[3];
          const float rs = rsqrtf(wave_sum(ss, lane) * (1.f / 512.f) + EPS); const f32x4 g0 = *(const f32x4*)(gkv + lane * 8), g1 = *(const f32x4*)(gkv + lane * 8 + 4);
          const f32x4 c0 = a * rs * g0, c1 = b * rs * g1;
          *(f32x4*)(oc + lane * 8) = c0; *(f32x4*)(oc + lane * 8 + 4) = c1;
          u32x4 o; o.x = pk2(c0[0], c0[1]); o.y = pk2(c0[2], c0[3]); o.z = pk2(c1[0], c1[1]); o.w = pk2(c1[2], c1[3]);
          *(u32x4*)(CKV + (size_t)kvrow * 512 + lane * 8) = o; }
        if (lane < 32) { const float x1 = z[1024 + lane], x2 = z[1056 + lane]; const float c = tbl[(size_t)(p * 32 + lane) * 2], s = tbl[(size_t)(p * 32 + lane) * 2 + 1];
          const float o1 = x1 * c - x2 * s, o2 = x1 * s + x2 * c; ok[lane] = o1; ok[32 + lane] = o2;
          KPE[(size_t)kvrow * 64 + lane] = f2bf(o1); KPE[(size_t)kvrow * 64 + 32 + lane] = f2bf(o2); }
    }
}

struct HUnit { int rowbase, nvalid, h; };
DI HUnit hunit(int u) { HUnit r; if (u < 2048) { const int sh = u >> 5, c = u & 31; r.h = sh & 15; r.rowbase = (sh >> 4) * 2048 + c * 64; r.nvalid = 64; } else { const int s = u - 2048; r.h = s & 15; r.rowbase = MP + (s >> 4) * 32; r.nvalid = 32; } return r; }
DI void hgrn_cumsum(const float* __restrict__ LF, LAS float* psum, const HUnit& hu, int k, int tq, float (&b)[16], float& b31, float& b63) {
    const float* p = LF + (size_t)(hu.rowbase + 16 * tq) * 2048 + hu.h * 128 + k; const bool valid = 16 * tq < hu.nvalid;
    float run = 0.f;
#pragma unroll
    for (int i = 0; i < 16; ++i) { const float v = valid ? p[(size_t)i * 2048] : 0.f; run += v; b[i] = run; }
    psum[tq * 128 + k] = run;
    __syncthreads();
    const float p0 = psum[k], p1 = psum[128 + k], p2 = psum[256 + k], p3 = psum[384 + k];
    const float off = (tq > 0 ? p0 : 0.f) + (tq > 1 ? p1 : 0.f) + (tq > 2 ? p2 : 0.f);
#pragma unroll
    for (int i = 0; i < 16; ++i) b[i] += off;
    b31 = p0 + p1; b63 = b31 + p2 + p3;
}
DI void hgrn_pass1(LAS unsigned char* lds, const float* __restrict__ LF, const bf16_t* __restrict__ HK, const bf16_t* __restrict__ HV, float* __restrict__ UT, float* __restrict__ Dv, int u, int tid) {
    LAS float* psum = (LAS float*)lds; LAS bf16_t* KhT = (LAS bf16_t*)(lds + 2048); LAS bf16_t* VTl = (LAS bf16_t*)(lds + 2048 + 18432);
    const HUnit hu = hunit(u); const int k = tid & 127, tq = tid >> 7; const bool valid = 16 * tq < hu.nvalid;
    const size_t g0 = (size_t)(hu.rowbase + 16 * tq) * 2048 + hu.h * 128 + k;
    unsigned kraw[8], vw[8];
#pragma unroll
    for (int i2 = 0; i2 < 8; ++i2) { unsigned k0 = 0u, k1 = 0u, v0 = 0u, v1 = 0u;
        if (valid) { k0 = HK[g0 + (size_t)(2 * i2) * 2048]; k1 = HK[g0 + (size_t)(2 * i2 + 1) * 2048]; v0 = HV[g0 + (size_t)(2 * i2) * 2048]; v1 = HV[g0 + (size_t)(2 * i2 + 1) * 2048]; }
        kraw[i2] = k0 | (k1 << 16); vw[i2] = v0 | (v1 << 16); }
    float b[16], b31, b63; hgrn_cumsum(LF, psum, hu, k, tq, b, b31, b63);
    unsigned kw[8];
#pragma unroll
    for (int i2 = 0; i2 < 8; ++i2) kw[i2] = pk2(bflo(kraw[i2]) * __expf(b63 - b[2 * i2]), bfhi(kraw[i2]) * __expf(b63 - b[2 * i2 + 1]));
    { u32x4 a, c; a.x = kw[0]; a.y = kw[1]; a.z = kw[2]; a.w = kw[3]; c.x = kw[4]; c.y = kw[5]; c.z = kw[6]; c.w = kw[7];
      *(LAS u32x4*)(KhT + k * 72 + 16 * tq) = a; *(LAS u32x4*)(KhT + k * 72 + 16 * tq + 8) = c;
      a.x = vw[0]; a.y = vw[1]; a.z = vw[2]; a.w = vw[3]; c.x = vw[4]; c.y = vw[5]; c.z = vw[6]; c.w = vw[7];
      *(LAS u32x4*)(VTl + k * 72 + 16 * tq) = a; *(LAS u32x4*)(VTl + k * 72 + 16 * tq + 8) = c; }
    if (tq == 0) Dv[(size_t)u * 128 + k] = __expf(b63);
    __syncthreads();
    const int wave = tid >> 6, lane = tid & 63, r = lane & 31, hh = lane >> 5, vb = wave & 3, kg = wave >> 2;
#pragma unroll
    for (int kb2 = 0; kb2 < 2; ++kb2) {
        const int kbq = 2 * kg + kb2; f32x16 acc = zero16();
#pragma unroll
        for (int s = 0; s < 4; ++s) { const bf16x8 a = *(const LAS bf16x8*)(VTl + (32 * vb + r) * 72 + 16 * s + 8 * hh), bb = *(const LAS bf16x8*)(KhT + (32 * kbq + r) * 72 + 16 * s + 8 * hh); acc = MFMA32(a, bb, acc); }
        float* dst = UT + ((size_t)u * 128 + 32 * vb) * 128 + 32 * kbq + r;
#pragma unroll
        for (int i = 0; i < 16; ++i) dst[(size_t)crow(i, hh) * 128] = acc[i];
    }
    __syncthreads();
}
DI void hgrn_pass2(LAS unsigned char* lds, const Params& P, int l, int x, int tid) {
    const float* UT = (const float*)(P.ws + WS_UT); const float* Dv = (const float*)(P.ws + WS_D); bf16_t* SpT = (bf16_t*)(P.ws + WS_SPT);
    LAS float* tl = (LAS float*)lds;
    const bool sample = x >= 256; const int sidx = sample ? (x - 256) >> 2 : x >> 2, vq = x & 3;
    const int nch = sample ? 1 : 32, ubase = sample ? 2048 + sidx : sidx * 32;
    const int vloc = tid >> 4, k0 = (tid & 15) * 8, v = 32 * vq + vloc;
    const int kk = tid >> 2, vs = (tid & 3) * 8;
    float S[8];
#pragma unroll
    for (int i = 0; i < 8; ++i) S[i] = 0.f;
    if (sample) {
        const float* s0 = P.in[4] + ((size_t)l * 128 + sidx) * 16384 + (size_t)kk * 128 + 32 * vq + vs;
        const f32x4 a = *(const f32x4*)s0, b = *(const f32x4*)(s0 + 4);
#pragma unroll
        for (int i = 0; i < 4; ++i) { tl[kk * 33 + vs + i] = a[i]; tl[kk * 33 + vs + 4 + i] = b[i]; }
        __syncthreads();
#pragma unroll
        for (int i = 0; i < 8; ++i) S[i] = tl[(k0 + i) * 33 + vloc];
        __syncthreads();
    }
    size_t e = ((size_t)ubase * 128 + v) * 128 + k0;
    f32x4 u0 = *(const f32x4*)(UT + e), u1 = *(const f32x4*)(UT + e + 4), d0 = *(const f32x4*)(Dv + (size_t)ubase * 128 + k0), d1 = *(const f32x4*)(Dv + (size_t)ubase * 128 + k0 + 4);
    for (int c = 0; c < nch; ++c) {
        f32x4 nu0 = u0, nu1 = u1, nd0 = d0, nd1 = d1;
        if (c + 1 < nch) { const size_t e2 = e + 16384; nu0 = *(const f32x4*)(UT + e2); nu1 = *(const f32x4*)(UT + e2 + 4); nd0 = *(const f32x4*)(Dv + (size_t)(ubase + c + 1) * 128 + k0); nd1 = *(const f32x4*)(Dv + (size_t)(ubase + c + 1) * 128 + k0 + 4); }
        u32x4 o; o.x = pk2(S[0], S[1]); o.y = pk2(S[2], S[3]); o.z = pk2(S[4], S[5]); o.w = pk2(S[6], S[7]);
        *(u32x4*)(SpT + e) = o;
#pragma unroll
        for (int i = 0; i < 4; ++i) { S[i] = d0[i] * S[i] + u0[i]; S[4 + i] = d1[i] * S[4 + i] + u1[i]; }
        u0 = nu0; u1 = nu1; d0 = nd0; d1 = nd1; e += 16384;
    }
#pragma unroll
    for (int i = 0; i < 8; ++i) tl[(k0 + i) * 33 + vloc] = S[i];
    __syncthreads();
    float* o = (sample ? P.out + OUT_STS + ((size_t)l * 128 + sidx) * 16384 : P.out + OUT_STP + ((size_t)l * 64 + sidx) * 16384) + (size_t)kk * 128 + 32 * vq + vs;
    f32x4 a, b;
#pragma unroll
    for (int i = 0; i < 4; ++i) { a[i] = tl[kk * 33 + vs + i]; b[i] = tl[kk * 33 + vs + 4 + i]; }
    *(f32x4*)o = a; *(f32x4*)(o + 4) = b;
    __syncthreads();
}
DI void hgrn_pass3(LAS unsigned char* lds, const float* __restrict__ LF, const bf16_t* __restrict__ HQ, const bf16_t* __restrict__ HK, const bf16_t* __restrict__ HV, const bf16_t* __restrict__ HG,
                   const bf16_t* __restrict__ SpT, const float* __restrict__ gn, bf16_t* __restrict__ OH, int u, int tid) {
    LAS float* psum = (LAS float*)lds;
    LAS bf16_t* Qa = (LAS bf16_t*)(lds + 2048);
    LAS bf16_t* Qb = (LAS bf16_t*)(lds + 19456);
    LAS bf16_t* Ka = (LAS bf16_t*)(lds + 28160);
    LAS bf16_t* Kb = (LAS bf16_t*)(lds + 36864);
    LAS bf16_t* VTl = (LAS bf16_t*)(lds + 54272);
    LAS float* Ost = (LAS float*)(lds + 72704);
    const HUnit hu = hunit(u); const int k = tid & 127, tq = tid >> 7; const bool valid = 16 * tq < hu.nvalid;
    const size_t g0 = (size_t)(hu.rowbase + 16 * tq) * 2048 + hu.h * 128 + k;
    unsigned vw[8], qk[16];
#pragma unroll
    for (int i2 = 0; i2 < 8; ++i2) {
        unsigned vpair = 0u;
#pragma unroll
        for (int e = 0; e < 2; ++e) { const int i = 2 * i2 + e; unsigned q = 0u, kk = 0u, vv = 0u;
            if (valid) { q = HQ[g0 + (size_t)i * 2048]; kk = HK[g0 + (size_t)i * 2048]; vv = HV[g0 + (size_t)i * 2048]; }
            qk[i] = q | (kk << 16); vpair |= vv << (16 * e); }
        vw[i2] = vpair;
    }
    float b[16], b31, b63; hgrn_cumsum(LF, psum, hu, k, tq, b, b31, b63);
#pragma unroll
    for (int i = 0; i < 16; ++i) {
        const int t = 16 * tq + i; const float q = bflo(qk[i]), kk = bfhi(qk[i]);
        Qa[t * 136 + k] = f2bf(q * __expf(b[i]));
        if (tq >= 2) Qb[(t - 32) * 136 + k] = f2bf(q * __expf(b[i] - b31)); else Ka[t * 136 + k] = f2bf(kk * __expf(-b[i]));
        Kb[t * 136 + k] = f2bf(kk * __expf(b31 - b[i]));
    }
    { u32x4 a, c; a.x = vw[0]; a.y = vw[1]; a.z = vw[2]; a.w = vw[3]; c.x = vw[4]; c.y = vw[5]; c.z = vw[6]; c.w = vw[7];
      *(LAS u32x4*)(VTl + k * 72 + 16 * tq) = a; *(LAS u32x4*)(VTl + k * 72 + 16 * tq + 8) = c; }
    __syncthreads();
    const int wave = tid >> 6, lane = tid & 63, r = lane & 31, hh = lane >> 5, vb = wave & 3, tb = wave >> 2;
    f32x16 O = zero16();
    const LAS bf16_t* vrow = VTl + (32 * vb + r) * 72 + 4 * hh;
    if (tb == 0) {
        f32x16 A0 = zero16();
#pragma unroll
        for (int ks = 0; ks < 8; ++ks) { const bf16x8 a = *(const LAS bf16x8*)(Ka + r * 136 + 16 * ks + 8 * hh), q = *(const LAS bf16x8*)(Qa + r * 136 + 16 * ks + 8 * hh); A0 = MFMA32(a, q, A0); }
#pragma unroll
        for (int i = 0; i < 16; ++i) if (crow(i, hh) > r) A0[i] = 0.f;
        const bf16x8 p0 = pack8<0>(A0), p1 = pack8<1>(A0);
        { const s16x4 lo = *(const LAS s16x4*)(vrow), hi = *(const LAS s16x4*)(vrow + 8); O = MFMA32(__builtin_shufflevector(lo, hi, 0, 1, 2, 3, 4, 5, 6, 7), p0, O); }
        { const s16x4 lo = *(const LAS s16x4*)(vrow + 16), hi = *(const LAS s16x4*)(vrow + 24); O = MFMA32(__builtin_shufflevector(lo, hi, 0, 1, 2, 3, 4, 5, 6, 7), p1, O); }
    } else {
        f32x16 A0 = zero16(), A1 = zero16();
#pragma unroll
        for (int ks = 0; ks < 8; ++ks) { const bf16x8 q = *(const LAS bf16x8*)(Qb + r * 136 + 16 * ks + 8 * hh);
            const bf16x8 a0 = *(const LAS bf16x8*)(Kb + r * 136 + 16 * ks + 8 * hh), a1 = *(const LAS bf16x8*)(Kb + (32 + r) * 136 + 16 * ks + 8 * hh);
            A0 = MFMA32(a0, q, A0); A1 = MFMA32(a1, q, A1); }
#pragma unroll
        for (int i = 0; i < 16; ++i) if (crow(i, hh) > r) A1[i] = 0.f;
        const bf16x8 p0 = pack8<0>(A0), p1 = pack8<1>(A0), p2 = pack8<0>(A1), p3 = pack8<1>(A1);
        { const s16x4 lo = *(const LAS s16x4*)(vrow), hi = *(const LAS s16x4*)(vrow + 8); O = MFMA32(__builtin_shufflevector(lo, hi, 0, 1, 2, 3, 4, 5, 6, 7), p0, O); }
        { const s16x4 lo = *(const LAS s16x4*)(vrow + 16), hi = *(const LAS s16x4*)(vrow + 24); O = MFMA32(__builtin_shufflevector(lo, hi, 0, 1, 2, 3, 4, 5, 6, 7), p1, O); }
        { const s16x4 lo = *(const LAS s16x4*)(vrow + 32), hi = *(const LAS s16x4*)(vrow + 40); O = MFMA32(__builtin_shufflevector(lo, hi, 0, 1, 2, 3, 4, 5, 6, 7), p2, O); }
        { const s16x4 lo = *(const LAS s16x4*)(vrow + 48), hi = *(const LAS s16x4*)(vrow + 56); O = MFMA32(__builtin_shufflevector(lo, hi, 0, 1, 2, 3, 4, 5, 6, 7), p3, O); }
    }
    { const bf16_t* sp = SpT + ((size_t)u * 128 + 32 * vb + r) * 128 + 8 * hh;
#pragma unroll
      for (int ks = 0; ks < 8; ++ks) { const bf16x8 a = *(const bf16x8*)(sp + 16 * ks), q = *(const LAS bf16x8*)(Qa + (32 * tb + r) * 136 + 16 * ks + 8 * hh); O = MFMA32(a, q, O); } }
#pragma unroll
    for (int g = 0; g < 4; ++g) { f32x4 w; w[0] = O[4 * g]; w[1] = O[4 * g + 1]; w[2] = O[4 * g + 2]; w[3] = O[4 * g + 3]; *(LAS f32x4*)(Ost + (32 * tb + r) * 132 + 32 * vb + 8 * g + 4 * hh) = w; }
    __syncthreads();
    { const int t = tid >> 3, vs = (tid & 7) * 16;
      f32x4 x[4]; float ss = 0.f;
#pragma unroll
      for (int j = 0; j < 4; ++j) { x[j] = *(const LAS f32x4*)(Ost + t * 132 + vs + 4 * j); ss += x[j][0] * x[j][0] + x[j][1] * x[j][1] + x[j][2] * x[j][2] + x[j][3] * x[j][3]; }
      ss += shflx(ss, 1, lane); ss += shflx(ss, 2, lane); ss += shflx(ss, 4, lane);
      const float rs = rsqrtf(ss * (1.f / 128.f) + EPS);
      if (t < hu.nvalid) {
          const size_t off = (size_t)(hu.rowbase + t) * 2048 + hu.h * 128 + vs;
          const u32x4 ga = *(const u32x4*)(HG + off), gb = *(const u32x4*)(HG + off + 8);
          const f32x4 n0 = *(const f32x4*)(gn + vs), n1 = *(const f32x4*)(gn + vs + 4), n2 = *(const f32x4*)(gn + vs + 8), n3 = *(const f32x4*)(gn + vs + 12);
          u32x4 oa, ob;
          oa.x = pk2(x[0][0] * rs * n0[0] * bflo(ga.x), x[0][1] * rs * n0[1] * bfhi(ga.x)); oa.y = pk2(x[0][2] * rs * n0[2] * bflo(ga.y), x[0][3] * rs * n0[3] * bfhi(ga.y));
          oa.z = pk2(x[1][0] * rs * n1[0] * bflo(ga.z), x[1][1] * rs * n1[1] * bfhi(ga.z)); oa.w = pk2(x[1][2] * rs * n1[2] * bflo(ga.w), x[1][3] * rs * n1[3] * bfhi(ga.w));
          ob.x = pk2(x[2][0] * rs * n2[0] * bflo(gb.x), x[2][1] * rs * n2[1] * bfhi(gb.x)); ob.y = pk2(x[2][2] * rs * n2[2] * bflo(gb.y), x[2][3] * rs * n2[3] * bfhi(gb.y));
          ob.z = pk2(x[3][0] * rs * n3[0] * bflo(gb.z), x[3][1] * rs * n3[1] * bfhi(gb.z)); ob.w = pk2(x[3][2] * rs * n3[2] * bflo(gb.w), x[3][3] * rs * n3[3] * bfhi(gb.w));
          *(u32x4*)(OH + off) = oa; *(u32x4*)(OH + off + 8) = ob;
      } }
    __syncthreads();
}

template <bool SAMPLE>
DI void attn_wave(const bf16_t* __restrict__ Qp, const bf16_t* __restrict__ Kn, const bf16_t* __restrict__ Kp, const bf16_t* __restrict__ Vt, int t0, int t1, int tstep, int nkeys,
                  float& m, float& l, f32x16 (&O)[4], int r, int hh) {
    const int lane = r + 32 * hh;
    bf16x8 qf[12];
#pragma unroll
    for (int s = 0; s < 12; ++s) qf[s] = *(const bf16x8*)(Qp + (size_t)r * 3072 + 16 * s + 8 * hh);
    m = -INFINITY; l = 0.f;
#pragma unroll
    for (int vb = 0; vb < 4; ++vb) O[vb] = zero16();
    for (int t = t0; t < t1; t += tstep) {
        const bf16_t* kn = Kn + (size_t)(64 * t + r) * 2048 + 8 * hh; const bf16_t* kp = Kp + (size_t)(64 * t + r) * 64 + 8 * hh;
        f32x16 S0 = zero16(), S1 = zero16();
#pragma unroll
        for (int s = 0; s < 8; ++s) { const bf16x8 a0 = *(const bf16x8*)(kn + 16 * s), a1 = *(const bf16x8*)(kn + 32 * 2048 + 16 * s); S0 = MFMA32(a0, qf[s], S0); S1 = MFMA32(a1, qf[s], S1); }
#pragma unroll
        for (int s = 0; s < 4; ++s) { const bf16x8 a0 = *(const bf16x8*)(kp + 16 * s), a1 = *(const bf16x8*)(kp + 32 * 64 + 16 * s); S0 = MFMA32(a0, qf[8 + s], S0); S1 = MFMA32(a1, qf[8 + s], S1); }
        if (SAMPLE) { if (64 * t + 64 > nkeys) {
#pragma unroll
            for (int i = 0; i < 16; ++i) { if (64 * t + crow(i, hh) >= nkeys) S0[i] = -INFINITY; if (64 * t + 32 + crow(i, hh) >= nkeys) S1[i] = -INFINITY; } } }
        float mx = fmaxf(S0[0], S1[0]);
#pragma unroll
        for (int i = 1; i < 16; ++i) mx = fmaxf(mx, fmaxf(S0[i], S1[i]));
        mx = fmaxf(mx, shflx(mx, 32, lane));
        const float mn = fmaxf(m, mx), alpha = ex2(m - mn); m = mn;
        float ls = 0.f;
#pragma unroll
        for (int i = 0; i < 16; ++i) { S0[i] = ex2(S0[i] - mn); S1[i] = ex2(S1[i] - mn); ls += S0[i] + S1[i]; }
        l = l * alpha + ls;
#pragma unroll
        for (int vb = 0; vb < 4; ++vb) O[vb] = O[vb] * alpha;
        const bf16x8 p0 = pack8<0>(S0), p1 = pack8<1>(S0), p2 = pack8<0>(S1), p3 = pack8<1>(S1);
#pragma unroll
        for (int vb = 0; vb < 4; ++vb) {
            const bf16_t* vp = Vt + (size_t)(32 * vb + r) * KVR + 64 * t + 4 * hh;
            { const s16x4 lo = *(const s16x4*)(vp), hi = *(const s16x4*)(vp + 8); O[vb] = MFMA32(__builtin_shufflevector(lo, hi, 0, 1, 2, 3, 4, 5, 6, 7), p0, O[vb]); }
            { const s16x4 lo = *(const s16x4*)(vp + 16), hi = *(const s16x4*)(vp + 24); O[vb] = MFMA32(__builtin_shufflevector(lo, hi, 0, 1, 2, 3, 4, 5, 6, 7), p1, O[vb]); }
            { const s16x4 lo = *(const s16x4*)(vp + 32), hi = *(const s16x4*)(vp + 40); O[vb] = MFMA32(__builtin_shufflevector(lo, hi, 0, 1, 2, 3, 4, 5, 6, 7), p2, O[vb]); }
            { const s16x4 lo = *(const s16x4*)(vp + 48), hi = *(const s16x4*)(vp + 56); O[vb] = MFMA32(__builtin_shufflevector(lo, hi, 0, 1, 2, 3, 4, 5, 6, 7), p3, O[vb]); }
        }
    }
}
DI void attn_prompt_unit(const Params& P, int bh, int jq, int wave, int lane) {
    const bf16_t* Q = (const bf16_t*)(P.ws + WS_Q); const bf16_t* KN = (const bf16_t*)(P.ws + WS_KN); const bf16_t* KPE = (const bf16_t*)(P.ws + WS_KPE); const bf16_t* VT = (const bf16_t*)(P.ws + WS_VT);
    bf16_t* OA = (bf16_t*)(P.ws + WS_OA);
    const int b = bh >> 4, h = bh & 15, rb = 8 * jq + wave, row0 = b * 2048 + 32 * rb, kv0 = b * 2048, r = lane & 31, hh = lane >> 5;
    float m, l; f32x16 O[4];
    attn_wave<false>(Q + (size_t)row0 * 3072 + h * 192, KN + (size_t)kv0 * 2048 + h * 128, KPE + (size_t)kv0 * 64, VT + (size_t)(h * 128) * KVR + kv0, 0, (rb >> 1) + 1, 1, 0, m, l, O, r, hh);
    l += shflx(l, 32, lane); const float inv = 1.f / l;
#pragma unroll
    for (int vb = 0; vb < 4; ++vb)
#pragma unroll
        for (int g = 0; g < 4; ++g) { u32x2 w; w.x = pk2(O[vb][4 * g] * inv, O[vb][4 * g + 1] * inv); w.y = pk2(O[vb][4 * g + 2] * inv, O[vb][4 * g + 3] * inv);
            *(u32x2*)(OA + (size_t)(row0 + r) * 2048 + h * 128 + 32 * vb + 8 * g + 4 * hh) = w; }
}
constexpr int ATT_KB = 64 * 400, ATT_VB = 128 * 136, ATT_BUF = ATT_KB + ATT_VB;
DI void attn_prompt_lds(LAS unsigned char* lds, const Params& P, int bh, int jq, int wave, int lane, int tid) {
    const bf16_t* Q = (const bf16_t*)(P.ws + WS_Q); const bf16_t* KN = (const bf16_t*)(P.ws + WS_KN); const bf16_t* KPE = (const bf16_t*)(P.ws + WS_KPE); const bf16_t* VT = (const bf16_t*)(P.ws + WS_VT);
    bf16_t* OA = (bf16_t*)(P.ws + WS_OA);
    const int b = bh >> 4, h = bh & 15, rb = 8 * jq + wave, row0 = b * 2048 + 32 * rb, kv0 = b * 2048, r = lane & 31, hh = lane >> 5;
    const int ntiles = 4 * jq + 4, mytiles = (rb >> 1) + 1;
    const bf16_t* gk0 = KN + (size_t)(kv0 + (tid >> 4)) * 2048 + h * 128 + (tid & 15) * 8;
    const bf16_t* gkp = KPE + (size_t)(kv0 + (tid >> 3)) * 64 + (tid & 7) * 8;
    const bf16_t* gv0 = VT + (size_t)(h * 128 + (tid >> 3)) * KVR + kv0 + (tid & 7) * 8;
    const int lk0 = (tid >> 4) * 400 + (tid & 15) * 16, lkp = (tid >> 3) * 400 + 256 + (tid & 7) * 16, lv0 = ATT_KB + (tid >> 3) * 136 + (tid & 7) * 16;
    u32x4 sk0, sk1, skp, sv0, sv1;
#define ATT_LOAD(t) do { const size_t ko = (size_t)(64 * (t)) * 2048, po = (size_t)(64 * (t)) * 64, vo = (size_t)(64 * (t)); \
        sk0 = *(const u32x4*)(gk0 + ko); sk1 = *(const u32x4*)(gk0 + ko + 32 * 2048); skp = *(const u32x4*)(gkp + po); sv0 = *(const u32x4*)(gv0 + vo); sv1 = *(const u32x4*)(gv0 + vo + (size_t)64 * KVR); } while (0)
#define ATT_STORE(buf) do { LAS unsigned char* bb = lds + (buf) * ATT_BUF; \
        *(LAS u32x4*)(bb + lk0) = sk0; *(LAS u32x4*)(bb + lk0 + 32 * 400) = sk1; *(LAS u32x4*)(bb + lkp) = skp; \
        { u32x2 a_, b_; a_.x = sv0.x; a_.y = sv0.y; b_.x = sv0.z; b_.y = sv0.w; *(LAS u32x2*)(bb + lv0) = a_; *(LAS u32x2*)(bb + lv0 + 8) = b_; \
          a_.x = sv1.x; a_.y = sv1.y; b_.x = sv1.z; b_.y = sv1.w; *(LAS u32x2*)(bb + lv0 + 64 * 136) = a_; *(LAS u32x2*)(bb + lv0 + 64 * 136 + 8) = b_; } } while (0)
    ATT_LOAD(0);
    bf16x8 qf[12];
    { const bf16_t* Qp = Q + (size_t)row0 * 3072 + h * 192;
#pragma unroll
      for (int s = 0; s < 12; ++s) qf[s] = *(const bf16x8*)(Qp + (size_t)r * 3072 + 16 * s + 8 * hh); }
    float m = -INFINITY, l = 0.f; f32x16 O[4];
#pragma unroll
    for (int vb = 0; vb < 4; ++vb) O[vb] = zero16();
    ATT_STORE(0);
    __syncthreads();
    for (int t = 0; t < ntiles; ++t) {
        if (t + 1 < ntiles) ATT_LOAD(t + 1);
        if (t < mytiles) {
            const LAS unsigned char* kb_ = lds + (t & 1) * ATT_BUF; const LAS unsigned char* vb_ = kb_ + ATT_KB;
            const LAS bf16_t* kr = (const LAS bf16_t*)(kb_ + r * 400 + 16 * hh);
            f32x16 S0 = zero16(), S1 = zero16();
#pragma unroll
            for (int s = 0; s < 12; ++s) { const bf16x8 a0 = *(const LAS bf16x8*)(kr + 16 * s), a1 = *(const LAS bf16x8*)(kr + 32 * 200 + 16 * s); S0 = MFMA32(a0, qf[s], S0); S1 = MFMA32(a1, qf[s], S1); }
            float mx = fmaxf(S0[0], S1[0]);
#pragma unroll
            for (int i = 1; i < 16; ++i) mx = fmaxf(mx, fmaxf(S0[i], S1[i]));
            mx = fmaxf(mx, shflx(mx, 32, lane));
            const float mn = fmaxf(m, mx), alpha = ex2(m - mn); m = mn;
            float ls = 0.f;
#pragma unroll
            for (int i = 0; i < 16; ++i) { S0[i] = ex2(S0[i] - mn); S1[i] = ex2(S1[i] - mn); ls += S0[i] + S1[i]; }
            l = l * alpha + ls;
#pragma unroll
            for (int vb = 0; vb < 4; ++vb) O[vb] = O[vb] * alpha;
            const bf16x8 p0 = pack8<0>(S0), p1 = pack8<1>(S0), p2 = pack8<0>(S1), p3 = pack8<1>(S1);
#pragma unroll
            for (int vb = 0; vb < 4; ++vb) {
                const LAS bf16_t* vp = (const LAS bf16_t*)(vb_ + (32 * vb + r) * 136 + 8 * hh);
                { const s16x4 lo = *(const LAS s16x4*)(vp), hi = *(const LAS s16x4*)(vp + 8); O[vb] = MFMA32(__builtin_shufflevector(lo, hi, 0, 1, 2, 3, 4, 5, 6, 7), p0, O[vb]); }
                { const s16x4 lo = *(const LAS s16x4*)(vp + 16), hi = *(const LAS s16x4*)(vp + 24); O[vb] = MFMA32(__builtin_shufflevector(lo, hi, 0, 1, 2, 3, 4, 5, 6, 7), p1, O[vb]); }
                { const s16x4 lo = *(const LAS s16x4*)(vp + 32), hi = *(const LAS s16x4*)(vp + 40); O[vb] = MFMA32(__builtin_shufflevector(lo, hi, 0, 1, 2, 3, 4, 5, 6, 7), p2, O[vb]); }
                { const s16x4 lo = *(const LAS s16x4*)(vp + 48), hi = *(const LAS s16x4*)(vp + 56); O[vb] = MFMA32(__builtin_shufflevector(lo, hi, 0, 1, 2, 3, 4, 5, 6, 7), p3, O[vb]); }
            }
        }
        if (t + 1 < ntiles) ATT_STORE((t + 1) & 1);
        __syncthreads();
    }
#undef ATT_LOAD
#undef ATT_STORE
    l += shflx(l, 32, lane); const float inv = 1.f / l;
#pragma unroll
    for (int vb = 0; vb < 4; ++vb)
#pragma unroll
        for (int g = 0; g < 4; ++g) { u32x2 w; w.x = pk2(O[vb][4 * g] * inv, O[vb][4 * g + 1] * inv); w.y = pk2(O[vb][4 * g + 2] * inv, O[vb][4 * g + 3] * inv);
            *(u32x2*)(OA + (size_t)(row0 + r) * 2048 + h * 128 + 32 * vb + 8 * g + 4 * hh) = w; }
}
DI void attn_sample_unit(LAS unsigned char* lds, const Params& P, int su, int wave, int lane, int tid) {
    const bf16_t* Q = (const bf16_t*)(P.ws + WS_Q); const bf16_t* KN = (const bf16_t*)(P.ws + WS_KN); const bf16_t* KPE = (const bf16_t*)(P.ws + WS_KPE); const bf16_t* VT = (const bf16_t*)(P.ws + WS_VT);
    bf16_t* OA = (bf16_t*)(P.ws + WS_OA);
    const int b = su >> 4, h = su & 15, row0 = MP + b * 32, kv0 = MP + b * KVB, r = lane & 31, hh = lane >> 5;
    float m, l; f32x16 O[4];
    attn_wave<true>(Q + (size_t)row0 * 3072 + h * 192, KN + (size_t)kv0 * 2048 + h * 128, KPE + (size_t)kv0 * 64, VT + (size_t)(h * 128) * KVR + kv0, wave, 65, 8, 4128, m, l, O, r, hh);
    l += shflx(l, 32, lane);
    LAS float* ml = (LAS float*)(lds + 131072);
    if (hh == 0) { ml[(wave * 32 + r) * 2] = m; ml[(wave * 32 + r) * 2 + 1] = l; }
    __syncthreads();
    float ms = -INFINITY;
#pragma unroll
    for (int w = 0; w < 8; ++w) ms = fmaxf(ms, ml[(w * 32 + r) * 2]);
    float L = 0.f;
#pragma unroll
    for (int w = 0; w < 8; ++w) L += ml[(w * 32 + r) * 2 + 1] * ex2(ml[(w * 32 + r) * 2] - ms);
    const float sc = ex2(m - ms) / L;
    LAS float* slot = (LAS float*)(lds + wave * 16384);
#pragma unroll
    for (int vb = 0; vb < 4; ++vb)
#pragma unroll
        for (int i = 0; i < 16; ++i) slot[(32 * vb + crow(i, hh)) * 32 + r] = O[vb][i] * sc;
    __syncthreads();
    { const int q = tid & 31, vg = tid >> 5; float a[8];
#pragma unroll
      for (int e = 0; e < 8; ++e) { float s = 0.f;
#pragma unroll
          for (int w = 0; w < 8; ++w) s += ((const LAS float*)(lds + w * 16384))[(8 * vg + e) * 32 + q];
          a[e] = s; }
      u32x4 o; o.x = pk2(a[0], a[1]); o.y = pk2(a[2], a[3]); o.z = pk2(a[4], a[5]); o.w = pk2(a[6], a[7]);
      *(u32x4*)(OA + (size_t)(row0 + q) * 2048 + h * 128 + 8 * vg) = o; }
    __syncthreads();
}

#define XB_TMO      128
#define XB_XCNT(j)  (256  + 64 * (j))
#define XB_XSUB(j)  (1280 + 64 * (j))
#define XB_XGEN(j)  (2304 + 64 * (j))
#define XB_TOP      3328
#define XB_TOPGEN   3392
#define XCD_BAR_WORDS 3456
#define XB_SPIN_CAP (1u << 18)

__device__ __forceinline__ unsigned xb_ld(unsigned* p)              { return __hip_atomic_load(p, __ATOMIC_RELAXED, __HIP_MEMORY_SCOPE_AGENT); }
__device__ __forceinline__ unsigned xb_add(unsigned* p, unsigned v) { return __hip_atomic_fetch_add(p, v, __ATOMIC_RELAXED, __HIP_MEMORY_SCOPE_AGENT); }
__device__ __forceinline__ unsigned xb_xcc_id() { return (unsigned)__builtin_amdgcn_s_getreg((3 << 11) | 20) & 0xFu; }
#define XB_SPIN(cond, bar) do { unsigned _sp = 0; while (cond) { __builtin_amdgcn_s_sleep(1); \
    if ((++_sp & 255u) == 0u) { if (xb_ld(&(bar)[XB_TMO])) break; if (_sp > XB_SPIN_CAP) { atomicAdd(&(bar)[XB_TMO], 1u); break; } } } } while (0)

struct XcdBarrier {
    unsigned* bar; unsigned x;
    volatile LAS unsigned* st;
};

__device__ __forceinline__ XcdBarrier xcd_barrier_post(unsigned* bar, volatile LAS unsigned* st, bool t0) {
    XcdBarrier b; b.bar = bar; b.x = xb_xcc_id(); b.st = st;
    if (t0) (void)xb_add(&bar[XB_XCNT(b.x)], 1u);
    return b;
}
__device__ __forceinline__ void xcd_barrier_complete(unsigned* bar, unsigned x, unsigned& nloc, unsigned& nx) {
    const unsigned G = gridDim.x * gridDim.y * gridDim.z;
    unsigned sum, cnt, mine, sp = 0u;
    for (;;) {
        sum = 0u; cnt = 0u; mine = 0u;
#pragma unroll
        for (unsigned j = 0; j < 16; ++j) { const unsigned c = xb_ld(&bar[XB_XCNT(j)]); sum += c; cnt += (c > 0u) ? 1u : 0u; mine = (j == x) ? c : mine; }
        if (sum == G) break;
        __builtin_amdgcn_s_sleep(1);
        if ((++sp & 255u) == 0u) { if (xb_ld(&bar[XB_TMO])) break; if (sp > XB_SPIN_CAP) { atomicAdd(&bar[XB_TMO], 1u); break; } }
    }
    nloc = mine > 0u ? mine : 1u; nx = cnt > 0u ? cnt : 1u;
}

__device__ __forceinline__ void xcd_barrier(const XcdBarrier& b, bool t0) {
    asm volatile("s_waitcnt vmcnt(0)" ::: "memory");
    __syncthreads();
    if (t0) {
        unsigned* bar = b.bar;
        __builtin_amdgcn_s_waitcnt(0);
        unsigned nloc = b.st[0], nx = b.st[1];
        if (nloc == 0u) { xcd_barrier_complete(bar, b.x, nloc, nx); b.st[0] = nloc; b.st[1] = nx; }
        const unsigned old = xb_add(&bar[XB_XSUB(b.x)], 1u);
        const unsigned gen = old / nloc;
        if (old + 1u == (gen + 1u) * nloc) {
            __builtin_amdgcn_fence(__ATOMIC_RELEASE, "agent");
            asm volatile("s_waitcnt vmcnt(0)" ::: "memory");
            const unsigned og = xb_add(&bar[XB_TOP], 1u);
            const unsigned tg = og / nx;
            if (og + 1u == (tg + 1u) * nx) xb_add(&bar[XB_TOPGEN], 1u);
            else XB_SPIN(xb_ld(&bar[XB_TOPGEN]) == tg, bar);
            __builtin_amdgcn_fence(__ATOMIC_ACQUIRE, "agent");
            xb_add(&bar[XB_XGEN(b.x)], 1u);
            asm volatile("s_waitcnt vmcnt(0)" ::: "memory");
        } else {
            XB_SPIN(xb_ld(&bar[XB_XGEN(b.x)]) == gen, bar);
            __builtin_amdgcn_fence(__ATOMIC_ACQUIRE, "agent");
            asm volatile("s_waitcnt vmcnt(0)" ::: "memory");
        }
    }
    __syncthreads();
}

constexpr int LDS_BYTES = 147456;
template <class Epi> DI void run_gemm_(LAS unsigned char* lds, const bf16_t* A, const bf16_t* Bt, int M_, int N_, int K_, int G, int c, const Epi& E, int tid) {
    pg8::Gemm g{A, Bt, M_, N_, K_, K_}; pg8::StaticOrder S; S.init(M_, N_, G, c);
    pg8::gemm_phase<Epi, pg8::StaticOrder, true, true>(lds, g, S, E, tid);
}
DI void run_tail_(LAS unsigned char* lds, const bf16_t* A, const bf16_t* Bt, int N_, int K_, int KS, float* slab, int G, int c, int tid) {
    pg8::Gemm g{A, Bt, MTOK, N_, K_, K_ / KS}; pg8::TailOrder S{MP / 256, N_ / 256, KS, K_ / KS, G, c}; pg8::EpiSlab E{slab, N_, K_ / KS};
    pg8::gemm_phase<pg8::EpiSlab, pg8::TailOrder, true, true>(lds, g, S, E, tid);
}

#define run_gemm(...) run_gemm_(__VA_ARGS__, tid)
#define run_tail(...) run_tail_(__VA_ARGS__, tid)
typedef const __attribute__((address_space(4))) Params CParams;
#define PHASE_BEGIN \
    Params P; { CParams* pp_ = (CParams*)__builtin_amdgcn_kernarg_segment_ptr(); asm volatile("" : "+s"(pp_)); _Pragma("unroll") for (int i_ = 0; i_ < 22; ++i_) P.in[i_] = pp_->in[i_]; P.out = pp_->out; P.ws = pp_->ws; } \
    int lane_l; asm volatile("v_mbcnt_lo_u32_b32 %0, -1, 0\n\tv_mbcnt_hi_u32_b32 %0, -1, %0" : "=v"(lane_l)); int wave_l = wave_s; asm volatile("" : "+s"(wave_l)); \
    const int tid = wave_l * 64 + lane_l; int G = gridDim.x, bx = blockIdx.x; asm volatile("" : "+s"(G), "+s"(bx)); \
    const int lane = lane_l, wave = wave_l; \
    const int vcu = (G % 8 == 0) ? (bx % 8) * (G / 8) + bx / 8 : bx;       \
    const int gw = vcu * 8 + wave, NGW = G * 8, gt = bx * 512 + tid, NGT = G * 512; \
    unsigned char* ws = P.ws; (void)lane; (void)gw; (void)NGW; (void)gt; (void)NGT; (void)ws;

__global__ void __launch_bounds__(512, 2) fwd_kernel(Params Pk) {
    extern __shared__ __attribute__((aligned(16))) unsigned char lds_raw[];
    LAS unsigned char* lds = (LAS unsigned char*)lds_raw;
    cg::grid_group grid = cg::this_grid();
    const int wave_s = __builtin_amdgcn_readfirstlane((int)threadIdx.x >> 6);
#ifndef PROBE
#define PROBE 0
#endif
#define GSYNC() do { for (int rs_ = 0; rs_ < ((PROBE & 4) ? 2 : 1); ++rs_) { XcdBarrier xb_ = xbar; asm volatile("" : "+s"(xb_.bar)); int ln_; asm volatile("v_mbcnt_lo_u32_b32 %0, -1, 0\n\tv_mbcnt_hi_u32_b32 %0, -1, %0" : "=v"(ln_)); xcd_barrier(xb_, wave_s == 0 && ln_ == 0); } } while (0)
    const int tid0_ = threadIdx.x;
    if (tid0_ < 64) ((LAS unsigned*)(lds + 131072 + 8192))[tid0_] = 0u;
    __syncthreads();
    XcdBarrier xbar = xcd_barrier_post((unsigned*)(Pk.ws + WS_CTL), (volatile LAS unsigned*)(lds + 131072 + 8192), tid0_ == 0);
    { PHASE_BEGIN
      for (int rep = 0; rep < ((PROBE & 8) ? 2 : 1); ++rep) {
      layer_prep(P, lds, 0, gw, NGW, gt, NGT, lane, wave);
      rope_table(P, gt, NGT);
      init_x(P, gw, NGW, lane); } }
    __threadfence(); grid.sync(); __threadfence();
    for (int l = 0; l < 2; ++l) {
        { PHASE_BEGIN
          pg8::EpiWin E{(float*)(ws + WS_ZS), (bf16_t*)(ws + WS_HQ), (bf16_t*)(ws + WS_HK), (bf16_t*)(ws + WS_HV), (bf16_t*)(ws + WS_HG), (bf16_t*)(ws + WS_GA), (bf16_t*)(ws + WS_GB), (float*)(ws + WS_LF), (const float*)(ws + WS_LB)};
          run_gemm(lds, (const bf16_t*)(ws + WS_XN), (const bf16_t*)(ws + WS_WIN), MTOK, DINP, 2048, G, bx, E); }
        GSYNC();
        { PHASE_BEGIN
          for (int rep = 0; rep < ((PROBE & 8) ? 2 : 1); ++rep) small_norms(P, l, gw, NGW, lane);
          for (int rep = 0; rep < ((PROBE & 2) ? 2 : 1); ++rep)
          for (int u = vcu; u < NU; u += G) hgrn_pass1(lds, (const float*)(ws + WS_LF), (const bf16_t*)(ws + WS_HK), (const bf16_t*)(ws + WS_HV), (float*)(ws + WS_UT), (float*)(ws + WS_D), u, tid); }
        GSYNC();
        { PHASE_BEGIN
          for (int rep = 0; rep < ((PROBE & 2) ? 2 : 1); ++rep)
          for (int x = vcu; x < 768; x += G) hgrn_pass2(lds, P, l, x, tid); }
        GSYNC();
        { PHASE_BEGIN
          for (int rep = 0; rep < ((PROBE & 2) ? 2 : 1); ++rep)
          for (int u = vcu; u < NU; u += G) hgrn_pass3(lds, (const float*)(ws + WS_LF), (const bf16_t*)(ws + WS_HQ), (const bf16_t*)(ws + WS_HK), (const bf16_t*)(ws + WS_HV), (const bf16_t*)(ws + WS_HG),
                                                       (const bf16_t*)(ws + WS_SPT), P.in[14] + l * 128, (bf16_t*)(ws + WS_OH), u, tid); }
        GSYNC();
        { PHASE_BEGIN
          pg8::EpiQ E{(bf16_t*)(ws + WS_Q), (const float*)(ws + WS_TBL)}; run_gemm(lds, (const bf16_t*)(ws + WS_QN), (const bf16_t*)(ws + WS_WUQ), MTOK, 3072, 512, G, bx, E); }
        { PHASE_BEGIN
          pg8::EpiPlain E{(bf16_t*)(ws + WS_KN), 2048}; run_gemm(lds, (const bf16_t*)(ws + WS_CKV), (const bf16_t*)(ws + WS_WUK), KVR, 2048, 512, G, bx, E); }
        { PHASE_BEGIN
          pg8::EpiPlain E{(bf16_t*)(ws + WS_VT), KVR}; run_gemm(lds, (const bf16_t*)(ws + WS_WUV), (const bf16_t*)(ws + WS_CKV), 2048, KVR, 512, G, (bx + G / 2) % G, E); }
        GSYNC();
        { PHASE_BEGIN
          for (int rep = 0; rep < ((PROBE & 1) ? 2 : 1); ++rep) {
          for (int x = vcu; x < 256; x += G) { const int bh = x & 63, grp = x >> 6;
              const int code = grp == 0 ? 0x41 : grp == 1 ? 0x032 : grp == 2 ? 0x1273 : 0x562;
              if (grp < 2) attn_sample_unit(lds, P, x, wave, lane, tid);
              for (int i = 0; i < (code & 15); ++i) attn_prompt_lds(lds, P, bh, (code >> (4 + 4 * i)) & 15, wave, lane, tid); } } }
        GSYNC();
        { PHASE_BEGIN
          pg8::EpiGate<false> E{(const bf16_t*)(ws + WS_GA), (bf16_t*)(ws + WS_T)}; run_gemm(lds, (const bf16_t*)(ws + WS_OA), (const bf16_t*)(ws + WS_WOA), MP, 2048, 2048, G, bx, E); }
        { PHASE_BEGIN
          run_tail(lds, (const bf16_t*)(ws + WS_OA), (const bf16_t*)(ws + WS_WOA), 2048, 2048, 16, (float*)(ws + WS_SLAB0), G, bx); }
        { PHASE_BEGIN
          pg8::EpiGate<true> E{(const bf16_t*)(ws + WS_GB), (bf16_t*)(ws + WS_T)}; run_gemm(lds, (const bf16_t*)(ws + WS_OH), (const bf16_t*)(ws + WS_WOB), MP, 2048, 2048, G, bx, E); }
        { PHASE_BEGIN
          run_tail(lds, (const bf16_t*)(ws + WS_OH), (const bf16_t*)(ws + WS_WOB), 2048, 2048, 16, (float*)(ws + WS_SLAB1), G, (bx + G / 2) % G); }
        GSYNC();
        { PHASE_BEGIN
          for (int x = vcu; x < 64; x += G) { const int pn = x >> 3, mk = 1 << (x & 7);
              { pg8::EpiGate<false> E{(const bf16_t*)(ws + WS_GA), (bf16_t*)(ws + WS_T)}; pg8::tail_fixup(( const float*)(ws + WS_SLAB0), 16, 2048, MP / 256, pn, mk, E, tid); }
              { pg8::EpiGate<true> E{(const bf16_t*)(ws + WS_GB), (bf16_t*)(ws + WS_T)}; pg8::tail_fixup((const float*)(ws + WS_SLAB1), 16, 2048, MP / 256, pn, mk, E, tid); } } }
        GSYNC();
        for (int repI = 0; repI < ((PROBE & 32) ? 2 : 1); ++repI) {
        { PHASE_BEGIN
          pg8::EpiF32 E{(float*)(ws + WS_MIX), 2048}; run_gemm(lds, (const bf16_t*)(ws + WS_T), (const bf16_t*)(ws + WS_WOUT), MP, 2048, 2048, G, bx, E); }
        { PHASE_BEGIN
          run_tail(lds, (const bf16_t*)(ws + WS_T), (const bf16_t*)(ws + WS_WOUT), 2048, 2048, 16, (float*)(ws + WS_SLAB0), G, bx); }
        GSYNC();
        { PHASE_BEGIN
          for (int x = vcu; x < 64; x += G) { pg8::EpiF32 E{(float*)(ws + WS_MIX), 2048}; pg8::tail_fixup((const float*)(ws + WS_SLAB0), 16, 2048, MP / 256, x >> 3, 1 << (x & 7), E, tid); } }
        GSYNC();
        }
        { PHASE_BEGIN
          resid_norm((const float*)(ws + WS_MIX), P.in[17] + l * 2048, P.out, P.in[18] + l * 2048, (bf16_t*)(ws + WS_XN), gw, NGW, lane); }
        GSYNC();
        for (int repK = 0; repK < ((PROBE & 16) ? 2 : 1); ++repK) {
        { PHASE_BEGIN
          pg8::EpiRelu2 E{(bf16_t*)(ws + WS_H), FFN}; run_gemm(lds, (const bf16_t*)(ws + WS_XN), (const bf16_t*)(ws + WS_WUP), MP, FFN, 2048, G, bx, E); }
        { PHASE_BEGIN
          run_tail(lds, (const bf16_t*)(ws + WS_XN), (const bf16_t*)(ws + WS_WUP), FFN, 2048, 4, (float*)(ws + WS_SLAB0), G, bx); }
        GSYNC();
        { PHASE_BEGIN
          for (int x = vcu; x < 256; x += G) { pg8::EpiRelu2 E{(bf16_t*)(ws + WS_H), FFN}; pg8::tail_fixup((const float*)(ws + WS_SLAB0), 4, FFN, MP / 256, x >> 3, 1 << (x & 7), E, tid); } }
        GSYNC();
        }
        { PHASE_BEGIN
          pg8::EpiF32 E{(float*)(ws + WS_M2), 2048}; run_gemm(lds, (const bf16_t*)(ws + WS_H), (const bf16_t*)(ws + WS_WDN), MP, 2048, FFN, G, bx, E); }
        { PHASE_BEGIN
          run_tail(lds, (const bf16_t*)(ws + WS_H), (const bf16_t*)(ws + WS_WDN), 2048, FFN, 16, (float*)(ws + WS_SLAB0), G, bx); }
        GSYNC();
        { PHASE_BEGIN
          for (int x = vcu; x < 64; x += G) { pg8::EpiF32 E{(float*)(ws + WS_M2), 2048}; pg8::tail_fixup((const float*)(ws + WS_SLAB0), 16, 2048, MP / 256, x >> 3, 1 << (x & 7), E, tid); } }
        GSYNC();
        { PHASE_BEGIN
          resid_norm((const float*)(ws + WS_M2), P.in[21] + l * 2048, P.out, l == 0 ? P.in[5] + 2048 : nullptr, (bf16_t*)(ws + WS_XN), gw, NGW, lane);
          if (l == 0) for (int rep = 0; rep < ((PROBE & 8) ? 2 : 1); ++rep) layer_prep(P, lds, 1, gw, NGW, gt, NGT, lane, wave); }
        if (l == 0) GSYNC();
    }
}

extern "C" void kernel_launch(void* const* d_in, const int* in_sizes, int n_in, void* d_out, int out_size, void* d_ws, size_t ws_size, hipStream_t stream) {
    static int grid = 0;
    if (grid == 0) {
        if (n_in != 22 || (size_t)out_size != OUT_TOTAL || ws_size < WS_END) { fprintf(stderr, "kernel_launch: unexpected shapes (n_in %d, out %d, ws %zu, need %zu)\n", n_in, out_size, ws_size, (size_t)WS_END); grid = -1; return; }
        int dev = 0, cus = 0, per_cu = 0;
        if (hipGetDevice(&dev) != hipSuccess || hipDeviceGetAttribute(&cus, hipDeviceAttributeMultiprocessorCount, dev) != hipSuccess) { grid = -1; return; }
        if (hipFuncSetAttribute((const void*)fwd_kernel, hipFuncAttributeMaxDynamicSharedMemorySize, LDS_BYTES) != hipSuccess) { fprintf(stderr, "kernel_launch: hipFuncSetAttribute failed\n"); grid = -1; return; }
        if (hipOccupancyMaxActiveBlocksPerMultiprocessor(&per_cu, (const void*)fwd_kernel, 512, LDS_BYTES) != hipSuccess || per_cu < 1) { fprintf(stderr, "kernel_launch: occupancy query failed (%d)\n", per_cu); per_cu = 1; }
        (void)hipGetLastError();
        grid = cus * per_cu;
    }
    if (grid < 0) return;
    if (hipMemsetAsync((char*)d_ws + WS_CTL, 0, 16384, stream) != hipSuccess) { fprintf(stderr, "kernel_launch: memset failed\n"); return; }
    Params p{};
    for (int i = 0; i < 22; ++i) p.in[i] = (const float*)d_in[i];
    p.out = (float*)d_out; p.ws = (unsigned char*)d_ws;
    void* args[] = {&p};
    hipError_t e = hipLaunchCooperativeKernel((const void*)fwd_kernel, dim3(grid), dim3(512), args, LDS_BYTES, stream);
    if (e != hipSuccess) fprintf(stderr, "kernel_launch: cooperative launch failed: %s (grid %d)\n", hipGetErrorString(e), grid);
}
```

```cpp
#include <hip/hip_runtime.h>
#include <hip/hip_cooperative_groups.h>
#include <cstdio>
#include <cstdint>
namespace cg = cooperative_groups;

#define DI __device__ __forceinline__
#define LAS __attribute__((address_space(3)))
typedef short bf16x8 __attribute__((ext_vector_type(8)));
typedef short s16x4 __attribute__((ext_vector_type(4)));
typedef float f32x4 __attribute__((ext_vector_type(4)));
typedef float f32x16 __attribute__((ext_vector_type(16)));
typedef unsigned u32x4 __attribute__((ext_vector_type(4)));
typedef unsigned u32x2 __attribute__((ext_vector_type(2)));
typedef float f32x2_t __attribute__((ext_vector_type(2)));
typedef __bf16 bf16x2_t __attribute__((ext_vector_type(2)));

constexpr int MP = 8192, MS = 256, MTOK = 8448, DM = 2048, DINP = 13568, ZSW = 1280, FFN = 8192;
constexpr int KVB = 4160;
constexpr int KVR = 8192 + 8 * KVB;
constexpr int NU = 2048 + 128;
constexpr float EPS = 1e-6f;
constexpr float QSCALE = 0.07216878364870322f * 1.4426950408889634f;

constexpr size_t MiB = 1u << 20;
constexpr size_t WS_WIN = 0, WS_WUQ = 53 * MiB, WS_WUK = 56 * MiB, WS_WUV = 58 * MiB, WS_WOA = 60 * MiB, WS_WOB = 68 * MiB, WS_WOUT = 76 * MiB, WS_WUP = 84 * MiB, WS_WDN = 116 * MiB;
constexpr size_t WS_XN = 148 * MiB, WS_HG = 181 * MiB, WS_GA = 214 * MiB, WS_GB = 247 * MiB, WS_QN = 280 * MiB, WS_Q = 289 * MiB, WS_OA = 339 * MiB, WS_OH = 372 * MiB;
constexpr size_t WS_CKV = 405 * MiB, WS_KPE = 446 * MiB, WS_TBL = 452 * MiB, WS_LB = 453 * MiB, WS_D = 454 * MiB, WS_R = 456 * MiB;
constexpr size_t WS_SPT = WS_Q;
constexpr size_t WS_ZS = WS_R, WS_HQ = WS_R + 42 * MiB, WS_HK = WS_R + 75 * MiB, WS_HV = WS_R + 108 * MiB, WS_LF = WS_R + 141 * MiB, WS_UT = WS_R + 207 * MiB;
constexpr size_t WS_KN = WS_R, WS_VT = WS_R + 162 * MiB;
constexpr size_t WS_T = WS_R, WS_MIX = WS_R + 33 * MiB, WS_H = WS_R + 99 * MiB, WS_M2 = WS_R + 231 * MiB;
constexpr size_t WS_SLAB0 = WS_Q, WS_SLAB1 = WS_R + 297 * MiB;
constexpr size_t WS_CTL = WS_R + 343 * MiB;
constexpr size_t WS_END = WS_CTL + 1 * MiB;
static_assert((size_t)NU * 128 * 128 * 2 <= 83 * MiB && (size_t)NU * 65536 <= 136 * MiB && (size_t)KVR * 2048 * 2 <= 162 * MiB, "ws map");

constexpr size_t OUT_X = 0, OUT_CKVP = 17301504, OUT_KPEP = OUT_CKVP + 8388608, OUT_STP = OUT_KPEP + 1048576, OUT_CKVS = OUT_STP + 2097152, OUT_KPES = OUT_CKVS + 262144, OUT_STS = OUT_KPES + 32768;
constexpr size_t OUT_TOTAL = OUT_STS + 4194304;

DI unsigned pk2(float lo, float hi) { f32x2_t v = {lo, hi}; bf16x2_t b = __builtin_convertvector(v, bf16x2_t); return __builtin_bit_cast(unsigned, b); }
DI unsigned short f2bf(float f) { return (unsigned short)(pk2(f, 0.f) & 0xffffu); }
DI float bf2f(unsigned short u) { return __uint_as_float((unsigned)u << 16); }
DI float bflo(unsigned w) { return __uint_as_float(w << 16); }
DI float bfhi(unsigned w) { return __uint_as_float(w & 0xffff0000u); }
DI float sigm(float x) { return 1.f / (1.f + __expf(-x)); }
DI float ex2(float x) { return __builtin_amdgcn_exp2f(x); }
DI float shflx(float v, int mask, int lane) { return __int_as_float(__builtin_amdgcn_ds_bpermute((lane ^ mask) << 2, __float_as_int(v))); }
DI float wave_sum(float v, int lane) {
#pragma unroll
    for (int o = 1; o < 64; o <<= 1) v += shflx(v, o, lane);
    return v;
}
namespace pg8 {
#define PG8_LAS __attribute__((address_space(3)))
typedef unsigned short bf16_t;
typedef short bf16x8 __attribute__((ext_vector_type(8)));
typedef float f32x4 __attribute__((ext_vector_type(4)));
typedef unsigned u32x4 __attribute__((ext_vector_type(4)));
constexpr int BM = 256, BK = 64, HALF = 128, HTB = HALF * BK * 2  , STAGE_BYTES = 8 * HTB, NXCD = 8, WGM = 8;

__host__ __device__ __forceinline__ int lds_byte(int r, int c) { const int st = (r >> 4) * 2 + (c >> 5), rr = r & 15, cc = c & 31, ob = rr * 64 + cc * 2; return st * 1024 + (ob ^ (((ob >> 9) & 1) << 5)); }
__host__ __device__ __forceinline__ void stage_rc(int b, int& R, int& C) { const int st = b / 1024, sb = b % 1024, swz = sb ^ (((sb >> 9) & 1) << 5); R = (st >> 1) * 16 + swz / 64; C = (st & 1) * 32 + (swz % 64) / 2; }
__host__ __device__ __forceinline__ int perm32(int rho) { const int n = rho >> 4, i = rho & 15; return 8 * (i >> 2) + 4 * n + (i & 3); }

struct Unit { int pm, pn, koff, mask; };
struct Gemm { const bf16_t* A; const bf16_t* Bt; int M, N, K, kext; };

struct StaticOrder {
    int nM, nN, nwg, G, c;
    __host__ __device__ void init(int M, int N, int G_, int c_) { nM = M / BM; nN = N / BM; nwg = nM * nN; G = G_; c = c_; }
    __host__ __device__ bool next(int i, Unit& u) const {
        const long L = (long)i * G + c; if (L >= nwg) return false;
        int wgid = (int)L; { const int q = nwg / NXCD, r = nwg % NXCD, xcd = wgid % NXCD, off = wgid / NXCD; wgid = (xcd < r ? xcd * (q + 1) : r * (q + 1) + (xcd - r) * q) + off; }
        const int nig = WGM * nN, gid = wgid / nig, fm = gid * WGM, gsz = (nM - fm) < WGM ? (nM - fm) : WGM;
        u.pm = fm + ((wgid % nig) % gsz); u.pn = (wgid % nig) / gsz; u.koff = 0; u.mask = 0xff; return true;
    }
    __device__ __forceinline__ void a_ready(const Unit&) const {}
    __device__ __forceinline__ void done(const Unit&) const {}
};

struct TailOrder {
    int pm, nN, KS, kext, G, c;
    __host__ __device__ bool next(int i, Unit& u) const { const int L = i * G + c; if (L >= nN * KS) return false; u.pm = pm; u.pn = L / KS; u.koff = (L - u.pn * KS) * kext; u.mask = 0xff; return true; }
    __device__ __forceinline__ void a_ready(const Unit&) const {}
    __device__ __forceinline__ void done(const Unit&) const {}
};
#define EPI_LOOP _Pragma("unroll") for (int ai = 0; ai < 2; ++ai) _Pragma("unroll") for (int m = 0; m < 4; ++m) if ((u.mask >> (ai * 4 + m)) & 1) _Pragma("unroll") for (int bj = 0; bj < 2; ++bj)
__device__ __forceinline__ u32x4 pack8f(const f32x4 a, const f32x4 b) { u32x4 w; w.x = pk2(a[0], a[1]); w.y = pk2(a[2], a[3]); w.z = pk2(b[0], b[1]); w.w = pk2(b[2], b[3]); return w; }

struct EpiWin {
    static constexpr bool PERM = true, AFTER_DRAIN = false;
    float* Zs; bf16_t *HQ, *HK, *HV, *HG, *GA, *GB; float* LF; const float* lb;
    __device__ __forceinline__ void operator()(const f32x4 (&acc)[2][2][4][2], const Unit& u, int wr, int wc, int fr, int fq) const {
        const int row0 = u.pm * 256 + wr * 64 + fr, ct = wc * 32 + 8 * fq, pn = u.pn;
        if (pn < 5) {
            EPI_LOOP { float* p = Zs + (size_t)(row0 + ai * 128 + m * 16) * ZSW + pn * 256 + ct + bj * 128; *(f32x4*)p = acc[ai][bj][m][0]; *(f32x4*)(p + 4) = acc[ai][bj][m][1]; }
            return;
        }
        const int seg = (pn - 5) >> 3, cseg = ((pn - 5) & 7) * 256 + ct;
        if (seg == 1) {
#pragma unroll
            for (int bj = 0; bj < 2; ++bj) {
                const f32x4 l0 = *(const f32x4*)(lb + cseg + bj * 128), l1 = *(const f32x4*)(lb + cseg + bj * 128 + 4);
#pragma unroll
                for (int ai = 0; ai < 2; ++ai)
#pragma unroll
                    for (int m = 0; m < 4; ++m) {
                        const size_t off = (size_t)(row0 + ai * 128 + m * 16) * 2048 + cseg + bj * 128;
                        f32x4 lf0, lf1, k0, k1;
#pragma unroll
                        for (int e = 0; e < 4; ++e) {
                            { const float z = acc[ai][bj][m][0][e], lbv = l0[e], ez = __expf(-z), sg = 1.f / (1.f + ez); lf0[e] = __logf(lbv + (1.f - lbv) * sg); k0[e] = (1.f - lbv) * ez * sg; }
                            { const float z = acc[ai][bj][m][1][e], lbv = l1[e], ez = __expf(-z), sg = 1.f / (1.f + ez); lf1[e] = __logf(lbv + (1.f - lbv) * sg); k1[e] = (1.f - lbv) * ez * sg; }
                        }
                        *(f32x4*)(LF + off) = lf0; *(f32x4*)(LF + off + 4) = lf1; *(u32x4*)(HK + off) = pack8f(k0, k1);
                    }
            }
            return;
        }
        bf16_t* O = seg == 0 ? HQ : seg == 2 ? HV : seg == 3 ? HG : seg == 4 ? GA : GB;
        const int act = (seg == 0 || seg == 3) ? 1 : (seg == 2 ? 0 : 2);
        EPI_LOOP {
            f32x4 a = acc[ai][bj][m][0], b = acc[ai][bj][m][1];
#pragma unroll
            for (int e = 0; e < 4; ++e) { const float sa = sigm(a[e]), sb = sigm(b[e]); a[e] = act == 0 ? a[e] : act == 1 ? a[e] * sa : sa; b[e] = act == 0 ? b[e] : act == 1 ? b[e] * sb : sb; }
            *(u32x4*)(O + (size_t)(row0 + ai * 128 + m * 16) * 2048 + cseg + bj * 128) = pack8f(a, b);
        }
    }
};

struct EpiQ {
    static constexpr bool PERM = true, AFTER_DRAIN = false;
    bf16_t* Q; const float* tbl;
    __device__ __forceinline__ void operator()(const f32x4 (&acc)[2][2][4][2], const Unit& u, int wr, int wc, int fr, int fq) const {
        const int row0 = u.pm * 256 + wr * 64 + fr, ct = wc * 32 + 8 * fq, pn = u.pn;
        if (pn < 8) {
            EPI_LOOP { const int col = pn * 256 + ct + bj * 128, h = col >> 7, i = col & 127;
                *(u32x4*)(Q + (size_t)(row0 + ai * 128 + m * 16) * 3072 + h * 192 + i) = pack8f(acc[ai][bj][m][0] * QSCALE, acc[ai][bj][m][1] * QSCALE); }
            return;
        }
        EPI_LOOP {
            const int row = row0 + ai * 128 + m * 16, p = row < MP ? (row & 2047) : 2048 + ((row - MP) & 31);
            const int c = (pn - 8) * 256 + ct + bj * 128, h = c >> 6, j0 = (c & 63) >> 1;
            const f32x4 t0 = *(const f32x4*)(tbl + (size_t)(p * 32 + j0) * 2), t1 = *(const f32x4*)(tbl + (size_t)(p * 32 + j0) * 2 + 4);
            const f32x4 x = acc[ai][bj][m][0] * QSCALE, y = acc[ai][bj][m][1] * QSCALE;
            const float a0 = x[0] * t0[0] - x[1] * t0[1], b0 = x[0] * t0[1] + x[1] * t0[0];
            const float a1 = x[2] * t0[2] - x[3] * t0[3], b1 = x[2] * t0[3] + x[3] * t0[2];
            const float a2 = y[0] * t1[0] - y[1] * t1[1], b2 = y[0] * t1[1] + y[1] * t1[0];
            const float a3 = y[2] * t1[2] - y[3] * t1[3], b3 = y[2] * t1[3] + y[3] * t1[2];
            bf16_t* q = Q + (size_t)row * 3072 + h * 192 + 128 + j0;
            u32x2 w1, w2; w1.x = pk2(a0, a1); w1.y = pk2(a2, a3); w2.x = pk2(b0, b1); w2.y = pk2(b2, b3);
            *(u32x2*)q = w1; *(u32x2*)(q + 32) = w2;
            if (bj == 1) asm volatile("" ::: "memory");
        }
    }
};

struct EpiPlain {
    static constexpr bool PERM = true, AFTER_DRAIN = false;
    bf16_t* O; int ldc;
    __device__ __forceinline__ void operator()(const f32x4 (&acc)[2][2][4][2], const Unit& u, int wr, int wc, int fr, int fq) const {
        const int row0 = u.pm * 256 + wr * 64 + fr, c0 = u.pn * 256 + wc * 32 + 8 * fq;
        EPI_LOOP { *(u32x4*)(O + (size_t)(row0 + ai * 128 + m * 16) * ldc + c0 + bj * 128) = pack8f(acc[ai][bj][m][0], acc[ai][bj][m][1]); }
    }
};
struct EpiF32 {
    static constexpr bool PERM = true, AFTER_DRAIN = false;
    float* O; int ldc;
    __device__ __forceinline__ void operator()(const f32x4 (&acc)[2][2][4][2], const Unit& u, int wr, int wc, int fr, int fq) const {
        const int row0 = u.pm * 256 + wr * 64 + fr, c0 = u.pn * 256 + wc * 32 + 8 * fq;
        EPI_LOOP { float* p = O + (size_t)(row0 + ai * 128 + m * 16) * ldc + c0 + bj * 128; *(f32x4*)p = acc[ai][bj][m][0]; *(f32x4*)(p + 4) = acc[ai][bj][m][1]; }
    }
};
struct EpiRelu2 {
    static constexpr bool PERM = true, AFTER_DRAIN = false;
    bf16_t* O; int ldc;
    __device__ __forceinline__ void operator()(const f32x4 (&acc)[2][2][4][2], const Unit& u, int wr, int wc, int fr, int fq) const {
        const int row0 = u.pm * 256 + wr * 64 + fr, c0 = u.pn * 256 + wc * 32 + 8 * fq;
        EPI_LOOP { f32x4 a = acc[ai][bj][m][0], b = acc[ai][bj][m][1];
#pragma unroll
            for (int e = 0; e < 4; ++e) { const float ra = fmaxf(a[e], 0.f), rb = fmaxf(b[e], 0.f); a[e] = ra * ra; b[e] = rb * rb; }
            *(u32x4*)(O + (size_t)(row0 + ai * 128 + m * 16) * ldc + c0 + bj * 128) = pack8f(a, b); }
    }
};
template <bool SECOND> struct EpiGate {
    static constexpr bool PERM = true, AFTER_DRAIN = false;
    const bf16_t* Gt; bf16_t* T;
    __device__ __forceinline__ void operator()(const f32x4 (&acc)[2][2][4][2], const Unit& u, int wr, int wc, int fr, int fq) const {
        const int row0 = u.pm * 256 + wr * 64 + fr, c0 = u.pn * 256 + wc * 32 + 8 * fq;
        EPI_LOOP { const size_t off = (size_t)(row0 + ai * 128 + m * 16) * 2048 + c0 + bj * 128;
            const u32x4 g = *(const u32x4*)(Gt + off); f32x4 a = acc[ai][bj][m][0], b = acc[ai][bj][m][1];
            a[0] *= bflo(g.x); a[1] *= bfhi(g.x); a[2] *= bflo(g.y); a[3] *= bfhi(g.y); b[0] *= bflo(g.z); b[1] *= bfhi(g.z); b[2] *= bflo(g.w); b[3] *= bfhi(g.w);
            if (SECOND) { const u32x4 t = *(const u32x4*)(T + off);
                a[0] += bflo(t.x); a[1] += bfhi(t.x); a[2] += bflo(t.y); a[3] += bfhi(t.y); b[0] += bflo(t.z); b[1] += bfhi(t.z); b[2] += bflo(t.w); b[3] += bfhi(t.w); }
            *(u32x4*)(T + off) = pack8f(a, b);
            if (bj == 1 && (m & 1)) asm volatile("" ::: "memory"); }
    }
};

struct EpiSlab {
    static constexpr bool PERM = true, AFTER_DRAIN = false;
    float* slab; int ldc, kext;
    __device__ __forceinline__ void operator()(const f32x4 (&acc)[2][2][4][2], const Unit& u, int wr, int wc, int fr, int fq) const {
        const int kp = u.koff / kext, r0 = wr * 64 + fr, c0 = u.pn * 256 + wc * 32 + 8 * fq;
        EPI_LOOP { float* p = slab + ((size_t)kp * 256 + r0 + ai * 128 + m * 16) * ldc + c0 + bj * 128; *(f32x4*)p = acc[ai][bj][m][0]; *(f32x4*)(p + 4) = acc[ai][bj][m][1]; }
    }
};
template <class Epi> __device__ __forceinline__ void tail_fixup(const float* slab, int KS, int ldc, int pm, int pn, int mask, const Epi& E, int tid_in) {
    Unit u; u.pm = pm; u.pn = pn; u.koff = 0; u.mask = mask;
    int tid_l = tid_in; asm volatile("" : "+v"(tid_l));
    const int wid = tid_l >> 6, lane = tid_l & 63, wr = wid >> 2, wc = wid & 3, fr = lane & 15, fq = lane >> 4;
    const int r0 = wr * 64 + fr, c0 = pn * 256 + wc * 32 + 8 * fq;
    f32x4 acc[2][2][4][2];
    EPI_LOOP { acc[ai][bj][m][0] = (f32x4){0.f, 0.f, 0.f, 0.f}; acc[ai][bj][m][1] = (f32x4){0.f, 0.f, 0.f, 0.f}; }
    const char* sb = (const char*)slab; unsigned off = ((unsigned)r0 * (unsigned)ldc + (unsigned)c0) * 4u;
    for (int kp = 0; kp < KS; ++kp) {
        EPI_LOOP { const char* p = sb + (off + (unsigned)((ai * 128 + m * 16) * ldc + bj * 128) * 4u); acc[ai][bj][m][0] += *(const f32x4*)p; acc[ai][bj][m][1] += *(const f32x4*)(p + 16); }
        off += 256u * (unsigned)ldc * 4u;
    }
    E(acc, u, wr, wc, fr, fq);
}
template <class Epi, class Sched, bool ALIGN_EPI = false, bool SP2 = false>
__device__ __forceinline__ void gemm_phase(PG8_LAS unsigned char* lds, const Gemm g, const Sched& S, const Epi& E, int tid_in) {
    int tid_l = tid_in; asm volatile("" : "+v"(tid_l));
    const int tid = tid_l, wid = __builtin_amdgcn_readfirstlane(tid >> 6), lane = tid & 63, wr = wid >> 2, wc = wid & 3, fr = lane & 15, fq = lane >> 4;
    const int K = g.K, nt = g.kext / BK;
    unsigned voffA[2], voffB[2];
#pragma unroll
    for (int i = 0; i < 2; ++i) { int R, C; stage_rc(tid * 16 + i * 8192, R, C); const int Rb = Epi::PERM ? ((R & ~31) + perm32(R & 31)) : R;
        voffA[i] = (unsigned)(R * K + C) * 2u; voffB[i] = (unsigned)(Rb * K + C) * 2u; }
    const size_t kstep = (size_t)(BK * 2);
    const size_t hstep = (size_t)HALF * K * 2;
    const size_t tstep = 2 * hstep;
    const unsigned ldsw = (unsigned)wid * 1024u;
    const int aoff = lds_byte(wr * 64 + fr, fq * 8), boff = lds_byte(wc * 32 + fr, fq * 8);
#define PG8_SA(b, h) (((b) * 2 + (h)) * HTB)
#define PG8_SB(b, h) ((4 + (b) * 2 + (h)) * HTB)
#define PG8_STAGE(bufoff, gbase, voff) do { _Pragma("unroll") for (int _i = 0; _i < 2; ++_i) \
        __builtin_amdgcn_global_load_lds((const unsigned*)((const char*)(gbase) + (voff)[_i]), (PG8_LAS unsigned*)(lds + (bufoff) + ldsw + _i * 8192), 16, 0, 0); } while (0)
#define PG8_LDA(dst, b, h) do { _Pragma("unroll") for (int m = 0; m < 4; ++m) _Pragma("unroll") for (int k = 0; k < 2; ++k) dst[m][k] = *(const PG8_LAS bf16x8*)(lds + PG8_SA(b, h) + aoff + m * 2048 + k * 1024); } while (0)
#define PG8_LDB(dst, b, h) do { _Pragma("unroll") for (int n = 0; n < 2; ++n) _Pragma("unroll") for (int k = 0; k < 2; ++k) dst[n][k] = *(const PG8_LAS bf16x8*)(lds + PG8_SB(b, h) + boff + n * 2048 + k * 1024); } while (0)
#define PG8_MMA(ai, bj, At, Bt) do { __builtin_amdgcn_s_setprio(1); _Pragma("unroll") for (int m = 0; m < 4; ++m) _Pragma("unroll") for (int n = 0; n < 2; ++n) _Pragma("unroll") for (int k = 0; k < 2; ++k) \
        acc[ai][bj][m][n] = __builtin_amdgcn_mfma_f32_16x16x32_bf16(Bt[n][k], At[m][k], acc[ai][bj][m][n], 0, 0, 0); __builtin_amdgcn_s_setprio(0); } while (0)
#define PG8_WAIT_V(n) asm volatile("s_waitcnt vmcnt(" #n ")" ::: "memory")
#define PG8_WAIT_L(n) asm volatile("s_waitcnt lgkmcnt(" #n ")" ::: "memory")
#define PG8_BAR __builtin_amdgcn_s_barrier()
#define PG8_SCHED __builtin_amdgcn_sched_barrier(0)
    Unit cur, nxt; int ui = 0;
    if (!S.next(0, cur)) return;
    f32x4 acc[2][2][4][2];
#pragma unroll
    for (int a = 0; a < 2; ++a)
#pragma unroll
        for (int b = 0; b < 2; ++b)
#pragma unroll
            for (int m = 0; m < 4; ++m)
#pragma unroll
                for (int n = 0; n < 2; ++n) acc[a][b][m][n] = (f32x4){0.f, 0.f, 0.f, 0.f};
    bf16x8 At[4][2], B0[2][2], B1[2][2];
    const char* cA = (const char*)g.A + (size_t)cur.pm * tstep + (size_t)cur.koff * 2; const char* cB = (const char*)g.Bt + (size_t)cur.pn * tstep + (size_t)cur.koff * 2;
    S.a_ready(cur);
    if constexpr (SP2) {
        PG8_STAGE(PG8_SB(0, 0), cB, voffB); PG8_STAGE(PG8_SB(0, 1), cB + hstep, voffB); PG8_STAGE(PG8_SA(0, 0), cA, voffA); PG8_STAGE(PG8_SA(0, 1), cA + hstep, voffA);
        if (wr == 1) PG8_BAR;
        PG8_WAIT_V(2); PG8_BAR;
        PG8_STAGE(PG8_SB(1, 0), cB + kstep, voffB); PG8_STAGE(PG8_SA(1, 0), cA + kstep, voffA); PG8_STAGE(PG8_SB(1, 1), cB + hstep + kstep, voffB);
        PG8_WAIT_V(6); PG8_BAR;
    } else {
        PG8_STAGE(PG8_SB(0, 0), cB, voffB); PG8_STAGE(PG8_SA(0, 0), cA, voffA); PG8_STAGE(PG8_SB(0, 1), cB + hstep, voffB); PG8_STAGE(PG8_SA(0, 1), cA + hstep, voffA);
        if (wr == 1) PG8_BAR;
        PG8_WAIT_V(4); PG8_BAR;
        PG8_STAGE(PG8_SB(1, 0), cB + kstep, voffB); PG8_STAGE(PG8_SA(1, 0), cA + kstep, voffA); PG8_STAGE(PG8_SB(1, 1), cB + hstep + kstep, voffB);
        PG8_WAIT_V(6); PG8_BAR;
    }
    for (;;) {
        const bool has_next = S.next(ui + 1, nxt);
        const char* nA = has_next ? (const char*)g.A + (size_t)nxt.pm * tstep + (size_t)nxt.koff * 2 : cA; const char* nB = has_next ? (const char*)g.Bt + (size_t)nxt.pn * tstep + (size_t)nxt.koff * 2 : cB;
        for (int t = 0; t < nt; t += 2) {
            const bool last = (t == nt - 2);
            const char* a1 = cA + (size_t)(t + 1) * kstep;
            const char* a2 = last ? nA : cA + (size_t)(t + 2) * kstep; const char* b2 = last ? nB : cB + (size_t)(t + 2) * kstep;
            const char* a3 = a2 + kstep; const char* b3 = b2 + kstep;
            if (last && has_next) S.a_ready(nxt);
            if constexpr (SP2) {
            PG8_LDB(B0, 0, 0); PG8_LDB(B1, 0, 1); PG8_SCHED; PG8_LDA(At, 0, 0); PG8_STAGE(PG8_SA(1, 1), a1 + hstep, voffA);
            PG8_WAIT_V(8); PG8_WAIT_L(0); PG8_BAR; PG8_MMA(0, 0, At, B0); PG8_MMA(0, 1, At, B1); PG8_BAR; PG8_SCHED;
            PG8_LDA(At, 0, 1); PG8_STAGE(PG8_SB(0, 0), b2, voffB); PG8_STAGE(PG8_SB(0, 1), b2 + hstep, voffB); PG8_STAGE(PG8_SA(0, 0), a2, voffA);
            PG8_WAIT_V(8); PG8_WAIT_L(0); PG8_BAR; PG8_MMA(1, 0, At, B0); PG8_MMA(1, 1, At, B1); PG8_BAR; PG8_SCHED;
            PG8_LDB(B0, 1, 0); PG8_LDB(B1, 1, 1); PG8_SCHED; PG8_LDA(At, 1, 0); PG8_STAGE(PG8_SA(0, 1), a2 + hstep, voffA);
            PG8_WAIT_V(8); PG8_WAIT_L(0); PG8_BAR; PG8_MMA(0, 0, At, B0); PG8_MMA(0, 1, At, B1); PG8_BAR; PG8_SCHED;
            PG8_LDA(At, 1, 1); PG8_STAGE(PG8_SB(1, 0), b3, voffB); PG8_STAGE(PG8_SB(1, 1), b3 + hstep, voffB); PG8_STAGE(PG8_SA(1, 0), a3, voffA);
            PG8_WAIT_V(8); PG8_WAIT_L(0); PG8_BAR; PG8_MMA(1, 0, At, B0); PG8_MMA(1, 1, At, B1); PG8_BAR; PG8_SCHED;
            } else {
            PG8_LDB(B0, 0, 0); PG8_SCHED; PG8_LDA(At, 0, 0); PG8_STAGE(PG8_SA(1, 1), a1 + hstep, voffA);
            PG8_WAIT_L(8); PG8_BAR; PG8_WAIT_L(0); PG8_MMA(0, 0, At, B0); PG8_BAR; PG8_SCHED;
            PG8_LDB(B1, 0, 1); PG8_STAGE(PG8_SB(0, 0), b2, voffB);
            PG8_BAR; PG8_WAIT_L(0); PG8_MMA(0, 1, At, B1); PG8_BAR;
            PG8_LDA(At, 0, 1); PG8_STAGE(PG8_SA(0, 0), a2, voffA);
            PG8_BAR; PG8_WAIT_L(0); PG8_MMA(1, 0, At, B0); PG8_BAR; PG8_SCHED;
            PG8_STAGE(PG8_SB(0, 1), b2 + hstep, voffB);
            PG8_WAIT_V(6); PG8_BAR; PG8_MMA(1, 1, At, B1); PG8_BAR;
            PG8_LDB(B0, 1, 0); PG8_SCHED; PG8_LDA(At, 1, 0); PG8_STAGE(PG8_SA(0, 1), a2 + hstep, voffA);
            PG8_WAIT_L(8); PG8_BAR; PG8_WAIT_L(0); PG8_MMA(0, 0, At, B0); PG8_BAR; PG8_SCHED;
            PG8_LDB(B1, 1, 1); PG8_STAGE(PG8_SB(1, 0), b3, voffB);
            PG8_BAR; PG8_WAIT_L(0); PG8_MMA(0, 1, At, B1); PG8_BAR;
            PG8_LDA(At, 1, 1); PG8_STAGE(PG8_SA(1, 0), a3, voffA);
            PG8_BAR; PG8_WAIT_L(0); PG8_MMA(1, 0, At, B0); PG8_BAR; PG8_SCHED;
            PG8_STAGE(PG8_SB(1, 1), b3 + hstep, voffB);
            PG8_WAIT_V(6); PG8_BAR; PG8_MMA(1, 1, At, B1); PG8_BAR;
            }
        }
        if constexpr (ALIGN_EPI) { if (wr == 0) PG8_BAR; }
        if constexpr (!Epi::AFTER_DRAIN) { E(acc, cur, wr, wc, fr, fq); S.done(cur); }
        if (!has_next) break;
#pragma unroll
        for (int a = 0; a < 2; ++a)
#pragma unroll
            for (int b = 0; b < 2; ++b)
#pragma unroll
                for (int m = 0; m < 4; ++m)
#pragma unroll
                    for (int n = 0; n < 2; ++n) acc[a][b][m][n] = (f32x4){0.f, 0.f, 0.f, 0.f};
        cur = nxt; cA = nA; cB = nB; ++ui;
        if constexpr (ALIGN_EPI) { if (wr == 1) PG8_BAR; }
    }
    PG8_WAIT_V(0);
    if constexpr (!ALIGN_EPI) { if (wr == 0) PG8_BAR; }
    PG8_BAR;
    if constexpr (Epi::AFTER_DRAIN) { E.fused(acc, cur, wr, wc, fr, fq, lds, wid, lane); S.done(cur); }
#undef PG8_SA
#undef PG8_SB
#undef PG8_STAGE
#undef PG8_LDA
#undef PG8_LDB
#undef PG8_MMA
#undef PG8_WAIT_V
#undef PG8_WAIT_L
#undef PG8_BAR
#undef PG8_SCHED
}
}
using pg8::bf16_t;
#define MFMA32(a, b, c) __builtin_amdgcn_mfma_f32_32x32x16_bf16((a), (b), (c), 0, 0, 0)
#define LDS_WAIT() asm volatile("s_waitcnt lgkmcnt(0)" ::: "memory")
DI int crow(int i, int h) { return (i & 3) + 8 * (i >> 2) + 4 * h; }
template <int S> DI bf16x8 pack8(const f32x16& x) {
    u32x4 p; p.x = pk2(x[8 * S], x[8 * S + 1]); p.y = pk2(x[8 * S + 2], x[8 * S + 3]); p.z = pk2(x[8 * S + 4], x[8 * S + 5]); p.w = pk2(x[8 * S + 6], x[8 * S + 7]);
    return __builtin_bit_cast(bf16x8, p);
}
DI f32x16 zero16() { f32x16 z;
#pragma unroll
    for (int i = 0; i < 16; ++i) z[i] = 0.f; return z; }

struct Params { const float* in[22]; float* out; unsigned char* ws; };

enum { MAP_ID = 0, MAP_WIN = 1, MAP_WUQ = 2 };
template <int MAP> DI int dest_row(int n) {
    if (MAP == MAP_WIN) return n < 1088 ? n : n + 192;
    if (MAP == MAP_WUQ) { const int h = n / 192, i = n - h * 192; return i < 128 ? h * 128 + i : 2048 + h * 64 + 2 * ((i - 128) & 31) + ((i - 128) >> 5); }
    return n;
}
template <int MAP> DI void transpose_item(const float* __restrict__ W, int K, int N, bf16_t* __restrict__ WT, LAS float* scr, int item, int lane) {
    const int nblk = N / 32, kb = item / nblk, nb = item - kb * nblk, k0 = 64 * kb, n0 = 32 * nb;
    float wv[32];
#pragma unroll
    for (int i = 0; i < 32; ++i) wv[i] = W[(size_t)(k0 + 2 * i + (lane >> 5)) * N + n0 + (lane & 31)];
#pragma unroll
    for (int i = 0; i < 32; ++i) scr[(2 * i + (lane >> 5)) * 33 + (lane & 31)] = wv[i];
    LDS_WAIT();
    const int c = lane & 7;
#pragma unroll
    for (int j = 0; j < 4; ++j) { const int n = (lane >> 3) + 8 * j; const LAS float* s = scr + (8 * c) * 33 + n;
        u32x4 o; o.x = pk2(s[0 * 33], s[1 * 33]); o.y = pk2(s[2 * 33], s[3 * 33]); o.z = pk2(s[4 * 33], s[5 * 33]); o.w = pk2(s[6 * 33], s[7 * 33]);
        *(u32x4*)(WT + (size_t)dest_row<MAP>(n0 + n) * K + k0 + 8 * c) = o; }
    LDS_WAIT();
}

DI void layer_prep(const Params& P, LAS unsigned char* lds, int l, int gw, int NGW, int gt, int NGT, int lane, int wave) {
    unsigned char* ws = P.ws;
    LAS float* scr = (LAS float*)(lds + wave * 16384);
    const float* w_in = P.in[6] + (size_t)l * 2048 * 13376; const float* w_uq = P.in[8] + (size_t)l * 512 * 3072;
    const float* w_uk = P.in[10] + (size_t)l * 512 * 2048;  const float* w_uv = P.in[11] + (size_t)l * 512 * 2048;
    const float* w_oa = P.in[12] + (size_t)l * 2048 * 2048; const float* w_ob = P.in[15] + (size_t)l * 2048 * 2048; const float* w_out = P.in[16] + (size_t)l * 2048 * 2048;
    const float* w_up = P.in[19] + (size_t)l * 2048 * 8192; const float* w_dn = P.in[20] + (size_t)l * 8192 * 2048;
    constexpr int I_IN = 32 * 418, I_UQ = 8 * 96, I_UK = 8 * 64, I_SQ = 32 * 64, I_UP = 32 * 256, I_DN = 128 * 64;
    constexpr int NIT = I_IN + I_UQ + 2 * I_UK + 3 * I_SQ + I_UP + I_DN;
    for (int it = gw; it < NIT; it += NGW) {
        int r = it;
        if (r < I_IN) { transpose_item<MAP_WIN>(w_in, 2048, 13376, (bf16_t*)(ws + WS_WIN), scr, r, lane); continue; } r -= I_IN;
        if (r < I_UQ) { transpose_item<MAP_WUQ>(w_uq, 512, 3072, (bf16_t*)(ws + WS_WUQ), scr, r, lane); continue; } r -= I_UQ;
        if (r < I_UK) { transpose_item<MAP_ID>(w_uk, 512, 2048, (bf16_t*)(ws + WS_WUK), scr, r, lane); continue; } r -= I_UK;
        if (r < I_UK) { transpose_item<MAP_ID>(w_uv, 512, 2048, (bf16_t*)(ws + WS_WUV), scr, r, lane); continue; } r -= I_UK;
        if (r < I_SQ) { transpose_item<MAP_ID>(w_oa, 2048, 2048, (bf16_t*)(ws + WS_WOA), scr, r, lane); continue; } r -= I_SQ;
        if (r < I_SQ) { transpose_item<MAP_ID>(w_ob, 2048, 2048, (bf16_t*)(ws + WS_WOB), scr, r, lane); continue; } r -= I_SQ;
        if (r < I_SQ) { transpose_item<MAP_ID>(w_out, 2048, 2048, (bf16_t*)(ws + WS_WOUT), scr, r, lane); continue; } r -= I_SQ;
        if (r < I_UP) { transpose_item<MAP_ID>(w_up, 2048, 8192, (bf16_t*)(ws + WS_WUP), scr, r, lane); continue; } r -= I_UP;
        transpose_item<MAP_ID>(w_dn, 8192, 2048, (bf16_t*)(ws + WS_WDN), scr, r, lane);
    }
    u32x4 z4; { unsigned z_; asm volatile("v_mov_b32 %0, 0" : "=v"(z_)); z4.x = z_; z4.y = z_; z4.z = z_; z4.w = z_; }
    { u32x4* z = (u32x4*)((bf16_t*)(ws + WS_WIN) + (size_t)1088 * 2048); for (int i = gt; i < 192 * 2048 / 8; i += NGT) z[i] = z4; }
    bf16_t* CKV = (bf16_t*)(ws + WS_CKV); bf16_t* KPE = (bf16_t*)(ws + WS_KPE);
    const float* cc = P.in[2] + (size_t)l * 8 * 4096 * 512; const float* ck = P.in[3] + (size_t)l * 8 * 4096 * 64;
#pragma unroll 4
    for (int i = gt; i < 8 * 4096 * 512 / 8; i += NGT) { const int b = i >> 18, rem = i & 262143, t = rem >> 6, c8 = rem & 63;
        const f32x4 a = *(const f32x4*)(cc + (size_t)i * 8), bq = *(const f32x4*)(cc + (size_t)i * 8 + 4);
        u32x4 o; o.x = pk2(a[0], a[1]); o.y = pk2(a[2], a[3]); o.z = pk2(bq[0], bq[1]); o.w = pk2(bq[2], bq[3]);
        *(u32x4*)(CKV + (size_t)(MP + b * KVB + t) * 512 + c8 * 8) = o; }
#pragma unroll 2
    for (int i = gt; i < 8 * 4096 * 64 / 8; i += NGT) { const int b = i >> 15, rem = i & 32767, t = rem >> 3, c8 = rem & 7;
        const f32x4 a = *(const f32x4*)(ck + (size_t)i * 8), bq = *(const f32x4*)(ck + (size_t)i * 8 + 4);
        u32x4 o; o.x = pk2(a[0], a[1]); o.y = pk2(a[2], a[3]); o.z = pk2(bq[0], bq[1]); o.w = pk2(bq[2], bq[3]);
        *(u32x4*)(KPE + (size_t)(MP + b * KVB + t) * 64 + c8 * 8) = o; }
    for (int i = gt; i < 8 * 32 * 64; i += NGT) { const int b = i >> 11, rem = i & 2047; *(u32x4*)(CKV + (size_t)(MP + b * KVB + 4128) * 512 + rem * 8) = z4; }
    for (int i = gt; i < 8 * 32 * 8; i += NGT) { const int b = i >> 8, rem = i & 255; *(u32x4*)(KPE + (size_t)(MP + b * KVB + 4128) * 64 + rem * 8) = z4; }
    float* LB = (float*)(ws + WS_LB); const float* hl = P.in[13];
    for (int i = gt; i < 2048; i += NGT) LB[i] = l == 0 ? 0.f : 1.f / (1.f + expf(hl[i] - hl[2048 + i]));
}

DI void rope_table(const Params& P, int gt, int NGT) {
    float* T = (float*)(P.ws + WS_TBL);
    for (int i = gt; i < 2080 * 32; i += NGT) { const int p = i >> 5, j = i & 31; const int pos = p < 2048 ? p : 4096 + (p - 2048);
        const float inv = exp2f(-(float)j * (13.287712379549449f / 32.f)); const float ang = (float)pos * inv;
        const double a = (double)ang; const double kq = rint(a * 0.15915494309189535); const float rr = (float)(a - kq * 6.283185307179586);
        T[2 * i] = __cosf(rr); T[2 * i + 1] = __sinf(rr); }
}

DI void init_x(const Params& P, int gw, int NGW, int lane) {
    const float* g = P.in[5]; float* X = P.out; bf16_t* XN = (bf16_t*)(P.ws + WS_XN);
    for (int row = gw; row < MTOK; row += NGW) {
        const float* src = row < MP ? P.in[0] + (size_t)row * 2048 : P.in[1] + (size_t)(row - MP) * 2048;
        f32x4 v[8]; float ss = 0.f;
#pragma unroll
        for (int j = 0; j < 8; ++j) { v[j] = *(const f32x4*)(src + j * 256 + lane * 4); ss += v[j][0] * v[j][0] + v[j][1] * v[j][1] + v[j][2] * v[j][2] + v[j][3] * v[j][3]; }
        const float rs = rsqrtf(wave_sum(ss, lane) * (1.f / 2048.f) + EPS);
#pragma unroll
        for (int j = 0; j < 8; ++j) { *(f32x4*)(X + (size_t)row * 2048 + j * 256 + lane * 4) = v[j];
            const f32x4 gg = *(const f32x4*)(g + j * 256 + lane * 4); u32x2 w; w.x = pk2(v[j][0] * rs * gg[0], v[j][1] * rs * gg[1]); w.y = pk2(v[j][2] * rs * gg[2], v[j][3] * rs * gg[3]);
            *(u32x2*)(XN + (size_t)row * 2048 + j * 256 + lane * 4) = w; }
    }
}
DI void resid_norm(const float* __restrict__ Y, const float* __restrict__ gY, float* X, const float* __restrict__ gN, bf16_t* XN, int gw, int NGW, int lane) {
    for (int row = gw; row < MP; row += NGW) {
        f32x4 y[8]; float ss = 0.f;
#pragma unroll
        for (int j = 0; j < 8; ++j) { y[j] = *(const f32x4*)(Y + (size_t)row * 2048 + j * 256 + lane * 4); ss += y[j][0] * y[j][0] + y[j][1] * y[j][1] + y[j][2] * y[j][2] + y[j][3] * y[j][3]; }
        const float rs = rsqrtf(wave_sum(ss, lane) * (1.f / 2048.f) + EPS); float s2 = 0.f;
#pragma unroll
        for (int j = 0; j < 8; ++j) { const f32x4 gg = *(const f32x4*)(gY + j * 256 + lane * 4); const f32x4 x = *(const f32x4*)(X + (size_t)row * 2048 + j * 256 + lane * 4);
            y[j] = x + y[j] * rs * gg; *(f32x4*)(X + (size_t)row * 2048 + j * 256 + lane * 4) = y[j];
            s2 += y[j][0] * y[j][0] + y[j][1] * y[j][1] + y[j][2] * y[j][2] + y[j][3] * y[j][3]; }
        if (gN) {
            const float r2 = rsqrtf(wave_sum(s2, lane) * (1.f / 2048.f) + EPS);
#pragma unroll
            for (int j = 0; j < 8; ++j) { const f32x4 gg = *(const f32x4*)(gN + j * 256 + lane * 4); u32x2 w; w.x = pk2(y[j][0] * r2 * gg[0], y[j][1] * r2 * gg[1]); w.y = pk2(y[j][2] * r2 * gg[2], y[j][3] * r2 * gg[3]);
                *(u32x2*)(XN + (size_t)row * 2048 + j * 256 + lane * 4) = w; }
        }
    }
}
DI void resid_norm_tail(LAS unsigned char* lds, const float* __restrict__ slab, int KS, const float* __restrict__ gY, float* X, const float* __restrict__ gN, bf16_t* XN, int vcu, int G, int wave, int lane) {
    LAS float* red = (LAS float*)lds;
    for (int tr = vcu; tr < MS; tr += G) {
        const size_t off = (size_t)(MP + tr) * 2048 + wave * 256 + lane * 4;
        f32x4 y = {0.f, 0.f, 0.f, 0.f};
        for (int kp = 0; kp < KS; ++kp) y += *(const f32x4*)(slab + ((size_t)kp * 256 + tr) * 2048 + wave * 256 + lane * 4);
        const float ss = wave_sum(y[0] * y[0] + y[1] * y[1] + y[2] * y[2] + y[3] * y[3], lane);
        if (lane == 0) red[wave] = ss;
        __syncthreads();
        float tot = 0.f;
#pragma unroll
        for (int w = 0; w < 8; ++w) tot += red[w];
        const float rs = rsqrtf(tot * (1.f / 2048.f) + EPS);
        const f32x4 gg = *(const f32x4*)(gY + wave * 256 + lane * 4); const f32x4 x = *(const f32x4*)(X + off);
        y = x + y * rs * gg; *(f32x4*)(X + off) = y;
        const float s2 = wave_sum(y[0] * y[0] + y[1] * y[1] + y[2] * y[2] + y[3] * y[3], lane);
        if (lane == 0) red[8 + wave] = s2;
        __syncthreads();
        if (gN) { float t2 = 0.f;
#pragma unroll
            for (int w = 0; w < 8; ++w) t2 += red[8 + w];
            const float r2 = rsqrtf(t2 * (1.f / 2048.f) + EPS); const f32x4 g2 = *(const f32x4*)(gN + wave * 256 + lane * 4);
            u32x2 wv; wv.x = pk2(y[0] * r2 * g2[0], y[1] * r2 * g2[1]); wv.y = pk2(y[2] * r2 * g2[2], y[3] * r2 * g2[3]); *(u32x2*)(XN + off) = wv; }
        __syncthreads();
    }
}
DI void small_norms(const Params& P, int l, int gw, int NGW, int lane) {
    const float* Zs = (const float*)(P.ws + WS_ZS); bf16_t* QN = (bf16_t*)(P.ws + WS_QN); bf16_t* CKV = (bf16_t*)(P.ws + WS_CKV); bf16_t* KPE = (bf16_t*)(P.ws + WS_KPE);
    const float* tbl = (const float*)(P.ws + WS_TBL); const float* gq = P.in[7] + l * 512; const float* gkv = P.in[9] + l * 512;
    for (int row = gw; row < MTOK; row += NGW) {
        const float* z = Zs + (size_t)row * ZSW;
        const bool pr = row < MP; const int rs_ = row - MP;
        const int kvrow = pr ? row : MP + (rs_ >> 5) * KVB + 4096 + (rs_ & 31);
        const int p = pr ? (row & 2047) : 2048 + (rs_ & 31);
        float* oc = pr ? P.out + OUT_CKVP + ((size_t)l * MP + row) * 512 : P.out + OUT_CKVS + ((size_t)l * MS + rs_) * 512;
        float* ok = pr ? P.out + OUT_KPEP + ((size_t)l * MP + row) * 64 : P.out + OUT_KPES + ((size_t)l * MS + rs_) * 64;
        { const f32x4 a = *(const f32x4*)(z + lane * 8), b = *(const f32x4*)(z + lane * 8 + 4);
          const float ss = a[0] * a[0] + a[1] * a[1] + a[2] * a[2] + a[3] * a[3] + b[0] * b[0] + b[1] * b[1] + b[2] * b[2] + b[3] * b[3];
          const float rs = rsqrtf(wave_sum(ss, lane) * (1.f / 512.f) + EPS); const f32x4 g0 = *(const f32x4*)(gq + lane * 8), g1 = *(const f32x4*)(gq + lane * 8 + 4);
          u32x4 o; o.x = pk2(a[0] * rs * g0[0], a[1] * rs * g0[1]); o.y = pk2(a[2] * rs * g0[2], a[3] * rs * g0[3]); o.z = pk2(b[0] * rs * g1[0], b[1] * rs * g1[1]); o.w = pk2(b[2] * rs * g1[2], b[3] * rs * g1[3]);
          *(u32x4*)(QN + (size_t)row * 512 + lane * 8) = o; }
        { const f32x4 a = *(const f32x4*)(z + 512 + lane * 8), b = *(const f32x4*)(z + 512 + lane * 8 + 4);
          const float ss = a[0] * a[0] + a[1] * a[1] + a[2] * a[2] + a[3] * a[3] + b[0] * b[0] + b[1] * b[1] + b[2] * b[2] + b[3] * b[3];
          const float rs = rsqrtf(wave_sum(ss, lane) * (1.f / 512.f) + EPS); const f32x4 g0 = *(const f32x4*)(gkv + lane * 8), g1 = *(const f32x4*)(gkv + lane * 8 + 4);
          const f32x4 c0 = a * rs * g0, c1 = b * rs * g1;
          *(f32x4*)(oc + lane * 8) = c0; *(f32x4*)(oc + lane * 8 + 4) = c1;
          u32x4 o; o.x = pk2(c0[0], c0[1]); o.y = pk2(c0[2], c0[3]); o.z = pk2(c1[0], c1[1]); o.w = pk2(c1[2], c1[3]);
          *(u32x4*)(CKV + (size_t)kvrow * 512 + lane * 8) = o; }
        if (lane < 32) { const float x1 = z[1024 + lane], x2 = z[1056 + lane]; const float c = tbl[(size_t)(p * 32 + lane) * 2], s = tbl[(size_t)(p * 32 + lane) * 2 + 1];
          const float o1 = x1 * c - x2 * s, o2 = x1 * s + x2 * c; ok[lane] = o1; ok[32 + lane] = o2;
          KPE[(size_t)kvrow * 64 + lane] = f2bf(o1); KPE[(size_t)kvrow * 64 + 32 + lane] = f2bf(o2); }
    }
}

struct HUnit { int rowbase, nvalid, h; };
DI HUnit hunit(int u) { HUnit r; if (u < 2048) { const int sh = u >> 5, c = u & 31; r.h = sh & 15; r.rowbase = (sh >> 4) * 2048 + c * 64; r.nvalid = 64; } else { const int s = u - 2048; r.h = s & 15; r.rowbase = MP + (s >> 4) * 32; r.nvalid = 32; } return r; }
DI void hgrn_cumsum(const float* __restrict__ LF, LAS float* psum, const HUnit& hu, int k, int tq, float (&b)[16], float& b31, float& b63) {
    const float* p = LF + (size_t)(hu.rowbase + 16 * tq) * 2048 + hu.h * 128 + k; const bool valid = 16 * tq < hu.nvalid;
    float run = 0.f;
#pragma unroll
    for (int i = 0; i < 16; ++i) { const float v = valid ? p[(size_t)i * 2048] : 0.f; run += v; b[i] = run; }
    psum[tq * 128 + k] = run;
    __syncthreads();
    const float p0 = psum[k], p1 = psum[128 + k], p2 = psum[256 + k], p3 = psum[384 + k];
    const float off = (tq > 0 ? p0 : 0.f) + (tq > 1 ? p1 : 0.f) + (tq > 2 ? p2 : 0.f);
#pragma unroll
    for (int i = 0; i < 16; ++i) b[i] += off;
    b31 = p0 + p1; b63 = b31 + p2 + p3;
}
DI void hgrn_pass1(LAS unsigned char* lds, const float* __restrict__ LF, const bf16_t* __restrict__ HK, const bf16_t* __restrict__ HV, bf16_t* __restrict__ UT, float* __restrict__ Dv, int u, int tid) {
    LAS float* psum = (LAS float*)lds; LAS bf16_t* KhT = (LAS bf16_t*)(lds + 2048); LAS bf16_t* VTl = (LAS bf16_t*)(lds + 2048 + 18432);
    const HUnit hu = hunit(u); const int k = tid & 127, tq = tid >> 7; const bool valid = 16 * tq < hu.nvalid;
    const size_t g0 = (size_t)(hu.rowbase + 16 * tq) * 2048 + hu.h * 128 + k;
    unsigned kraw[8], vw[8];
#pragma unroll
    for (int i2 = 0; i2 < 8; ++i2) { unsigned k0 = 0u, k1 = 0u, v0 = 0u, v1 = 0u;
        if (valid) { k0 = HK[g0 + (size_t)(2 * i2) * 2048]; k1 = HK[g0 + (size_t)(2 * i2 + 1) * 2048]; v0 = HV[g0 + (size_t)(2 * i2) * 2048]; v1 = HV[g0 + (size_t)(2 * i2 + 1) * 2048]; }
        kraw[i2] = k0 | (k1 << 16); vw[i2] = v0 | (v1 << 16); }
    float b[16], b31, b63; hgrn_cumsum(LF, psum, hu, k, tq, b, b31, b63);
    unsigned kw[8];
#pragma unroll
    for (int i2 = 0; i2 < 8; ++i2) kw[i2] = pk2(bflo(kraw[i2]) * __expf(b63 - b[2 * i2]), bfhi(kraw[i2]) * __expf(b63 - b[2 * i2 + 1]));
    { u32x4 a, c; a.x = kw[0]; a.y = kw[1]; a.z = kw[2]; a.w = kw[3]; c.x = kw[4]; c.y = kw[5]; c.z = kw[6]; c.w = kw[7];
      *(LAS u32x4*)(KhT + k * 72 + 16 * tq) = a; *(LAS u32x4*)(KhT + k * 72 + 16 * tq + 8) = c;
      a.x = vw[0]; a.y = vw[1]; a.z = vw[2]; a.w = vw[3]; c.x = vw[4]; c.y = vw[5]; c.z = vw[6]; c.w = vw[7];
      *(LAS u32x4*)(VTl + k * 72 + 16 * tq) = a; *(LAS u32x4*)(VTl + k * 72 + 16 * tq + 8) = c; }
    if (tq == 0) Dv[(size_t)u * 128 + k] = __expf(b63);
    __syncthreads();
    const int wave = tid >> 6, lane = tid & 63, r = lane & 31, hh = lane >> 5, vb = wave & 3, kg = wave >> 2;
#pragma unroll
    for (int kb2 = 0; kb2 < 2; ++kb2) {
        const int kbq = 2 * kg + kb2; f32x16 acc = zero16();
#pragma unroll
        for (int s = 0; s < 4; ++s) { const bf16x8 a = *(const LAS bf16x8*)(VTl + (32 * vb + r) * 72 + 16 * s + 8 * hh), bb = *(const LAS bf16x8*)(KhT + (32 * kbq + r) * 72 + 16 * s + 8 * hh); acc = MFMA32(a, bb, acc); }
        bf16_t* dst = UT + ((size_t)u * 128 + 32 * vb) * 128 + 32 * kbq + r;
#pragma unroll
        for (int i = 0; i < 16; ++i) dst[(size_t)crow(i, hh) * 128] = f2bf(acc[i]);
    }
    __syncthreads();
}
DI void hgrn_pass2(LAS unsigned char* lds, const Params& P, int l, int x, int tid) {
    const bf16_t* UT = (const bf16_t*)(P.ws + WS_UT); const float* Dv = (const float*)(P.ws + WS_D); bf16_t* SpT = (bf16_t*)(P.ws + WS_SPT);
    LAS float* tl = (LAS float*)lds;
    const bool sample = x >= 256; const int sidx = sample ? (x - 256) >> 2 : x >> 2, vq = x & 3;
    const int nch = sample ? 1 : 32, ubase = sample ? 2048 + sidx : sidx * 32;
    const int vloc = tid >> 4, k0 = (tid & 15) * 8, v = 32 * vq + vloc;
    const int kk = tid >> 2, vs = (tid & 3) * 8;
    float S[8];
#pragma unroll
    for (int i = 0; i < 8; ++i) S[i] = 0.f;
    if (sample) {
        const float* s0 = P.in[4] + ((size_t)l * 128 + sidx) * 16384 + (size_t)kk * 128 + 32 * vq + vs;
        const f32x4 a = *(const f32x4*)s0, b = *(const f32x4*)(s0 + 4);
#pragma unroll
        for (int i = 0; i < 4; ++i) { tl[kk * 33 + vs + i] = a[i]; tl[kk * 33 + vs + 4 + i] = b[i]; }
        __syncthreads();
#pragma unroll
        for (int i = 0; i < 8; ++i) S[i] = tl[(k0 + i) * 33 + vloc];
        __syncthreads();
    }
    size_t e = ((size_t)ubase * 128 + v) * 128 + k0;
    u32x4 uu = *(const u32x4*)(UT + e); f32x4 d0 = *(const f32x4*)(Dv + (size_t)ubase * 128 + k0), d1 = *(const f32x4*)(Dv + (size_t)ubase * 128 + k0 + 4);
    for (int c = 0; c < nch; ++c) {
        u32x4 nuu = uu; f32x4 nd0 = d0, nd1 = d1;
        if (c + 1 < nch) { const size_t e2 = e + 16384; nuu = *(const u32x4*)(UT + e2); nd0 = *(const f32x4*)(Dv + (size_t)(ubase + c + 1) * 128 + k0); nd1 = *(const f32x4*)(Dv + (size_t)(ubase + c + 1) * 128 + k0 + 4); }
        u32x4 o; o.x = pk2(S[0], S[1]); o.y = pk2(S[2], S[3]); o.z = pk2(S[4], S[5]); o.w = pk2(S[6], S[7]);
        *(u32x4*)(SpT + e) = o;
        S[0] = d0[0] * S[0] + bflo(uu.x); S[1] = d0[1] * S[1] + bfhi(uu.x); S[2] = d0[2] * S[2] + bflo(uu.y); S[3] = d0[3] * S[3] + bfhi(uu.y);
        S[4] = d1[0] * S[4] + bflo(uu.z); S[5] = d1[1] * S[5] + bfhi(uu.z); S[6] = d1[2] * S[6] + bflo(uu.w); S[7] = d1[3] * S[7] + bfhi(uu.w);
        uu = nuu; d0 = nd0; d1 = nd1; e += 16384;
    }
#pragma unroll
    for (int i = 0; i < 8; ++i) tl[(k0 + i) * 33 + vloc] = S[i];
    __syncthreads();
    float* o = (sample ? P.out + OUT_STS + ((size_t)l * 128 + sidx) * 16384 : P.out + OUT_STP + ((size_t)l * 64 + sidx) * 16384) + (size_t)kk * 128 + 32 * vq + vs;
    f32x4 a, b;
#pragma unroll
    for (int i = 0; i < 4; ++i) { a[i] = tl[kk * 33 + vs + i]; b[i] = tl[kk * 33 + vs + 4 + i]; }
    *(f32x4*)o = a; *(f32x4*)(o + 4) = b;
    __syncthreads();
}
DI void hgrn_pass3(LAS unsigned char* lds, const float* __restrict__ LF, const bf16_t* __restrict__ HQ, const bf16_t* __restrict__ HK, const bf16_t* __restrict__ HV, const bf16_t* __restrict__ HG,
                   const bf16_t* __restrict__ SpT, const float* __restrict__ gn, bf16_t* __restrict__ OH, int u, int tid) {
    LAS float* psum = (LAS float*)lds;
    LAS bf16_t* Qa = (LAS bf16_t*)(lds + 2048);
    LAS bf16_t* Qb = (LAS bf16_t*)(lds + 19456);
    LAS bf16_t* Ka = (LAS bf16_t*)(lds + 28160);
    LAS bf16_t* Kb = (LAS bf16_t*)(lds + 36864);
    LAS bf16_t* VTl = (LAS bf16_t*)(lds + 54272);
    LAS float* Ost = (LAS float*)(lds + 72704);
    const HUnit hu = hunit(u); const int k = tid & 127, tq = tid >> 7; const bool valid = 16 * tq < hu.nvalid;
    const size_t g0 = (size_t)(hu.rowbase + 16 * tq) * 2048 + hu.h * 128 + k;
    unsigned vw[8], qk[16];
#pragma unroll
    for (int i2 = 0; i2 < 8; ++i2) {
        unsigned vpair = 0u;
#pragma unroll
        for (int e = 0; e < 2; ++e) { const int i = 2 * i2 + e; unsigned q = 0u, kk = 0u, vv = 0u;
            if (valid) { q = HQ[g0 + (size_t)i * 2048]; kk = HK[g0 + (size_t)i * 2048]; vv = HV[g0 + (size_t)i * 2048]; }
            qk[i] = q | (kk << 16); vpair |= vv << (16 * e); }
        vw[i2] = vpair;
    }
    float b[16], b31, b63; hgrn_cumsum(LF, psum, hu, k, tq, b, b31, b63);
#pragma unroll
    for (int i = 0; i < 16; ++i) {
        const int t = 16 * tq + i; const float q = bflo(qk[i]), kk = bfhi(qk[i]);
        Qa[t * 136 + k] = f2bf(q * __expf(b[i]));
        if (tq >= 2) Qb[(t - 32) * 136 + k] = f2bf(q * __expf(b[i] - b31)); else Ka[t * 136 + k] = f2bf(kk * __expf(-b[i]));
        Kb[t * 136 + k] = f2bf(kk * __expf(b31 - b[i]));
    }
    { u32x4 a, c; a.x = vw[0]; a.y = vw[1]; a.z = vw[2]; a.w = vw[3]; c.x = vw[4]; c.y = vw[5]; c.z = vw[6]; c.w = vw[7];
      *(LAS u32x4*)(VTl + k * 72 + 16 * tq) = a; *(LAS u32x4*)(VTl + k * 72 + 16 * tq + 8) = c; }
    __syncthreads();
    const int wave = tid >> 6, lane = tid & 63, r = lane & 31, hh = lane >> 5, vb = wave & 3, tb = wave >> 2;
    f32x16 O = zero16();
    const LAS bf16_t* vrow = VTl + (32 * vb + r) * 72 + 4 * hh;
    if (tb == 0) {
        f32x16 A0 = zero16();
#pragma unroll
        for (int ks = 0; ks < 8; ++ks) { const bf16x8 a = *(const LAS bf16x8*)(Ka + r * 136 + 16 * ks + 8 * hh), q = *(const LAS bf16x8*)(Qa + r * 136 + 16 * ks + 8 * hh); A0 = MFMA32(a, q, A0); }
#pragma unroll
        for (int i = 0; i < 16; ++i) if (crow(i, hh) > r) A0[i] = 0.f;
        const bf16x8 p0 = pack8<0>(A0), p1 = pack8<1>(A0);
        { const s16x4 lo = *(const LAS s16x4*)(vrow), hi = *(const LAS s16x4*)(vrow + 8); O = MFMA32(__builtin_shufflevector(lo, hi, 0, 1, 2, 3, 4, 5, 6, 7), p0, O); }
        { const s16x4 lo = *(const LAS s16x4*)(vrow + 16), hi = *(const LAS s16x4*)(vrow + 24); O = MFMA32(__builtin_shufflevector(lo, hi, 0, 1, 2, 3, 4, 5, 6, 7), p1, O); }
    } else {
        f32x16 A0 = zero16(), A1 = zero16();
#pragma unroll
        for (int ks = 0; ks < 8; ++ks) { const bf16x8 q = *(const LAS bf16x8*)(Qb + r * 136 + 16 * ks + 8 * hh);
            const bf16x8 a0 = *(const LAS bf16x8*)(Kb + r * 136 + 16 * ks + 8 * hh), a1 = *(const LAS bf16x8*)(Kb + (32 + r) * 136 + 16 * ks + 8 * hh);
            A0 = MFMA32(a0, q, A0); A1 = MFMA32(a1, q, A1); }
#pragma unroll
        for (int i = 0; i < 16; ++i) if (crow(i, hh) > r) A1[i] = 0.f;
        const bf16x8 p0 = pack8<0>(A0), p1 = pack8<1>(A0), p2 = pack8<0>(A1), p3 = pack8<1>(A1);
        { const s16x4 lo = *(const LAS s16x4*)(vrow), hi = *(const LAS s16x4*)(vrow + 8); O = MFMA32(__builtin_shufflevector(lo, hi, 0, 1, 2, 3, 4, 5, 6, 7), p0, O); }
        { const s16x4 lo = *(const LAS s16x4*)(vrow + 16), hi = *(const LAS s16x4*)(vrow + 24); O = MFMA32(__builtin_shufflevector(lo, hi, 0, 1, 2, 3, 4, 5, 6, 7), p1, O); }
        { const s16x4 lo = *(const LAS s16x4*)(vrow + 32), hi = *(const LAS s16x4*)(vrow + 40); O = MFMA32(__builtin_shufflevector(lo, hi, 0, 1, 2, 3, 4, 5, 6, 7), p2, O); }
        { const s16x4 lo = *(const LAS s16x4*)(vrow + 48), hi = *(const LAS s16x4*)(vrow + 56); O = MFMA32(__builtin_shufflevector(lo, hi, 0, 1, 2, 3, 4, 5, 6, 7), p3, O); }
    }
    { const bf16_t* sp = SpT + ((size_t)u * 128 + 32 * vb + r) * 128 + 8 * hh;
#pragma unroll
      for (int ks = 0; ks < 8; ++ks) { const bf16x8 a = *(const bf16x8*)(sp + 16 * ks), q = *(const LAS bf16x8*)(Qa + (32 * tb + r) * 136 + 16 * ks + 8 * hh); O = MFMA32(a, q, O); } }
#pragma unroll
    for (int g = 0; g < 4; ++g) { f32x4 w; w[0] = O[4 * g]; w[1] = O[4 * g + 1]; w[2] = O[4 * g + 2]; w[3] = O[4 * g + 3]; *(LAS f32x4*)(Ost + (32 * tb + r) * 132 + 32 * vb + 8 * g + 4 * hh) = w; }
    __syncthreads();
    { const int t = tid >> 3, vs = (tid & 7) * 16;
      f32x4 x[4]; float ss = 0.f;
#pragma unroll
      for (int j = 0; j < 4; ++j) { x[j] = *(const LAS f32x4*)(Ost + t * 132 + vs + 4 * j); ss += x[j][0] * x[j][0] + x[j][1] * x[j][1] + x[j][2] * x[j][2] + x[j][3] * x[j][3]; }
      ss += shflx(ss, 1, lane); ss += shflx(ss, 2, lane); ss += shflx(ss, 4, lane);
      const float rs = rsqrtf(ss * (1.f / 128.f) + EPS);
      if (t < hu.nvalid) {
          const size_t off = (size_t)(hu.rowbase + t) * 2048 + hu.h * 128 + vs;
          const u32x4 ga = *(const u32x4*)(HG + off), gb = *(const u32x4*)(HG + off + 8);
          const f32x4 n0 = *(const f32x4*)(gn + vs), n1 = *(const f32x4*)(gn + vs + 4), n2 = *(const f32x4*)(gn + vs + 8), n3 = *(const f32x4*)(gn + vs + 12);
          u32x4 oa, ob;
          oa.x = pk2(x[0][0] * rs * n0[0] * bflo(ga.x), x[0][1] * rs * n0[1] * bfhi(ga.x)); oa.y = pk2(x[0][2] * rs * n0[2] * bflo(ga.y), x[0][3] * rs * n0[3] * bfhi(ga.y));
          oa.z = pk2(x[1][0] * rs * n1[0] * bflo(ga.z), x[1][1] * rs * n1[1] * bfhi(ga.z)); oa.w = pk2(x[1][2] * rs * n1[2] * bflo(ga.w), x[1][3] * rs * n1[3] * bfhi(ga.w));
          ob.x = pk2(x[2][0] * rs * n2[0] * bflo(gb.x), x[2][1] * rs * n2[1] * bfhi(gb.x)); ob.y = pk2(x[2][2] * rs * n2[2] * bflo(gb.y), x[2][3] * rs * n2[3] * bfhi(gb.y));
          ob.z = pk2(x[3][0] * rs * n3[0] * bflo(gb.z), x[3][1] * rs * n3[1] * bfhi(gb.z)); ob.w = pk2(x[3][2] * rs * n3[2] * bflo(gb.w), x[3][3] * rs * n3[3] * bfhi(gb.w));
          *(u32x4*)(OH + off) = oa; *(u32x4*)(OH + off + 8) = ob;
      } }
    __syncthreads();
}

template <bool SAMPLE>
DI void attn_wave(const bf16_t* __restrict__ Qp, const bf16_t* __restrict__ Kn, const bf16_t* __restrict__ Kp, const bf16_t* __restrict__ Vt, int t0, int t1, int tstep, int nkeys,
                  float& m, float& l, f32x16 (&O)[4], int r, int hh) {
    const int lane = r + 32 * hh;
    bf16x8 qf[12];
#pragma unroll
    for (int s = 0; s < 12; ++s) qf[s] = *(const bf16x8*)(Qp + (size_t)r * 3072 + 16 * s + 8 * hh);
    m = -INFINITY; l = 0.f;
#pragma unroll
    for (int vb = 0; vb < 4; ++vb) O[vb] = zero16();
    for (int t = t0; t < t1; t += tstep) {
        const bf16_t* kn = Kn + (size_t)(64 * t + r) * 2048 + 8 * hh; const bf16_t* kp = Kp + (size_t)(64 * t + r) * 64 + 8 * hh;
        f32x16 S0 = zero16(), S1 = zero16();
#pragma unroll
        for (int s = 0; s < 8; ++s) { const bf16x8 a0 = *(const bf16x8*)(kn + 16 * s), a1 = *(const bf16x8*)(kn + 32 * 2048 + 16 * s); S0 = MFMA32(a0, qf[s], S0); S1 = MFMA32(a1, qf[s], S1); }
#pragma unroll
        for (int s = 0; s < 4; ++s) { const bf16x8 a0 = *(const bf16x8*)(kp + 16 * s), a1 = *(const bf16x8*)(kp + 32 * 64 + 16 * s); S0 = MFMA32(a0, qf[8 + s], S0); S1 = MFMA32(a1, qf[8 + s], S1); }
        if (SAMPLE) { if (64 * t + 64 > nkeys) {
#pragma unroll
            for (int i = 0; i < 16; ++i) { if (64 * t + crow(i, hh) >= nkeys) S0[i] = -INFINITY; if (64 * t + 32 + crow(i, hh) >= nkeys) S1[i] = -INFINITY; } } }
        float mx = fmaxf(S0[0], S1[0]);
#pragma unroll
        for (int i = 1; i < 16; ++i) mx = fmaxf(mx, fmaxf(S0[i], S1[i]));
        mx = fmaxf(mx, shflx(mx, 32, lane));
        const float mn = fmaxf(m, mx), alpha = ex2(m - mn); m = mn;
        float ls = 0.f;
#pragma unroll
        for (int i = 0; i < 16; ++i) { S0[i] = ex2(S0[i] - mn); S1[i] = ex2(S1[i] - mn); ls += S0[i] + S1[i]; }
        l = l * alpha + ls;
#pragma unroll
        for (int vb = 0; vb < 4; ++vb) O[vb] = O[vb] * alpha;
        const bf16x8 p0 = pack8<0>(S0), p1 = pack8<1>(S0), p2 = pack8<0>(S1), p3 = pack8<1>(S1);
#pragma unroll
        for (int vb = 0; vb < 4; ++vb) {
            const bf16_t* vp = Vt + (size_t)(32 * vb + r) * KVR + 64 * t + 4 * hh;
            { const s16x4 lo = *(const s16x4*)(vp), hi = *(const s16x4*)(vp + 8); O[vb] = MFMA32(__builtin_shufflevector(lo, hi, 0, 1, 2, 3, 4, 5, 6, 7), p0, O[vb]); }
            { const s16x4 lo = *(const s16x4*)(vp + 16), hi = *(const s16x4*)(vp + 24); O[vb] = MFMA32(__builtin_shufflevector(lo, hi, 0, 1, 2, 3, 4, 5, 6, 7), p1, O[vb]); }
            { const s16x4 lo = *(const s16x4*)(vp + 32), hi = *(const s16x4*)(vp + 40); O[vb] = MFMA32(__builtin_shufflevector(lo, hi, 0, 1, 2, 3, 4, 5, 6, 7), p2, O[vb]); }
            { const s16x4 lo = *(const s16x4*)(vp + 48), hi = *(const s16x4*)(vp + 56); O[vb] = MFMA32(__builtin_shufflevector(lo, hi, 0, 1, 2, 3, 4, 5, 6, 7), p3, O[vb]); }
        }
    }
}
DI void attn_prompt_unit(const Params& P, int bh, int jq, int wave, int lane) {
    const bf16_t* Q = (const bf16_t*)(P.ws + WS_Q); const bf16_t* KN = (const bf16_t*)(P.ws + WS_KN); const bf16_t* KPE = (const bf16_t*)(P.ws + WS_KPE); const bf16_t* VT = (const bf16_t*)(P.ws + WS_VT);
    bf16_t* OA = (bf16_t*)(P.ws + WS_OA);
    const int b = bh >> 4, h = bh & 15, rb = 8 * jq + wave, row0 = b * 2048 + 32 * rb, kv0 = b * 2048, r = lane & 31, hh = lane >> 5;
    float m, l; f32x16 O[4];
    attn_wave<false>(Q + (size_t)row0 * 3072 + h * 192, KN + (size_t)kv0 * 2048 + h * 128, KPE + (size_t)kv0 * 64, VT + (size_t)(h * 128) * KVR + kv0, 0, (rb >> 1) + 1, 1, 0, m, l, O, r, hh);
    l += shflx(l, 32, lane); const float inv = 1.f / l;
#pragma unroll
    for (int vb = 0; vb < 4; ++vb)
#pragma unroll
        for (int g = 0; g < 4; ++g) { u32x2 w; w.x = pk2(O[vb][4 * g] * inv, O[vb][4 * g + 1] * inv); w.y = pk2(O[vb][4 * g + 2] * inv, O[vb][4 * g + 3] * inv);
            *(u32x2*)(OA + (size_t)(row0 + r) * 2048 + h * 128 + 32 * vb + 8 * g + 4 * hh) = w; }
}
constexpr int ATT_KB = 64 * 400, ATT_VB = 128 * 136, ATT_BUF = ATT_KB + ATT_VB;
DI void attn_prompt_lds(LAS unsigned char* lds, const Params& P, int bh, int jq, int wave, int lane, int tid) {
    const bf16_t* Q = (const bf16_t*)(P.ws + WS_Q); const bf16_t* KN = (const bf16_t*)(P.ws + WS_KN); const bf16_t* KPE = (const bf16_t*)(P.ws + WS_KPE); const bf16_t* VT = (const bf16_t*)(P.ws + WS_VT);
    bf16_t* OA = (bf16_t*)(P.ws + WS_OA);
    const int b = bh >> 4, h = bh & 15, rb = 8 * jq + wave, row0 = b * 2048 + 32 * rb, kv0 = b * 2048, r = lane & 31, hh = lane >> 5;
    const int ntiles = 4 * jq + 4, mytiles = (rb >> 1) + 1;
    const bf16_t* gk0 = KN + (size_t)(kv0 + (tid >> 4)) * 2048 + h * 128 + (tid & 15) * 8;
    const bf16_t* gkp = KPE + (size_t)(kv0 + (tid >> 3)) * 64 + (tid & 7) * 8;
    const bf16_t* gv0 = VT + (size_t)(h * 128 + (tid >> 3)) * KVR + kv0 + (tid & 7) * 8;
    const int lk0 = (tid >> 4) * 400 + (tid & 15) * 16, lkp = (tid >> 3) * 400 + 256 + (tid & 7) * 16, lv0 = ATT_KB + (tid >> 3) * 136 + (tid & 7) * 16;
    u32x4 sk0, sk1, skp, sv0, sv1;
#define ATT_LOAD(t) do { const size_t ko = (size_t)(64 * (t)) * 2048, po = (size_t)(64 * (t)) * 64, vo = (size_t)(64 * (t)); \
        sk0 = *(const u32x4*)(gk0 + ko); sk1 = *(const u32x4*)(gk0 + ko + 32 * 2048); skp = *(const u32x4*)(gkp + po); sv0 = *(const u32x4*)(gv0 + vo); sv1 = *(const u32x4*)(gv0 + vo + (size_t)64 * KVR); } while (0)
#define ATT_STORE(buf) do { LAS unsigned char* bb = lds + (buf) * ATT_BUF; \
        *(LAS u32x4*)(bb + lk0) = sk0; *(LAS u32x4*)(bb + lk0 + 32 * 400) = sk1; *(LAS u32x4*)(bb + lkp) = skp; \
        { u32x2 a_, b_; a_.x = sv0.x; a_.y = sv0.y; b_.x = sv0.z; b_.y = sv0.w; *(LAS u32x2*)(bb + lv0) = a_; *(LAS u32x2*)(bb + lv0 + 8) = b_; \
          a_.x = sv1.x; a_.y = sv1.y; b_.x = sv1.z; b_.y = sv1.w; *(LAS u32x2*)(bb + lv0 + 64 * 136) = a_; *(LAS u32x2*)(bb + lv0 + 64 * 136 + 8) = b_; } } while (0)
    ATT_LOAD(0);
    bf16x8 qf[12];
    { const bf16_t* Qp = Q + (size_t)row0 * 3072 + h * 192;
#pragma unroll
      for (int s = 0; s < 12; ++s) qf[s] = *(const bf16x8*)(Qp + (size_t)r * 3072 + 16 * s + 8 * hh); }
    float m = -INFINITY, l = 0.f; f32x16 O[4];
#pragma unroll
    for (int vb = 0; vb < 4; ++vb) O[vb] = zero16();
    ATT_STORE(0);
    __syncthreads();
    for (int t = 0; t < ntiles; ++t) {
        if (t + 1 < ntiles) ATT_LOAD(t + 1);
        if (t < mytiles) {
            const LAS unsigned char* kb_ = lds + (t & 1) * ATT_BUF; const LAS unsigned char* vb_ = kb_ + ATT_KB;
            const LAS bf16_t* kr = (const LAS bf16_t*)(kb_ + r * 400 + 16 * hh);
            f32x16 S0 = zero16(), S1 = zero16();
#pragma unroll
            for (int s = 0; s < 12; ++s) { const bf16x8 a0 = *(const LAS bf16x8*)(kr + 16 * s), a1 = *(const LAS bf16x8*)(kr + 32 * 200 + 16 * s); S0 = MFMA32(a0, qf[s], S0); S1 = MFMA32(a1, qf[s], S1); }
            float mx = fmaxf(S0[0], S1[0]);
#pragma unroll
            for (int i = 1; i < 16; ++i) mx = fmaxf(mx, fmaxf(S0[i], S1[i]));
            mx = fmaxf(mx, shflx(mx, 32, lane));
            const float mn = fmaxf(m, mx), alpha = ex2(m - mn); m = mn;
            float ls = 0.f;
#pragma unroll
            for (int i = 0; i < 16; ++i) { S0[i] = ex2(S0[i] - mn); S1[i] = ex2(S1[i] - mn); ls += S0[i] + S1[i]; }
            l = l * alpha + ls;
#pragma unroll
            for (int vb = 0; vb < 4; ++vb) O[vb] = O[vb] * alpha;
            const bf16x8 p0 = pack8<0>(S0), p1 = pack8<1>(S0), p2 = pack8<0>(S1), p3 = pack8<1>(S1);
#pragma unroll
            for (int vb = 0; vb < 4; ++vb) {
                const LAS bf16_t* vp = (const LAS bf16_t*)(vb_ + (32 * vb + r) * 136 + 8 * hh);
                { const s16x4 lo = *(const LAS s16x4*)(vp), hi = *(const LAS s16x4*)(vp + 8); O[vb] = MFMA32(__builtin_shufflevector(lo, hi, 0, 1, 2, 3, 4, 5, 6, 7), p0, O[vb]); }
                { const s16x4 lo = *(const LAS s16x4*)(vp + 16), hi = *(const LAS s16x4*)(vp + 24); O[vb] = MFMA32(__builtin_shufflevector(lo, hi, 0, 1, 2, 3, 4, 5, 6, 7), p1, O[vb]); }
                { const s16x4 lo = *(const LAS s16x4*)(vp + 32), hi = *(const LAS s16x4*)(vp + 40); O[vb] = MFMA32(__builtin_shufflevector(lo, hi, 0, 1, 2, 3, 4, 5, 6, 7), p2, O[vb]); }
                { const s16x4 lo = *(const LAS s16x4*)(vp + 48), hi = *(const LAS s16x4*)(vp + 56); O[vb] = MFMA32(__builtin_shufflevector(lo, hi, 0, 1, 2, 3, 4, 5, 6, 7), p3, O[vb]); }
            }
        }
        if (t + 1 < ntiles) ATT_STORE((t + 1) & 1);
        __syncthreads();
    }
#undef ATT_LOAD
#undef ATT_STORE
    l += shflx(l, 32, lane); const float inv = 1.f / l;
#pragma unroll
    for (int vb = 0; vb < 4; ++vb)
#pragma unroll
        for (int g = 0; g < 4; ++g) { u32x2 w; w.x = pk2(O[vb][4 * g] * inv, O[vb][4 * g + 1] * inv); w.y = pk2(O[vb][4 * g + 2] * inv, O[vb][4 * g + 3] * inv);
            *(u32x2*)(OA + (size_t)(row0 + r) * 2048 + h * 128 + 32 * vb + 8 * g + 4 * hh) = w; }
}
DI void attn_sample_unit(LAS unsigned char* lds, const Params& P, int su, int wave, int lane, int tid) {
    const bf16_t* Q = (const bf16_t*)(P.ws + WS_Q); const bf16_t* KN = (const bf16_t*)(P.ws + WS_KN); const bf16_t* KPE = (const bf16_t*)(P.ws + WS_KPE); const bf16_t* VT = (const bf16_t*)(P.ws + WS_VT);
    bf16_t* OA = (bf16_t*)(P.ws + WS_OA);
    const int b = su >> 4, h = su & 15, row0 = MP + b * 32, kv0 = MP + b * KVB, r = lane & 31, hh = lane >> 5;
    float m, l; f32x16 O[4];
    attn_wave<true>(Q + (size_t)row0 * 3072 + h * 192, KN + (size_t)kv0 * 2048 + h * 128, KPE + (size_t)kv0 * 64, VT + (size_t)(h * 128) * KVR + kv0, wave, 65, 8, 4128, m, l, O, r, hh);
    l += shflx(l, 32, lane);
    LAS float* ml = (LAS float*)(lds + 131072);
    if (hh == 0) { ml[(wave * 32 + r) * 2] = m; ml[(wave * 32 + r) * 2 + 1] = l; }
    __syncthreads();
    float ms = -INFINITY;
#pragma unroll
    for (int w = 0; w < 8; ++w) ms = fmaxf(ms, ml[(w * 32 + r) * 2]);
    float L = 0.f;
#pragma unroll
    for (int w = 0; w < 8; ++w) L += ml[(w * 32 + r) * 2 + 1] * ex2(ml[(w * 32 + r) * 2] - ms);
    const float sc = ex2(m - ms) / L;
    LAS float* slot = (LAS float*)(lds + wave * 16384);
#pragma unroll
    for (int vb = 0; vb < 4; ++vb)
#pragma unroll
        for (int i = 0; i < 16; ++i) slot[(32 * vb + crow(i, hh)) * 32 + r] = O[vb][i] * sc;
    __syncthreads();
    { const int q = tid & 31, vg = tid >> 5; float a[8];
#pragma unroll
      for (int e = 0; e < 8; ++e) { float s = 0.f;
#pragma unroll
          for (int w = 0; w < 8; ++w) s += ((const LAS float*)(lds + w * 16384))[(8 * vg + e) * 32 + q];
          a[e] = s; }
      u32x4 o; o.x = pk2(a[0], a[1]); o.y = pk2(a[2], a[3]); o.z = pk2(a[4], a[5]); o.w = pk2(a[6], a[7]);
      *(u32x4*)(OA + (size_t)(row0 + q) * 2048 + h * 128 + 8 * vg) = o; }
    __syncthreads();
}

#define XB_TMO      128
#define XB_XCNT(j)  (256  + 64 * (j))
#define XB_XSUB(j)  (1280 + 64 * (j))
#define XB_XGEN(j)  (2304 + 64 * (j))
#define XB_TOP      3328
#define XB_TOPGEN   3392
#define XCD_BAR_WORDS 3456
#define XB_SPIN_CAP (1u << 18)

__device__ __forceinline__ unsigned xb_ld(unsigned* p)              { return __hip_atomic_load(p, __ATOMIC_RELAXED, __HIP_MEMORY_SCOPE_AGENT); }
__device__ __forceinline__ unsigned xb_add(unsigned* p, unsigned v) { return __hip_atomic_fetch_add(p, v, __ATOMIC_RELAXED, __HIP_MEMORY_SCOPE_AGENT); }
__device__ __forceinline__ unsigned xb_xcc_id() { return (unsigned)__builtin_amdgcn_s_getreg((3 << 11) | 20) & 0xFu; }
#define XB_SPIN(cond, bar) do { unsigned _sp = 0; while (cond) { __builtin_amdgcn_s_sleep(1); \
    if ((++_sp & 255u) == 0u) { if (xb_ld(&(bar)[XB_TMO])) break; if (_sp > XB_SPIN_CAP) { atomicAdd(&(bar)[XB_TMO], 1u); break; } } } } while (0)

struct XcdBarrier {
    unsigned* bar; unsigned x;
    volatile LAS unsigned* st;
};

__device__ __forceinline__ XcdBarrier xcd_barrier_post(unsigned* bar, volatile LAS unsigned* st, bool t0) {
    XcdBarrier b; b.bar = bar; b.x = xb_xcc_id(); b.st = st;
    if (t0) (void)xb_add(&bar[XB_XCNT(b.x)], 1u);
    return b;
}
__device__ __forceinline__ void xcd_barrier_complete(unsigned* bar, unsigned x, unsigned& nloc, unsigned& nx) {
    const unsigned G = gridDim.x * gridDim.y * gridDim.z;
    unsigned sum, cnt, mine, sp = 0u;
    for (;;) {
        sum = 0u; cnt = 0u; mine = 0u;
#pragma unroll
        for (unsigned j = 0; j < 16; ++j) { const unsigned c = xb_ld(&bar[XB_XCNT(j)]); sum += c; cnt += (c > 0u) ? 1u : 0u; mine = (j == x) ? c : mine; }
        if (sum == G) break;
        __builtin_amdgcn_s_sleep(1);
        if ((++sp & 255u) == 0u) { if (xb_ld(&bar[XB_TMO])) break; if (sp > XB_SPIN_CAP) { atomicAdd(&bar[XB_TMO], 1u); break; } }
    }
    nloc = mine > 0u ? mine : 1u; nx = cnt > 0u ? cnt : 1u;
}

__device__ __forceinline__ void xcd_barrier(const XcdBarrier& b, bool t0) {
    asm volatile("s_waitcnt vmcnt(0)" ::: "memory");
    __syncthreads();
    if (t0) {
        unsigned* bar = b.bar;
        __builtin_amdgcn_s_waitcnt(0);
        unsigned nloc = b.st[0], nx = b.st[1];
        if (nloc == 0u) { xcd_barrier_complete(bar, b.x, nloc, nx); b.st[0] = nloc; b.st[1] = nx; }
        const unsigned old = xb_add(&bar[XB_XSUB(b.x)], 1u);
        const unsigned gen = old / nloc;
        if (old + 1u == (gen + 1u) * nloc) {
            __builtin_amdgcn_fence(__ATOMIC_RELEASE, "agent");
            asm volatile("s_waitcnt vmcnt(0)" ::: "memory");
            const unsigned og = xb_add(&bar[XB_TOP], 1u);
            const unsigned tg = og / nx;
            if (og + 1u == (tg + 1u) * nx) xb_add(&bar[XB_TOPGEN], 1u);
            else XB_SPIN(xb_ld(&bar[XB_TOPGEN]) == tg, bar);
            __builtin_amdgcn_fence(__ATOMIC_ACQUIRE, "agent");
            xb_add(&bar[XB_XGEN(b.x)], 1u);
            asm volatile("s_waitcnt vmcnt(0)" ::: "memory");
        } else {
            XB_SPIN(xb_ld(&bar[XB_XGEN(b.x)]) == gen, bar);
            __builtin_amdgcn_fence(__ATOMIC_ACQUIRE, "agent");
            asm volatile("s_waitcnt vmcnt(0)" ::: "memory");
        }
    }
    __syncthreads();
}

constexpr int LDS_BYTES = 147456;
template <class Epi> DI void run_gemm_(LAS unsigned char* lds, const bf16_t* A, const bf16_t* Bt, int M_, int N_, int K_, int G, int c, const Epi& E, int tid) {
    pg8::Gemm g{A, Bt, M_, N_, K_, K_}; pg8::StaticOrder S; S.init(M_, N_, G, c);
    pg8::gemm_phase<Epi, pg8::StaticOrder, true, true>(lds, g, S, E, tid);
}
DI void run_tail_(LAS unsigned char* lds, const bf16_t* A, const bf16_t* Bt, int N_, int K_, int KS, float* slab, int G, int c, int tid) {
    pg8::Gemm g{A, Bt, MTOK, N_, K_, K_ / KS}; pg8::TailOrder S{MP / 256, N_ / 256, KS, K_ / KS, G, c}; pg8::EpiSlab E{slab, N_, K_ / KS};
    pg8::gemm_phase<pg8::EpiSlab, pg8::TailOrder, true, true>(lds, g, S, E, tid);
}

#define run_gemm(...) run_gemm_(__VA_ARGS__, tid)
#define run_tail(...) run_tail_(__VA_ARGS__, tid)
typedef const __attribute__((address_space(4))) Params CParams;
#define PHASE_BEGIN \
    Params P; { CParams* pp_ = (CParams*)__builtin_amdgcn_kernarg_segment_ptr(); asm volatile("" : "+s"(pp_)); _Pragma("unroll") for (int i_ = 0; i_ < 22; ++i_) P.in[i_] = pp_->in[i_]; P.out = pp_->out; P.ws = pp_->ws; } \
    int lane_l; asm volatile("v_mbcnt_lo_u32_b32 %0, -1, 0\n\tv_mbcnt_hi_u32_b32 %0, -1, %0" : "=v"(lane_l)); int wave_l = wave_s; asm volatile("" : "+s"(wave_l)); \
    const int tid = wave_l * 64 + lane_l; int G = gridDim.x, bx = blockIdx.x; asm volatile("" : "+s"(G), "+s"(bx)); \
    const int lane = lane_l, wave = wave_l; \
    const int vcu = (G % 8 == 0) ? (bx % 8) * (G / 8) + bx / 8 : bx;       \
    const int gw = vcu * 8 + wave, NGW = G * 8, gt = bx * 512 + tid, NGT = G * 512; \
    unsigned char* ws = P.ws; (void)lane; (void)gw; (void)NGW; (void)gt; (void)NGT; (void)ws;

__global__ void __launch_bounds__(512, 2) fwd_kernel(Params Pk) {
    extern __shared__ __attribute__((aligned(16))) unsigned char lds_raw[];
    LAS unsigned char* lds = (LAS unsigned char*)lds_raw;
    cg::grid_group grid = cg::this_grid();
    const int wave_s = __builtin_amdgcn_readfirstlane((int)threadIdx.x >> 6);
#ifndef PROBE
#define PROBE 0
#endif
#define GSYNC() do { for (int rs_ = 0; rs_ < ((PROBE & 4) ? 2 : 1); ++rs_) { XcdBarrier xb_ = xbar; asm volatile("" : "+s"(xb_.bar)); int ln_; asm volatile("v_mbcnt_lo_u32_b32 %0, -1, 0\n\tv_mbcnt_hi_u32_b32 %0, -1, %0" : "=v"(ln_)); xcd_barrier(xb_, wave_s == 0 && ln_ == 0); } } while (0)
    const int tid0_ = threadIdx.x;
    if (tid0_ < 64) ((LAS unsigned*)(lds + 131072 + 8192))[tid0_] = 0u;
    __syncthreads();
    XcdBarrier xbar = xcd_barrier_post((unsigned*)(Pk.ws + WS_CTL), (volatile LAS unsigned*)(lds + 131072 + 8192), tid0_ == 0);
    { PHASE_BEGIN
      for (int rep = 0; rep < ((PROBE & 8) ? 2 : 1); ++rep) {
      layer_prep(P, lds, 0, gw, NGW, gt, NGT, lane, wave);
      rope_table(P, gt, NGT);
      init_x(P, gw, NGW, lane); } }
    __threadfence(); grid.sync(); __threadfence();
    for (int l = 0; l < 2; ++l) {
        { PHASE_BEGIN
          pg8::EpiWin E{(float*)(ws + WS_ZS), (bf16_t*)(ws + WS_HQ), (bf16_t*)(ws + WS_HK), (bf16_t*)(ws + WS_HV), (bf16_t*)(ws + WS_HG), (bf16_t*)(ws + WS_GA), (bf16_t*)(ws + WS_GB), (float*)(ws + WS_LF), (const float*)(ws + WS_LB)};
          run_gemm(lds, (const bf16_t*)(ws + WS_XN), (const bf16_t*)(ws + WS_WIN), MTOK, DINP, 2048, G, bx, E); }
        GSYNC();
        { PHASE_BEGIN
          for (int rep = 0; rep < ((PROBE & 8) ? 2 : 1); ++rep) small_norms(P, l, gw, NGW, lane);
          for (int rep = 0; rep < ((PROBE & 2) ? 2 : 1); ++rep)
          for (int u = vcu; u < NU; u += G) hgrn_pass1(lds, (const float*)(ws + WS_LF), (const bf16_t*)(ws + WS_HK), (const bf16_t*)(ws + WS_HV), (bf16_t*)(ws + WS_UT), (float*)(ws + WS_D), u, tid); }
        GSYNC();
        { PHASE_BEGIN
          for (int rep = 0; rep < ((PROBE & 2) ? 2 : 1); ++rep)
          for (int x = vcu; x < 768; x += G) hgrn_pass2(lds, P, l, x, tid); }
        GSYNC();
        { PHASE_BEGIN
          for (int rep = 0; rep < ((PROBE & 2) ? 2 : 1); ++rep)
          for (int u = vcu; u < NU; u += G) hgrn_pass3(lds, (const float*)(ws + WS_LF), (const bf16_t*)(ws + WS_HQ), (const bf16_t*)(ws + WS_HK), (const bf16_t*)(ws + WS_HV), (const bf16_t*)(ws + WS_HG),
                                                       (const bf16_t*)(ws + WS_SPT), P.in[14] + l * 128, (bf16_t*)(ws + WS_OH), u, tid); }
        GSYNC();
        { PHASE_BEGIN
          pg8::EpiQ E{(bf16_t*)(ws + WS_Q), (const float*)(ws + WS_TBL)}; run_gemm(lds, (const bf16_t*)(ws + WS_QN), (const bf16_t*)(ws + WS_WUQ), MTOK, 3072, 512, G, bx, E); }
        { PHASE_BEGIN
          pg8::EpiPlain E{(bf16_t*)(ws + WS_KN), 2048}; run_gemm(lds, (const bf16_t*)(ws + WS_CKV), (const bf16_t*)(ws + WS_WUK), KVR, 2048, 512, G, (bx + 116) % G, E); }
        { PHASE_BEGIN
          pg8::EpiPlain E{(bf16_t*)(ws + WS_VT), KVR}; run_gemm(lds, (const bf16_t*)(ws + WS_WUV), (const bf16_t*)(ws + WS_CKV), 2048, KVR, 512, G, (bx + 100) % G, E); }
        GSYNC();
        { PHASE_BEGIN
          for (int rep = 0; rep < ((PROBE & 1) ? 2 : 1); ++rep) {
          for (int x = vcu; x < 256; x += G) { const int bh = x & 63, grp = x >> 6;
              const int code = grp == 0 ? 0x41 : grp == 1 ? 0x032 : grp == 2 ? 0x1273 : 0x562;
              if (grp < 2) attn_sample_unit(lds, P, x, wave, lane, tid);
              for (int i = 0; i < (code & 15); ++i) attn_prompt_lds(lds, P, bh, (code >> (4 + 4 * i)) & 15, wave, lane, tid); } } }
        GSYNC();
        { PHASE_BEGIN
          pg8::EpiGate<false> E{(const bf16_t*)(ws + WS_GA), (bf16_t*)(ws + WS_T)}; run_gemm(lds, (const bf16_t*)(ws + WS_OA), (const bf16_t*)(ws + WS_WOA), MP, 2048, 2048, G, bx, E); }
        { PHASE_BEGIN
          run_tail(lds, (const bf16_t*)(ws + WS_OA), (const bf16_t*)(ws + WS_WOA), 2048, 2048, 16, (float*)(ws + WS_SLAB0), G, bx); }
        { PHASE_BEGIN
          pg8::EpiGate<true> E{(const bf16_t*)(ws + WS_GB), (bf16_t*)(ws + WS_T)}; run_gemm(lds, (const bf16_t*)(ws + WS_OH), (const bf16_t*)(ws + WS_WOB), MP, 2048, 2048, G, bx, E); }
        { PHASE_BEGIN
          run_tail(lds, (const bf16_t*)(ws + WS_OH), (const bf16_t*)(ws + WS_WOB), 2048, 2048, 16, (float*)(ws + WS_SLAB1), G, (bx + G / 2) % G); }
        GSYNC();
        { PHASE_BEGIN
          for (int x = vcu; x < 64; x += G) { const int pn = x >> 3, mk = 1 << (x & 7);
              { pg8::EpiGate<false> E{(const bf16_t*)(ws + WS_GA), (bf16_t*)(ws + WS_T)}; pg8::tail_fixup(( const float*)(ws + WS_SLAB0), 16, 2048, MP / 256, pn, mk, E, tid); }
              { pg8::EpiGate<true> E{(const bf16_t*)(ws + WS_GB), (bf16_t*)(ws + WS_T)}; pg8::tail_fixup((const float*)(ws + WS_SLAB1), 16, 2048, MP / 256, pn, mk, E, tid); } } }
        GSYNC();
        for (int repI = 0; repI < ((PROBE & 32) ? 2 : 1); ++repI) {
        { PHASE_BEGIN
          pg8::EpiF32 E{(float*)(ws + WS_MIX), 2048}; run_gemm(lds, (const bf16_t*)(ws + WS_T), (const bf16_t*)(ws + WS_WOUT), MP, 2048, 2048, G, bx, E); }
        { PHASE_BEGIN
          run_tail(lds, (const bf16_t*)(ws + WS_T), (const bf16_t*)(ws + WS_WOUT), 2048, 2048, 16, (float*)(ws + WS_SLAB0), G, bx); }
        GSYNC();
        }
        { PHASE_BEGIN
          resid_norm((const float*)(ws + WS_MIX), P.in[17] + l * 2048, P.out, P.in[18] + l * 2048, (bf16_t*)(ws + WS_XN), gw, NGW, lane);
          resid_norm_tail(lds, (const float*)(ws + WS_SLAB0), 16, P.in[17] + l * 2048, P.out, P.in[18] + l * 2048, (bf16_t*)(ws + WS_XN), vcu, G, wave, lane); }
        GSYNC();
        for (int repK = 0; repK < ((PROBE & 16) ? 2 : 1); ++repK) {
        { PHASE_BEGIN
          pg8::EpiRelu2 E{(bf16_t*)(ws + WS_H), FFN}; run_gemm(lds, (const bf16_t*)(ws + WS_XN), (const bf16_t*)(ws + WS_WUP), MP, FFN, 2048, G, bx, E); }
        { PHASE_BEGIN
          run_tail(lds, (const bf16_t*)(ws + WS_XN), (const bf16_t*)(ws + WS_WUP), FFN, 2048, 4, (float*)(ws + WS_SLAB0), G, bx); }
        GSYNC();
        { PHASE_BEGIN
          for (int x = vcu; x < 256; x += G) { pg8::EpiRelu2 E{(bf16_t*)(ws + WS_H), FFN}; pg8::tail_fixup((const float*)(ws + WS_SLAB0), 4, FFN, MP / 256, x >> 3, 1 << (x & 7), E, tid); } }
        GSYNC();
        }
        { PHASE_BEGIN
          pg8::EpiF32 E{(float*)(ws + WS_M2), 2048}; run_gemm(lds, (const bf16_t*)(ws + WS_H), (const bf16_t*)(ws + WS_WDN), MP, 2048, FFN, G, bx, E); }
        { PHASE_BEGIN
          run_tail(lds, (const bf16_t*)(ws + WS_H), (const bf16_t*)(ws + WS_WDN), 2048, FFN, 16, (float*)(ws + WS_SLAB0), G, bx); }
        GSYNC();
        { PHASE_BEGIN
          resid_norm((const float*)(ws + WS_M2), P.in[21] + l * 2048, P.out, l == 0 ? P.in[5] + 2048 : nullptr, (bf16_t*)(ws + WS_XN), gw, NGW, lane);
          resid_norm_tail(lds, (const float*)(ws + WS_SLAB0), 16, P.in[21] + l * 2048, P.out, l == 0 ? P.in[5] + 2048 : nullptr, (bf16_t*)(ws + WS_XN), vcu, G, wave, lane);
          if (l == 0) for (int rep = 0; rep < ((PROBE & 8) ? 2 : 1); ++rep) layer_prep(P, lds, 1, gw, NGW, gt, NGT, lane, wave); }
        if (l == 0) GSYNC();
    }
}

extern "C" void kernel_launch(void* const* d_in, const int* in_sizes, int n_in, void* d_out, int out_size, void* d_ws, size_t ws_size, hipStream_t stream) {
    static int grid = 0;
    if (grid == 0) {
        if (n_in != 22 || (size_t)out_size != OUT_TOTAL || ws_size < WS_END) { fprintf(stderr, "kernel_launch: unexpected shapes (n_in %d, out %d, ws %zu, need %zu)\n", n_in, out_size, ws_size, (size_t)WS_END); grid = -1; return; }
        int dev = 0, cus = 0, per_cu = 0;
        if (hipGetDevice(&dev) != hipSuccess || hipDeviceGetAttribute(&cus, hipDeviceAttributeMultiprocessorCount, dev) != hipSuccess) { grid = -1; return; }
        if (hipFuncSetAttribute((const void*)fwd_kernel, hipFuncAttributeMaxDynamicSharedMemorySize, LDS_BYTES) != hipSuccess) { fprintf(stderr, "kernel_launch: hipFuncSetAttribute failed\n"); grid = -1; return; }
        if (hipOccupancyMaxActiveBlocksPerMultiprocessor(&per_cu, (const void*)fwd_kernel, 512, LDS_BYTES) != hipSuccess || per_cu < 1) { fprintf(stderr, "kernel_launch: occupancy query failed (%d)\n", per_cu); per_cu = 1; }
        (void)hipGetLastError();
        grid = cus * per_cu;
    }
    if (grid < 0) return;
    if (hipMemsetAsync((char*)d_ws + WS_CTL, 0, 16384, stream) != hipSuccess) { fprintf(stderr, "kernel_launch: memset failed\n"); return; }
    Params p{};
    for (int i = 0; i < 22; ++i) p.in[i] = (const float*)d_in[i];
    p.out = (float*)d_out; p.ws = (unsigned char*)d_ws;
    void* args[] = {&p};
    hipError_t e = hipLaunchCooperativeKernel((const void*)fwd_kernel, dim3(grid), dim3(512), args, LDS_BYTES, stream);
    if (e != hipSuccess) fprintf(stderr, "kernel_launch: cooperative launch failed: %s (grid %d)\n", hipGetErrorString(e), grid);
}
```

```cpp
#include <hip/hip_runtime.h>
#include <hip/hip_cooperative_groups.h>
#include <cstdio>
#include <cstdint>
namespace cg = cooperative_groups;

#define DI __device__ __forceinline__
#define LAS __attribute__((address_space(3)))
typedef short bf16x8 __attribute__((ext_vector_type(8)));
typedef short s16x4 __attribute__((ext_vector_type(4)));
typedef float f32x4 __attribute__((ext_vector_type(4)));
typedef float f32x16 __attribute__((ext_vector_type(16)));
typedef unsigned u32x4 __attribute__((ext_vector_type(4)));
typedef unsigned u32x2 __attribute__((ext_vector_type(2)));
typedef float f32x2_t __attribute__((ext_vector_type(2)));
typedef __bf16 bf16x2_t __attribute__((ext_vector_type(2)));

constexpr int MP = 8192, MS = 256, MTOK = 8448, DM = 2048, DINP = 13568, ZSW = 1280, FFN = 8192;
constexpr int KVB = 4160;
constexpr int KVR = 8192 + 8 * KVB;
constexpr int NU = 2048 + 128;
constexpr float EPS = 1e-6f;
constexpr float QSCALE = 0.07216878364870322f * 1.4426950408889634f;

constexpr size_t MiB = 1u << 20;
constexpr size_t WS_WIN = 0, WS_WUQ = 53 * MiB, WS_WUK = 56 * MiB, WS_WUV = 58 * MiB, WS_WOA = 60 * MiB, WS_WOB = 68 * MiB, WS_WOUT = 76 * MiB, WS_WUP = 84 * MiB, WS_WDN = 116 * MiB;
constexpr size_t WS_XN = 148 * MiB, WS_HG = 181 * MiB, WS_GA = 214 * MiB, WS_GB = 247 * MiB, WS_QN = 280 * MiB, WS_Q = 289 * MiB, WS_OA = 339 * MiB, WS_OH = 372 * MiB;
constexpr size_t WS_CKV = 405 * MiB, WS_KPE = 446 * MiB, WS_TBL = 452 * MiB, WS_LB = 453 * MiB, WS_D = 454 * MiB, WS_R = 456 * MiB;
constexpr size_t WS_SPT = WS_Q;
constexpr size_t WS_ZS = WS_R, WS_HQ = WS_R + 42 * MiB, WS_HK = WS_R + 75 * MiB, WS_HV = WS_R + 108 * MiB, WS_LF = WS_R + 141 * MiB, WS_UT = WS_R + 207 * MiB;
constexpr size_t WS_KN = WS_R, WS_VT = WS_R + 162 * MiB;
constexpr size_t WS_T = WS_R, WS_MIX = WS_R + 33 * MiB, WS_H = WS_R + 99 * MiB, WS_M2 = WS_R + 231 * MiB;
constexpr size_t WS_SLAB0 = WS_Q, WS_SLAB1 = WS_R + 297 * MiB;
constexpr size_t WS_CTL = WS_R + 343 * MiB;
constexpr size_t WS_END = WS_CTL + 1 * MiB;
static_assert((size_t)NU * 128 * 128 * 2 <= 83 * MiB && (size_t)NU * 65536 <= 136 * MiB && (size_t)KVR * 2048 * 2 <= 162 * MiB, "ws map");

constexpr size_t OUT_X = 0, OUT_CKVP = 17301504, OUT_KPEP = OUT_CKVP + 8388608, OUT_STP = OUT_KPEP + 1048576, OUT_CKVS = OUT_STP + 2097152, OUT_KPES = OUT_CKVS + 262144, OUT_STS = OUT_KPES + 32768;
constexpr size_t OUT_TOTAL = OUT_STS + 4194304;

DI unsigned pk2(float lo, float hi) { f32x2_t v = {lo, hi}; bf16x2_t b = __builtin_convertvector(v, bf16x2_t); return __builtin_bit_cast(unsigned, b); }
DI unsigned short f2bf(float f) { return (unsigned short)(pk2(f, 0.f) & 0xffffu); }
DI float bf2f(unsigned short u) { return __uint_as_float((unsigned)u << 16); }
DI float bflo(unsigned w) { return __uint_as_float(w << 16); }
DI float bfhi(unsigned w) { return __uint_as_float(w & 0xffff0000u); }
DI float sigm(float x) { return 1.f / (1.f + __expf(-x)); }
DI float ex2(float x) { return __builtin_amdgcn_exp2f(x); }
DI float shflx(float v, int mask, int lane) { return __int_as_float(__builtin_amdgcn_ds_bpermute((lane ^ mask) << 2, __float_as_int(v))); }
DI float wave_sum(float v, int lane) {
#pragma unroll
    for (int o = 1; o < 64; o <<= 1) v += shflx(v, o, lane);
    return v;
}
namespace pg8 {
#define PG8_LAS __attribute__((address_space(3)))
typedef unsigned short bf16_t;
typedef short bf16x8 __attribute__((ext_vector_type(8)));
typedef float f32x4 __attribute__((ext_vector_type(4)));
typedef unsigned u32x4 __attribute__((ext_vector_type(4)));
constexpr int BM = 256, BK = 64, HALF = 128, HTB = HALF * BK * 2  , STAGE_BYTES = 8 * HTB, NXCD = 8, WGM = 8;

__host__ __device__ __forceinline__ int lds_byte(int r, int c) { const int st = (r >> 4) * 2 + (c >> 5), rr = r & 15, cc = c & 31, ob = rr * 64 + cc * 2; return st * 1024 + (ob ^ (((ob >> 9) & 1) << 5)); }
__host__ __device__ __forceinline__ void stage_rc(int b, int& R, int& C) { const int st = b / 1024, sb = b % 1024, swz = sb ^ (((sb >> 9) & 1) << 5); R = (st >> 1) * 16 + swz / 64; C = (st & 1) * 32 + (swz % 64) / 2; }
__host__ __device__ __forceinline__ int perm32(int rho) { const int n = rho >> 4, i = rho & 15; return 8 * (i >> 2) + 4 * n + (i & 3); }

struct Unit { int pm, pn, koff, mask; };
struct Gemm { const bf16_t* A; const bf16_t* Bt; int M, N, K, kext; };

struct StaticOrder {
    int nM, nN, nwg, G, c;
    __host__ __device__ void init(int M, int N, int G_, int c_) { nM = M / BM; nN = N / BM; nwg = nM * nN; G = G_; c = c_; }
    __host__ __device__ bool next(int i, Unit& u) const {
        const long L = (long)i * G + c; if (L >= nwg) return false;
        int wgid = (int)L; { const int q = nwg / NXCD, r = nwg % NXCD, xcd = wgid % NXCD, off = wgid / NXCD; wgid = (xcd < r ? xcd * (q + 1) : r * (q + 1) + (xcd - r) * q) + off; }
        const int nig = WGM * nN, gid = wgid / nig, fm = gid * WGM, gsz = (nM - fm) < WGM ? (nM - fm) : WGM;
        u.pm = fm + ((wgid % nig) % gsz); u.pn = (wgid % nig) / gsz; u.koff = 0; u.mask = 0xff; return true;
    }
    __device__ __forceinline__ void a_ready(const Unit&) const {}
    __device__ __forceinline__ void done(const Unit&) const {}
};

struct TailOrder {
    int pm, nN, KS, kext, G, c;
    __host__ __device__ bool next(int i, Unit& u) const { const int L = i * G + c; if (L >= nN * KS) return false; u.pm = pm; u.pn = L / KS; u.koff = (L - u.pn * KS) * kext; u.mask = 0xff; return true; }
    __device__ __forceinline__ void a_ready(const Unit&) const {}
    __device__ __forceinline__ void done(const Unit&) const {}
};
#define EPI_LOOP _Pragma("unroll") for (int ai = 0; ai < 2; ++ai) _Pragma("unroll") for (int m = 0; m < 4; ++m) if ((u.mask >> (ai * 4 + m)) & 1) _Pragma("unroll") for (int bj = 0; bj < 2; ++bj)
__device__ __forceinline__ u32x4 pack8f(const f32x4 a, const f32x4 b) { u32x4 w; w.x = pk2(a[0], a[1]); w.y = pk2(a[2], a[3]); w.z = pk2(b[0], b[1]); w.w = pk2(b[2], b[3]); return w; }

struct EpiWin {
    static constexpr bool PERM = true, AFTER_DRAIN = false;
    float* Zs; bf16_t *HQ, *HK, *HV, *HG, *GA, *GB; float* LF; const float* lb;
    __device__ __forceinline__ void operator()(const f32x4 (&acc)[2][2][4][2], const Unit& u, int wr, int wc, int fr, int fq) const {
        const int row0 = u.pm * 256 + wr * 64 + fr, ct = wc * 32 + 8 * fq, pn = u.pn;
        if (pn < 5) {
            EPI_LOOP { float* p = Zs + (size_t)(row0 + ai * 128 + m * 16) * ZSW + pn * 256 + ct + bj * 128; *(f32x4*)p = acc[ai][bj][m][0]; *(f32x4*)(p + 4) = acc[ai][bj][m][1]; }
            return;
        }
        const int seg = (pn - 5) >> 3, cseg = ((pn - 5) & 7) * 256 + ct;
        if (seg == 1) {
#pragma unroll
            for (int bj = 0; bj < 2; ++bj) {
                const f32x4 l0 = *(const f32x4*)(lb + cseg + bj * 128), l1 = *(const f32x4*)(lb + cseg + bj * 128 + 4);
#pragma unroll
                for (int ai = 0; ai < 2; ++ai)
#pragma unroll
                    for (int m = 0; m < 4; ++m) {
                        const size_t off = (size_t)(row0 + ai * 128 + m * 16) * 2048 + cseg + bj * 128;
                        f32x4 lf0, lf1, k0, k1;
#pragma unroll
                        for (int e = 0; e < 4; ++e) {
                            { const float z = acc[ai][bj][m][0][e], lbv = l0[e], ez = __expf(-z), sg = 1.f / (1.f + ez); lf0[e] = __logf(lbv + (1.f - lbv) * sg); k0[e] = (1.f - lbv) * ez * sg; }
                            { const float z = acc[ai][bj][m][1][e], lbv = l1[e], ez = __expf(-z), sg = 1.f / (1.f + ez); lf1[e] = __logf(lbv + (1.f - lbv) * sg); k1[e] = (1.f - lbv) * ez * sg; }
                        }
                        *(f32x4*)(LF + off) = lf0; *(f32x4*)(LF + off + 4) = lf1; *(u32x4*)(HK + off) = pack8f(k0, k1);
                    }
            }
            return;
        }
        bf16_t* O = seg == 0 ? HQ : seg == 2 ? HV : seg == 3 ? HG : seg == 4 ? GA : GB;
        const int act = (seg == 0 || seg == 3) ? 1 : (seg == 2 ? 0 : 2);
        EPI_LOOP {
            f32x4 a = acc[ai][bj][m][0], b = acc[ai][bj][m][1];
#pragma unroll
            for (int e = 0; e < 4; ++e) { const float sa = sigm(a[e]), sb = sigm(b[e]); a[e] = act == 0 ? a[e] : act == 1 ? a[e] * sa : sa; b[e] = act == 0 ? b[e] : act == 1 ? b[e] * sb : sb; }
            *(u32x4*)(O + (size_t)(row0 + ai * 128 + m * 16) * 2048 + cseg + bj * 128) = pack8f(a, b);
        }
    }
};

struct EpiQ {
    static constexpr bool PERM = true, AFTER_DRAIN = false;
    bf16_t* Q; const float* tbl;
    __device__ __forceinline__ void operator()(const f32x4 (&acc)[2][2][4][2], const Unit& u, int wr, int wc, int fr, int fq) const {
        const int row0 = u.pm * 256 + wr * 64 + fr, ct = wc * 32 + 8 * fq, pn = u.pn;
        if (pn < 8) {
            EPI_LOOP { const int col = pn * 256 + ct + bj * 128, h = col >> 7, i = col & 127;
                *(u32x4*)(Q + (size_t)(row0 + ai * 128 + m * 16) * 3072 + h * 192 + i) = pack8f(acc[ai][bj][m][0] * QSCALE, acc[ai][bj][m][1] * QSCALE); }
            return;
        }
        EPI_LOOP {
            const int row = row0 + ai * 128 + m * 16, p = row < MP ? (row & 2047) : 2048 + ((row - MP) & 31);
            const int c = (pn - 8) * 256 + ct + bj * 128, h = c >> 6, j0 = (c & 63) >> 1;
            const f32x4 t0 = *(const f32x4*)(tbl + (size_t)(p * 32 + j0) * 2), t1 = *(const f32x4*)(tbl + (size_t)(p * 32 + j0) * 2 + 4);
            const f32x4 x = acc[ai][bj][m][0] * QSCALE, y = acc[ai][bj][m][1] * QSCALE;
            const float a0 = x[0] * t0[0] - x[1] * t0[1], b0 = x[0] * t0[1] + x[1] * t0[0];
            const float a1 = x[2] * t0[2] - x[3] * t0[3], b1 = x[2] * t0[3] + x[3] * t0[2];
            const float a2 = y[0] * t1[0] - y[1] * t1[1], b2 = y[0] * t1[1] + y[1] * t1[0];
            const float a3 = y[2] * t1[2] - y[3] * t1[3], b3 = y[2] * t1[3] + y[3] * t1[2];
            bf16_t* q = Q + (size_t)row * 3072 + h * 192 + 128 + j0;
            u32x2 w1, w2; w1.x = pk2(a0, a1); w1.y = pk2(a2, a3); w2.x = pk2(b0, b1); w2.y = pk2(b2, b3);
            *(u32x2*)q = w1; *(u32x2*)(q + 32) = w2;
            if (bj == 1) asm volatile("" ::: "memory");
        }
    }
};

struct EpiPlain {
    static constexpr bool PERM = true, AFTER_DRAIN = false;
    bf16_t* O; int ldc;
    __device__ __forceinline__ void operator()(const f32x4 (&acc)[2][2][4][2], const Unit& u, int wr, int wc, int fr, int fq) const {
        const int row0 = u.pm * 256 + wr * 64 + fr, c0 = u.pn * 256 + wc * 32 + 8 * fq;
        EPI_LOOP { *(u32x4*)(O + (size_t)(row0 + ai * 128 + m * 16) * ldc + c0 + bj * 128) = pack8f(acc[ai][bj][m][0], acc[ai][bj][m][1]); }
    }
};
struct EpiF32 {
    static constexpr bool PERM = true, AFTER_DRAIN = false;
    float* O; int ldc;
    __device__ __forceinline__ void operator()(const f32x4 (&acc)[2][2][4][2], const Unit& u, int wr, int wc, int fr, int fq) const {
        const int row0 = u.pm * 256 + wr * 64 + fr, c0 = u.pn * 256 + wc * 32 + 8 * fq;
        EPI_LOOP { float* p = O + (size_t)(row0 + ai * 128 + m * 16) * ldc + c0 + bj * 128; *(f32x4*)p = acc[ai][bj][m][0]; *(f32x4*)(p + 4) = acc[ai][bj][m][1]; }
    }
};
struct EpiRelu2 {
    static constexpr bool PERM = true, AFTER_DRAIN = false;
    bf16_t* O; int ldc;
    __device__ __forceinline__ void operator()(const f32x4 (&acc)[2][2][4][2], const Unit& u, int wr, int wc, int fr, int fq) const {
        const int row0 = u.pm * 256 + wr * 64 + fr, c0 = u.pn * 256 + wc * 32 + 8 * fq;
        EPI_LOOP { f32x4 a = acc[ai][bj][m][0], b = acc[ai][bj][m][1];
#pragma unroll
            for (int e = 0; e < 4; ++e) { const float ra = fmaxf(a[e], 0.f), rb = fmaxf(b[e], 0.f); a[e] = ra * ra; b[e] = rb * rb; }
            *(u32x4*)(O + (size_t)(row0 + ai * 128 + m * 16) * ldc + c0 + bj * 128) = pack8f(a, b); }
    }
};
template <bool SECOND> struct EpiGate {
    static constexpr bool PERM = true, AFTER_DRAIN = false;
    const bf16_t* Gt; bf16_t* T;
    __device__ __forceinline__ void operator()(const f32x4 (&acc)[2][2][4][2], const Unit& u, int wr, int wc, int fr, int fq) const {
        const int row0 = u.pm * 256 + wr * 64 + fr, c0 = u.pn * 256 + wc * 32 + 8 * fq;
        EPI_LOOP { const size_t off = (size_t)(row0 + ai * 128 + m * 16) * 2048 + c0 + bj * 128;
            const u32x4 g = *(const u32x4*)(Gt + off); f32x4 a = acc[ai][bj][m][0], b = acc[ai][bj][m][1];
            a[0] *= bflo(g.x); a[1] *= bfhi(g.x); a[2] *= bflo(g.y); a[3] *= bfhi(g.y); b[0] *= bflo(g.z); b[1] *= bfhi(g.z); b[2] *= bflo(g.w); b[3] *= bfhi(g.w);
            if (SECOND) { const u32x4 t = *(const u32x4*)(T + off);
                a[0] += bflo(t.x); a[1] += bfhi(t.x); a[2] += bflo(t.y); a[3] += bfhi(t.y); b[0] += bflo(t.z); b[1] += bfhi(t.z); b[2] += bflo(t.w); b[3] += bfhi(t.w); }
            *(u32x4*)(T + off) = pack8f(a, b);
            if (bj == 1 && (m & 1)) asm volatile("" ::: "memory"); }
    }
};

struct EpiSlab {
    static constexpr bool PERM = true, AFTER_DRAIN = false;
    float* slab; int ldc, kext;
    __device__ __forceinline__ void operator()(const f32x4 (&acc)[2][2][4][2], const Unit& u, int wr, int wc, int fr, int fq) const {
        const int kp = u.koff / kext, r0 = wr * 64 + fr, c0 = u.pn * 256 + wc * 32 + 8 * fq;
        EPI_LOOP { float* p = slab + ((size_t)kp * 256 + r0 + ai * 128 + m * 16) * ldc + c0 + bj * 128; *(f32x4*)p = acc[ai][bj][m][0]; *(f32x4*)(p + 4) = acc[ai][bj][m][1]; }
    }
};
template <class Epi> __device__ __forceinline__ void tail_fixup(const float* slab, int KS, int ldc, int pm, int pn, int mask, const Epi& E, int tid_in) {
    Unit u; u.pm = pm; u.pn = pn; u.koff = 0; u.mask = mask;
    int tid_l = tid_in; asm volatile("" : "+v"(tid_l));
    const int wid = tid_l >> 6, lane = tid_l & 63, wr = wid >> 2, wc = wid & 3, fr = lane & 15, fq = lane >> 4;
    const int r0 = wr * 64 + fr, c0 = pn * 256 + wc * 32 + 8 * fq;
    f32x4 acc[2][2][4][2];
    EPI_LOOP { acc[ai][bj][m][0] = (f32x4){0.f, 0.f, 0.f, 0.f}; acc[ai][bj][m][1] = (f32x4){0.f, 0.f, 0.f, 0.f}; }
    const char* sb = (const char*)slab; unsigned off = ((unsigned)r0 * (unsigned)ldc + (unsigned)c0) * 4u;
    for (int kp = 0; kp < KS; ++kp) {
        EPI_LOOP { const char* p = sb + (off + (unsigned)((ai * 128 + m * 16) * ldc + bj * 128) * 4u); acc[ai][bj][m][0] += *(const f32x4*)p; acc[ai][bj][m][1] += *(const f32x4*)(p + 16); }
        off += 256u * (unsigned)ldc * 4u;
    }
    E(acc, u, wr, wc, fr, fq);
}
template <class Epi, class Sched, bool ALIGN_EPI = false, bool SP2 = false>
__device__ __forceinline__ void gemm_phase(PG8_LAS unsigned char* lds, const Gemm g, const Sched& S, const Epi& E, int tid_in) {
    int tid_l = tid_in; asm volatile("" : "+v"(tid_l));
    const int tid = tid_l, wid = __builtin_amdgcn_readfirstlane(tid >> 6), lane = tid & 63, wr = wid >> 2, wc = wid & 3, fr = lane & 15, fq = lane >> 4;
    const int K = g.K, nt = g.kext / BK;
    unsigned voffA[2], voffB[2];
#pragma unroll
    for (int i = 0; i < 2; ++i) { int R, C; stage_rc(tid * 16 + i * 8192, R, C); const int Rb = Epi::PERM ? ((R & ~31) + perm32(R & 31)) : R;
        voffA[i] = (unsigned)(R * K + C) * 2u; voffB[i] = (unsigned)(Rb * K + C) * 2u; }
    const size_t kstep = (size_t)(BK * 2);
    const size_t hstep = (size_t)HALF * K * 2;
    const size_t tstep = 2 * hstep;
    const unsigned ldsw = (unsigned)wid * 1024u;
    const int aoff = lds_byte(wr * 64 + fr, fq * 8), boff = lds_byte(wc * 32 + fr, fq * 8);
#define PG8_SA(b, h) (((b) * 2 + (h)) * HTB)
#define PG8_SB(b, h) ((4 + (b) * 2 + (h)) * HTB)
#define PG8_STAGE(bufoff, gbase, voff) do { _Pragma("unroll") for (int _i = 0; _i < 2; ++_i) \
        __builtin_amdgcn_global_load_lds((const unsigned*)((const char*)(gbase) + (voff)[_i]), (PG8_LAS unsigned*)(lds + (bufoff) + ldsw + _i * 8192), 16, 0, 0); } while (0)
#define PG8_LDA(dst, b, h) do { _Pragma("unroll") for (int m = 0; m < 4; ++m) _Pragma("unroll") for (int k = 0; k < 2; ++k) dst[m][k] = *(const PG8_LAS bf16x8*)(lds + PG8_SA(b, h) + aoff + m * 2048 + k * 1024); } while (0)
#define PG8_LDB(dst, b, h) do { _Pragma("unroll") for (int n = 0; n < 2; ++n) _Pragma("unroll") for (int k = 0; k < 2; ++k) dst[n][k] = *(const PG8_LAS bf16x8*)(lds + PG8_SB(b, h) + boff + n * 2048 + k * 1024); } while (0)
#define PG8_MMA(ai, bj, At, Bt) do { __builtin_amdgcn_s_setprio(1); _Pragma("unroll") for (int m = 0; m < 4; ++m) _Pragma("unroll") for (int n = 0; n < 2; ++n) _Pragma("unroll") for (int k = 0; k < 2; ++k) \
        acc[ai][bj][m][n] = __builtin_amdgcn_mfma_f32_16x16x32_bf16(Bt[n][k], At[m][k], acc[ai][bj][m][n], 0, 0, 0); __builtin_amdgcn_s_setprio(0); } while (0)
#define PG8_WAIT_V(n) asm volatile("s_waitcnt vmcnt(" #n ")" ::: "memory")
#define PG8_WAIT_L(n) asm volatile("s_waitcnt lgkmcnt(" #n ")" ::: "memory")
#define PG8_BAR __builtin_amdgcn_s_barrier()
#define PG8_SCHED __builtin_amdgcn_sched_barrier(0)
    Unit cur, nxt; int ui = 0;
    if (!S.next(0, cur)) return;
    f32x4 acc[2][2][4][2];
#pragma unroll
    for (int a = 0; a < 2; ++a)
#pragma unroll
        for (int b = 0; b < 2; ++b)
#pragma unroll
            for (int m = 0; m < 4; ++m)
#pragma unroll
                for (int n = 0; n < 2; ++n) acc[a][b][m][n] = (f32x4){0.f, 0.f, 0.f, 0.f};
    bf16x8 At[4][2], B0[2][2], B1[2][2];
    const char* cA = (const char*)g.A + (size_t)cur.pm * tstep + (size_t)cur.koff * 2; const char* cB = (const char*)g.Bt + (size_t)cur.pn * tstep + (size_t)cur.koff * 2;
    S.a_ready(cur);
    if constexpr (SP2) {
        PG8_STAGE(PG8_SB(0, 0), cB, voffB); PG8_STAGE(PG8_SB(0, 1), cB + hstep, voffB); PG8_STAGE(PG8_SA(0, 0), cA, voffA); PG8_STAGE(PG8_SA(0, 1), cA + hstep, voffA);
        if (wr == 1) PG8_BAR;
        PG8_WAIT_V(2); PG8_BAR;
        PG8_STAGE(PG8_SB(1, 0), cB + kstep, voffB); PG8_STAGE(PG8_SA(1, 0), cA + kstep, voffA); PG8_STAGE(PG8_SB(1, 1), cB + hstep + kstep, voffB);
        PG8_WAIT_V(6); PG8_BAR;
    } else {
        PG8_STAGE(PG8_SB(0, 0), cB, voffB); PG8_STAGE(PG8_SA(0, 0), cA, voffA); PG8_STAGE(PG8_SB(0, 1), cB + hstep, voffB); PG8_STAGE(PG8_SA(0, 1), cA + hstep, voffA);
        if (wr == 1) PG8_BAR;
        PG8_WAIT_V(4); PG8_BAR;
        PG8_STAGE(PG8_SB(1, 0), cB + kstep, voffB); PG8_STAGE(PG8_SA(1, 0), cA + kstep, voffA); PG8_STAGE(PG8_SB(1, 1), cB + hstep + kstep, voffB);
        PG8_WAIT_V(6); PG8_BAR;
    }
    for (;;) {
        const bool has_next = S.next(ui + 1, nxt);
        const char* nA = has_next ? (const char*)g.A + (size_t)nxt.pm * tstep + (size_t)nxt.koff * 2 : cA; const char* nB = has_next ? (const char*)g.Bt + (size_t)nxt.pn * tstep + (size_t)nxt.koff * 2 : cB;
        for (int t = 0; t < nt; t += 2) {
            const bool last = (t == nt - 2);
            const char* a1 = cA + (size_t)(t + 1) * kstep;
            const char* a2 = last ? nA : cA + (size_t)(t + 2) * kstep; const char* b2 = last ? nB : cB + (size_t)(t + 2) * kstep;
            const char* a3 = a2 + kstep; const char* b3 = b2 + kstep;
            if (last && has_next) S.a_ready(nxt);
            if constexpr (SP2) {
            PG8_LDB(B0, 0, 0); PG8_LDB(B1, 0, 1); PG8_SCHED; PG8_LDA(At, 0, 0); PG8_STAGE(PG8_SA(1, 1), a1 + hstep, voffA);
            PG8_WAIT_V(8); PG8_WAIT_L(0); PG8_BAR; PG8_MMA(0, 0, At, B0); PG8_MMA(0, 1, At, B1); PG8_BAR; PG8_SCHED;
            PG8_LDA(At, 0, 1); PG8_STAGE(PG8_SB(0, 0), b2, voffB); PG8_STAGE(PG8_SB(0, 1), b2 + hstep, voffB); PG8_STAGE(PG8_SA(0, 0), a2, voffA);
            PG8_WAIT_V(8); PG8_WAIT_L(0); PG8_BAR; PG8_MMA(1, 0, At, B0); PG8_MMA(1, 1, At, B1); PG8_BAR; PG8_SCHED;
            PG8_LDB(B0, 1, 0); PG8_LDB(B1, 1, 1); PG8_SCHED; PG8_LDA(At, 1, 0); PG8_STAGE(PG8_SA(0, 1), a2 + hstep, voffA);
            PG8_WAIT_V(8); PG8_WAIT_L(0); PG8_BAR; PG8_MMA(0, 0, At, B0); PG8_MMA(0, 1, At, B1); PG8_BAR; PG8_SCHED;
            PG8_LDA(At, 1, 1); PG8_STAGE(PG8_SB(1, 0), b3, voffB); PG8_STAGE(PG8_SB(1, 1), b3 + hstep, voffB); PG8_STAGE(PG8_SA(1, 0), a3, voffA);
            PG8_WAIT_V(8); PG8_WAIT_L(0); PG8_BAR; PG8_MMA(1, 0, At, B0); PG8_MMA(1, 1, At, B1); PG8_BAR; PG8_SCHED;
            } else {
            PG8_LDB(B0, 0, 0); PG8_SCHED; PG8_LDA(At, 0, 0); PG8_STAGE(PG8_SA(1, 1), a1 + hstep, voffA);
            PG8_WAIT_L(8); PG8_BAR; PG8_WAIT_L(0); PG8_MMA(0, 0, At, B0); PG8_BAR; PG8_SCHED;
            PG8_LDB(B1, 0, 1); PG8_STAGE(PG8_SB(0, 0), b2, voffB);
            PG8_BAR; PG8_WAIT_L(0); PG8_MMA(0, 1, At, B1); PG8_BAR;
            PG8_LDA(At, 0, 1); PG8_STAGE(PG8_SA(0, 0), a2, voffA);
            PG8_BAR; PG8_WAIT_L(0); PG8_MMA(1, 0, At, B0); PG8_BAR; PG8_SCHED;
            PG8_STAGE(PG8_SB(0, 1), b2 + hstep, voffB);
            PG8_WAIT_V(6); PG8_BAR; PG8_MMA(1, 1, At, B1); PG8_BAR;
            PG8_LDB(B0, 1, 0); PG8_SCHED; PG8_LDA(At, 1, 0); PG8_STAGE(PG8_SA(0, 1), a2 + hstep, voffA);
            PG8_WAIT_L(8); PG8_BAR; PG8_WAIT_L(0); PG8_MMA(0, 0, At, B0); PG8_BAR; PG8_SCHED;
            PG8_LDB(B1, 1, 1); PG8_STAGE(PG8_SB(1, 0), b3, voffB);
            PG8_BAR; PG8_WAIT_L(0); PG8_MMA(0, 1, At, B1); PG8_BAR;
            PG8_LDA(At, 1, 1); PG8_STAGE(PG8_SA(1, 0), a3, voffA);
            PG8_BAR; PG8_WAIT_L(0); PG8_MMA(1, 0, At, B0); PG8_BAR; PG8_SCHED;
            PG8_STAGE(PG8_SB(1, 1), b3 + hstep, voffB);
            PG8_WAIT_V(6); PG8_BAR; PG8_MMA(1, 1, At, B1); PG8_BAR;
            }
        }
        if constexpr (ALIGN_EPI) { if (wr == 0) PG8_BAR; }
        if constexpr (!Epi::AFTER_DRAIN) { E(acc, cur, wr, wc, fr, fq); S.done(cur); }
        if (!has_next) break;
#pragma unroll
        for (int a = 0; a < 2; ++a)
#pragma unroll
            for (int b = 0; b < 2; ++b)
#pragma unroll
                for (int m = 0; m < 4; ++m)
#pragma unroll
                    for (int n = 0; n < 2; ++n) acc[a][b][m][n] = (f32x4){0.f, 0.f, 0.f, 0.f};
        cur = nxt; cA = nA; cB = nB; ++ui;
        if constexpr (ALIGN_EPI) { if (wr == 1) PG8_BAR; }
    }
    PG8_WAIT_V(0);
    if constexpr (!ALIGN_EPI) { if (wr == 0) PG8_BAR; }
    PG8_BAR;
    if constexpr (Epi::AFTER_DRAIN) { E.fused(acc, cur, wr, wc, fr, fq, lds, wid, lane); S.done(cur); }
#undef PG8_SA
#undef PG8_SB
#undef PG8_STAGE
#undef PG8_LDA
#undef PG8_LDB
#undef PG8_MMA
#undef PG8_WAIT_V
#undef PG8_WAIT_L
#undef PG8_BAR
#undef PG8_SCHED
}
}
using pg8::bf16_t;
#define MFMA32(a, b, c) __builtin_amdgcn_mfma_f32_32x32x16_bf16((a), (b), (c), 0, 0, 0)
#define LDS_WAIT() asm volatile("s_waitcnt lgkmcnt(0)" ::: "memory")
DI int crow(int i, int h) { return (i & 3) + 8 * (i >> 2) + 4 * h; }
template <int S> DI bf16x8 pack8(const f32x16& x) {
    u32x4 p; p.x = pk2(x[8 * S], x[8 * S + 1]); p.y = pk2(x[8 * S + 2], x[8 * S + 3]); p.z = pk2(x[8 * S + 4], x[8 * S + 5]); p.w = pk2(x[8 * S + 6], x[8 * S + 7]);
    return __builtin_bit_cast(bf16x8, p);
}
DI f32x16 zero16() { f32x16 z;
#pragma unroll
    for (int i = 0; i < 16; ++i) z[i] = 0.f; return z; }

struct Params { const float* in[22]; float* out; unsigned char* ws; };

enum { MAP_ID = 0, MAP_WIN = 1, MAP_WUQ = 2 };
template <int MAP> DI int dest_row(int n) {
    if (MAP == MAP_WIN) return n < 1088 ? n : n + 192;
    if (MAP == MAP_WUQ) { const int h = n / 192, i = n - h * 192; return i < 128 ? h * 128 + i : 2048 + h * 64 + 2 * ((i - 128) & 31) + ((i - 128) >> 5); }
    return n;
}
template <int MAP> DI void transpose_item(const float* __restrict__ W, int K, int N, bf16_t* __restrict__ WT, LAS float* scr, int item, int lane) {
    const int nblk = N / 32, kb = item / nblk, nb = item - kb * nblk, k0 = 64 * kb, n0 = 32 * nb;
    float wv[32];
#pragma unroll
    for (int i = 0; i < 32; ++i) wv[i] = W[(size_t)(k0 + 2 * i + (lane >> 5)) * N + n0 + (lane & 31)];
#pragma unroll
    for (int i = 0; i < 32; ++i) scr[(2 * i + (lane >> 5)) * 33 + (lane & 31)] = wv[i];
    LDS_WAIT();
    const int c = lane & 7;
#pragma unroll
    for (int j = 0; j < 4; ++j) { const int n = (lane >> 3) + 8 * j; const LAS float* s = scr + (8 * c) * 33 + n;
        u32x4 o; o.x = pk2(s[0 * 33], s[1 * 33]); o.y = pk2(s[2 * 33], s[3 * 33]); o.z = pk2(s[4 * 33], s[5 * 33]); o.w = pk2(s[6 * 33], s[7 * 33]);
        *(u32x4*)(WT + (size_t)dest_row<MAP>(n0 + n) * K + k0 + 8 * c) = o; }
    LDS_WAIT();
}

DI void layer_prep(const Params& P, LAS unsigned char* lds, int l, int gw, int NGW, int gt, int NGT, int lane, int wave) {
    unsigned char* ws = P.ws;
    LAS float* scr = (LAS float*)(lds + wave * 16384);
    const float* w_in = P.in[6] + (size_t)l * 2048 * 13376; const float* w_uq = P.in[8] + (size_t)l * 512 * 3072;
    const float* w_uk = P.in[10] + (size_t)l * 512 * 2048;  const float* w_uv = P.in[11] + (size_t)l * 512 * 2048;
    const float* w_oa = P.in[12] + (size_t)l * 2048 * 2048; const float* w_ob = P.in[15] + (size_t)l * 2048 * 2048; const float* w_out = P.in[16] + (size_t)l * 2048 * 2048;
    const float* w_up = P.in[19] + (size_t)l * 2048 * 8192; const float* w_dn = P.in[20] + (size_t)l * 8192 * 2048;
    constexpr int I_IN = 32 * 418, I_UQ = 8 * 96, I_UK = 8 * 64, I_SQ = 32 * 64, I_UP = 32 * 256, I_DN = 128 * 64;
    constexpr int NIT = I_IN + I_UQ + 2 * I_UK + 3 * I_SQ + I_UP + I_DN;
    for (int it = gw; it < NIT; it += NGW) {
        int r = it;
        if (r < I_IN) { transpose_item<MAP_WIN>(w_in, 2048, 13376, (bf16_t*)(ws + WS_WIN), scr, r, lane); continue; } r -= I_IN;
        if (r < I_UQ) { transpose_item<MAP_WUQ>(w_uq, 512, 3072, (bf16_t*)(ws + WS_WUQ), scr, r, lane); continue; } r -= I_UQ;
        if (r < I_UK) { transpose_item<MAP_ID>(w_uk, 512, 2048, (bf16_t*)(ws + WS_WUK), scr, r, lane); continue; } r -= I_UK;
        if (r < I_UK) { transpose_item<MAP_ID>(w_uv, 512, 2048, (bf16_t*)(ws + WS_WUV), scr, r, lane); continue; } r -= I_UK;
        if (r < I_SQ) { transpose_item<MAP_ID>(w_oa, 2048, 2048, (bf16_t*)(ws + WS_WOA), scr, r, lane); continue; } r -= I_SQ;
        if (r < I_SQ) { transpose_item<MAP_ID>(w_ob, 2048, 2048, (bf16_t*)(ws + WS_WOB), scr, r, lane); continue; } r -= I_SQ;
        if (r < I_SQ) { transpose_item<MAP_ID>(w_out, 2048, 2048, (bf16_t*)(ws + WS_WOUT), scr, r, lane); continue; } r -= I_SQ;
        if (r < I_UP) { transpose_item<MAP_ID>(w_up, 2048, 8192, (bf16_t*)(ws + WS_WUP), scr, r, lane); continue; } r -= I_UP;
        transpose_item<MAP_ID>(w_dn, 8192, 2048, (bf16_t*)(ws + WS_WDN), scr, r, lane);
    }
    u32x4 z4; { unsigned z_; asm volatile("v_mov_b32 %0, 0" : "=v"(z_)); z4.x = z_; z4.y = z_; z4.z = z_; z4.w = z_; }
    { u32x4* z = (u32x4*)((bf16_t*)(ws + WS_WIN) + (size_t)1088 * 2048); for (int i = gt; i < 192 * 2048 / 8; i += NGT) z[i] = z4; }
    bf16_t* CKV = (bf16_t*)(ws + WS_CKV); bf16_t* KPE = (bf16_t*)(ws + WS_KPE);
    const float* cc = P.in[2] + (size_t)l * 8 * 4096 * 512; const float* ck = P.in[3] + (size_t)l * 8 * 4096 * 64;
#pragma unroll 4
    for (int i = gt; i < 8 * 4096 * 512 / 8; i += NGT) { const int b = i >> 18, rem = i & 262143, t = rem >> 6, c8 = rem & 63;
        const f32x4 a = *(const f32x4*)(cc + (size_t)i * 8), bq = *(const f32x4*)(cc + (size_t)i * 8 + 4);
        u32x4 o; o.x = pk2(a[0], a[1]); o.y = pk2(a[2], a[3]); o.z = pk2(bq[0], bq[1]); o.w = pk2(bq[2], bq[3]);
        *(u32x4*)(CKV + (size_t)(MP + b * KVB + t) * 512 + c8 * 8) = o; }
#pragma unroll 2
    for (int i = gt; i < 8 * 4096 * 64 / 8; i += NGT) { const int b = i >> 15, rem = i & 32767, t = rem >> 3, c8 = rem & 7;
        const f32x4 a = *(const f32x4*)(ck + (size_t)i * 8), bq = *(const f32x4*)(ck + (size_t)i * 8 + 4);
        u32x4 o; o.x = pk2(a[0], a[1]); o.y = pk2(a[2], a[3]); o.z = pk2(bq[0], bq[1]); o.w = pk2(bq[2], bq[3]);
        *(u32x4*)(KPE + (size_t)(MP + b * KVB + t) * 64 + c8 * 8) = o; }
    for (int i = gt; i < 8 * 32 * 64; i += NGT) { const int b = i >> 11, rem = i & 2047; *(u32x4*)(CKV + (size_t)(MP + b * KVB + 4128) * 512 + rem * 8) = z4; }
    for (int i = gt; i < 8 * 32 * 8; i += NGT) { const int b = i >> 8, rem = i & 255; *(u32x4*)(KPE + (size_t)(MP + b * KVB + 4128) * 64 + rem * 8) = z4; }
    float* LB = (float*)(ws + WS_LB); const float* hl = P.in[13];
    for (int i = gt; i < 2048; i += NGT) LB[i] = l == 0 ? 0.f : 1.f / (1.f + expf(hl[i] - hl[2048 + i]));
}

DI void rope_table(const Params& P, int gt, int NGT) {
    float* T = (float*)(P.ws + WS_TBL);
    for (int i = gt; i < 2080 * 32; i += NGT) { const int p = i >> 5, j = i & 31; const int pos = p < 2048 ? p : 4096 + (p - 2048);
        const float inv = exp2f(-(float)j * (13.287712379549449f / 32.f)); const float ang = (float)pos * inv;
        const double a = (double)ang; const double kq = rint(a * 0.15915494309189535); const float rr = (float)(a - kq * 6.283185307179586);
        T[2 * i] = __cosf(rr); T[2 * i + 1] = __sinf(rr); }
}

DI void init_x(const Params& P, int gw, int NGW, int lane) {
    const float* g = P.in[5]; float* X = P.out; bf16_t* XN = (bf16_t*)(P.ws + WS_XN);
    for (int row = gw; row < MTOK; row += NGW) {
        const float* src = row < MP ? P.in[0] + (size_t)row * 2048 : P.in[1] + (size_t)(row - MP) * 2048;
        f32x4 v[8]; float ss = 0.f;
#pragma unroll
        for (int j = 0; j < 8; ++j) { v[j] = *(const f32x4*)(src + j * 256 + lane * 4); ss += v[j][0] * v[j][0] + v[j][1] * v[j][1] + v[j][2] * v[j][2] + v[j][3] * v[j][3]; }
        const float rs = rsqrtf(wave_sum(ss, lane) * (1.f / 2048.f) + EPS);
#pragma unroll
        for (int j = 0; j < 8; ++j) { *(f32x4*)(X + (size_t)row * 2048 + j * 256 + lane * 4) = v[j];
            const f32x4 gg = *(const f32x4*)(g + j * 256 + lane * 4); u32x2 w; w.x = pk2(v[j][0] * rs * gg[0], v[j][1] * rs * gg[1]); w.y = pk2(v[j][2] * rs * gg[2], v[j][3] * rs * gg[3]);
            *(u32x2*)(XN + (size_t)row * 2048 + j * 256 + lane * 4) = w; }
    }
}
DI void resid_norm(const float* __restrict__ Y, const float* __restrict__ gY, float* X, const float* __restrict__ gN, bf16_t* XN, int gw, int NGW, int lane) {
    for (int row = gw; row < MP; row += NGW) {
        f32x4 y[8]; float ss = 0.f;
#pragma unroll
        for (int j = 0; j < 8; ++j) { y[j] = *(const f32x4*)(Y + (size_t)row * 2048 + j * 256 + lane * 4); ss += y[j][0] * y[j][0] + y[j][1] * y[j][1] + y[j][2] * y[j][2] + y[j][3] * y[j][3]; }
        const float rs = rsqrtf(wave_sum(ss, lane) * (1.f / 2048.f) + EPS); float s2 = 0.f;
#pragma unroll
        for (int j = 0; j < 8; ++j) { const f32x4 gg = *(const f32x4*)(gY + j * 256 + lane * 4); const f32x4 x = *(const f32x4*)(X + (size_t)row * 2048 + j * 256 + lane * 4);
            y[j] = x + y[j] * rs * gg; *(f32x4*)(X + (size_t)row * 2048 + j * 256 + lane * 4) = y[j];
            s2 += y[j][0] * y[j][0] + y[j][1] * y[j][1] + y[j][2] * y[j][2] + y[j][3] * y[j][3]; }
        if (gN) {
            const float r2 = rsqrtf(wave_sum(s2, lane) * (1.f / 2048.f) + EPS);
#pragma unroll
            for (int j = 0; j < 8; ++j) { const f32x4 gg = *(const f32x4*)(gN + j * 256 + lane * 4); u32x2 w; w.x = pk2(y[j][0] * r2 * gg[0], y[j][1] * r2 * gg[1]); w.y = pk2(y[j][2] * r2 * gg[2], y[j][3] * r2 * gg[3]);
                *(u32x2*)(XN + (size_t)row * 2048 + j * 256 + lane * 4) = w; }
        }
    }
}
DI void resid_norm_tail(LAS unsigned char* lds, const float* __restrict__ slab, int KS, const float* __restrict__ gY, float* X, const float* __restrict__ gN, bf16_t* XN, int vcu, int G, int wave, int lane) {
    LAS float* red = (LAS float*)lds;
    for (int tr = vcu; tr < MS; tr += G) {
        const size_t off = (size_t)(MP + tr) * 2048 + wave * 256 + lane * 4;
        f32x4 y = {0.f, 0.f, 0.f, 0.f};
        for (int kp = 0; kp < KS; ++kp) y += *(const f32x4*)(slab + ((size_t)kp * 256 + tr) * 2048 + wave * 256 + lane * 4);
        const float ss = wave_sum(y[0] * y[0] + y[1] * y[1] + y[2] * y[2] + y[3] * y[3], lane);
        if (lane == 0) red[wave] = ss;
        __syncthreads();
        float tot = 0.f;
#pragma unroll
        for (int w = 0; w < 8; ++w) tot += red[w];
        const float rs = rsqrtf(tot * (1.f / 2048.f) + EPS);
        const f32x4 gg = *(const f32x4*)(gY + wave * 256 + lane * 4); const f32x4 x = *(const f32x4*)(X + off);
        y = x + y * rs * gg; *(f32x4*)(X + off) = y;
        const float s2 = wave_sum(y[0] * y[0] + y[1] * y[1] + y[2] * y[2] + y[3] * y[3], lane);
        if (lane == 0) red[8 + wave] = s2;
        __syncthreads();
        if (gN) { float t2 = 0.f;
#pragma unroll
            for (int w = 0; w < 8; ++w) t2 += red[8 + w];
            const float r2 = rsqrtf(t2 * (1.f / 2048.f) + EPS); const f32x4 g2 = *(const f32x4*)(gN + wave * 256 + lane * 4);
            u32x2 wv; wv.x = pk2(y[0] * r2 * g2[0], y[1] * r2 * g2[1]); wv.y = pk2(y[2] * r2 * g2[2], y[3] * r2 * g2[3]); *(u32x2*)(XN + off) = wv; }
        __syncthreads();
    }
}
DI void small_norms(const Params& P, int l, int gw, int NGW, int lane) {
    const float* Zs = (const float*)(P.ws + WS_ZS); bf16_t* QN = (bf16_t*)(P.ws + WS_QN); bf16_t* CKV = (bf16_t*)(P.ws + WS_CKV); bf16_t* KPE = (bf16_t*)(P.ws + WS_KPE);
    const float* tbl = (const float*)(P.ws + WS_TBL); const float* gq = P.in[7] + l * 512; const float* gkv = P.in[9] + l * 512;
    for (int row = gw; row < MTOK; row += NGW) {
        const float* z = Zs + (size_t)row * ZSW;
        const bool pr = row < MP; const int rs_ = row - MP;
        const int kvrow = pr ? row : MP + (rs_ >> 5) * KVB + 4096 + (rs_ & 31);
        const int p = pr ? (row & 2047) : 2048 + (rs_ & 31);
        float* oc = pr ? P.out + OUT_CKVP + ((size_t)l * MP + row) * 512 : P.out + OUT_CKVS + ((size_t)l * MS + rs_) * 512;
        float* ok = pr ? P.out + OUT_KPEP + ((size_t)l * MP + row) * 64 : P.out + OUT_KPES + ((size_t)l * MS + rs_) * 64;
        { const f32x4 a = *(const f32x4*)(z + lane * 8), b = *(const f32x4*)(z + lane * 8 + 4);
          const float ss = a[0] * a[0] + a[1] * a[1] + a[2] * a[2] + a[3] * a[3] + b[0] * b[0] + b[1] * b[1] + b[2] * b[2] + b[3] * b[3];
          const float rs = rsqrtf(wave_sum(ss, lane) * (1.f / 512.f) + EPS); const f32x4 g0 = *(const f32x4*)(gq + lane * 8), g1 = *(const f32x4*)(gq + lane * 8 + 4);
          u32x4 o; o.x = pk2(a[0] * rs * g0[0], a[1] * rs * g0[1]); o.y = pk2(a[2] * rs * g0[2], a[3] * rs * g0[3]); o.z = pk2(b[0] * rs * g1[0], b[1] * rs * g1[1]); o.w = pk2(b[2] * rs * g1[2], b[3] * rs * g1[3]);
          *(u32x4*)(QN + (size_t)row * 512 + lane * 8) = o; }
        { const f32x4 a = *(const f32x4*)(z + 512 + lane * 8), b = *(const f32x4*)(z + 512 + lane * 8 + 4);
          const float ss = a[0] * a[0] + a[1] * a[1] + a[2] * a[2] + a[3] * a[3] + b[0] * b[0] + b[1] * b[1] + b[2] * b[2] + b[3] * b[3];
          const float rs = rsqrtf(wave_sum(ss, lane) * (1.f / 512.f) + EPS); const f32x4 g0 = *(const f32x4*)(gkv + lane * 8), g1 = *(const f32x4*)(gkv + lane * 8 + 4);
          const f32x4 c0 = a * rs * g0, c1 = b * rs * g1;
          *(f32x4*)(oc + lane * 8) = c0; *(f32x4*)(oc + lane * 8 + 4) = c1;
          u32x4 o; o.x = pk2(c0[0], c0[1]); o.y = pk2(c0[2], c0[3]); o.z = pk2(c1[0], c1[1]); o.w = pk2(c1[2], c1[3]);
          *(u32x4*)(CKV + (size_t)kvrow * 512 + lane * 8) = o; }
        if (lane < 32) { const float x1 = z[1024 + lane], x2 = z[1056 + lane]; const float c = tbl[(size_t)(p * 32 + lane) * 2], s = tbl[(size_t)(p * 32 + lane) * 2 + 1];
          const float o1 = x1 * c - x2 * s, o2 = x1 * s + x2 * c; ok[lane] = o1; ok[32 + lane] = o2;
          KPE[(size_t)kvrow * 64 + lane] = f2bf(o1); KPE[(size_t)kvrow * 64 + 32 + lane] = f2bf(o2); }
    }
}

struct HUnit { int rowbase, nvalid, h; };
DI HUnit hunit(int u) { HUnit r; if (u < 2048) { const int sh = u >> 5, c = u & 31; r.h = sh & 15; r.rowbase = (sh >> 4) * 2048 + c * 64; r.nvalid = 64; } else { const int s = u - 2048; r.h = s & 15; r.rowbase = MP + (s >> 4) * 32; r.nvalid = 32; } return r; }
DI void hgrn_cumsum(const float* __restrict__ LF, LAS float* psum, const HUnit& hu, int k, int tq, float (&b)[16], float& b31, float& b63) {
    const float* p = LF + (size_t)(hu.rowbase + 16 * tq) * 2048 + hu.h * 128 + k; const bool valid = 16 * tq < hu.nvalid;
    float run = 0.f;
#pragma unroll
    for (int i = 0; i < 16; ++i) { const float v = valid ? p[(size_t)i * 2048] : 0.f; run += v; b[i] = run; }
    psum[tq * 128 + k] = run;
    __syncthreads();
    const float p0 = psum[k], p1 = psum[128 + k], p2 = psum[256 + k], p3 = psum[384 + k];
    const float off = (tq > 0 ? p0 : 0.f) + (tq > 1 ? p1 : 0.f) + (tq > 2 ? p2 : 0.f);
#pragma unroll
    for (int i = 0; i < 16; ++i) b[i] += off;
    b31 = p0 + p1; b63 = b31 + p2 + p3;
}
DI void hgrn_pass1(LAS unsigned char* lds, const float* __restrict__ LF, const bf16_t* __restrict__ HK, const bf16_t* __restrict__ HV, bf16_t* __restrict__ UT, float* __restrict__ Dv, int u, int tid) {
    LAS float* psum = (LAS float*)lds; LAS bf16_t* KhT = (LAS bf16_t*)(lds + 2048); LAS bf16_t* VTl = (LAS bf16_t*)(lds + 2048 + 18432);
    const HUnit hu = hunit(u); const int k = tid & 127, tq = tid >> 7; const bool valid = 16 * tq < hu.nvalid;
    const size_t g0 = (size_t)(hu.rowbase + 16 * tq) * 2048 + hu.h * 128 + k;
    unsigned kraw[8], vw[8];
#pragma unroll
    for (int i2 = 0; i2 < 8; ++i2) { unsigned k0 = 0u, k1 = 0u, v0 = 0u, v1 = 0u;
        if (valid) { k0 = HK[g0 + (size_t)(2 * i2) * 2048]; k1 = HK[g0 + (size_t)(2 * i2 + 1) * 2048]; v0 = HV[g0 + (size_t)(2 * i2) * 2048]; v1 = HV[g0 + (size_t)(2 * i2 + 1) * 2048]; }
        kraw[i2] = k0 | (k1 << 16); vw[i2] = v0 | (v1 << 16); }
    float b[16], b31, b63; hgrn_cumsum(LF, psum, hu, k, tq, b, b31, b63);
    unsigned kw[8];
#pragma unroll
    for (int i2 = 0; i2 < 8; ++i2) kw[i2] = pk2(bflo(kraw[i2]) * __expf(b63 - b[2 * i2]), bfhi(kraw[i2]) * __expf(b63 - b[2 * i2 + 1]));
    { u32x4 a, c; a.x = kw[0]; a.y = kw[1]; a.z = kw[2]; a.w = kw[3]; c.x = kw[4]; c.y = kw[5]; c.z = kw[6]; c.w = kw[7];
      *(LAS u32x4*)(KhT + k * 72 + 16 * tq) = a; *(LAS u32x4*)(KhT + k * 72 + 16 * tq + 8) = c;
      a.x = vw[0]; a.y = vw[1]; a.z = vw[2]; a.w = vw[3]; c.x = vw[4]; c.y = vw[5]; c.z = vw[6]; c.w = vw[7];
      *(LAS u32x4*)(VTl + k * 72 + 16 * tq) = a; *(LAS u32x4*)(VTl + k * 72 + 16 * tq + 8) = c; }
    if (tq == 0) Dv[(size_t)u * 128 + k] = __expf(b63);
    __syncthreads();
    const int wave = tid >> 6, lane = tid & 63, r = lane & 31, hh = lane >> 5, vb = wave & 3, kg = wave >> 2;
#pragma unroll
    for (int kb2 = 0; kb2 < 2; ++kb2) {
        const int kbq = 2 * kg + kb2; f32x16 acc = zero16();
#pragma unroll
        for (int s = 0; s < 4; ++s) { const bf16x8 a = *(const LAS bf16x8*)(VTl + (32 * vb + r) * 72 + 16 * s + 8 * hh), bb = *(const LAS bf16x8*)(KhT + (32 * kbq + r) * 72 + 16 * s + 8 * hh); acc = MFMA32(a, bb, acc); }
        bf16_t* dst = UT + ((size_t)u * 128 + 32 * vb) * 128 + 32 * kbq + r;
#pragma unroll
        for (int i = 0; i < 16; ++i) dst[(size_t)crow(i, hh) * 128] = f2bf(acc[i]);
    }
    __syncthreads();
}
DI void hgrn_pass2(LAS unsigned char* lds, const Params& P, int l, int x, int tid) {
    const bf16_t* UT = (const bf16_t*)(P.ws + WS_UT); const float* Dv = (const float*)(P.ws + WS_D); bf16_t* SpT = (bf16_t*)(P.ws + WS_SPT);
    LAS float* tl = (LAS float*)lds;
    const bool sample = x >= 256; const int sidx = sample ? (x - 256) >> 2 : x >> 2, vq = x & 3;
    const int nch = sample ? 1 : 32, ubase = sample ? 2048 + sidx : sidx * 32;
    const int vloc = tid >> 4, k0 = (tid & 15) * 8, v = 32 * vq + vloc;
    const int kk = tid >> 2, vs = (tid & 3) * 8;
    float S[8];
#pragma unroll
    for (int i = 0; i < 8; ++i) S[i] = 0.f;
    if (sample) {
        const float* s0 = P.in[4] + ((size_t)l * 128 + sidx) * 16384 + (size_t)kk * 128 + 32 * vq + vs;
        const f32x4 a = *(const f32x4*)s0, b = *(const f32x4*)(s0 + 4);
#pragma unroll
        for (int i = 0; i < 4; ++i) { tl[kk * 33 + vs + i] = a[i]; tl[kk * 33 + vs + 4 + i] = b[i]; }
        __syncthreads();
#pragma unroll
        for (int i = 0; i < 8; ++i) S[i] = tl[(k0 + i) * 33 + vloc];
        __syncthreads();
    }
    size_t e = ((size_t)ubase * 128 + v) * 128 + k0;
    u32x4 uu = *(const u32x4*)(UT + e); f32x4 d0 = *(const f32x4*)(Dv + (size_t)ubase * 128 + k0), d1 = *(const f32x4*)(Dv + (size_t)ubase * 128 + k0 + 4);
    for (int c = 0; c < nch; ++c) {
        u32x4 nuu = uu; f32x4 nd0 = d0, nd1 = d1;
        if (c + 1 < nch) { const size_t e2 = e + 16384; nuu = *(const u32x4*)(UT + e2); nd0 = *(const f32x4*)(Dv + (size_t)(ubase + c + 1) * 128 + k0); nd1 = *(const f32x4*)(Dv + (size_t)(ubase + c + 1) * 128 + k0 + 4); }
        u32x4 o; o.x = pk2(S[0], S[1]); o.y = pk2(S[2], S[3]); o.z = pk2(S[4], S[5]); o.w = pk2(S[6], S[7]);
        *(u32x4*)(SpT + e) = o;
        S[0] = d0[0] * S[0] + bflo(uu.x); S[1] = d0[1] * S[1] + bfhi(uu.x); S[2] = d0[2] * S[2] + bflo(uu.y); S[3] = d0[3] * S[3] + bfhi(uu.y);
        S[4] = d1[0] * S[4] + bflo(uu.z); S[5] = d1[1] * S[5] + bfhi(uu.z); S[6] = d1[2] * S[6] + bflo(uu.w); S[7] = d1[3] * S[7] + bfhi(uu.w);
        uu = nuu; d0 = nd0; d1 = nd1; e += 16384;
    }
#pragma unroll
    for (int i = 0; i < 8; ++i) tl[(k0 + i) * 33 + vloc] = S[i];
    __syncthreads();
    float* o = (sample ? P.out + OUT_STS + ((size_t)l * 128 + sidx) * 16384 : P.out + OUT_STP + ((size_t)l * 64 + sidx) * 16384) + (size_t)kk * 128 + 32 * vq + vs;
    f32x4 a, b;
#pragma unroll
    for (int i = 0; i < 4; ++i) { a[i] = tl[kk * 33 + vs + i]; b[i] = tl[kk * 33 + vs + 4 + i]; }
    *(f32x4*)o = a; *(f32x4*)(o + 4) = b;
    __syncthreads();
}
DI void hgrn_pass3(LAS unsigned char* lds, const float* __restrict__ LF, const bf16_t* __restrict__ HQ, const bf16_t* __restrict__ HK, const bf16_t* __restrict__ HV, const bf16_t* __restrict__ HG,
                   const bf16_t* __restrict__ SpT, const float* __restrict__ gn, bf16_t* __restrict__ OH, int u, int tid) {
    LAS float* psum = (LAS float*)lds;
    LAS bf16_t* Qa = (LAS bf16_t*)(lds + 2048);
    LAS bf16_t* Qb = (LAS bf16_t*)(lds + 19456);
    LAS bf16_t* Ka = (LAS bf16_t*)(lds + 28160);
    LAS bf16_t* Kb = (LAS bf16_t*)(lds + 36864);
    LAS bf16_t* VTl = (LAS bf16_t*)(lds + 54272);
    LAS float* Ost = (LAS float*)(lds + 72704);
    const HUnit hu = hunit(u); const int k = tid & 127, tq = tid >> 7; const bool valid = 16 * tq < hu.nvalid;
    const size_t g0 = (size_t)(hu.rowbase + 16 * tq) * 2048 + hu.h * 128 + k;
    unsigned vw[8], qk[16];
#pragma unroll
    for (int i2 = 0; i2 < 8; ++i2) {
        unsigned vpair = 0u;
#pragma unroll
        for (int e = 0; e < 2; ++e) { const int i = 2 * i2 + e; unsigned q = 0u, kk = 0u, vv = 0u;
            if (valid) { q = HQ[g0 + (size_t)i * 2048]; kk = HK[g0 + (size_t)i * 2048]; vv = HV[g0 + (size_t)i * 2048]; }
            qk[i] = q | (kk << 16); vpair |= vv << (16 * e); }
        vw[i2] = vpair;
    }
    float b[16], b31, b63; hgrn_cumsum(LF, psum, hu, k, tq, b, b31, b63);
#pragma unroll
    for (int i = 0; i < 16; ++i) {
        const int t = 16 * tq + i; const float q = bflo(qk[i]), kk = bfhi(qk[i]);
        Qa[t * 136 + k] = f2bf(q * __expf(b[i]));
        if (tq >= 2) Qb[(t - 32) * 136 + k] = f2bf(q * __expf(b[i] - b31)); else Ka[t * 136 + k] = f2bf(kk * __expf(-b[i]));
        Kb[t * 136 + k] = f2bf(kk * __expf(b31 - b[i]));
    }
    { u32x4 a, c; a.x = vw[0]; a.y = vw[1]; a.z = vw[2]; a.w = vw[3]; c.x = vw[4]; c.y = vw[5]; c.z = vw[6]; c.w = vw[7];
      *(LAS u32x4*)(VTl + k * 72 + 16 * tq) = a; *(LAS u32x4*)(VTl + k * 72 + 16 * tq + 8) = c; }
    __syncthreads();
    const int wave = tid >> 6, lane = tid & 63, r = lane & 31, hh = lane >> 5, vb = wave & 3, tb = wave >> 2;
    f32x16 O = zero16();
    const LAS bf16_t* vrow = VTl + (32 * vb + r) * 72 + 4 * hh;
    if (tb == 0) {
        f32x16 A0 = zero16();
#pragma unroll
        for (int ks = 0; ks < 8; ++ks) { const bf16x8 a = *(const LAS bf16x8*)(Ka + r * 136 + 16 * ks + 8 * hh), q = *(const LAS bf16x8*)(Qa + r * 136 + 16 * ks + 8 * hh); A0 = MFMA32(a, q, A0); }
#pragma unroll
        for (int i = 0; i < 16; ++i) if (crow(i, hh) > r) A0[i] = 0.f;
        const bf16x8 p0 = pack8<0>(A0), p1 = pack8<1>(A0);
        { const s16x4 lo = *(const LAS s16x4*)(vrow), hi = *(const LAS s16x4*)(vrow + 8); O = MFMA32(__builtin_shufflevector(lo, hi, 0, 1, 2, 3, 4, 5, 6, 7), p0, O); }
        { const s16x4 lo = *(const LAS s16x4*)(vrow + 16), hi = *(const LAS s16x4*)(vrow + 24); O = MFMA32(__builtin_shufflevector(lo, hi, 0, 1, 2, 3, 4, 5, 6, 7), p1, O); }
    } else {
        f32x16 A0 = zero16(), A1 = zero16();
#pragma unroll
        for (int ks = 0; ks < 8; ++ks) { const bf16x8 q = *(const LAS bf16x8*)(Qb + r * 136 + 16 * ks + 8 * hh);
            const bf16x8 a0 = *(const LAS bf16x8*)(Kb + r * 136 + 16 * ks + 8 * hh), a1 = *(const LAS bf16x8*)(Kb + (32 + r) * 136 + 16 * ks + 8 * hh);
            A0 = MFMA32(a0, q, A0); A1 = MFMA32(a1, q, A1); }
#pragma unroll
        for (int i = 0; i < 16; ++i) if (crow(i, hh) > r) A1[i] = 0.f;
        const bf16x8 p0 = pack8<0>(A0), p1 = pack8<1>(A0), p2 = pack8<0>(A1), p3 = pack8<1>(A1);
        { const s16x4 lo = *(const LAS s16x4*)(vrow), hi = *(const LAS s16x4*)(vrow + 8); O = MFMA32(__builtin_shufflevector(lo, hi, 0, 1, 2, 3, 4, 5, 6, 7), p0, O); }
        { const s16x4 lo = *(const LAS s16x4*)(vrow + 16), hi = *(const LAS s16x4*)(vrow + 24); O = MFMA32(__builtin_shufflevector(lo, hi, 0, 1, 2, 3, 4, 5, 6, 7), p1, O); }
        { const s16x4 lo = *(const LAS s16x4*)(vrow + 32), hi = *(const LAS s16x4*)(vrow + 40); O = MFMA32(__builtin_shufflevector(lo, hi, 0, 1, 2, 3, 4, 5, 6, 7), p2, O); }
        { const s16x4 lo = *(const LAS s16x4*)(vrow + 48), hi = *(const LAS s16x4*)(vrow + 56); O = MFMA32(__builtin_shufflevector(lo, hi, 0, 1, 2, 3, 4, 5, 6, 7), p3, O); }
    }
    { const bf16_t* sp = SpT + ((size_t)u * 128 + 32 * vb + r) * 128 + 8 * hh;
#pragma unroll
      for (int ks = 0; ks < 8; ++ks) { const bf16x8 a = *(const bf16x8*)(sp + 16 * ks), q = *(const LAS bf16x8*)(Qa + (32 * tb + r) * 136 + 16 * ks + 8 * hh); O = MFMA32(a, q, O); } }
#pragma unroll
    for (int g = 0; g < 4; ++g) { f32x4 w; w[0] = O[4 * g]; w[1] = O[4 * g + 1]; w[2] = O[4 * g + 2]; w[3] = O[4 * g + 3]; *(LAS f32x4*)(Ost + (32 * tb + r) * 132 + 32 * vb + 8 * g + 4 * hh) = w; }
    __syncthreads();
    { const int t = tid >> 3, vs = (tid & 7) * 16;
      f32x4 x[4]; float ss = 0.f;
#pragma unroll
      for (int j = 0; j < 4; ++j) { x[j] = *(const LAS f32x4*)(Ost + t * 132 + vs + 4 * j); ss += x[j][0] * x[j][0] + x[j][1] * x[j][1] + x[j][2] * x[j][2] + x[j][3] * x[j][3]; }
      ss += shflx(ss, 1, lane); ss += shflx(ss, 2, lane); ss += shflx(ss, 4, lane);
      const float rs = rsqrtf(ss * (1.f / 128.f) + EPS);
      if (t < hu.nvalid) {
          const size_t off = (size_t)(hu.rowbase + t) * 2048 + hu.h * 128 + vs;
          const u32x4 ga = *(const u32x4*)(HG + off), gb = *(const u32x4*)(HG + off + 8);
          const f32x4 n0 = *(const f32x4*)(gn + vs), n1 = *(const f32x4*)(gn + vs + 4), n2 = *(const f32x4*)(gn + vs + 8), n3 = *(const f32x4*)(gn + vs + 12);
          u32x4 oa, ob;
          oa.x = pk2(x[0][0] * rs * n0[0] * bflo(ga.x), x[0][1] * rs * n0[1] * bfhi(ga.x)); oa.y = pk2(x[0][2] * rs * n0[2] * bflo(ga.y), x[0][3] * rs * n0[3] * bfhi(ga.y));
          oa.z = pk2(x[1][0] * rs * n1[0] * bflo(ga.z), x[1][1] * rs * n1[1] * bfhi(ga.z)); oa.w = pk2(x[1][2] * rs * n1[2] * bflo(ga.w), x[1][3] * rs * n1[3] * bfhi(ga.w));
          ob.x = pk2(x[2][0] * rs * n2[0] * bflo(gb.x), x[2][1] * rs * n2[1] * bfhi(gb.x)); ob.y = pk2(x[2][2] * rs * n2[2] * bflo(gb.y), x[2][3] * rs * n2[3] * bfhi(gb.y));
          ob.z = pk2(x[3][0] * rs * n3[0] * bflo(gb.z), x[3][1] * rs * n3[1] * bfhi(gb.z)); ob.w = pk2(x[3][2] * rs * n3[2] * bflo(gb.w), x[3][3] * rs * n3[3] * bfhi(gb.w));
          *(u32x4*)(OH + off) = oa; *(u32x4*)(OH + off + 8) = ob;
      } }
    __syncthreads();
}

template <bool SAMPLE>
DI void attn_wave(const bf16_t* __restrict__ Qp, const bf16_t* __restrict__ Kn, const bf16_t* __restrict__ Kp, const bf16_t* __restrict__ Vt, int t0, int t1, int tstep, int nkeys,
                  float& m, float& l, f32x16 (&O)[4], int r, int hh) {
    const int lane = r + 32 * hh;
    bf16x8 qf[12];
#pragma unroll
    for (int s = 0; s < 12; ++s) qf[s] = *(const bf16x8*)(Qp + (size_t)r * 3072 + 16 * s + 8 * hh);
    m = -INFINITY; l = 0.f;
#pragma unroll
    for (int vb = 0; vb < 4; ++vb) O[vb] = zero16();
    for (int t = t0; t < t1; t += tstep) {
        const bf16_t* kn = Kn + (size_t)(64 * t + r) * 2048 + 8 * hh; const bf16_t* kp = Kp + (size_t)(64 * t + r) * 64 + 8 * hh;
        f32x16 S0 = zero16(), S1 = zero16();
#pragma unroll
        for (int s = 0; s < 8; ++s) { const bf16x8 a0 = *(const bf16x8*)(kn + 16 * s), a1 = *(const bf16x8*)(kn + 32 * 2048 + 16 * s); S0 = MFMA32(a0, qf[s], S0); S1 = MFMA32(a1, qf[s], S1); }
#pragma unroll
        for (int s = 0; s < 4; ++s) { const bf16x8 a0 = *(const bf16x8*)(kp + 16 * s), a1 = *(const bf16x8*)(kp + 32 * 64 + 16 * s); S0 = MFMA32(a0, qf[8 + s], S0); S1 = MFMA32(a1, qf[8 + s], S1); }
        if (SAMPLE) { if (64 * t + 64 > nkeys) {
#pragma unroll
            for (int i = 0; i < 16; ++i) { if (64 * t + crow(i, hh) >= nkeys) S0[i] = -INFINITY; if (64 * t + 32 + crow(i, hh) >= nkeys) S1[i] = -INFINITY; } } }
        float mx = fmaxf(S0[0], S1[0]);
#pragma unroll
        for (int i = 1; i < 16; ++i) mx = fmaxf(mx, fmaxf(S0[i], S1[i]));
        mx = fmaxf(mx, shflx(mx, 32, lane));
        const float mn = fmaxf(m, mx), alpha = ex2(m - mn); m = mn;
        float ls = 0.f;
#pragma unroll
        for (int i = 0; i < 16; ++i) { S0[i] = ex2(S0[i] - mn); S1[i] = ex2(S1[i] - mn); ls += S0[i] + S1[i]; }
        l = l * alpha + ls;
#pragma unroll
        for (int vb = 0; vb < 4; ++vb) O[vb] = O[vb] * alpha;
        const bf16x8 p0 = pack8<0>(S0), p1 = pack8<1>(S0), p2 = pack8<0>(S1), p3 = pack8<1>(S1);
#pragma unroll
        for (int vb = 0; vb < 4; ++vb) {
            const bf16_t* vp = Vt + (size_t)(32 * vb + r) * KVR + 64 * t + 4 * hh;
            { const s16x4 lo = *(const s16x4*)(vp), hi = *(const s16x4*)(vp + 8); O[vb] = MFMA32(__builtin_shufflevector(lo, hi, 0, 1, 2, 3, 4, 5, 6, 7), p0, O[vb]); }
            { const s16x4 lo = *(const s16x4*)(vp + 16), hi = *(const s16x4*)(vp + 24); O[vb] = MFMA32(__builtin_shufflevector(lo, hi, 0, 1, 2, 3, 4, 5, 6, 7), p1, O[vb]); }
            { const s16x4 lo = *(const s16x4*)(vp + 32), hi = *(const s16x4*)(vp + 40); O[vb] = MFMA32(__builtin_shufflevector(lo, hi, 0, 1, 2, 3, 4, 5, 6, 7), p2, O[vb]); }
            { const s16x4 lo = *(const s16x4*)(vp + 48), hi = *(const s16x4*)(vp + 56); O[vb] = MFMA32(__builtin_shufflevector(lo, hi, 0, 1, 2, 3, 4, 5, 6, 7), p3, O[vb]); }
        }
    }
}
DI void attn_prompt_unit(const Params& P, int bh, int jq, int wave, int lane) {
    const bf16_t* Q = (const bf16_t*)(P.ws + WS_Q); const bf16_t* KN = (const bf16_t*)(P.ws + WS_KN); const bf16_t* KPE = (const bf16_t*)(P.ws + WS_KPE); const bf16_t* VT = (const bf16_t*)(P.ws + WS_VT);
    bf16_t* OA = (bf16_t*)(P.ws + WS_OA);
    const int b = bh >> 4, h = bh & 15, rb = 8 * jq + wave, row0 = b * 2048 + 32 * rb, kv0 = b * 2048, r = lane & 31, hh = lane >> 5;
    float m, l; f32x16 O[4];
    attn_wave<false>(Q + (size_t)row0 * 3072 + h * 192, KN + (size_t)kv0 * 2048 + h * 128, KPE + (size_t)kv0 * 64, VT + (size_t)(h * 128) * KVR + kv0, 0, (rb >> 1) + 1, 1, 0, m, l, O, r, hh);
    l += shflx(l, 32, lane); const float inv = 1.f / l;
#pragma unroll
    for (int vb = 0; vb < 4; ++vb)
#pragma unroll
        for (int g = 0; g < 4; ++g) { u32x2 w; w.x = pk2(O[vb][4 * g] * inv, O[vb][4 * g + 1] * inv); w.y = pk2(O[vb][4 * g + 2] * inv, O[vb][4 * g + 3] * inv);
            *(u32x2*)(OA + (size_t)(row0 + r) * 2048 + h * 128 + 32 * vb + 8 * g + 4 * hh) = w; }
}
constexpr int ATT_KB = 64 * 400, ATT_VB = 128 * 144, ATT_BUF = ATT_KB + ATT_VB;
DI void attn_prompt_lds(LAS unsigned char* lds, const Params& P, int bh, int jq, int wave_in, int lane_in, int tid) {
    int lane = lane_in, wave = wave_in; asm volatile("" : "+v"(lane), "+s"(wave));
    const bf16_t* Q = (const bf16_t*)(P.ws + WS_Q); const bf16_t* KN = (const bf16_t*)(P.ws + WS_KN); const bf16_t* KPE = (const bf16_t*)(P.ws + WS_KPE); const bf16_t* VT = (const bf16_t*)(P.ws + WS_VT);
    bf16_t* OA = (bf16_t*)(P.ws + WS_OA);
    const int b = bh >> 4, h = bh & 15, rb = 8 * jq + wave, row0 = b * 2048 + 32 * rb, kv0 = b * 2048, r = lane & 31, hh = lane >> 5;
    const int ntiles = 4 * jq + 4, mytiles = (rb >> 1) + 1;
    const char* src[6]; unsigned inc[6]; unsigned dsto[6];
#pragma unroll
    for (int i = 0; i < 6; ++i) {
        const int ii = (i < 5 || wave < 3) ? i * 8 + wave : 32 + wave;
        const int sl = ii * 64 + lane; dsto[i] = (unsigned)ii * 1024u;
        if (sl < 1600) { const int row = sl / 25; int c = sl - row * 25; c = c == 24 ? 23 : c;
            if (c < 16) { src[i] = (const char*)(KN + (size_t)(kv0 + row) * 2048 + h * 128 + c * 8); inc[i] = 64u * 2048u * 2u; }
            else { src[i] = (const char*)(KPE + (size_t)(kv0 + row) * 64 + (c - 16) * 8); inc[i] = 64u * 64u * 2u; } }
        else { const int s2 = sl - 1600, vr = s2 / 9; int p = s2 - vr * 9; p = p == 8 ? 7 : p; const int c = p ^ ((vr >> 4) & 1);
            src[i] = (const char*)(VT + (size_t)(h * 128 + vr) * KVR + kv0 + c * 8); inc[i] = 128u; }
    }
#define ATT_FILL(t) do { LAS unsigned char* sb_ = lds + ((t) % 3) * ATT_BUF; _Pragma("unroll") for (int i_ = 0; i_ < 6; ++i_) \
        __builtin_amdgcn_global_load_lds((const unsigned*)(src[i_] + (size_t)(t) * inc[i_]), (LAS unsigned*)(sb_ + dsto[i_]), 16, 0, 0); } while (0)
    bf16x8 qf[12];
    { const bf16_t* Qp = Q + (size_t)row0 * 3072 + h * 192;
#pragma unroll
      for (int s = 0; s < 12; ++s) qf[s] = *(const bf16x8*)(Qp + (size_t)r * 3072 + 16 * s + 8 * hh); }
    asm volatile("s_waitcnt vmcnt(0)" ::: "memory");
    ATT_FILL(0); ATT_FILL(1);
    float m = -INFINITY, l = 0.f; f32x16 O[4];
#pragma unroll
    for (int vb = 0; vb < 4; ++vb) O[vb] = zero16();
    const int sw = (r >> 4) & 1;
    for (int t = 0; t < ntiles; ++t) {
        if (t + 1 < ntiles) asm volatile("s_waitcnt vmcnt(6)" ::: "memory"); else asm volatile("s_waitcnt vmcnt(0)" ::: "memory");
        __builtin_amdgcn_s_barrier(); asm volatile("" ::: "memory");
        if (t + 2 < ntiles) ATT_FILL(t + 2);
        if (t < mytiles) {
            const LAS unsigned char* kb_ = lds + (t % 3) * ATT_BUF; const LAS unsigned char* vb_ = kb_ + ATT_KB;
            const LAS bf16_t* kr = (const LAS bf16_t*)(kb_ + r * 400 + 16 * hh);
            f32x16 S0 = zero16(), S1 = zero16();
#pragma unroll
            for (int s = 0; s < 12; ++s) { const bf16x8 a0 = *(const LAS bf16x8*)(kr + 16 * s), a1 = *(const LAS bf16x8*)(kr + 32 * 200 + 16 * s); S0 = MFMA32(a0, qf[s], S0); S1 = MFMA32(a1, qf[s], S1); }
            float mx = fmaxf(S0[0], S1[0]);
#pragma unroll
            for (int i = 1; i < 16; ++i) mx = fmaxf(mx, fmaxf(S0[i], S1[i]));
            mx = fmaxf(mx, shflx(mx, 32, lane));
            const float mn = fmaxf(m, mx), alpha = ex2(m - mn); m = mn;
            float ls = 0.f;
#pragma unroll
            for (int i = 0; i < 16; ++i) { S0[i] = ex2(S0[i] - mn); S1[i] = ex2(S1[i] - mn); ls += S0[i] + S1[i]; }
            l = l * alpha + ls;
#pragma unroll
            for (int vb = 0; vb < 4; ++vb) O[vb] = O[vb] * alpha;
            const bf16x8 p0 = pack8<0>(S0), p1 = pack8<1>(S0), p2 = pack8<0>(S1), p3 = pack8<1>(S1);
#pragma unroll
            for (int vb = 0; vb < 4; ++vb) {
                const LAS unsigned char* vp = vb_ + (32 * vb + r) * 144 + 8 * hh;
                const LAS unsigned char* vlo = vp + 16 * sw; const LAS unsigned char* vhi = vp + 16 * (1 - sw);
                { const s16x4 lo = *(const LAS s16x4*)(vlo), hi = *(const LAS s16x4*)(vhi); O[vb] = MFMA32(__builtin_shufflevector(lo, hi, 0, 1, 2, 3, 4, 5, 6, 7), p0, O[vb]); }
                { const s16x4 lo = *(const LAS s16x4*)(vlo + 32), hi = *(const LAS s16x4*)(vhi + 32); O[vb] = MFMA32(__builtin_shufflevector(lo, hi, 0, 1, 2, 3, 4, 5, 6, 7), p1, O[vb]); }
                { const s16x4 lo = *(const LAS s16x4*)(vlo + 64), hi = *(const LAS s16x4*)(vhi + 64); O[vb] = MFMA32(__builtin_shufflevector(lo, hi, 0, 1, 2, 3, 4, 5, 6, 7), p2, O[vb]); }
                { const s16x4 lo = *(const LAS s16x4*)(vlo + 96), hi = *(const LAS s16x4*)(vhi + 96); O[vb] = MFMA32(__builtin_shufflevector(lo, hi, 0, 1, 2, 3, 4, 5, 6, 7), p3, O[vb]); }
            }
            asm volatile("s_waitcnt lgkmcnt(0)" ::: "memory");
        }
    }
#undef ATT_FILL
    __builtin_amdgcn_s_barrier(); asm volatile("" ::: "memory");
    l += shflx(l, 32, lane); const float inv = 1.f / l;
#pragma unroll
    for (int vb = 0; vb < 4; ++vb)
#pragma unroll
        for (int g = 0; g < 4; ++g) { u32x2 w; w.x = pk2(O[vb][4 * g] * inv, O[vb][4 * g + 1] * inv); w.y = pk2(O[vb][4 * g + 2] * inv, O[vb][4 * g + 3] * inv);
            *(u32x2*)(OA + (size_t)(row0 + r) * 2048 + h * 128 + 32 * vb + 8 * g + 4 * hh) = w; }
    asm volatile("s_waitcnt vmcnt(0)" ::: "memory");
}
DI void attn_sample_unit(LAS unsigned char* lds, const Params& P, int su, int wave, int lane, int tid) {
    const bf16_t* Q = (const bf16_t*)(P.ws + WS_Q); const bf16_t* KN = (const bf16_t*)(P.ws + WS_KN); const bf16_t* KPE = (const bf16_t*)(P.ws + WS_KPE); const bf16_t* VT = (const bf16_t*)(P.ws + WS_VT);
    bf16_t* OA = (bf16_t*)(P.ws + WS_OA);
    const int b = su >> 4, h = su & 15, row0 = MP + b * 32, kv0 = MP + b * KVB, r = lane & 31, hh = lane >> 5;
    float m, l; f32x16 O[4];
    attn_wave<true>(Q + (size_t)row0 * 3072 + h * 192, KN + (size_t)kv0 * 2048 + h * 128, KPE + (size_t)kv0 * 64, VT + (size_t)(h * 128) * KVR + kv0, wave, 65, 8, 4128, m, l, O, r, hh);
    l += shflx(l, 32, lane);
    LAS float* ml = (LAS float*)(lds + 131072);
    if (hh == 0) { ml[(wave * 32 + r) * 2] = m; ml[(wave * 32 + r) * 2 + 1] = l; }
    __syncthreads();
    float ms = -INFINITY;
#pragma unroll
    for (int w = 0; w < 8; ++w) ms = fmaxf(ms, ml[(w * 32 + r) * 2]);
    float L = 0.f;
#pragma unroll
    for (int w = 0; w < 8; ++w) L += ml[(w * 32 + r) * 2 + 1] * ex2(ml[(w * 32 + r) * 2] - ms);
    const float sc = ex2(m - ms) / L;
    LAS float* slot = (LAS float*)(lds + wave * 16384);
#pragma unroll
    for (int vb = 0; vb < 4; ++vb)
#pragma unroll
        for (int i = 0; i < 16; ++i) slot[(32 * vb + crow(i, hh)) * 32 + r] = O[vb][i] * sc;
    __syncthreads();
    { const int q = tid & 31, vg = tid >> 5; float a[8];
#pragma unroll
      for (int e = 0; e < 8; ++e) { float s = 0.f;
#pragma unroll
          for (int w = 0; w < 8; ++w) s += ((const LAS float*)(lds + w * 16384))[(8 * vg + e) * 32 + q];
          a[e] = s; }
      u32x4 o; o.x = pk2(a[0], a[1]); o.y = pk2(a[2], a[3]); o.z = pk2(a[4], a[5]); o.w = pk2(a[6], a[7]);
      *(u32x4*)(OA + (size_t)(row0 + q) * 2048 + h * 128 + 8 * vg) = o; }
    __syncthreads();
}

#define XB_TMO      128
#define XB_XCNT(j)  (256  + 64 * (j))
#define XB_XSUB(j)  (1280 + 64 * (j))
#define XB_XGEN(j)  (2304 + 64 * (j))
#define XB_TOP      3328
#define XB_TOPGEN   3392
#define XCD_BAR_WORDS 3456
#define XB_SPIN_CAP (1u << 18)

__device__ __forceinline__ unsigned xb_ld(unsigned* p)              { return __hip_atomic_load(p, __ATOMIC_RELAXED, __HIP_MEMORY_SCOPE_AGENT); }
__device__ __forceinline__ unsigned xb_add(unsigned* p, unsigned v) { return __hip_atomic_fetch_add(p, v, __ATOMIC_RELAXED, __HIP_MEMORY_SCOPE_AGENT); }
__device__ __forceinline__ unsigned xb_xcc_id() { return (unsigned)__builtin_amdgcn_s_getreg((3 << 11) | 20) & 0xFu; }
#define XB_SPIN(cond, bar) do { unsigned _sp = 0; while (cond) { __builtin_amdgcn_s_sleep(1); \
    if ((++_sp & 255u) == 0u) { if (xb_ld(&(bar)[XB_TMO])) break; if (_sp > XB_SPIN_CAP) { atomicAdd(&(bar)[XB_TMO], 1u); break; } } } } while (0)

struct XcdBarrier {
    unsigned* bar; unsigned x;
    volatile LAS unsigned* st;
};

__device__ __forceinline__ XcdBarrier xcd_barrier_post(unsigned* bar, volatile LAS unsigned* st, bool t0) {
    XcdBarrier b; b.bar = bar; b.x = xb_xcc_id(); b.st = st;
    if (t0) (void)xb_add(&bar[XB_XCNT(b.x)], 1u);
    return b;
}
__device__ __forceinline__ void xcd_barrier_complete(unsigned* bar, unsigned x, unsigned& nloc, unsigned& nx) {
    const unsigned G = gridDim.x * gridDim.y * gridDim.z;
    unsigned sum, cnt, mine, sp = 0u;
    for (;;) {
        sum = 0u; cnt = 0u; mine = 0u;
#pragma unroll
        for (unsigned j = 0; j < 16; ++j) { const unsigned c = xb_ld(&bar[XB_XCNT(j)]); sum += c; cnt += (c > 0u) ? 1u : 0u; mine = (j == x) ? c : mine; }
        if (sum == G) break;
        __builtin_amdgcn_s_sleep(1);
        if ((++sp & 255u) == 0u) { if (xb_ld(&bar[XB_TMO])) break; if (sp > XB_SPIN_CAP) { atomicAdd(&bar[XB_TMO], 1u); break; } }
    }
    nloc = mine > 0u ? mine : 1u; nx = cnt > 0u ? cnt : 1u;
}

__device__ __forceinline__ void xcd_barrier(const XcdBarrier& b, bool t0) {
    asm volatile("s_waitcnt vmcnt(0)" ::: "memory");
    __syncthreads();
    if (t0) {
        unsigned* bar = b.bar;
        __builtin_amdgcn_s_waitcnt(0);
        unsigned nloc = b.st[0], nx = b.st[1];
        if (nloc == 0u) { xcd_barrier_complete(bar, b.x, nloc, nx); b.st[0] = nloc; b.st[1] = nx; }
        const unsigned old = xb_add(&bar[XB_XSUB(b.x)], 1u);
        const unsigned gen = old / nloc;
        if (old + 1u == (gen + 1u) * nloc) {
            __builtin_amdgcn_fence(__ATOMIC_RELEASE, "agent");
            asm volatile("s_waitcnt vmcnt(0)" ::: "memory");
            const unsigned og = xb_add(&bar[XB_TOP], 1u);
            const unsigned tg = og / nx;
            if (og + 1u == (tg + 1u) * nx) xb_add(&bar[XB_TOPGEN], 1u);
            else XB_SPIN(xb_ld(&bar[XB_TOPGEN]) == tg, bar);
            __builtin_amdgcn_fence(__ATOMIC_ACQUIRE, "agent");
            xb_add(&bar[XB_XGEN(b.x)], 1u);
            asm volatile("s_waitcnt vmcnt(0)" ::: "memory");
        } else {
            XB_SPIN(xb_ld(&bar[XB_XGEN(b.x)]) == gen, bar);
            __builtin_amdgcn_fence(__ATOMIC_ACQUIRE, "agent");
            asm volatile("s_waitcnt vmcnt(0)" ::: "memory");
        }
    }
    __syncthreads();
}

constexpr int LDS_BYTES = 147456;
template <class Epi> DI void run_gemm_(LAS unsigned char* lds, const bf16_t* A, const bf16_t* Bt, int M_, int N_, int K_, int G, int c, const Epi& E, int tid) {
    pg8::Gemm g{A, Bt, M_, N_, K_, K_}; pg8::StaticOrder S; S.init(M_, N_, G, c);
    pg8::gemm_phase<Epi, pg8::StaticOrder, true, true>(lds, g, S, E, tid);
}
DI void run_tail_(LAS unsigned char* lds, const bf16_t* A, const bf16_t* Bt, int N_, int K_, int KS, float* slab, int G, int c, int tid) {
    pg8::Gemm g{A, Bt, MTOK, N_, K_, K_ / KS}; pg8::TailOrder S{MP / 256, N_ / 256, KS, K_ / KS, G, c}; pg8::EpiSlab E{slab, N_, K_ / KS};
    pg8::gemm_phase<pg8::EpiSlab, pg8::TailOrder, true, true>(lds, g, S, E, tid);
}

#define run_gemm(...) run_gemm_(__VA_ARGS__, tid)
#define run_tail(...) run_tail_(__VA_ARGS__, tid)
typedef const __attribute__((address_space(4))) Params CParams;
#define PHASE_BEGIN \
    Params P; { CParams* pp_ = (CParams*)__builtin_amdgcn_kernarg_segment_ptr(); asm volatile("" : "+s"(pp_)); _Pragma("unroll") for (int i_ = 0; i_ < 22; ++i_) P.in[i_] = pp_->in[i_]; P.out = pp_->out; P.ws = pp_->ws; } \
    int lane_l; asm volatile("v_mbcnt_lo_u32_b32 %0, -1, 0\n\tv_mbcnt_hi_u32_b32 %0, -1, %0" : "=v"(lane_l)); int wave_l = wave_s; asm volatile("" : "+s"(wave_l)); \
    const int tid = wave_l * 64 + lane_l; int G = gridDim.x, bx = blockIdx.x; asm volatile("" : "+s"(G), "+s"(bx)); \
    const int lane = lane_l, wave = wave_l; \
    const int vcu = (G % 8 == 0) ? (bx % 8) * (G / 8) + bx / 8 : bx;       \
    const int gw = vcu * 8 + wave, NGW = G * 8, gt = bx * 512 + tid, NGT = G * 512; \
    unsigned char* ws = P.ws; (void)lane; (void)gw; (void)NGW; (void)gt; (void)NGT; (void)ws;

__global__ void __launch_bounds__(512, 2) fwd_kernel(Params Pk) {
    extern __shared__ __attribute__((aligned(16))) unsigned char lds_raw[];
    LAS unsigned char* lds = (LAS unsigned char*)lds_raw;
    cg::grid_group grid = cg::this_grid();
    const int wave_s = __builtin_amdgcn_readfirstlane((int)threadIdx.x >> 6);
#ifndef PROBE
#define PROBE 0
#endif
#define GSYNC() do { for (int rs_ = 0; rs_ < ((PROBE & 4) ? 2 : 1); ++rs_) { XcdBarrier xb_ = xbar; asm volatile("" : "+s"(xb_.bar)); int ln_; asm volatile("v_mbcnt_lo_u32_b32 %0, -1, 0\n\tv_mbcnt_hi_u32_b32 %0, -1, %0" : "=v"(ln_)); xcd_barrier(xb_, wave_s == 0 && ln_ == 0); } } while (0)
    const int tid0_ = threadIdx.x;
    if (tid0_ < 64) ((LAS unsigned*)(lds + 131072 + 8192))[tid0_] = 0u;
    __syncthreads();
    XcdBarrier xbar = xcd_barrier_post((unsigned*)(Pk.ws + WS_CTL), (volatile LAS unsigned*)(lds + 131072 + 8192), tid0_ == 0);
    { PHASE_BEGIN
      for (int rep = 0; rep < ((PROBE & 8) ? 2 : 1); ++rep) {
      layer_prep(P, lds, 0, gw, NGW, gt, NGT, lane, wave);
      rope_table(P, gt, NGT);
      init_x(P, gw, NGW, lane); } }
    __threadfence(); grid.sync(); __threadfence();
    for (int l = 0; l < 2; ++l) {
        { PHASE_BEGIN
          pg8::EpiWin E{(float*)(ws + WS_ZS), (bf16_t*)(ws + WS_HQ), (bf16_t*)(ws + WS_HK), (bf16_t*)(ws + WS_HV), (bf16_t*)(ws + WS_HG), (bf16_t*)(ws + WS_GA), (bf16_t*)(ws + WS_GB), (float*)(ws + WS_LF), (const float*)(ws + WS_LB)};
          run_gemm(lds, (const bf16_t*)(ws + WS_XN), (const bf16_t*)(ws + WS_WIN), MTOK, DINP, 2048, G, bx, E); }
        GSYNC();
        { PHASE_BEGIN
          for (int rep = 0; rep < ((PROBE & 8) ? 2 : 1); ++rep) small_norms(P, l, gw, NGW, lane);
          for (int rep = 0; rep < ((PROBE & 2) ? 2 : 1); ++rep)
          for (int u = vcu; u < NU; u += G) hgrn_pass1(lds, (const float*)(ws + WS_LF), (const bf16_t*)(ws + WS_HK), (const bf16_t*)(ws + WS_HV), (bf16_t*)(ws + WS_UT), (float*)(ws + WS_D), u, tid); }
        GSYNC();
        { PHASE_BEGIN
          for (int rep = 0; rep < ((PROBE & 2) ? 2 : 1); ++rep)
          for (int x = vcu; x < 768; x += G) hgrn_pass2(lds, P, l, x, tid); }
        GSYNC();
        { PHASE_BEGIN
          for (int rep = 0; rep < ((PROBE & 2) ? 2 : 1); ++rep)
          for (int u = vcu; u < NU; u += G) hgrn_pass3(lds, (const float*)(ws + WS_LF), (const bf16_t*)(ws + WS_HQ), (const bf16_t*)(ws + WS_HK), (const bf16_t*)(ws + WS_HV), (const bf16_t*)(ws + WS_HG),
                                                       (const bf16_t*)(ws + WS_SPT), P.in[14] + l * 128, (bf16_t*)(ws + WS_OH), u, tid); }
        GSYNC();
        { PHASE_BEGIN
          pg8::EpiQ E{(bf16_t*)(ws + WS_Q), (const float*)(ws + WS_TBL)}; run_gemm(lds, (const bf16_t*)(ws + WS_QN), (const bf16_t*)(ws + WS_WUQ), MTOK, 3072, 512, G, bx, E); }
        { PHASE_BEGIN
          pg8::EpiPlain E{(bf16_t*)(ws + WS_KN), 2048}; run_gemm(lds, (const bf16_t*)(ws + WS_CKV), (const bf16_t*)(ws + WS_WUK), KVR, 2048, 512, G, (bx + 116) % G, E); }
        { PHASE_BEGIN
          pg8::EpiPlain E{(bf16_t*)(ws + WS_VT), KVR}; run_gemm(lds, (const bf16_t*)(ws + WS_WUV), (const bf16_t*)(ws + WS_CKV), 2048, KVR, 512, G, (bx + 100) % G, E); }
        GSYNC();
        { PHASE_BEGIN
          for (int rep = 0; rep < ((PROBE & 1) ? 2 : 1); ++rep) {
          for (int x = vcu; x < 256; x += G) { const int bh = x & 63, grp = x >> 6;
              const int code = grp == 0 ? 0x21 : grp == 1 ? 0x012 : grp == 2 ? 0x672 : 0x3453;
              if (grp < 2) attn_sample_unit(lds, P, x, wave, lane, tid);
              for (int i = 0; i < (code & 15); ++i) attn_prompt_lds(lds, P, bh, (code >> (4 + 4 * i)) & 15, wave, lane, tid); } } }
        GSYNC();
        { PHASE_BEGIN
          pg8::EpiGate<false> E{(const bf16_t*)(ws + WS_GA), (bf16_t*)(ws + WS_T)}; run_gemm(lds, (const bf16_t*)(ws + WS_OA), (const bf16_t*)(ws + WS_WOA), MP, 2048, 2048, G, bx, E); }
        { PHASE_BEGIN
          run_tail(lds, (const bf16_t*)(ws + WS_OA), (const bf16_t*)(ws + WS_WOA), 2048, 2048, 16, (float*)(ws + WS_SLAB0), G, bx); }
        { PHASE_BEGIN
          pg8::EpiGate<true> E{(const bf16_t*)(ws + WS_GB), (bf16_t*)(ws + WS_T)}; run_gemm(lds, (const bf16_t*)(ws + WS_OH), (const bf16_t*)(ws + WS_WOB), MP, 2048, 2048, G, bx, E); }
        { PHASE_BEGIN
          run_tail(lds, (const bf16_t*)(ws + WS_OH), (const bf16_t*)(ws + WS_WOB), 2048, 2048, 16, (float*)(ws + WS_SLAB1), G, (bx + G / 2) % G); }
        GSYNC();
        { PHASE_BEGIN
          for (int x = vcu; x < 64; x += G) { const int pn = x >> 3, mk = 1 << (x & 7);
              { pg8::EpiGate<false> E{(const bf16_t*)(ws + WS_GA), (bf16_t*)(ws + WS_T)}; pg8::tail_fixup(( const float*)(ws + WS_SLAB0), 16, 2048, MP / 256, pn, mk, E, tid); }
              { pg8::EpiGate<true> E{(const bf16_t*)(ws + WS_GB), (bf16_t*)(ws + WS_T)}; pg8::tail_fixup((const float*)(ws + WS_SLAB1), 16, 2048, MP / 256, pn, mk, E, tid); } } }
        GSYNC();
        for (int repI = 0; repI < ((PROBE & 32) ? 2 : 1); ++repI) {
        { PHASE_BEGIN
          pg8::EpiF32 E{(float*)(ws + WS_MIX), 2048}; run_gemm(lds, (const bf16_t*)(ws + WS_T), (const bf16_t*)(ws + WS_WOUT), MP, 2048, 2048, G, bx, E); }
        { PHASE_BEGIN
          run_tail(lds, (const bf16_t*)(ws + WS_T), (const bf16_t*)(ws + WS_WOUT), 2048, 2048, 16, (float*)(ws + WS_SLAB0), G, bx); }
        GSYNC();
        }
        { PHASE_BEGIN
          resid_norm((const float*)(ws + WS_MIX), P.in[17] + l * 2048, P.out, P.in[18] + l * 2048, (bf16_t*)(ws + WS_XN), gw, NGW, lane);
          resid_norm_tail(lds, (const float*)(ws + WS_SLAB0), 16, P.in[17] + l * 2048, P.out, P.in[18] + l * 2048, (bf16_t*)(ws + WS_XN), vcu, G, wave, lane); }
        GSYNC();
        for (int repK = 0; repK < ((PROBE & 16) ? 2 : 1); ++repK) {
        { PHASE_BEGIN
          pg8::EpiRelu2 E{(bf16_t*)(ws + WS_H), FFN}; run_gemm(lds, (const bf16_t*)(ws + WS_XN), (const bf16_t*)(ws + WS_WUP), MP, FFN, 2048, G, bx, E); }
        { PHASE_BEGIN
          run_tail(lds, (const bf16_t*)(ws + WS_XN), (const bf16_t*)(ws + WS_WUP), FFN, 2048, 4, (float*)(ws + WS_SLAB0), G, bx); }
        GSYNC();
        { PHASE_BEGIN
          for (int x = vcu; x < 256; x += G) { pg8::EpiRelu2 E{(bf16_t*)(ws + WS_H), FFN}; pg8::tail_fixup((const float*)(ws + WS_SLAB0), 4, FFN, MP / 256, x >> 3, 1 << (x & 7), E, tid); } }
        GSYNC();
        }
        { PHASE_BEGIN
          pg8::EpiF32 E{(float*)(ws + WS_M2), 2048}; run_gemm(lds, (const bf16_t*)(ws + WS_H), (const bf16_t*)(ws + WS_WDN), MP, 2048, FFN, G, bx, E); }
        { PHASE_BEGIN
          run_tail(lds, (const bf16_t*)(ws + WS_H), (const bf16_t*)(ws + WS_WDN), 2048, FFN, 16, (float*)(ws + WS_SLAB0), G, bx); }
        GSYNC();
        { PHASE_BEGIN
          resid_norm((const float*)(ws + WS_M2), P.in[21] + l * 2048, P.out, l == 0 ? P.in[5] + 2048 : nullptr, (bf16_t*)(ws + WS_XN), gw, NGW, lane);
          resid_norm_tail(lds, (const float*)(ws + WS_SLAB0), 16, P.in[21] + l * 2048, P.out, l == 0 ? P.in[5] + 2048 : nullptr, (bf16_t*)(ws + WS_XN), vcu, G, wave, lane);
          if (l == 0) for (int rep = 0; rep < ((PROBE & 8) ? 2 : 1); ++rep) layer_prep(P, lds, 1, gw, NGW, gt, NGT, lane, wave); }
        if (l == 0) GSYNC();
    }
}

extern "C" void kernel_launch(void* const* d_in, const int* in_sizes, int n_in, void* d_out, int out_size, void* d_ws, size_t ws_size, hipStream_t stream) {
    static int grid = 0;
    if (grid == 0) {
        if (n_in != 22 || (size_t)out_size != OUT_TOTAL || ws_size < WS_END) { fprintf(stderr, "kernel_launch: unexpected shapes (n_in %d, out %d, ws %zu, need %zu)\n", n_in, out_size, ws_size, (size_t)WS_END); grid = -1; return; }
        int dev = 0, cus = 0, per_cu = 0;
        if (hipGetDevice(&dev) != hipSuccess || hipDeviceGetAttribute(&cus, hipDeviceAttributeMultiprocessorCount, dev) != hipSuccess) { grid = -1; return; }
        if (hipFuncSetAttribute((const void*)fwd_kernel, hipFuncAttributeMaxDynamicSharedMemorySize, LDS_BYTES) != hipSuccess) { fprintf(stderr, "kernel_launch: hipFuncSetAttribute failed\n"); grid = -1; return; }
        if (hipOccupancyMaxActiveBlocksPerMultiprocessor(&per_cu, (const void*)fwd_kernel, 512, LDS_BYTES) != hipSuccess || per_cu < 1) { fprintf(stderr, "kernel_launch: occupancy query failed (%d)\n", per_cu); per_cu = 1; }
        (void)hipGetLastError();
        grid = cus * per_cu;
    }
    if (grid < 0) return;
    if (hipMemsetAsync((char*)d_ws + WS_CTL, 0, 16384, stream) != hipSuccess) { fprintf(stderr, "kernel_launch: memset failed\n"); return; }
    Params p{};
    for (int i = 0; i < 22; ++i) p.in[i] = (const float*)d_in[i];
    p.out = (float*)d_out; p.ws = (unsigned char*)d_ws;
    void* args[] = {&p};
    hipError_t e = hipLaunchCooperativeKernel((const void*)fwd_kernel, dim3(grid), dim3(512), args, LDS_BYTES, stream);
    if (e != hipSuccess) fprintf(stderr, "kernel_launch: cooperative launch failed: %s (grid %d)\n", hipGetErrorString(e), grid);
}
```

```cpp
#include <hip/hip_runtime.h>
#include <hip/hip_cooperative_groups.h>
#include <cstdio>
#include <cstdint>
namespace cg = cooperative_groups;

#define DI __device__ __forceinline__
#define LAS __attribute__((address_space(3)))
typedef short bf16x8 __attribute__((ext_vector_type(8)));
typedef short s16x4 __attribute__((ext_vector_type(4)));
typedef float f32x4 __attribute__((ext_vector_type(4)));
typedef float f32x16 __attribute__((ext_vector_type(16)));
typedef unsigned u32x4 __attribute__((ext_vector_type(4)));
typedef unsigned u32x2 __attribute__((ext_vector_type(2)));
typedef float f32x2_t __attribute__((ext_vector_type(2)));
typedef __bf16 bf16x2_t __attribute__((ext_vector_type(2)));

constexpr int MP = 8192, MS = 256, MTOK = 8448, DM = 2048, DINP = 13568, ZSW = 1280, FFN = 8192;
constexpr int KVB = 4160;
constexpr int KVR = 8192 + 8 * KVB;
constexpr int NU = 2048 + 128;
constexpr float EPS = 1e-6f;
constexpr float QSCALE = 0.07216878364870322f * 1.4426950408889634f;

constexpr size_t MiB = 1u << 20;
constexpr size_t WS_WIN = 0, WS_WUQ = 53 * MiB, WS_WUK = 56 * MiB, WS_WUV = 58 * MiB, WS_WOA = 60 * MiB, WS_WOB = 68 * MiB, WS_WOUT = 76 * MiB, WS_WUP = 84 * MiB, WS_WDN = 116 * MiB;
constexpr size_t WS_XN = 148 * MiB, WS_HG = 181 * MiB, WS_GA = 214 * MiB, WS_GB = 247 * MiB, WS_QN = 280 * MiB, WS_Q = 289 * MiB, WS_OA = 339 * MiB, WS_OH = 372 * MiB;
constexpr size_t WS_CKV = 405 * MiB, WS_KPE = 446 * MiB, WS_TBL = 452 * MiB, WS_LB = 453 * MiB, WS_D = 454 * MiB, WS_R = 456 * MiB;
constexpr size_t WS_SPT = WS_Q;
constexpr size_t WS_ZS = WS_R, WS_HQ = WS_R + 42 * MiB, WS_HK = WS_R + 75 * MiB, WS_HV = WS_R + 108 * MiB, WS_LF = WS_R + 141 * MiB, WS_UT = WS_R + 207 * MiB;
constexpr size_t WS_KN = WS_R, WS_VT = WS_R + 162 * MiB;
constexpr size_t WS_T = WS_R, WS_MIX = WS_R + 33 * MiB, WS_H = WS_R + 99 * MiB, WS_M2 = WS_R + 231 * MiB;
constexpr size_t WS_SLAB0 = WS_Q, WS_SLAB1 = WS_R + 297 * MiB;
constexpr size_t WS_CTL = WS_R + 343 * MiB;
constexpr size_t WS_END = WS_CTL + 1 * MiB;
static_assert((size_t)NU * 128 * 128 * 2 <= 83 * MiB && (size_t)NU * 65536 <= 136 * MiB && (size_t)KVR * 2048 * 2 <= 162 * MiB, "ws map");

constexpr size_t OUT_X = 0, OUT_CKVP = 17301504, OUT_KPEP = OUT_CKVP + 8388608, OUT_STP = OUT_KPEP + 1048576, OUT_CKVS = OUT_STP + 2097152, OUT_KPES = OUT_CKVS + 262144, OUT_STS = OUT_KPES + 32768;
constexpr size_t OUT_TOTAL = OUT_STS + 4194304;

DI unsigned pk2(float lo, float hi) { f32x2_t v = {lo, hi}; bf16x2_t b = __builtin_convertvector(v, bf16x2_t); return __builtin_bit_cast(unsigned, b); }
DI unsigned short f2bf(float f) { return (unsigned short)(pk2(f, 0.f) & 0xffffu); }
DI float bf2f(unsigned short u) { return __uint_as_float((unsigned)u << 16); }
DI float bflo(unsigned w) { return __uint_as_float(w << 16); }
DI float bfhi(unsigned w) { return __uint_as_float(w & 0xffff0000u); }
DI float sigm(float x) { return 1.f / (1.f + __expf(-x)); }
DI float ex2(float x) { return __builtin_amdgcn_exp2f(x); }
DI float shflx(float v, int mask, int lane) { return __int_as_float(__builtin_amdgcn_ds_bpermute((lane ^ mask) << 2, __float_as_int(v))); }
DI float wave_sum(float v, int lane) {
#pragma unroll
    for (int o = 1; o < 64; o <<= 1) v += shflx(v, o, lane);
    return v;
}
namespace pg8 {
#define PG8_LAS __attribute__((address_space(3)))
typedef unsigned short bf16_t;
typedef short bf16x8 __attribute__((ext_vector_type(8)));
typedef float f32x4 __attribute__((ext_vector_type(4)));
typedef unsigned u32x4 __attribute__((ext_vector_type(4)));
constexpr int BM = 256, BK = 64, HALF = 128, HTB = HALF * BK * 2  , STAGE_BYTES = 8 * HTB, NXCD = 8, WGM = 8;

__host__ __device__ __forceinline__ int lds_byte(int r, int c) { const int st = (r >> 4) * 2 + (c >> 5), rr = r & 15, cc = c & 31, ob = rr * 64 + cc * 2; return st * 1024 + (ob ^ (((ob >> 9) & 1) << 5)); }
__host__ __device__ __forceinline__ void stage_rc(int b, int& R, int& C) { const int st = b / 1024, sb = b % 1024, swz = sb ^ (((sb >> 9) & 1) << 5); R = (st >> 1) * 16 + swz / 64; C = (st & 1) * 32 + (swz % 64) / 2; }
__host__ __device__ __forceinline__ int perm32(int rho) { const int n = rho >> 4, i = rho & 15; return 8 * (i >> 2) + 4 * n + (i & 3); }

struct Unit { int pm, pn, koff, mask; };
struct Gemm { const bf16_t* A; const bf16_t* Bt; int M, N, K, kext; };

struct StaticOrder {
    int nM, nN, nwg, G, c;
    __host__ __device__ void init(int M, int N, int G_, int c_) { nM = M / BM; nN = N / BM; nwg = nM * nN; G = G_; c = c_; }
    __host__ __device__ bool next(int i, Unit& u) const {
        const long L = (long)i * G + c; if (L >= nwg) return false;
        int wgid = (int)L; { const int q = nwg / NXCD, r = nwg % NXCD, xcd = wgid % NXCD, off = wgid / NXCD; wgid = (xcd < r ? xcd * (q + 1) : r * (q + 1) + (xcd - r) * q) + off; }
        const int nig = WGM * nN, gid = wgid / nig, fm = gid * WGM, gsz = (nM - fm) < WGM ? (nM - fm) : WGM;
        u.pm = fm + ((wgid % nig) % gsz); u.pn = (wgid % nig) / gsz; u.koff = 0; u.mask = 0xff; return true;
    }
    __device__ __forceinline__ void a_ready(const Unit&) const {}
    __device__ __forceinline__ void done(const Unit&) const {}
};

struct TailOrder {
    int pm, nN, KS, kext, G, c;
    __host__ __device__ bool next(int i, Unit& u) const { const int L = i * G + c; if (L >= nN * KS) return false; u.pm = pm; u.pn = L / KS; u.koff = (L - u.pn * KS) * kext; u.mask = 0xff; return true; }
    __device__ __forceinline__ void a_ready(const Unit&) const {}
    __device__ __forceinline__ void done(const Unit&) const {}
};
#define EPI_LOOP _Pragma("unroll") for (int ai = 0; ai < 2; ++ai) _Pragma("unroll") for (int m = 0; m < 4; ++m) if ((u.mask >> (ai * 4 + m)) & 1) _Pragma("unroll") for (int bj = 0; bj < 2; ++bj)
__device__ __forceinline__ u32x4 pack8f(const f32x4 a, const f32x4 b) { u32x4 w; w.x = pk2(a[0], a[1]); w.y = pk2(a[2], a[3]); w.z = pk2(b[0], b[1]); w.w = pk2(b[2], b[3]); return w; }

struct EpiWin {
    static constexpr bool PERM = true, AFTER_DRAIN = false;
    float* Zs; bf16_t *HQ, *HK, *HV, *HG, *GA, *GB; float* LF; const float* lb;
    __device__ __forceinline__ void operator()(const f32x4 (&acc)[2][2][4][2], const Unit& u, int wr, int wc, int fr, int fq) const {
        const int row0 = u.pm * 256 + wr * 64 + fr, ct = wc * 32 + 8 * fq, pn = u.pn;
        if (pn < 5) {
            EPI_LOOP { float* p = Zs + (size_t)(row0 + ai * 128 + m * 16) * ZSW + pn * 256 + ct + bj * 128; *(f32x4*)p = acc[ai][bj][m][0]; *(f32x4*)(p + 4) = acc[ai][bj][m][1]; }
            return;
        }
        const int seg = (pn - 5) >> 3, cseg = ((pn - 5) & 7) * 256 + ct;
        if (seg == 1) {
#pragma unroll
            for (int bj = 0; bj < 2; ++bj) {
                const f32x4 l0 = *(const f32x4*)(lb + cseg + bj * 128), l1 = *(const f32x4*)(lb + cseg + bj * 128 + 4);
#pragma unroll
                for (int ai = 0; ai < 2; ++ai)
#pragma unroll
                    for (int m = 0; m < 4; ++m) {
                        const size_t off = (size_t)(row0 + ai * 128 + m * 16) * 2048 + cseg + bj * 128;
                        f32x4 lf0, lf1, k0, k1;
#pragma unroll
                        for (int e = 0; e < 4; ++e) {
                            { const float z = acc[ai][bj][m][0][e], lbv = l0[e], ez = __expf(-z), sg = 1.f / (1.f + ez); lf0[e] = __logf(lbv + (1.f - lbv) * sg); k0[e] = (1.f - lbv) * ez * sg; }
                            { const float z = acc[ai][bj][m][1][e], lbv = l1[e], ez = __expf(-z), sg = 1.f / (1.f + ez); lf1[e] = __logf(lbv + (1.f - lbv) * sg); k1[e] = (1.f - lbv) * ez * sg; }
                        }
                        *(f32x4*)(LF + off) = lf0; *(f32x4*)(LF + off + 4) = lf1; *(u32x4*)(HK + off) = pack8f(k0, k1);
                    }
            }
            return;
        }
        bf16_t* O = seg == 0 ? HQ : seg == 2 ? HV : seg == 3 ? HG : seg == 4 ? GA : GB;
        const int act = (seg == 0 || seg == 3) ? 1 : (seg == 2 ? 0 : 2);
        EPI_LOOP {
            f32x4 a = acc[ai][bj][m][0], b = acc[ai][bj][m][1];
#pragma unroll
            for (int e = 0; e < 4; ++e) { const float sa = sigm(a[e]), sb = sigm(b[e]); a[e] = act == 0 ? a[e] : act == 1 ? a[e] * sa : sa; b[e] = act == 0 ? b[e] : act == 1 ? b[e] * sb : sb; }
            *(u32x4*)(O + (size_t)(row0 + ai * 128 + m * 16) * 2048 + cseg + bj * 128) = pack8f(a, b);
        }
    }
};

struct EpiQ {
    static constexpr bool PERM = true, AFTER_DRAIN = false;
    bf16_t* Q; const float* tbl;
    __device__ __forceinline__ void operator()(const f32x4 (&acc)[2][2][4][2], const Unit& u, int wr, int wc, int fr, int fq) const {
        const int row0 = u.pm * 256 + wr * 64 + fr, ct = wc * 32 + 8 * fq, pn = u.pn;
        if (pn < 8) {
            EPI_LOOP { const int col = pn * 256 + ct + bj * 128, h = col >> 7, i = col & 127;
                *(u32x4*)(Q + (size_t)(row0 + ai * 128 + m * 16) * 3072 + h * 192 + i) = pack8f(acc[ai][bj][m][0] * QSCALE, acc[ai][bj][m][1] * QSCALE); }
            return;
        }
        EPI_LOOP {
            const int row = row0 + ai * 128 + m * 16, p = row < MP ? (row & 2047) : 2048 + ((row - MP) & 31);
            const int c = (pn - 8) * 256 + ct + bj * 128, h = c >> 6, j0 = (c & 63) >> 1;
            const f32x4 t0 = *(const f32x4*)(tbl + (size_t)(p * 32 + j0) * 2), t1 = *(const f32x4*)(tbl + (size_t)(p * 32 + j0) * 2 + 4);
            const f32x4 x = acc[ai][bj][m][0] * QSCALE, y = acc[ai][bj][m][1] * QSCALE;
            const float a0 = x[0] * t0[0] - x[1] * t0[1], b0 = x[0] * t0[1] + x[1] * t0[0];
            const float a1 = x[2] * t0[2] - x[3] * t0[3], b1 = x[2] * t0[3] + x[3] * t0[2];
            const float a2 = y[0] * t1[0] - y[1] * t1[1], b2 = y[0] * t1[1] + y[1] * t1[0];
            const float a3 = y[2] * t1[2] - y[3] * t1[3], b3 = y[2] * t1[3] + y[3] * t1[2];
            bf16_t* q = Q + (size_t)row * 3072 + h * 192 + 128 + j0;
            u32x2 w1, w2; w1.x = pk2(a0, a1); w1.y = pk2(a2, a3); w2.x = pk2(b0, b1); w2.y = pk2(b2, b3);
            *(u32x2*)q = w1; *(u32x2*)(q + 32) = w2;
            if (bj == 1) asm volatile("" ::: "memory");
        }
    }
};

struct EpiPlain {
    static constexpr bool PERM = true, AFTER_DRAIN = false;
    bf16_t* O; int ldc;
    __device__ __forceinline__ void operator()(const f32x4 (&acc)[2][2][4][2], const Unit& u, int wr, int wc, int fr, int fq) const {
        const int row0 = u.pm * 256 + wr * 64 + fr, c0 = u.pn * 256 + wc * 32 + 8 * fq;
        EPI_LOOP { *(u32x4*)(O + (size_t)(row0 + ai * 128 + m * 16) * ldc + c0 + bj * 128) = pack8f(acc[ai][bj][m][0], acc[ai][bj][m][1]); }
    }
};
struct EpiF32 {
    static constexpr bool PERM = true, AFTER_DRAIN = false;
    float* O; int ldc;
    __device__ __forceinline__ void operator()(const f32x4 (&acc)[2][2][4][2], const Unit& u, int wr, int wc, int fr, int fq) const {
        const int row0 = u.pm * 256 + wr * 64 + fr, c0 = u.pn * 256 + wc * 32 + 8 * fq;
        EPI_LOOP { float* p = O + (size_t)(row0 + ai * 128 + m * 16) * ldc + c0 + bj * 128; *(f32x4*)p = acc[ai][bj][m][0]; *(f32x4*)(p + 4) = acc[ai][bj][m][1]; }
    }
};
struct EpiRelu2 {
    static constexpr bool PERM = true, AFTER_DRAIN = false;
    bf16_t* O; int ldc;
    __device__ __forceinline__ void operator()(const f32x4 (&acc)[2][2][4][2], const Unit& u, int wr, int wc, int fr, int fq) const {
        const int row0 = u.pm * 256 + wr * 64 + fr, c0 = u.pn * 256 + wc * 32 + 8 * fq;
        EPI_LOOP { f32x4 a = acc[ai][bj][m][0], b = acc[ai][bj][m][1];
#pragma unroll
            for (int e = 0; e < 4; ++e) { const float ra = fmaxf(a[e], 0.f), rb = fmaxf(b[e], 0.f); a[e] = ra * ra; b[e] = rb * rb; }
            *(u32x4*)(O + (size_t)(row0 + ai * 128 + m * 16) * ldc + c0 + bj * 128) = pack8f(a, b); }
    }
};
template <bool SECOND> struct EpiGate {
    static constexpr bool PERM = true, AFTER_DRAIN = false;
    const bf16_t* Gt; bf16_t* T;
    __device__ __forceinline__ void operator()(const f32x4 (&acc)[2][2][4][2], const Unit& u, int wr, int wc, int fr, int fq) const {
        const int row0 = u.pm * 256 + wr * 64 + fr, c0 = u.pn * 256 + wc * 32 + 8 * fq;
        EPI_LOOP { const size_t off = (size_t)(row0 + ai * 128 + m * 16) * 2048 + c0 + bj * 128;
            const u32x4 g = *(const u32x4*)(Gt + off); f32x4 a = acc[ai][bj][m][0], b = acc[ai][bj][m][1];
            a[0] *= bflo(g.x); a[1] *= bfhi(g.x); a[2] *= bflo(g.y); a[3] *= bfhi(g.y); b[0] *= bflo(g.z); b[1] *= bfhi(g.z); b[2] *= bflo(g.w); b[3] *= bfhi(g.w);
            if (SECOND) { const u32x4 t = *(const u32x4*)(T + off);
                a[0] += bflo(t.x); a[1] += bfhi(t.x); a[2] += bflo(t.y); a[3] += bfhi(t.y); b[0] += bflo(t.z); b[1] += bfhi(t.z); b[2] += bflo(t.w); b[3] += bfhi(t.w); }
            *(u32x4*)(T + off) = pack8f(a, b);
            if (bj == 1 && (m & 1)) asm volatile("" ::: "memory"); }
    }
};

struct EpiSlab {
    static constexpr bool PERM = true, AFTER_DRAIN = false;
    float* slab; int ldc, kext;
    __device__ __forceinline__ void operator()(const f32x4 (&acc)[2][2][4][2], const Unit& u, int wr, int wc, int fr, int fq) const {
        const int kp = u.koff / kext, r0 = wr * 64 + fr, c0 = u.pn * 256 + wc * 32 + 8 * fq;
        EPI_LOOP { float* p = slab + ((size_t)kp * 256 + r0 + ai * 128 + m * 16) * ldc + c0 + bj * 128; *(f32x4*)p = acc[ai][bj][m][0]; *(f32x4*)(p + 4) = acc[ai][bj][m][1]; }
    }
};
template <class Epi> __device__ __forceinline__ void tail_fixup(const float* slab, int KS, int ldc, int pm, int pn, int mask, const Epi& E, int tid_in) {
    Unit u; u.pm = pm; u.pn = pn; u.koff = 0; u.mask = mask;
    int tid_l = tid_in; asm volatile("" : "+v"(tid_l));
    const int wid = tid_l >> 6, lane = tid_l & 63, wr = wid >> 2, wc = wid & 3, fr = lane & 15, fq = lane >> 4;
    const int r0 = wr * 64 + fr, c0 = pn * 256 + wc * 32 + 8 * fq;
    f32x4 acc[2][2][4][2];
    EPI_LOOP { acc[ai][bj][m][0] = (f32x4){0.f, 0.f, 0.f, 0.f}; acc[ai][bj][m][1] = (f32x4){0.f, 0.f, 0.f, 0.f}; }
    const char* sb = (const char*)slab; unsigned off = ((unsigned)r0 * (unsigned)ldc + (unsigned)c0) * 4u;
    for (int kp = 0; kp < KS; ++kp) {
        EPI_LOOP { const char* p = sb + (off + (unsigned)((ai * 128 + m * 16) * ldc + bj * 128) * 4u); acc[ai][bj][m][0] += *(const f32x4*)p; acc[ai][bj][m][1] += *(const f32x4*)(p + 16); }
        off += 256u * (unsigned)ldc * 4u;
    }
    E(acc, u, wr, wc, fr, fq);
}
template <class Epi, class Sched, bool ALIGN_EPI = false, bool SP2 = false>
__device__ __forceinline__ void gemm_phase(PG8_LAS unsigned char* lds, const Gemm g, const Sched& S, const Epi& E, int tid_in) {
    int tid_l = tid_in; asm volatile("" : "+v"(tid_l));
    const int tid = tid_l, wid = __builtin_amdgcn_readfirstlane(tid >> 6), lane = tid & 63, wr = wid >> 2, wc = wid & 3, fr = lane & 15, fq = lane >> 4;
    const int K = g.K, nt = g.kext / BK;
    unsigned voffA[2], voffB[2];
#pragma unroll
    for (int i = 0; i < 2; ++i) { int R, C; stage_rc(tid * 16 + i * 8192, R, C); const int Rb = Epi::PERM ? ((R & ~31) + perm32(R & 31)) : R;
        voffA[i] = (unsigned)(R * K + C) * 2u; voffB[i] = (unsigned)(Rb * K + C) * 2u; }
    const size_t kstep = (size_t)(BK * 2);
    const size_t hstep = (size_t)HALF * K * 2;
    const size_t tstep = 2 * hstep;
    const unsigned ldsw = (unsigned)wid * 1024u;
    const int aoff = lds_byte(wr * 64 + fr, fq * 8), boff = lds_byte(wc * 32 + fr, fq * 8);
#define PG8_SA(b, h) (((b) * 2 + (h)) * HTB)
#define PG8_SB(b, h) ((4 + (b) * 2 + (h)) * HTB)
#define PG8_STAGE(bufoff, gbase, voff) do { _Pragma("unroll") for (int _i = 0; _i < 2; ++_i) \
        __builtin_amdgcn_global_load_lds((const unsigned*)((const char*)(gbase) + (voff)[_i]), (PG8_LAS unsigned*)(lds + (bufoff) + ldsw + _i * 8192), 16, 0, 0); } while (0)
#define PG8_LDA(dst, b, h) do { _Pragma("unroll") for (int m = 0; m < 4; ++m) _Pragma("unroll") for (int k = 0; k < 2; ++k) dst[m][k] = *(const PG8_LAS bf16x8*)(lds + PG8_SA(b, h) + aoff + m * 2048 + k * 1024); } while (0)
#define PG8_LDB(dst, b, h) do { _Pragma("unroll") for (int n = 0; n < 2; ++n) _Pragma("unroll") for (int k = 0; k < 2; ++k) dst[n][k] = *(const PG8_LAS bf16x8*)(lds + PG8_SB(b, h) + boff + n * 2048 + k * 1024); } while (0)
#define PG8_MMA(ai, bj, At, Bt) do { __builtin_amdgcn_s_setprio(1); _Pragma("unroll") for (int m = 0; m < 4; ++m) _Pragma("unroll") for (int n = 0; n < 2; ++n) _Pragma("unroll") for (int k = 0; k < 2; ++k) \
        acc[ai][bj][m][n] = __builtin_amdgcn_mfma_f32_16x16x32_bf16(Bt[n][k], At[m][k], acc[ai][bj][m][n], 0, 0, 0); __builtin_amdgcn_s_setprio(0); } while (0)
#define PG8_WAIT_V(n) asm volatile("s_waitcnt vmcnt(" #n ")" ::: "memory")
#define PG8_WAIT_L(n) asm volatile("s_waitcnt lgkmcnt(" #n ")" ::: "memory")
#define PG8_BAR __builtin_amdgcn_s_barrier()
#define PG8_SCHED __builtin_amdgcn_sched_barrier(0)
    Unit cur, nxt; int ui = 0;
    if (!S.next(0, cur)) return;
    f32x4 acc[2][2][4][2];
#pragma unroll
    for (int a = 0; a < 2; ++a)
#pragma unroll
        for (int b = 0; b < 2; ++b)
#pragma unroll
            for (int m = 0; m < 4; ++m)
#pragma unroll
                for (int n = 0; n < 2; ++n) acc[a][b][m][n] = (f32x4){0.f, 0.f, 0.f, 0.f};
    bf16x8 At[4][2], B0[2][2], B1[2][2];
    const char* cA = (const char*)g.A + (size_t)cur.pm * tstep + (size_t)cur.koff * 2; const char* cB = (const char*)g.Bt + (size_t)cur.pn * tstep + (size_t)cur.koff * 2;
    S.a_ready(cur);
    if constexpr (SP2) {
        PG8_STAGE(PG8_SB(0, 0), cB, voffB); PG8_STAGE(PG8_SB(0, 1), cB + hstep, voffB); PG8_STAGE(PG8_SA(0, 0), cA, voffA); PG8_STAGE(PG8_SA(0, 1), cA + hstep, voffA);
        if (wr == 1) PG8_BAR;
        PG8_WAIT_V(2); PG8_BAR;
        PG8_STAGE(PG8_SB(1, 0), cB + kstep, voffB); PG8_STAGE(PG8_SA(1, 0), cA + kstep, voffA); PG8_STAGE(PG8_SB(1, 1), cB + hstep + kstep, voffB);
        PG8_WAIT_V(6); PG8_BAR;
    } else {
        PG8_STAGE(PG8_SB(0, 0), cB, voffB); PG8_STAGE(PG8_SA(0, 0), cA, voffA); PG8_STAGE(PG8_SB(0, 1), cB + hstep, voffB); PG8_STAGE(PG8_SA(0, 1), cA + hstep, voffA);
        if (wr == 1) PG8_BAR;
        PG8_WAIT_V(4); PG8_BAR;
        PG8_STAGE(PG8_SB(1, 0), cB + kstep, voffB); PG8_STAGE(PG8_SA(1, 0), cA + kstep, voffA); PG8_STAGE(PG8_SB(1, 1), cB + hstep + kstep, voffB);
        PG8_WAIT_V(6); PG8_BAR;
    }
    for (;;) {
        const bool has_next = S.next(ui + 1, nxt);
        const char* nA = has_next ? (const char*)g.A + (size_t)nxt.pm * tstep + (size_t)nxt.koff * 2 : cA; const char* nB = has_next ? (const char*)g.Bt + (size_t)nxt.pn * tstep + (size_t)nxt.koff * 2 : cB;
        for (int t = 0; t < nt; t += 2) {
            const bool last = (t == nt - 2);
            const char* a1 = cA + (size_t)(t + 1) * kstep;
            const char* a2 = last ? nA : cA + (size_t)(t + 2) * kstep; const char* b2 = last ? nB : cB + (size_t)(t + 2) * kstep;
            const char* a3 = a2 + kstep; const char* b3 = b2 + kstep;
            if (last && has_next) S.a_ready(nxt);
            if constexpr (SP2) {
            PG8_LDB(B0, 0, 0); PG8_LDB(B1, 0, 1); PG8_SCHED; PG8_LDA(At, 0, 0); PG8_STAGE(PG8_SA(1, 1), a1 + hstep, voffA);
            PG8_WAIT_V(8); PG8_WAIT_L(0); PG8_BAR; PG8_MMA(0, 0, At, B0); PG8_MMA(0, 1, At, B1); PG8_BAR; PG8_SCHED;
            PG8_LDA(At, 0, 1); PG8_STAGE(PG8_SB(0, 0), b2, voffB); PG8_STAGE(PG8_SB(0, 1), b2 + hstep, voffB); PG8_STAGE(PG8_SA(0, 0), a2, voffA);
            PG8_WAIT_V(8); PG8_WAIT_L(0); PG8_BAR; PG8_MMA(1, 0, At, B0); PG8_MMA(1, 1, At, B1); PG8_BAR; PG8_SCHED;
            PG8_LDB(B0, 1, 0); PG8_LDB(B1, 1, 1); PG8_SCHED; PG8_LDA(At, 1, 0); PG8_STAGE(PG8_SA(0, 1), a2 + hstep, voffA);
            PG8_WAIT_V(8); PG8_WAIT_L(0); PG8_BAR; PG8_MMA(0, 0, At, B0); PG8_MMA(0, 1, At, B1); PG8_BAR; PG8_SCHED;
            PG8_LDA(At, 1, 1); PG8_STAGE(PG8_SB(1, 0), b3, voffB); PG8_STAGE(PG8_SB(1, 1), b3 + hstep, voffB); PG8_STAGE(PG8_SA(1, 0), a3, voffA);
            PG8_WAIT_V(8); PG8_WAIT_L(0); PG8_BAR; PG8_MMA(1, 0, At, B0); PG8_MMA(1, 1, At, B1); PG8_BAR; PG8_SCHED;
            } else {
            PG8_LDB(B0, 0, 0); PG8_SCHED; PG8_LDA(At, 0, 0); PG8_STAGE(PG8_SA(1, 1), a1 + hstep, voffA);
            PG8_WAIT_L(8); PG8_BAR; PG8_WAIT_L(0); PG8_MMA(0, 0, At, B0); PG8_BAR; PG8_SCHED;
            PG8_LDB(B1, 0, 1); PG8_STAGE(PG8_SB(0, 0), b2, voffB);
            PG8_BAR; PG8_WAIT_L(0); PG8_MMA(0, 1, At, B1); PG8_BAR;
            PG8_LDA(At, 0, 1); PG8_STAGE(PG8_SA(0, 0), a2, voffA);
            PG8_BAR; PG8_WAIT_L(0); PG8_MMA(1, 0, At, B0); PG8_BAR; PG8_SCHED;
            PG8_STAGE(PG8_SB(0, 1), b2 + hstep, voffB);
            PG8_WAIT_V(6); PG8_BAR; PG8_MMA(1, 1, At, B1); PG8_BAR;
            PG8_LDB(B0, 1, 0); PG8_SCHED; PG8_LDA(At, 1, 0); PG8_STAGE(PG8_SA(0, 1), a2 + hstep, voffA);
            PG8_WAIT_L(8); PG8_BAR; PG8_WAIT_L(0); PG8_MMA(0, 0, At, B0); PG8_BAR; PG8_SCHED;
            PG8_LDB(B1, 1, 1); PG8_STAGE(PG8_SB(1, 0), b3, voffB);
            PG8_BAR; PG8_WAIT_L(0); PG8_MMA(0, 1, At, B1); PG8_BAR;
            PG8_LDA(At, 1, 1); PG8_STAGE(PG8_SA(1, 0), a3, voffA);
            PG8_BAR; PG8_WAIT_L(0); PG8_MMA(1, 0, At, B0); PG8_BAR; PG8_SCHED;
            PG8_STAGE(PG8_SB(1, 1), b3 + hstep, voffB);
            PG8_WAIT_V(6); PG8_BAR; PG8_MMA(1, 1, At, B1); PG8_BAR;
            }
        }
        if constexpr (ALIGN_EPI) { if (wr == 0) PG8_BAR; }
        if constexpr (!Epi::AFTER_DRAIN) { E(acc, cur, wr, wc, fr, fq); S.done(cur); }
        if (!has_next) break;
#pragma unroll
        for (int a = 0; a < 2; ++a)
#pragma unroll
            for (int b = 0; b < 2; ++b)
#pragma unroll
                for (int m = 0; m < 4; ++m)
#pragma unroll
                    for (int n = 0; n < 2; ++n) acc[a][b][m][n] = (f32x4){0.f, 0.f, 0.f, 0.f};
        cur = nxt; cA = nA; cB = nB; ++ui;
        if constexpr (ALIGN_EPI) { if (wr == 1) PG8_BAR; }
    }
    PG8_WAIT_V(0);
    if constexpr (!ALIGN_EPI) { if (wr == 0) PG8_BAR; }
    PG8_BAR;
    if constexpr (Epi::AFTER_DRAIN) { E.fused(acc, cur, wr, wc, fr, fq, lds, wid, lane); S.done(cur); }
#undef PG8_SA
#undef PG8_SB
#undef PG8_STAGE
#undef PG8_LDA
#undef PG8_LDB
#undef PG8_MMA
#undef PG8_WAIT_V
#undef PG8_WAIT_L
#undef PG8_BAR
#undef PG8_SCHED
}
}
using pg8::bf16_t;
#define MFMA32(a, b, c) __builtin_amdgcn_mfma_f32_32x32x16_bf16((a), (b), (c), 0, 0, 0)
#define LDS_WAIT() asm volatile("s_waitcnt lgkmcnt(0)" ::: "memory")
DI int crow(int i, int h) { return (i & 3) + 8 * (i >> 2) + 4 * h; }
template <int S> DI bf16x8 pack8(const f32x16& x) {
    u32x4 p; p.x = pk2(x[8 * S], x[8 * S + 1]); p.y = pk2(x[8 * S + 2], x[8 * S + 3]); p.z = pk2(x[8 * S + 4], x[8 * S + 5]); p.w = pk2(x[8 * S + 6], x[8 * S + 7]);
    return __builtin_bit_cast(bf16x8, p);
}
DI f32x16 zero16() { f32x16 z;
#pragma unroll
    for (int i = 0; i < 16; ++i) z[i] = 0.f; return z; }

struct Params { const float* in[22]; float* out; unsigned char* ws; };

enum { MAP_ID = 0, MAP_WIN = 1, MAP_WUQ = 2 };
template <int MAP> DI int dest_row(int n) {
    if (MAP == MAP_WIN) return n < 1088 ? n : n + 192;
    if (MAP == MAP_WUQ) { const int h = n / 192, i = n - h * 192; return i < 128 ? h * 128 + i : 2048 + h * 64 + 2 * ((i - 128) & 31) + ((i - 128) >> 5); }
    return n;
}
template <int MAP> DI void transpose_item(const float* __restrict__ W, int K, int N, bf16_t* __restrict__ WT, LAS float* scr, int item, int lane) {
    const int nblk = N / 32, kb = item / nblk, nb = item - kb * nblk, k0 = 64 * kb, n0 = 32 * nb;
    float wv[32];
#pragma unroll
    for (int i = 0; i < 32; ++i) wv[i] = W[(size_t)(k0 + 2 * i + (lane >> 5)) * N + n0 + (lane & 31)];
#pragma unroll
    for (int i = 0; i < 32; ++i) scr[(2 * i + (lane >> 5)) * 33 + (lane & 31)] = wv[i];
    LDS_WAIT();
    const int c = lane & 7;
#pragma unroll
    for (int j = 0; j < 4; ++j) { const int n = (lane >> 3) + 8 * j; const LAS float* s = scr + (8 * c) * 33 + n;
        u32x4 o; o.x = pk2(s[0 * 33], s[1 * 33]); o.y = pk2(s[2 * 33], s[3 * 33]); o.z = pk2(s[4 * 33], s[5 * 33]); o.w = pk2(s[6 * 33], s[7 * 33]);
        *(u32x4*)(WT + (size_t)dest_row<MAP>(n0 + n) * K + k0 + 8 * c) = o; }
    LDS_WAIT();
}

DI void layer_prep(const Params& P, LAS unsigned char* lds, int l, int gw, int NGW, int gt, int NGT, int lane, int wave) {
    unsigned char* ws = P.ws;
    LAS float* scr = (LAS float*)(lds + wave * 16384);
    const float* w_in = P.in[6] + (size_t)l * 2048 * 13376; const float* w_uq = P.in[8] + (size_t)l * 512 * 3072;
    const float* w_uk = P.in[10] + (size_t)l * 512 * 2048;  const float* w_uv = P.in[11] + (size_t)l * 512 * 2048;
    const float* w_oa = P.in[12] + (size_t)l * 2048 * 2048; const float* w_ob = P.in[15] + (size_t)l * 2048 * 2048; const float* w_out = P.in[16] + (size_t)l * 2048 * 2048;
    const float* w_up = P.in[19] + (size_t)l * 2048 * 8192; const float* w_dn = P.in[20] + (size_t)l * 8192 * 2048;
    constexpr int I_IN = 32 * 418, I_UQ = 8 * 96, I_UK = 8 * 64, I_SQ = 32 * 64, I_UP = 32 * 256, I_DN = 128 * 64;
    constexpr int NIT = I_IN + I_UQ + 2 * I_UK + 3 * I_SQ + I_UP + I_DN;
    for (int it = gw; it < NIT; it += NGW) {
        int r = it;
        if (r < I_IN) { transpose_item<MAP_WIN>(w_in, 2048, 13376, (bf16_t*)(ws + WS_WIN), scr, r, lane); continue; } r -= I_IN;
        if (r < I_UQ) { transpose_item<MAP_WUQ>(w_uq, 512, 3072, (bf16_t*)(ws + WS_WUQ), scr, r, lane); continue; } r -= I_UQ;
        if (r < I_UK) { transpose_item<MAP_ID>(w_uk, 512, 2048, (bf16_t*)(ws + WS_WUK), scr, r, lane); continue; } r -= I_UK;
        if (r < I_UK) { transpose_item<MAP_ID>(w_uv, 512, 2048, (bf16_t*)(ws + WS_WUV), scr, r, lane); continue; } r -= I_UK;
        if (r < I_SQ) { transpose_item<MAP_ID>(w_oa, 2048, 2048, (bf16_t*)(ws + WS_WOA), scr, r, lane); continue; } r -= I_SQ;
        if (r < I_SQ) { transpose_item<MAP_ID>(w_ob, 2048, 2048, (bf16_t*)(ws + WS_WOB), scr, r, lane); continue; } r -= I_SQ;
        if (r < I_SQ) { transpose_item<MAP_ID>(w_out, 2048, 2048, (bf16_t*)(ws + WS_WOUT), scr, r, lane); continue; } r -= I_SQ;
        if (r < I_UP) { transpose_item<MAP_ID>(w_up, 2048, 8192, (bf16_t*)(ws + WS_WUP), scr, r, lane); continue; } r -= I_UP;
        transpose_item<MAP_ID>(w_dn, 8192, 2048, (bf16_t*)(ws + WS_WDN), scr, r, lane);
    }
    u32x4 z4; { unsigned z_; asm volatile("v_mov_b32 %0, 0" : "=v"(z_)); z4.x = z_; z4.y = z_; z4.z = z_; z4.w = z_; }
    { u32x4* z = (u32x4*)((bf16_t*)(ws + WS_WIN) + (size_t)1088 * 2048); for (int i = gt; i < 192 * 2048 / 8; i += NGT) z[i] = z4; }
    bf16_t* CKV = (bf16_t*)(ws + WS_CKV); bf16_t* KPE = (bf16_t*)(ws + WS_KPE);
    const float* cc = P.in[2] + (size_t)l * 8 * 4096 * 512; const float* ck = P.in[3] + (size_t)l * 8 * 4096 * 64;
#pragma unroll 4
    for (int i = gt; i < 8 * 4096 * 512 / 8; i += NGT) { const int b = i >> 18, rem = i & 262143, t = rem >> 6, c8 = rem & 63;
        const f32x4 a = *(const f32x4*)(cc + (size_t)i * 8), bq = *(const f32x4*)(cc + (size_t)i * 8 + 4);
        u32x4 o; o.x = pk2(a[0], a[1]); o.y = pk2(a[2], a[3]); o.z = pk2(bq[0], bq[1]); o.w = pk2(bq[2], bq[3]);
        *(u32x4*)(CKV + (size_t)(MP + b * KVB + t) * 512 + c8 * 8) = o; }
#pragma unroll 2
    for (int i = gt; i < 8 * 4096 * 64 / 8; i += NGT) { const int b = i >> 15, rem = i & 32767, t = rem >> 3, c8 = rem & 7;
        const f32x4 a = *(const f32x4*)(ck + (size_t)i * 8), bq = *(const f32x4*)(ck + (size_t)i * 8 + 4);
        u32x4 o; o.x = pk2(a[0], a[1]); o.y = pk2(a[2], a[3]); o.z = pk2(bq[0], bq[1]); o.w = pk2(bq[2], bq[3]);
        *(u32x4*)(KPE + (size_t)(MP + b * KVB + t) * 64 + c8 * 8) = o; }
    for (int i = gt; i < 8 * 32 * 64; i += NGT) { const int b = i >> 11, rem = i & 2047; *(u32x4*)(CKV + (size_t)(MP + b * KVB + 4128) * 512 + rem * 8) = z4; }
    for (int i = gt; i < 8 * 32 * 8; i += NGT) { const int b = i >> 8, rem = i & 255; *(u32x4*)(KPE + (size_t)(MP + b * KVB + 4128) * 64 + rem * 8) = z4; }
    float* LB = (float*)(ws + WS_LB); const float* hl = P.in[13];
    for (int i = gt; i < 2048; i += NGT) LB[i] = l == 0 ? 0.f : 1.f / (1.f + expf(hl[i] - hl[2048 + i]));
}

DI void rope_table(const Params& P, int gt, int NGT) {
    float* T = (float*)(P.ws + WS_TBL);
    for (int i = gt; i < 2080 * 32; i += NGT) { const int p = i >> 5, j = i & 31; const int pos = p < 2048 ? p : 4096 + (p - 2048);
        const float inv = exp2f(-(float)j * (13.287712379549449f / 32.f)); const float ang = (float)pos * inv;
        const double a = (double)ang; const double kq = rint(a * 0.15915494309189535); const float rr = (float)(a - kq * 6.283185307179586);
        T[2 * i] = __cosf(rr); T[2 * i + 1] = __sinf(rr); }
}

DI void init_x(const Params& P, int gw, int NGW, int lane) {
    const float* g = P.in[5]; float* X = P.out; bf16_t* XN = (bf16_t*)(P.ws + WS_XN);
    for (int row = gw; row < MTOK; row += NGW) {
        const float* src = row < MP ? P.in[0] + (size_t)row * 2048 : P.in[1] + (size_t)(row - MP) * 2048;
        f32x4 v[8]; float ss = 0.f;
#pragma unroll
        for (int j = 0; j < 8; ++j) { v[j] = *(const f32x4*)(src + j * 256 + lane * 4); ss += v[j][0] * v[j][0] + v[j][1] * v[j][1] + v[j][2] * v[j][2] + v[j][3] * v[j][3]; }
        const float rs = rsqrtf(wave_sum(ss, lane) * (1.f / 2048.f) + EPS);
#pragma unroll
        for (int j = 0; j < 8; ++j) { *(f32x4*)(X + (size_t)row * 2048 + j * 256 + lane * 4) = v[j];
            const f32x4 gg = *(const f32x4*)(g + j * 256 + lane * 4); u32x2 w; w.x = pk2(v[j][0] * rs * gg[0], v[j][1] * rs * gg[1]); w.y = pk2(v[j][2] * rs * gg[2], v[j][3] * rs * gg[3]);
            *(u32x2*)(XN + (size_t)row * 2048 + j * 256 + lane * 4) = w; }
    }
}
DI void resid_norm(const float* __restrict__ Y, const float* __restrict__ gY, float* X, const float* __restrict__ gN, bf16_t* XN, int gw, int NGW, int lane) {
    for (int row = gw; row < MP; row += NGW) {
        f32x4 y[8]; float ss = 0.f;
#pragma unroll
        for (int j = 0; j < 8; ++j) { y[j] = *(const f32x4*)(Y + (size_t)row * 2048 + j * 256 + lane * 4); ss += y[j][0] * y[j][0] + y[j][1] * y[j][1] + y[j][2] * y[j][2] + y[j][3] * y[j][3]; }
        const float rs = rsqrtf(wave_sum(ss, lane) * (1.f / 2048.f) + EPS); float s2 = 0.f;
#pragma unroll
        for (int j = 0; j < 8; ++j) { const f32x4 gg = *(const f32x4*)(gY + j * 256 + lane * 4); const f32x4 x = *(const f32x4*)(X + (size_t)row * 2048 + j * 256 + lane * 4);
            y[j] = x + y[j] * rs * gg; *(f32x4*)(X + (size_t)row * 2048 + j * 256 + lane * 4) = y[j];
            s2 += y[j][0] * y[j][0] + y[j][1] * y[j][1] + y[j][2] * y[j][2] + y[j][3] * y[j][3]; }
        if (gN) {
            const float r2 = rsqrtf(wave_sum(s2, lane) * (1.f / 2048.f) + EPS);
#pragma unroll
            for (int j = 0; j < 8; ++j) { const f32x4 gg = *(const f32x4*)(gN + j * 256 + lane * 4); u32x2 w; w.x = pk2(y[j][0] * r2 * gg[0], y[j][1] * r2 * gg[1]); w.y = pk2(y[j][2] * r2 * gg[2], y[j][3] * r2 * gg[3]);
                *(u32x2*)(XN + (size_t)row * 2048 + j * 256 + lane * 4) = w; }
        }
    }
}
DI void resid_norm_tail(LAS unsigned char* lds, const float* __restrict__ slab, int KS, const float* __restrict__ gY, float* X, const float* __restrict__ gN, bf16_t* XN, int vcu, int G, int wave, int lane) {
    LAS float* red = (LAS float*)lds;
    for (int tr = vcu; tr < MS; tr += G) {
        const size_t off = (size_t)(MP + tr) * 2048 + wave * 256 + lane * 4;
        f32x4 y = {0.f, 0.f, 0.f, 0.f};
        for (int kp = 0; kp < KS; ++kp) y += *(const f32x4*)(slab + ((size_t)kp * 256 + tr) * 2048 + wave * 256 + lane * 4);
        const float ss = wave_sum(y[0] * y[0] + y[1] * y[1] + y[2] * y[2] + y[3] * y[3], lane);
        if (lane == 0) red[wave] = ss;
        __syncthreads();
        float tot = 0.f;
#pragma unroll
        for (int w = 0; w < 8; ++w) tot += red[w];
        const float rs = rsqrtf(tot * (1.f / 2048.f) + EPS);
        const f32x4 gg = *(const f32x4*)(gY + wave * 256 + lane * 4); const f32x4 x = *(const f32x4*)(X + off);
        y = x + y * rs * gg; *(f32x4*)(X + off) = y;
        const float s2 = wave_sum(y[0] * y[0] + y[1] * y[1] + y[2] * y[2] + y[3] * y[3], lane);
        if (lane == 0) red[8 + wave] = s2;
        __syncthreads();
        if (gN) { float t2 = 0.f;
#pragma unroll
            for (int w = 0; w < 8; ++w) t2 += red[8 + w];
            const float r2 = rsqrtf(t2 * (1.f / 2048.f) + EPS); const f32x4 g2 = *(const f32x4*)(gN + wave * 256 + lane * 4);
            u32x2 wv; wv.x = pk2(y[0] * r2 * g2[0], y[1] * r2 * g2[1]); wv.y = pk2(y[2] * r2 * g2[2], y[3] * r2 * g2[3]); *(u32x2*)(XN + off) = wv; }
        __syncthreads();
    }
}
DI void small_norms(const Params& P, int l, int gw, int NGW, int lane) {
    const float* Zs = (const float*)(P.ws + WS_ZS); bf16_t* QN = (bf16_t*)(P.ws + WS_QN); bf16_t* CKV = (bf16_t*)(P.ws + WS_CKV); bf16_t* KPE = (bf16_t*)(P.ws + WS_KPE);
    const float* tbl = (const float*)(P.ws + WS_TBL); const float* gq = P.in[7] + l * 512; const float* gkv = P.in[9] + l * 512;
    for (int row = gw; row < MTOK; row += NGW) {
        const float* z = Zs + (size_t)row * ZSW;
        const bool pr = row < MP; const int rs_ = row - MP;
        const int kvrow = pr ? row : MP + (rs_ >> 5) * KVB + 4096 + (rs_ & 31);
        const int p = pr ? (row & 2047) : 2048 + (rs_ & 31);
        float* oc = pr ? P.out + OUT_CKVP + ((size_t)l * MP + row) * 512 : P.out + OUT_CKVS + ((size_t)l * MS + rs_) * 512;
        float* ok = pr ? P.out + OUT_KPEP + ((size_t)l * MP + row) * 64 : P.out + OUT_KPES + ((size_t)l * MS + rs_) * 64;
        { const f32x4 a = *(const f32x4*)(z + lane * 8), b = *(const f32x4*)(z + lane * 8 + 4);
          const float ss = a[0] * a[0] + a[1] * a[1] + a[2] * a[2] + a[3] * a[3] + b[0] * b[0] + b[1] * b[1] + b[2] * b[2] + b[3] * b[3];
          const float rs = rsqrtf(wave_sum(ss, lane) * (1.f / 512.f) + EPS); const f32x4 g0 = *(const f32x4*)(gq + lane * 8), g1 = *(const f32x4*)(gq + lane * 8 + 4);
          u32x4 o; o.x = pk2(a[0] * rs * g0[0], a[1] * rs * g0[1]); o.y = pk2(a[2] * rs * g0[2], a[3] * rs * g0[3]); o.z = pk2(b[0] * rs * g1[0], b[1] * rs * g1[1]); o.w = pk2(b[2] * rs * g1[2], b[3] * rs * g1[3]);
          *(u32x4*)(QN + (size_t)row * 512 + lane * 8) = o; }
        { const f32x4 a = *(const f32x4*)(z + 512 + lane * 8), b = *(const f32x4*)(z + 512 + lane * 8 + 4);
          const float ss = a[0] * a[0] + a[1] * a[1] + a[2] * a[2] + a[3] * a[3] + b[0] * b[0] + b[1] * b[1] + b[2] * b[2] + b[3] * b[3];
          const float rs = rsqrtf(wave_sum(ss, lane) * (1.f / 512.f) + EPS); const f32x4 g0 = *(const f32x4*)(gkv + lane * 8), g1 = *(const f32x4*)(gkv + lane * 8 + 4);
          const f32x4 c0 = a * rs * g0, c1 = b * rs * g1;
          *(f32x4*)(oc + lane * 8) = c0; *(f32x4*)(oc + lane * 8 + 4) = c1;
          u32x4 o; o.x = pk2(c0[0], c0[1]); o.y = pk2(c0[2], c0[3]); o.z = pk2(c1[0], c1[1]); o.w = pk2(c1[2], c1[3]);
          *(u32x4*)(CKV + (size_t)kvrow * 512 + lane * 8) = o; }
        if (lane < 32) { const float x1 = z[1024 + lane], x2 = z[1056 + lane]; const float c = tbl[(size_t)(p * 32 + lane) * 2], s = tbl[(size_t)(p * 32 + lane) * 2 + 1];
          const float o1 = x1 * c - x2 * s, o2 = x1 * s + x2 * c; ok[lane] = o1; ok[32 + lane] = o2;
          KPE[(size_t)kvrow * 64 + lane] = f2bf(o1); KPE[(size_t)kvrow * 64 + 32 + lane] = f2bf(o2); }
    }
}

struct HUnit { int rowbase, nvalid, h; };
DI HUnit hunit(int u) { HUnit r; if (u < 2048) { const int sh = u >> 5, c = u & 31; r.h = sh & 15; r.rowbase = (sh >> 4) * 2048 + c * 64; r.nvalid = 64; } else { const int s = u - 2048; r.h = s & 15; r.rowbase = MP + (s >> 4) * 32; r.nvalid = 32; } return r; }
DI void hgrn_cumsum(const float* __restrict__ LF, LAS float* psum, const HUnit& hu, int k, int tq, float (&b)[16], float& b31, float& b63) {
    const float* p = LF + (size_t)(hu.rowbase + 16 * tq) * 2048 + hu.h * 128 + k; const bool valid = 16 * tq < hu.nvalid;
    float run = 0.f;
#pragma unroll
    for (int i = 0; i < 16; ++i) { const float v = valid ? p[(size_t)i * 2048] : 0.f; run += v; b[i] = run; }
    psum[tq * 128 + k] = run;
    __syncthreads();
    const float p0 = psum[k], p1 = psum[128 + k], p2 = psum[256 + k], p3 = psum[384 + k];
    const float off = (tq > 0 ? p0 : 0.f) + (tq > 1 ? p1 : 0.f) + (tq > 2 ? p2 : 0.f);
#pragma unroll
    for (int i = 0; i < 16; ++i) b[i] += off;
    b31 = p0 + p1; b63 = b31 + p2 + p3;
}
DI void hgrn_pass1(LAS unsigned char* lds, const float* __restrict__ LF, const bf16_t* __restrict__ HK, const bf16_t* __restrict__ HV, bf16_t* __restrict__ UT, float* __restrict__ Dv, int u, int tid) {
    LAS float* psum = (LAS float*)lds; LAS bf16_t* KhT = (LAS bf16_t*)(lds + 2048); LAS bf16_t* VTl = (LAS bf16_t*)(lds + 2048 + 18432);
    const HUnit hu = hunit(u); const int k = tid & 127, tq = tid >> 7; const bool valid = 16 * tq < hu.nvalid;
    const size_t g0 = (size_t)(hu.rowbase + 16 * tq) * 2048 + hu.h * 128 + k;
    unsigned kraw[8], vw[8];
#pragma unroll
    for (int i2 = 0; i2 < 8; ++i2) { unsigned k0 = 0u, k1 = 0u, v0 = 0u, v1 = 0u;
        if (valid) { k0 = HK[g0 + (size_t)(2 * i2) * 2048]; k1 = HK[g0 + (size_t)(2 * i2 + 1) * 2048]; v0 = HV[g0 + (size_t)(2 * i2) * 2048]; v1 = HV[g0 + (size_t)(2 * i2 + 1) * 2048]; }
        kraw[i2] = k0 | (k1 << 16); vw[i2] = v0 | (v1 << 16); }
    float b[16], b31, b63; hgrn_cumsum(LF, psum, hu, k, tq, b, b31, b63);
    unsigned kw[8];
#pragma unroll
    for (int i2 = 0; i2 < 8; ++i2) kw[i2] = pk2(bflo(kraw[i2]) * __expf(b63 - b[2 * i2]), bfhi(kraw[i2]) * __expf(b63 - b[2 * i2 + 1]));
    { u32x4 a, c; a.x = kw[0]; a.y = kw[1]; a.z = kw[2]; a.w = kw[3]; c.x = kw[4]; c.y = kw[5]; c.z = kw[6]; c.w = kw[7];
      *(LAS u32x4*)(KhT + k * 72 + 16 * tq) = a; *(LAS u32x4*)(KhT + k * 72 + 16 * tq + 8) = c;
      a.x = vw[0]; a.y = vw[1]; a.z = vw[2]; a.w = vw[3]; c.x = vw[4]; c.y = vw[5]; c.z = vw[6]; c.w = vw[7];
      *(LAS u32x4*)(VTl + k * 72 + 16 * tq) = a; *(LAS u32x4*)(VTl + k * 72 + 16 * tq + 8) = c; }
    if (tq == 0) Dv[(size_t)u * 128 + k] = __expf(b63);
    __syncthreads();
    const int wave = tid >> 6, lane = tid & 63, r = lane & 31, hh = lane >> 5, vb = wave & 3, kg = wave >> 2;
#pragma unroll
    for (int kb2 = 0; kb2 < 2; ++kb2) {
        const int kbq = 2 * kg + kb2; f32x16 acc = zero16();
#pragma unroll
        for (int s = 0; s < 4; ++s) { const bf16x8 a = *(const LAS bf16x8*)(VTl + (32 * vb + r) * 72 + 16 * s + 8 * hh), bb = *(const LAS bf16x8*)(KhT + (32 * kbq + r) * 72 + 16 * s + 8 * hh); acc = MFMA32(a, bb, acc); }
        bf16_t* dst = UT + ((size_t)u * 128 + 32 * vb) * 128 + 32 * kbq + r;
#pragma unroll
        for (int i = 0; i < 16; ++i) dst[(size_t)crow(i, hh) * 128] = f2bf(acc[i]);
    }
    __syncthreads();
}
DI void hgrn_pass2(LAS unsigned char* lds, const Params& P, int l, int x, int tid) {
    const bf16_t* UT = (const bf16_t*)(P.ws + WS_UT); const float* Dv = (const float*)(P.ws + WS_D); bf16_t* SpT = (bf16_t*)(P.ws + WS_SPT);
    LAS float* tl = (LAS float*)lds;
    const bool sample = x >= 256; const int sidx = sample ? (x - 256) >> 2 : x >> 2, vq = x & 3;
    const int nch = sample ? 1 : 32, ubase = sample ? 2048 + sidx : sidx * 32;
    const int vloc = tid >> 4, k0 = (tid & 15) * 8, v = 32 * vq + vloc;
    const int kk = tid >> 2, vs = (tid & 3) * 8;
    float S[8];
#pragma unroll
    for (int i = 0; i < 8; ++i) S[i] = 0.f;
    if (sample) {
        const float* s0 = P.in[4] + ((size_t)l * 128 + sidx) * 16384 + (size_t)kk * 128 + 32 * vq + vs;
        const f32x4 a = *(const f32x4*)s0, b = *(const f32x4*)(s0 + 4);
#pragma unroll
        for (int i = 0; i < 4; ++i) { tl[kk * 33 + vs + i] = a[i]; tl[kk * 33 + vs + 4 + i] = b[i]; }
        __syncthreads();
#pragma unroll
        for (int i = 0; i < 8; ++i) S[i] = tl[(k0 + i) * 33 + vloc];
        __syncthreads();
    }
    size_t e = ((size_t)ubase * 128 + v) * 128 + k0;
    u32x4 uu = *(const u32x4*)(UT + e); f32x4 d0 = *(const f32x4*)(Dv + (size_t)ubase * 128 + k0), d1 = *(const f32x4*)(Dv + (size_t)ubase * 128 + k0 + 4);
    for (int c = 0; c < nch; ++c) {
        u32x4 nuu = uu; f32x4 nd0 = d0, nd1 = d1;
        if (c + 1 < nch) { const size_t e2 = e + 16384; nuu = *(const u32x4*)(UT + e2); nd0 = *(const f32x4*)(Dv + (size_t)(ubase + c + 1) * 128 + k0); nd1 = *(const f32x4*)(Dv + (size_t)(ubase + c + 1) * 128 + k0 + 4); }
        u32x4 o; o.x = pk2(S[0], S[1]); o.y = pk2(S[2], S[3]); o.z = pk2(S[4], S[5]); o.w = pk2(S[6], S[7]);
        *(u32x4*)(SpT + e) = o;
        S[0] = d0[0] * S[0] + bflo(uu.x); S[1] = d0[1] * S[1] + bfhi(uu.x); S[2] = d0[2] * S[2] + bflo(uu.y); S[3] = d0[3] * S[3] + bfhi(uu.y);
        S[4] = d1[0] * S[4] + bflo(uu.z); S[5] = d1[1] * S[5] + bfhi(uu.z); S[6] = d1[2] * S[6] + bflo(uu.w); S[7] = d1[3] * S[7] + bfhi(uu.w);
        uu = nuu; d0 = nd0; d1 = nd1; e += 16384;
    }
#pragma unroll
    for (int i = 0; i < 8; ++i) tl[(k0 + i) * 33 + vloc] = S[i];
    __syncthreads();
    float* o = (sample ? P.out + OUT_STS + ((size_t)l * 128 + sidx) * 16384 : P.out + OUT_STP + ((size_t)l * 64 + sidx) * 16384) + (size_t)kk * 128 + 32 * vq + vs;
    f32x4 a, b;
#pragma unroll
    for (int i = 0; i < 4; ++i) { a[i] = tl[kk * 33 + vs + i]; b[i] = tl[kk * 33 + vs + 4 + i]; }
    *(f32x4*)o = a; *(f32x4*)(o + 4) = b;
    __syncthreads();
}
DI void hgrn_pass3(LAS unsigned char* lds, const float* __restrict__ LF, const bf16_t* __restrict__ HQ, const bf16_t* __restrict__ HK, const bf16_t* __restrict__ HV, const bf16_t* __restrict__ HG,
                   const bf16_t* __restrict__ SpT, const float* __restrict__ gn, bf16_t* __restrict__ OH, int u, int tid) {
    LAS float* psum = (LAS float*)lds;
    LAS bf16_t* Qa = (LAS bf16_t*)(lds + 2048);
    LAS bf16_t* Qb = (LAS bf16_t*)(lds + 19456);
    LAS bf16_t* Ka = (LAS bf16_t*)(lds + 28160);
    LAS bf16_t* Kb = (LAS bf16_t*)(lds + 36864);
    LAS bf16_t* VTl = (LAS bf16_t*)(lds + 54272);
    LAS float* Ost = (LAS float*)(lds + 72704);
    const HUnit hu = hunit(u); const int k = tid & 127, tq = tid >> 7; const bool valid = 16 * tq < hu.nvalid;
    const size_t g0 = (size_t)(hu.rowbase + 16 * tq) * 2048 + hu.h * 128 + k;
    unsigned vw[8], qk[16];
#pragma unroll
    for (int i2 = 0; i2 < 8; ++i2) {
        unsigned vpair = 0u;
#pragma unroll
        for (int e = 0; e < 2; ++e) { const int i = 2 * i2 + e; unsigned q = 0u, kk = 0u, vv = 0u;
            if (valid) { q = HQ[g0 + (size_t)i * 2048]; kk = HK[g0 + (size_t)i * 2048]; vv = HV[g0 + (size_t)i * 2048]; }
            qk[i] = q | (kk << 16); vpair |= vv << (16 * e); }
        vw[i2] = vpair;
    }
    float b[16], b31, b63; hgrn_cumsum(LF, psum, hu, k, tq, b, b31, b63);
#pragma unroll
    for (int i = 0; i < 16; ++i) {
        const int t = 16 * tq + i; const float q = bflo(qk[i]), kk = bfhi(qk[i]);
        Qa[t * 136 + k] = f2bf(q * __expf(b[i]));
        if (tq >= 2) Qb[(t - 32) * 136 + k] = f2bf(q * __expf(b[i] - b31)); else Ka[t * 136 + k] = f2bf(kk * __expf(-b[i]));
        Kb[t * 136 + k] = f2bf(kk * __expf(b31 - b[i]));
    }
    { u32x4 a, c; a.x = vw[0]; a.y = vw[1]; a.z = vw[2]; a.w = vw[3]; c.x = vw[4]; c.y = vw[5]; c.z = vw[6]; c.w = vw[7];
      *(LAS u32x4*)(VTl + k * 72 + 16 * tq) = a; *(LAS u32x4*)(VTl + k * 72 + 16 * tq + 8) = c; }
    __syncthreads();
    const int wave = tid >> 6, lane = tid & 63, r = lane & 31, hh = lane >> 5, vb = wave & 3, tb = wave >> 2;
    f32x16 O = zero16();
    const LAS bf16_t* vrow = VTl + (32 * vb + r) * 72 + 4 * hh;
    if (tb == 0) {
        f32x16 A0 = zero16();
#pragma unroll
        for (int ks = 0; ks < 8; ++ks) { const bf16x8 a = *(const LAS bf16x8*)(Ka + r * 136 + 16 * ks + 8 * hh), q = *(const LAS bf16x8*)(Qa + r * 136 + 16 * ks + 8 * hh); A0 = MFMA32(a, q, A0); }
#pragma unroll
        for (int i = 0; i < 16; ++i) if (crow(i, hh) > r) A0[i] = 0.f;
        const bf16x8 p0 = pack8<0>(A0), p1 = pack8<1>(A0);
        { const s16x4 lo = *(const LAS s16x4*)(vrow), hi = *(const LAS s16x4*)(vrow + 8); O = MFMA32(__builtin_shufflevector(lo, hi, 0, 1, 2, 3, 4, 5, 6, 7), p0, O); }
        { const s16x4 lo = *(const LAS s16x4*)(vrow + 16), hi = *(const LAS s16x4*)(vrow + 24); O = MFMA32(__builtin_shufflevector(lo, hi, 0, 1, 2, 3, 4, 5, 6, 7), p1, O); }
    } else {
        f32x16 A0 = zero16(), A1 = zero16();
#pragma unroll
        for (int ks = 0; ks < 8; ++ks) { const bf16x8 q = *(const LAS bf16x8*)(Qb + r * 136 + 16 * ks + 8 * hh);
            const bf16x8 a0 = *(const LAS bf16x8*)(Kb + r * 136 + 16 * ks + 8 * hh), a1 = *(const LAS bf16x8*)(Kb + (32 + r) * 136 + 16 * ks + 8 * hh);
            A0 = MFMA32(a0, q, A0); A1 = MFMA32(a1, q, A1); }
#pragma unroll
        for (int i = 0; i < 16; ++i) if (crow(i, hh) > r) A1[i] = 0.f;
        const bf16x8 p0 = pack8<0>(A0), p1 = pack8<1>(A0), p2 = pack8<0>(A1), p3 = pack8<1>(A1);
        { const s16x4 lo = *(const LAS s16x4*)(vrow), hi = *(const LAS s16x4*)(vrow + 8); O = MFMA32(__builtin_shufflevector(lo, hi, 0, 1, 2, 3, 4, 5, 6, 7), p0, O); }
        { const s16x4 lo = *(const LAS s16x4*)(vrow + 16), hi = *(const LAS s16x4*)(vrow + 24); O = MFMA32(__builtin_shufflevector(lo, hi, 0, 1, 2, 3, 4, 5, 6, 7), p1, O); }
        { const s16x4 lo = *(const LAS s16x4*)(vrow + 32), hi = *(const LAS s16x4*)(vrow + 40); O = MFMA32(__builtin_shufflevector(lo, hi, 0, 1, 2, 3, 4, 5, 6, 7), p2, O); }
        { const s16x4 lo = *(const LAS s16x4*)(vrow + 48), hi = *(const LAS s16x4*)(vrow + 56); O = MFMA32(__builtin_shufflevector(lo, hi, 0, 1, 2, 3, 4, 5, 6, 7), p3, O); }
    }
    { const bf16_t* sp = SpT + ((size_t)u * 128 + 32 * vb + r) * 128 + 8 * hh;
#pragma unroll
      for (int ks = 0; ks < 8; ++ks) { const bf16x8 a = *(const bf16x8*)(sp + 16 * ks), q = *(const LAS bf16x8*)(Qa + (32 * tb + r) * 136 + 16 * ks + 8 * hh); O = MFMA32(a, q, O); } }
#pragma unroll
    for (int g = 0; g < 4; ++g) { f32x4 w; w[0] = O[4 * g]; w[1] = O[4 * g + 1]; w[2] = O[4 * g + 2]; w[3] = O[4 * g + 3]; *(LAS f32x4*)(Ost + (32 * tb + r) * 132 + 32 * vb + 8 * g + 4 * hh) = w; }
    __syncthreads();
    { const int t = tid >> 3, vs = (tid & 7) * 16;
      f32x4 x[4]; float ss = 0.f;
#pragma unroll
      for (int j = 0; j < 4; ++j) { x[j] = *(const LAS f32x4*)(Ost + t * 132 + vs + 4 * j); ss += x[j][0] * x[j][0] + x[j][1] * x[j][1] + x[j][2] * x[j][2] + x[j][3] * x[j][3]; }
      ss += shflx(ss, 1, lane); ss += shflx(ss, 2, lane); ss += shflx(ss, 4, lane);
      const float rs = rsqrtf(ss * (1.f / 128.f) + EPS);
      if (t < hu.nvalid) {
          const size_t off = (size_t)(hu.rowbase + t) * 2048 + hu.h * 128 + vs;
          const u32x4 ga = *(const u32x4*)(HG + off), gb = *(const u32x4*)(HG + off + 8);
          const f32x4 n0 = *(const f32x4*)(gn + vs), n1 = *(const f32x4*)(gn + vs + 4), n2 = *(const f32x4*)(gn + vs + 8), n3 = *(const f32x4*)(gn + vs + 12);
          u32x4 oa, ob;
          oa.x = pk2(x[0][0] * rs * n0[0] * bflo(ga.x), x[0][1] * rs * n0[1] * bfhi(ga.x)); oa.y = pk2(x[0][2] * rs * n0[2] * bflo(ga.y), x[0][3] * rs * n0[3] * bfhi(ga.y));
          oa.z = pk2(x[1][0] * rs * n1[0] * bflo(ga.z), x[1][1] * rs * n1[1] * bfhi(ga.z)); oa.w = pk2(x[1][2] * rs * n1[2] * bflo(ga.w), x[1][3] * rs * n1[3] * bfhi(ga.w));
          ob.x = pk2(x[2][0] * rs * n2[0] * bflo(gb.x), x[2][1] * rs * n2[1] * bfhi(gb.x)); ob.y = pk2(x[2][2] * rs * n2[2] * bflo(gb.y), x[2][3] * rs * n2[3] * bfhi(gb.y));
          ob.z = pk2(x[3][0] * rs * n3[0] * bflo(gb.z), x[3][1] * rs * n3[1] * bfhi(gb.z)); ob.w = pk2(x[3][2] * rs * n3[2] * bflo(gb.w), x[3][3] * rs * n3[3] * bfhi(gb.w));
          *(u32x4*)(OH + off) = oa; *(u32x4*)(OH + off + 8) = ob;
      } }
    __syncthreads();
}

template <bool SAMPLE>
DI void attn_wave(const bf16_t* __restrict__ Qp, const bf16_t* __restrict__ Kn, const bf16_t* __restrict__ Kp, const bf16_t* __restrict__ Vt, int t0, int t1, int tstep, int nkeys,
                  float& m, float& l, f32x16 (&O)[4], int r, int hh) {
    const int lane = r + 32 * hh;
    bf16x8 qf[12];
#pragma unroll
    for (int s = 0; s < 12; ++s) qf[s] = *(const bf16x8*)(Qp + (size_t)r * 3072 + 16 * s + 8 * hh);
    m = -INFINITY; l = 0.f;
#pragma unroll
    for (int vb = 0; vb < 4; ++vb) O[vb] = zero16();
    for (int t = t0; t < t1; t += tstep) {
        const bf16_t* kn = Kn + (size_t)(64 * t + r) * 2048 + 8 * hh; const bf16_t* kp = Kp + (size_t)(64 * t + r) * 64 + 8 * hh;
        f32x16 S0 = zero16(), S1 = zero16();
#pragma unroll
        for (int s = 0; s < 8; ++s) { const bf16x8 a0 = *(const bf16x8*)(kn + 16 * s), a1 = *(const bf16x8*)(kn + 32 * 2048 + 16 * s); S0 = MFMA32(a0, qf[s], S0); S1 = MFMA32(a1, qf[s], S1); }
#pragma unroll
        for (int s = 0; s < 4; ++s) { const bf16x8 a0 = *(const bf16x8*)(kp + 16 * s), a1 = *(const bf16x8*)(kp + 32 * 64 + 16 * s); S0 = MFMA32(a0, qf[8 + s], S0); S1 = MFMA32(a1, qf[8 + s], S1); }
        if (SAMPLE) { if (64 * t + 64 > nkeys) {
#pragma unroll
            for (int i = 0; i < 16; ++i) { if (64 * t + crow(i, hh) >= nkeys) S0[i] = -INFINITY; if (64 * t + 32 + crow(i, hh) >= nkeys) S1[i] = -INFINITY; } } }
        float mx = fmaxf(S0[0], S1[0]);
#pragma unroll
        for (int i = 1; i < 16; ++i) mx = fmaxf(mx, fmaxf(S0[i], S1[i]));
        mx = fmaxf(mx, shflx(mx, 32, lane));
        const float mn = fmaxf(m, mx), alpha = ex2(m - mn); m = mn;
        float ls = 0.f;
#pragma unroll
        for (int i = 0; i < 16; ++i) { S0[i] = ex2(S0[i] - mn); S1[i] = ex2(S1[i] - mn); ls += S0[i] + S1[i]; }
        l = l * alpha + ls;
#pragma unroll
        for (int vb = 0; vb < 4; ++vb) O[vb] = O[vb] * alpha;
        const bf16x8 p0 = pack8<0>(S0), p1 = pack8<1>(S0), p2 = pack8<0>(S1), p3 = pack8<1>(S1);
#pragma unroll
        for (int vb = 0; vb < 4; ++vb) {
            const bf16_t* vp = Vt + (size_t)(32 * vb + r) * KVR + 64 * t + 4 * hh;
            { const s16x4 lo = *(const s16x4*)(vp), hi = *(const s16x4*)(vp + 8); O[vb] = MFMA32(__builtin_shufflevector(lo, hi, 0, 1, 2, 3, 4, 5, 6, 7), p0, O[vb]); }
            { const s16x4 lo = *(const s16x4*)(vp + 16), hi = *(const s16x4*)(vp + 24); O[vb] = MFMA32(__builtin_shufflevector(lo, hi, 0, 1, 2, 3, 4, 5, 6, 7), p1, O[vb]); }
            { const s16x4 lo = *(const s16x4*)(vp + 32), hi = *(const s16x4*)(vp + 40); O[vb] = MFMA32(__builtin_shufflevector(lo, hi, 0, 1, 2, 3, 4, 5, 6, 7), p2, O[vb]); }
            { const s16x4 lo = *(const s16x4*)(vp + 48), hi = *(const s16x4*)(vp + 56); O[vb] = MFMA32(__builtin_shufflevector(lo, hi, 0, 1, 2, 3, 4, 5, 6, 7), p3, O[vb]); }
        }
    }
}
DI void attn_prompt_unit(const Params& P, int bh, int jq, int wave, int lane) {
    const bf16_t* Q = (const bf16_t*)(P.ws + WS_Q); const bf16_t* KN = (const bf16_t*)(P.ws + WS_KN); const bf16_t* KPE = (const bf16_t*)(P.ws + WS_KPE); const bf16_t* VT = (const bf16_t*)(P.ws + WS_VT);
    bf16_t* OA = (bf16_t*)(P.ws + WS_OA);
    const int b = bh >> 4, h = bh & 15, rb = 8 * jq + wave, row0 = b * 2048 + 32 * rb, kv0 = b * 2048, r = lane & 31, hh = lane >> 5;
    float m, l; f32x16 O[4];
    attn_wave<false>(Q + (size_t)row0 * 3072 + h * 192, KN + (size_t)kv0 * 2048 + h * 128, KPE + (size_t)kv0 * 64, VT + (size_t)(h * 128) * KVR + kv0, 0, (rb >> 1) + 1, 1, 0, m, l, O, r, hh);
    l += shflx(l, 32, lane); const float inv = 1.f / l;
#pragma unroll
    for (int vb = 0; vb < 4; ++vb)
#pragma unroll
        for (int g = 0; g < 4; ++g) { u32x2 w; w.x = pk2(O[vb][4 * g] * inv, O[vb][4 * g + 1] * inv); w.y = pk2(O[vb][4 * g + 2] * inv, O[vb][4 * g + 3] * inv);
            *(u32x2*)(OA + (size_t)(row0 + r) * 2048 + h * 128 + 32 * vb + 8 * g + 4 * hh) = w; }
}
constexpr int ATT_KB = 64 * 400, ATT_VB = 128 * 144, ATT_BUF = ATT_KB + ATT_VB;
template <bool SAMPLE> DI void attn_prompt_lds(LAS unsigned char* lds, const Params& P, int bh, int jq, int wave_in, int lane_in, int tid) {
    int lane = lane_in, wave = wave_in; asm volatile("" : "+v"(lane), "+s"(wave));
    const bf16_t* Q = (const bf16_t*)(P.ws + WS_Q); const bf16_t* KN = (const bf16_t*)(P.ws + WS_KN); const bf16_t* KPE = (const bf16_t*)(P.ws + WS_KPE); const bf16_t* VT = (const bf16_t*)(P.ws + WS_VT);
    bf16_t* OA = (bf16_t*)(P.ws + WS_OA);
    const int b = bh >> 4, h = bh & 15, rb = 8 * jq + wave, row0 = SAMPLE ? MP + b * 32 : b * 2048 + 32 * rb, kv0 = SAMPLE ? MP + b * KVB : b * 2048, r = lane & 31, hh = lane >> 5;
    const int ntiles = SAMPLE ? 65 : 4 * jq + 4, mytiles = (rb >> 1) + 1;
    const char* src[6]; unsigned inc[6]; unsigned dsto[6];
#pragma unroll
    for (int i = 0; i < 6; ++i) {
        const int ii = (i < 5 || wave < 3) ? i * 8 + wave : 32 + wave;
        const int sl = ii * 64 + lane; dsto[i] = (unsigned)ii * 1024u;
        if (sl < 1600) { const int row = sl / 25; int c = sl - row * 25; c = c == 24 ? 23 : c;
            if (c < 16) { src[i] = (const char*)(KN + (size_t)(kv0 + row) * 2048 + h * 128 + c * 8); inc[i] = 64u * 2048u * 2u; }
            else { src[i] = (const char*)(KPE + (size_t)(kv0 + row) * 64 + (c - 16) * 8); inc[i] = 64u * 64u * 2u; } }
        else { const int s2 = sl - 1600, vr = s2 / 9; int p = s2 - vr * 9; p = p == 8 ? 7 : p; const int c = p ^ ((vr >> 4) & 1);
            src[i] = (const char*)(VT + (size_t)(h * 128 + vr) * KVR + kv0 + c * 8); inc[i] = 128u; }
    }
#define ATT_FILL(t) do { LAS unsigned char* sb_ = lds + ((t) % 3) * ATT_BUF; _Pragma("unroll") for (int i_ = 0; i_ < 6; ++i_) \
        __builtin_amdgcn_global_load_lds((const unsigned*)(src[i_] + (size_t)(t) * inc[i_]), (LAS unsigned*)(sb_ + dsto[i_]), 16, 0, 0); } while (0)
    bf16x8 qf[12];
    { const bf16_t* Qp = Q + (size_t)row0 * 3072 + h * 192;
#pragma unroll
      for (int s = 0; s < 12; ++s) qf[s] = *(const bf16x8*)(Qp + (size_t)r * 3072 + 16 * s + 8 * hh); }
    asm volatile("s_waitcnt vmcnt(0)" ::: "memory");
    ATT_FILL(0); ATT_FILL(1);
    float m = -INFINITY, l = 0.f; f32x16 O[4];
#pragma unroll
    for (int vb = 0; vb < 4; ++vb) O[vb] = zero16();
    const int sw = (r >> 4) & 1;
    for (int t = 0; t < ntiles; ++t) {
        if (t + 1 < ntiles) asm volatile("s_waitcnt vmcnt(6)" ::: "memory"); else asm volatile("s_waitcnt vmcnt(0)" ::: "memory");
        __builtin_amdgcn_s_barrier(); asm volatile("" ::: "memory");
        if (t + 2 < ntiles) ATT_FILL(t + 2);
        if (SAMPLE ? ((t & 7) == wave) : (t < mytiles)) {
            const LAS unsigned char* kb_ = lds + (t % 3) * ATT_BUF; const LAS unsigned char* vb_ = kb_ + ATT_KB;
            const LAS bf16_t* kr = (const LAS bf16_t*)(kb_ + r * 400 + 16 * hh);
            f32x16 S0 = zero16(), S1 = zero16();
#pragma unroll
            for (int s = 0; s < 12; ++s) { const bf16x8 a0 = *(const LAS bf16x8*)(kr + 16 * s), a1 = *(const LAS bf16x8*)(kr + 32 * 200 + 16 * s); S0 = MFMA32(a0, qf[s], S0); S1 = MFMA32(a1, qf[s], S1); }
            if (SAMPLE) { if (t == 64) {
#pragma unroll
                for (int i = 0; i < 16; ++i) S1[i] = -INFINITY; } }
            float mx = fmaxf(S0[0], S1[0]);
#pragma unroll
            for (int i = 1; i < 16; ++i) mx = fmaxf(mx, fmaxf(S0[i], S1[i]));
            mx = fmaxf(mx, shflx(mx, 32, lane));
            const float mn = fmaxf(m, mx), alpha = ex2(m - mn); m = mn;
            float ls = 0.f;
#pragma unroll
            for (int i = 0; i < 16; ++i) { S0[i] = ex2(S0[i] - mn); S1[i] = ex2(S1[i] - mn); ls += S0[i] + S1[i]; }
            l = l * alpha + ls;
#pragma unroll
            for (int vb = 0; vb < 4; ++vb) O[vb] = O[vb] * alpha;
            const bf16x8 p0 = pack8<0>(S0), p1 = pack8<1>(S0), p2 = pack8<0>(S1), p3 = pack8<1>(S1);
#pragma unroll
            for (int vb = 0; vb < 4; ++vb) {
                const LAS unsigned char* vp = vb_ + (32 * vb + r) * 144 + 8 * hh;
                const LAS unsigned char* vlo = vp + 16 * sw; const LAS unsigned char* vhi = vp + 16 * (1 - sw);
                { const s16x4 lo = *(const LAS s16x4*)(vlo), hi = *(const LAS s16x4*)(vhi); O[vb] = MFMA32(__builtin_shufflevector(lo, hi, 0, 1, 2, 3, 4, 5, 6, 7), p0, O[vb]); }
                { const s16x4 lo = *(const LAS s16x4*)(vlo + 32), hi = *(const LAS s16x4*)(vhi + 32); O[vb] = MFMA32(__builtin_shufflevector(lo, hi, 0, 1, 2, 3, 4, 5, 6, 7), p1, O[vb]); }
                { const s16x4 lo = *(const LAS s16x4*)(vlo + 64), hi = *(const LAS s16x4*)(vhi + 64); O[vb] = MFMA32(__builtin_shufflevector(lo, hi, 0, 1, 2, 3, 4, 5, 6, 7), p2, O[vb]); }
                { const s16x4 lo = *(const LAS s16x4*)(vlo + 96), hi = *(const LAS s16x4*)(vhi + 96); O[vb] = MFMA32(__builtin_shufflevector(lo, hi, 0, 1, 2, 3, 4, 5, 6, 7), p3, O[vb]); }
            }
            asm volatile("s_waitcnt lgkmcnt(0)" ::: "memory");
        }
    }
#undef ATT_FILL
    __builtin_amdgcn_s_barrier(); asm volatile("" ::: "memory");
    l += shflx(l, 32, lane);
    if (SAMPLE) {
        LAS float* ml = (LAS float*)(lds + 131072);
        if (hh == 0) { ml[(wave * 32 + r) * 2] = m; ml[(wave * 32 + r) * 2 + 1] = l; }
        __syncthreads();
        float ms = -INFINITY;
#pragma unroll
        for (int w = 0; w < 8; ++w) ms = fmaxf(ms, ml[(w * 32 + r) * 2]);
        float L = 0.f;
#pragma unroll
        for (int w = 0; w < 8; ++w) L += ml[(w * 32 + r) * 2 + 1] * ex2(ml[(w * 32 + r) * 2] - ms);
        const float sc = ex2(m - ms) / L;
        LAS float* slot = (LAS float*)(lds + wave * 16384);
#pragma unroll
        for (int vb = 0; vb < 4; ++vb)
#pragma unroll
            for (int i = 0; i < 16; ++i) slot[(32 * vb + crow(i, hh)) * 32 + r] = O[vb][i] * sc;
        __syncthreads();
        { const int q = tid & 31, vg = tid >> 5; float a[8];
#pragma unroll
          for (int e = 0; e < 8; ++e) { float sacc = 0.f;
#pragma unroll
              for (int w = 0; w < 8; ++w) sacc += ((const LAS float*)(lds + w * 16384))[(8 * vg + e) * 32 + q];
              a[e] = sacc; }
          u32x4 o; o.x = pk2(a[0], a[1]); o.y = pk2(a[2], a[3]); o.z = pk2(a[4], a[5]); o.w = pk2(a[6], a[7]);
          *(u32x4*)(OA + (size_t)(row0 + q) * 2048 + h * 128 + 8 * vg) = o; }
        __syncthreads();
    } else {
    const float inv = 1.f / l;
#pragma unroll
    for (int vb = 0; vb < 4; ++vb)
#pragma unroll
        for (int g = 0; g < 4; ++g) { u32x2 w; w.x = pk2(O[vb][4 * g] * inv, O[vb][4 * g + 1] * inv); w.y = pk2(O[vb][4 * g + 2] * inv, O[vb][4 * g + 3] * inv);
            *(u32x2*)(OA + (size_t)(row0 + r) * 2048 + h * 128 + 32 * vb + 8 * g + 4 * hh) = w; }
    }
    asm volatile("s_waitcnt vmcnt(0)" ::: "memory");
}
DI void attn_sample_unit(LAS unsigned char* lds, const Params& P, int su, int wave, int lane, int tid) {
    const bf16_t* Q = (const bf16_t*)(P.ws + WS_Q); const bf16_t* KN = (const bf16_t*)(P.ws + WS_KN); const bf16_t* KPE = (const bf16_t*)(P.ws + WS_KPE); const bf16_t* VT = (const bf16_t*)(P.ws + WS_VT);
    bf16_t* OA = (bf16_t*)(P.ws + WS_OA);
    const int b = su >> 4, h = su & 15, row0 = MP + b * 32, kv0 = MP + b * KVB, r = lane & 31, hh = lane >> 5;
    float m, l; f32x16 O[4];
    attn_wave<true>(Q + (size_t)row0 * 3072 + h * 192, KN + (size_t)kv0 * 2048 + h * 128, KPE + (size_t)kv0 * 64, VT + (size_t)(h * 128) * KVR + kv0, wave, 65, 8, 4128, m, l, O, r, hh);
    l += shflx(l, 32, lane);
    LAS float* ml = (LAS float*)(lds + 131072);
    if (hh == 0) { ml[(wave * 32 + r) * 2] = m; ml[(wave * 32 + r) * 2 + 1] = l; }
    __syncthreads();
    float ms = -INFINITY;
#pragma unroll
    for (int w = 0; w < 8; ++w) ms = fmaxf(ms, ml[(w * 32 + r) * 2]);
    float L = 0.f;
#pragma unroll
    for (int w = 0; w < 8; ++w) L += ml[(w * 32 + r) * 2 + 1] * ex2(ml[(w * 32 + r) * 2] - ms);
    const float sc = ex2(m - ms) / L;
    LAS float* slot = (LAS float*)(lds + wave * 16384);
#pragma unroll
    for (int vb = 0; vb < 4; ++vb)
#pragma unroll
        for (int i = 0; i < 16; ++i) slot[(32 * vb + crow(i, hh)) * 32 + r] = O[vb][i] * sc;
    __syncthreads();
    { const int q = tid & 31, vg = tid >> 5; float a[8];
#pragma unroll
      for (int e = 0; e < 8; ++e) { float s = 0.f;
#pragma unroll
          for (int w = 0; w < 8; ++w) s += ((const LAS float*)(lds + w * 16384))[(8 * vg + e) * 32 + q];
          a[e] = s; }
      u32x4 o; o.x = pk2(a[0], a[1]); o.y = pk2(a[2], a[3]); o.z = pk2(a[4], a[5]); o.w = pk2(a[6], a[7]);
      *(u32x4*)(OA + (size_t)(row0 + q) * 2048 + h * 128 + 8 * vg) = o; }
    __syncthreads();
}

#define XB_TMO      128
#define XB_XCNT(j)  (256  + 64 * (j))
#define XB_XSUB(j)  (1280 + 64 * (j))
#define XB_XGEN(j)  (2304 + 64 * (j))
#define XB_TOP      3328
#define XB_TOPGEN   3392
#define XCD_BAR_WORDS 3456
#define XB_SPIN_CAP (1u << 18)

__device__ __forceinline__ unsigned xb_ld(unsigned* p)              { return __hip_atomic_load(p, __ATOMIC_RELAXED, __HIP_MEMORY_SCOPE_AGENT); }
__device__ __forceinline__ unsigned xb_add(unsigned* p, unsigned v) { return __hip_atomic_fetch_add(p, v, __ATOMIC_RELAXED, __HIP_MEMORY_SCOPE_AGENT); }
__device__ __forceinline__ unsigned xb_xcc_id() { return (unsigned)__builtin_amdgcn_s_getreg((3 << 11) | 20) & 0xFu; }
#define XB_SPIN(cond, bar) do { unsigned _sp = 0; while (cond) { __builtin_amdgcn_s_sleep(1); \
    if ((++_sp & 255u) == 0u) { if (xb_ld(&(bar)[XB_TMO])) break; if (_sp > XB_SPIN_CAP) { atomicAdd(&(bar)[XB_TMO], 1u); break; } } } } while (0)

struct XcdBarrier {
    unsigned* bar; unsigned x;
    volatile LAS unsigned* st;
};

__device__ __forceinline__ XcdBarrier xcd_barrier_post(unsigned* bar, volatile LAS unsigned* st, bool t0) {
    XcdBarrier b; b.bar = bar; b.x = xb_xcc_id(); b.st = st;
    if (t0) (void)xb_add(&bar[XB_XCNT(b.x)], 1u);
    return b;
}
__device__ __forceinline__ void xcd_barrier_complete(unsigned* bar, unsigned x, unsigned& nloc, unsigned& nx) {
    const unsigned G = gridDim.x * gridDim.y * gridDim.z;
    unsigned sum, cnt, mine, sp = 0u;
    for (;;) {
        sum = 0u; cnt = 0u; mine = 0u;
#pragma unroll
        for (unsigned j = 0; j < 16; ++j) { const unsigned c = xb_ld(&bar[XB_XCNT(j)]); sum += c; cnt += (c > 0u) ? 1u : 0u; mine = (j == x) ? c : mine; }
        if (sum == G) break;
        __builtin_amdgcn_s_sleep(1);
        if ((++sp & 255u) == 0u) { if (xb_ld(&bar[XB_TMO])) break; if (sp > XB_SPIN_CAP) { atomicAdd(&bar[XB_TMO], 1u); break; } }
    }
    nloc = mine > 0u ? mine : 1u; nx = cnt > 0u ? cnt : 1u;
}

__device__ __forceinline__ void xcd_barrier(const XcdBarrier& b, bool t0) {
    asm volatile("s_waitcnt vmcnt(0)" ::: "memory");
    __syncthreads();
    if (t0) {
        unsigned* bar = b.bar;
        __builtin_amdgcn_s_waitcnt(0);
        unsigned nloc = b.st[0], nx = b.st[1];
        if (nloc == 0u) { xcd_barrier_complete(bar, b.x, nloc, nx); b.st[0] = nloc; b.st[1] = nx; }
        const unsigned old = xb_add(&bar[XB_XSUB(b.x)], 1u);
        const unsigned gen = old / nloc;
        if (old + 1u == (gen + 1u) * nloc) {
            __builtin_amdgcn_fence(__ATOMIC_RELEASE, "agent");
            asm volatile("s_waitcnt vmcnt(0)" ::: "memory");
            const unsigned og = xb_add(&bar[XB_TOP], 1u);
            const unsigned tg = og / nx;
            if (og + 1u == (tg + 1u) * nx) xb_add(&bar[XB_TOPGEN], 1u);
            else XB_SPIN(xb_ld(&bar[XB_TOPGEN]) == tg, bar);
            __builtin_amdgcn_fence(__ATOMIC_ACQUIRE, "agent");
            xb_add(&bar[XB_XGEN(b.x)], 1u);
            asm volatile("s_waitcnt vmcnt(0)" ::: "memory");
        } else {
            XB_SPIN(xb_ld(&bar[XB_XGEN(b.x)]) == gen, bar);
            __builtin_amdgcn_fence(__ATOMIC_ACQUIRE, "agent");
            asm volatile("s_waitcnt vmcnt(0)" ::: "memory");
        }
    }
    __syncthreads();
}

constexpr int LDS_BYTES = 147456;
template <class Epi> DI void run_gemm_(LAS unsigned char* lds, const bf16_t* A, const bf16_t* Bt, int M_, int N_, int K_, int G, int c, const Epi& E, int tid) {
    pg8::Gemm g{A, Bt, M_, N_, K_, K_}; pg8::StaticOrder S; S.init(M_, N_, G, c);
    pg8::gemm_phase<Epi, pg8::StaticOrder, true, true>(lds, g, S, E, tid);
}
DI void run_tail_(LAS unsigned char* lds, const bf16_t* A, const bf16_t* Bt, int N_, int K_, int KS, float* slab, int G, int c, int tid) {
    pg8::Gemm g{A, Bt, MTOK, N_, K_, K_ / KS}; pg8::TailOrder S{MP / 256, N_ / 256, KS, K_ / KS, G, c}; pg8::EpiSlab E{slab, N_, K_ / KS};
    pg8::gemm_phase<pg8::EpiSlab, pg8::TailOrder, true, true>(lds, g, S, E, tid);
}

#define run_gemm(...) run_gemm_(__VA_ARGS__, tid)
#define run_tail(...) run_tail_(__VA_ARGS__, tid)
typedef const __attribute__((address_space(4))) Params CParams;
#define PHASE_BEGIN \
    Params P; { CParams* pp_ = (CParams*)__builtin_amdgcn_kernarg_segment_ptr(); asm volatile("" : "+s"(pp_)); _Pragma("unroll") for (int i_ = 0; i_ < 22; ++i_) P.in[i_] = pp_->in[i_]; P.out = pp_->out; P.ws = pp_->ws; } \
    int lane_l; asm volatile("v_mbcnt_lo_u32_b32 %0, -1, 0\n\tv_mbcnt_hi_u32_b32 %0, -1, %0" : "=v"(lane_l)); int wave_l = wave_s; asm volatile("" : "+s"(wave_l)); \
    const int tid = wave_l * 64 + lane_l; int G = gridDim.x, bx = blockIdx.x; asm volatile("" : "+s"(G), "+s"(bx)); \
    const int lane = lane_l, wave = wave_l; \
    const int vcu = (G % 8 == 0) ? (bx % 8) * (G / 8) + bx / 8 : bx;       \
    const int gw = vcu * 8 + wave, NGW = G * 8, gt = bx * 512 + tid, NGT = G * 512; \
    unsigned char* ws = P.ws; (void)lane; (void)gw; (void)NGW; (void)gt; (void)NGT; (void)ws;

__global__ void __launch_bounds__(512, 2) fwd_kernel(Params Pk) {
    extern __shared__ __attribute__((aligned(16))) unsigned char lds_raw[];
    LAS unsigned char* lds = (LAS unsigned char*)lds_raw;
    cg::grid_group grid = cg::this_grid();
    const int wave_s = __builtin_amdgcn_readfirstlane((int)threadIdx.x >> 6);
#ifndef PROBE
#define PROBE 0
#endif
#define GSYNC() do { for (int rs_ = 0; rs_ < ((PROBE & 4) ? 2 : 1); ++rs_) { XcdBarrier xb_ = xbar; asm volatile("" : "+s"(xb_.bar)); int ln_; asm volatile("v_mbcnt_lo_u32_b32 %0, -1, 0\n\tv_mbcnt_hi_u32_b32 %0, -1, %0" : "=v"(ln_)); xcd_barrier(xb_, wave_s == 0 && ln_ == 0); } } while (0)
    const int tid0_ = threadIdx.x;
    if (tid0_ < 64) ((LAS unsigned*)(lds + 131072 + 8192))[tid0_] = 0u;
    __syncthreads();
    XcdBarrier xbar = xcd_barrier_post((unsigned*)(Pk.ws + WS_CTL), (volatile LAS unsigned*)(lds + 131072 + 8192), tid0_ == 0);
    { PHASE_BEGIN
      for (int rep = 0; rep < ((PROBE & 8) ? 2 : 1); ++rep) {
      layer_prep(P, lds, 0, gw, NGW, gt, NGT, lane, wave);
      rope_table(P, gt, NGT);
      init_x(P, gw, NGW, lane); } }
    __threadfence(); grid.sync(); __threadfence();
    for (int l = 0; l < 2; ++l) {
        { PHASE_BEGIN
          pg8::EpiWin E{(float*)(ws + WS_ZS), (bf16_t*)(ws + WS_HQ), (bf16_t*)(ws + WS_HK), (bf16_t*)(ws + WS_HV), (bf16_t*)(ws + WS_HG), (bf16_t*)(ws + WS_GA), (bf16_t*)(ws + WS_GB), (float*)(ws + WS_LF), (const float*)(ws + WS_LB)};
          run_gemm(lds, (const bf16_t*)(ws + WS_XN), (const bf16_t*)(ws + WS_WIN), MTOK, DINP, 2048, G, bx, E); }
        GSYNC();
        { PHASE_BEGIN
          for (int rep = 0; rep < ((PROBE & 8) ? 2 : 1); ++rep) small_norms(P, l, gw, NGW, lane);
          for (int rep = 0; rep < ((PROBE & 2) ? 2 : 1); ++rep)
          for (int u = vcu; u < NU; u += G) hgrn_pass1(lds, (const float*)(ws + WS_LF), (const bf16_t*)(ws + WS_HK), (const bf16_t*)(ws + WS_HV), (bf16_t*)(ws + WS_UT), (float*)(ws + WS_D), u, tid); }
        GSYNC();
        { PHASE_BEGIN
          for (int rep = 0; rep < ((PROBE & 2) ? 2 : 1); ++rep)
          for (int x = vcu; x < 768; x += G) hgrn_pass2(lds, P, l, x, tid); }
        GSYNC();
        { PHASE_BEGIN
          for (int rep = 0; rep < ((PROBE & 2) ? 2 : 1); ++rep)
          for (int u = vcu; u < NU; u += G) hgrn_pass3(lds, (const float*)(ws + WS_LF), (const bf16_t*)(ws + WS_HQ), (const bf16_t*)(ws + WS_HK), (const bf16_t*)(ws + WS_HV), (const bf16_t*)(ws + WS_HG),
                                                       (const bf16_t*)(ws + WS_SPT), P.in[14] + l * 128, (bf16_t*)(ws + WS_OH), u, tid); }
        GSYNC();
        { PHASE_BEGIN
          pg8::EpiQ E{(bf16_t*)(ws + WS_Q), (const float*)(ws + WS_TBL)}; run_gemm(lds, (const bf16_t*)(ws + WS_QN), (const bf16_t*)(ws + WS_WUQ), MTOK, 3072, 512, G, bx, E); }
        { PHASE_BEGIN
          pg8::EpiPlain E{(bf16_t*)(ws + WS_KN), 2048}; run_gemm(lds, (const bf16_t*)(ws + WS_CKV), (const bf16_t*)(ws + WS_WUK), KVR, 2048, 512, G, (bx + 116) % G, E); }
        { PHASE_BEGIN
          pg8::EpiPlain E{(bf16_t*)(ws + WS_VT), KVR}; run_gemm(lds, (const bf16_t*)(ws + WS_WUV), (const bf16_t*)(ws + WS_CKV), 2048, KVR, 512, G, (bx + 100) % G, E); }
        GSYNC();
        { PHASE_BEGIN
          for (int rep = 0; rep < ((PROBE & 1) ? 2 : 1); ++rep) {
          for (int x = vcu; x < 256; x += G) { const int bh = x & 63, grp = x >> 6;
              const int code = grp == 0 ? 0x41 : grp == 1 ? 0x032 : grp == 2 ? 0x1273 : 0x562;
              if (grp < 2) attn_prompt_lds<true>(lds, P, x, 0, wave, lane, tid);
              for (int i = 0; i < (code & 15); ++i) attn_prompt_lds<false>(lds, P, bh, (code >> (4 + 4 * i)) & 15, wave, lane, tid); } } }
        GSYNC();
        { PHASE_BEGIN
          pg8::EpiGate<false> E{(const bf16_t*)(ws + WS_GA), (bf16_t*)(ws + WS_T)}; run_gemm(lds, (const bf16_t*)(ws + WS_OA), (const bf16_t*)(ws + WS_WOA), MP, 2048, 2048, G, bx, E); }
        { PHASE_BEGIN
          run_tail(lds, (const bf16_t*)(ws + WS_OA), (const bf16_t*)(ws + WS_WOA), 2048, 2048, 16, (float*)(ws + WS_SLAB0), G, bx); }
        { PHASE_BEGIN
          pg8::EpiGate<true> E{(const bf16_t*)(ws + WS_GB), (bf16_t*)(ws + WS_T)}; run_gemm(lds, (const bf16_t*)(ws + WS_OH), (const bf16_t*)(ws + WS_WOB), MP, 2048, 2048, G, bx, E); }
        { PHASE_BEGIN
          run_tail(lds, (const bf16_t*)(ws + WS_OH), (const bf16_t*)(ws + WS_WOB), 2048, 2048, 16, (float*)(ws + WS_SLAB1), G, (bx + G / 2) % G); }
        GSYNC();
        { PHASE_BEGIN
          for (int x = vcu; x < 64; x += G) { const int pn = x >> 3, mk = 1 << (x & 7);
              { pg8::EpiGate<false> E{(const bf16_t*)(ws + WS_GA), (bf16_t*)(ws + WS_T)}; pg8::tail_fixup(( const float*)(ws + WS_SLAB0), 16, 2048, MP / 256, pn, mk, E, tid); }
              { pg8::EpiGate<true> E{(const bf16_t*)(ws + WS_GB), (bf16_t*)(ws + WS_T)}; pg8::tail_fixup((const float*)(ws + WS_SLAB1), 16, 2048, MP / 256, pn, mk, E, tid); } } }
        GSYNC();
        for (int repI = 0; repI < ((PROBE & 32) ? 2 : 1); ++repI) {
        { PHASE_BEGIN
          pg8::EpiF32 E{(float*)(ws + WS_MIX), 2048}; run_gemm(lds, (const bf16_t*)(ws + WS_T), (const bf16_t*)(ws + WS_WOUT), MP, 2048, 2048, G, bx, E); }
        { PHASE_BEGIN
          run_tail(lds, (const bf16_t*)(ws + WS_T), (const bf16_t*)(ws + WS_WOUT), 2048, 2048, 16, (float*)(ws + WS_SLAB0), G, bx); }
        GSYNC();
        }
        { PHASE_BEGIN
          resid_norm((const float*)(ws + WS_MIX), P.in[17] + l * 2048, P.out, P.in[18] + l * 2048, (bf16_t*)(ws + WS_XN), gw, NGW, lane);
          resid_norm_tail(lds, (const float*)(ws + WS_SLAB0), 16, P.in[17] + l * 2048, P.out, P.in[18] + l * 2048, (bf16_t*)(ws + WS_XN), vcu, G, wave, lane); }
        GSYNC();
        for (int repK = 0; repK < ((PROBE & 16) ? 2 : 1); ++repK) {
        { PHASE_BEGIN
          pg8::EpiRelu2 E{(bf16_t*)(ws + WS_H), FFN}; run_gemm(lds, (const bf16_t*)(ws + WS_XN), (const bf16_t*)(ws + WS_WUP), MP, FFN, 2048, G, bx, E); }
        { PHASE_BEGIN
          run_tail(lds, (const bf16_t*)(ws + WS_XN), (const bf16_t*)(ws + WS_WUP), FFN, 2048, 4, (float*)(ws + WS_SLAB0), G, bx); }
        GSYNC();
        { PHASE_BEGIN
          for (int x = vcu; x < 256; x += G) { pg8::EpiRelu2 E{(bf16_t*)(ws + WS_H), FFN}; pg8::tail_fixup((const float*)(ws + WS_SLAB0), 4, FFN, MP / 256, x >> 3, 1 << (x & 7), E, tid); } }
        GSYNC();
        }
        { PHASE_BEGIN
          pg8::EpiF32 E{(float*)(ws + WS_M2), 2048}; run_gemm(lds, (const bf16_t*)(ws + WS_H), (const bf16_t*)(ws + WS_WDN), MP, 2048, FFN, G, bx, E); }
        { PHASE_BEGIN
          run_tail(lds, (const bf16_t*)(ws + WS_H), (const bf16_t*)(ws + WS_WDN), 2048, FFN, 16, (float*)(ws + WS_SLAB0), G, bx); }
        GSYNC();
        { PHASE_BEGIN
          resid_norm((const float*)(ws + WS_M2), P.in[21] + l * 2048, P.out, l == 0 ? P.in[5] + 2048 : nullptr, (bf16_t*)(ws + WS_XN), gw, NGW, lane);
          resid_norm_tail(lds, (const float*)(ws + WS_SLAB0), 16, P.in[21] + l * 2048, P.out, l == 0 ? P.in[5] + 2048 : nullptr, (bf16_t*)(ws + WS_XN), vcu, G, wave, lane);
          if (l == 0) for (int rep = 0; rep < ((PROBE & 8) ? 2 : 1); ++rep) layer_prep(P, lds, 1, gw, NGW, gt, NGT, lane, wave); }
        if (l == 0) GSYNC();
    }
}

extern "C" void kernel_launch(void* const* d_in, const int* in_sizes, int n_in, void* d_out, int out_size, void* d_ws, size_t ws_size, hipStream_t stream) {
    static int grid = 0;
    if (grid == 0) {
        if (n_in != 22 || (size_t)out_size != OUT_TOTAL || ws_size < WS_END) { fprintf(stderr, "kernel_launch: unexpected shapes (n_in %d, out %d, ws %zu, need %zu)\n", n_in, out_size, ws_size, (size_t)WS_END); grid = -1; return; }
        int dev = 0, cus = 0, per_cu = 0;
        if (hipGetDevice(&dev) != hipSuccess || hipDeviceGetAttribute(&cus, hipDeviceAttributeMultiprocessorCount, dev) != hipSuccess) { grid = -1; return; }
        if (hipFuncSetAttribute((const void*)fwd_kernel, hipFuncAttributeMaxDynamicSharedMemorySize, LDS_BYTES) != hipSuccess) { fprintf(stderr, "kernel_launch: hipFuncSetAttribute failed\n"); grid = -1; return; }
        if (hipOccupancyMaxActiveBlocksPerMultiprocessor(&per_cu, (const void*)fwd_kernel, 512, LDS_BYTES) != hipSuccess || per_cu < 1) { fprintf(stderr, "kernel_launch: occupancy query failed (%d)\n", per_cu); per_cu = 1; }
        (void)hipGetLastError();
        grid = cus * per_cu;
    }
    if (grid < 0) return;
    if (hipMemsetAsync((char*)d_ws + WS_CTL, 0, 16384, stream) != hipSuccess) { fprintf(stderr, "kernel_launch: memset failed\n"); return; }
    Params p{};
    for (int i = 0; i < 22; ++i) p.in[i] = (const float*)d_in[i];
    p.out = (float*)d_out; p.ws = (unsigned char*)d_ws;
    void* args[] = {&p};
    hipError_t e = hipLaunchCooperativeKernel((const void*)fwd_kernel, dim3(grid), dim3(512), args, LDS_BYTES, stream);
    if (e != hipSuccess) fprintf(stderr, "kernel_launch: cooperative launch failed: %s (grid %d)\n", hipGetErrorString(e), grid);
}
```
